# Optimizing an MI355X kernel written in HIP

```python
import math
import jax, jax.numpy as jnp
from jax import lax
import numpy as np

D_MODEL = 1024
BATCH = 2
SEQ = 8192
DEPTH = 2

GRID_W = 64
CTX_LEN = 256
HEAD_DIM = 64
A_HEADS = 8
A_KV_HEADS = 2
A_GROUP = A_HEADS // A_KV_HEADS
B_HEADS = 4
B_V_DIM = 2 * HEAD_DIM
C_GROUPS = 4
C_GROUP_DIM = 128
N_BRANCH = 3
BRANCH_W = 512
A_Q_W = A_HEADS * HEAD_DIM
A_KV_W = A_KV_HEADS * HEAD_DIM
B_QK_W = B_HEADS * 2 * HEAD_DIM
B_V_W = B_HEADS * B_V_DIM
C_W = C_GROUPS * C_GROUP_DIM
GATE_W = N_BRANCH * D_MODEL
IN_W = A_Q_W + 2 * A_KV_W + 2 * B_QK_W + B_V_W + C_W + GATE_W
D_FF = ((8 * D_MODEL // 3 + 127) // 128) * 128
N_MOD = 9
Q_BLOCK = 128
ROPE_THETA = 10000.0
EPS = 1e-6

kernel_name = "hybrid_gqa_diffattn_fourier_macaron_dit"


def rmsnorm(x, g):
    xf = x.astype(jnp.float32)
    y = xf * lax.rsqrt(jnp.mean(xf * xf, axis=-1, keepdims=True) + EPS)
    return (y * g.astype(jnp.float32)).astype(x.dtype)


def modulate(x, shift, scale):
    return x * (1 + scale[:, None, :]) + shift[:, None, :]


def swiglu(x, wi, wo):
    g, u = jnp.split(x @ wi, 2, axis=-1)
    return (jax.nn.silu(g) * u) @ wo


def ffn_half(h, m, k, g_norm, wi, wo):
    hn = modulate(rmsnorm(h, g_norm), m[3 * k], m[3 * k + 1])
    return h + 0.5 * m[3 * k + 2][:, None, :] * swiglu(hn, wi, wo)


def axial_rope(n_tok):
    rows = n_tok // GRID_W
    row = jnp.repeat(jnp.arange(rows, dtype=jnp.float32), GRID_W)
    col = jnp.tile(jnp.arange(GRID_W, dtype=jnp.float32), rows)
    n_freq = HEAD_DIM // 4
    inv = jnp.power(ROPE_THETA, -jnp.arange(n_freq, dtype=jnp.float32) / n_freq)
    ang = jnp.concatenate([row[:, None] * inv, col[:, None] * inv], axis=-1)
    return jnp.cos(ang), jnp.sin(ang)


def apply_rope(x, cos, sin):
    shp = (1, x.shape[1]) + (1,) * (x.ndim - 3) + (x.shape[-1] // 2,)
    cs = cos.reshape(shp).astype(x.dtype)
    sn = sin.reshape(shp).astype(x.dtype)
    x1, x2 = jnp.split(x, 2, axis=-1)
    return jnp.concatenate([x1 * cs - x2 * sn, x1 * sn + x2 * cs], axis=-1)


def split_projection(z):
    sizes = (A_Q_W, A_KV_W, A_KV_W, B_QK_W, B_QK_W, B_V_W, C_W)
    idx = []
    o = 0
    for s in sizes:
        o += s
        idx.append(o)
    return jnp.split(z, idx, axis=-1)


def project_tokens(hn, w_in, qk_g, cos, sin):
    bn, n = hn.shape[:2]
    qa, ka, va, qb, kb, vb, uc, gl = split_projection(hn @ w_in)
    qa = rmsnorm(qa.reshape(bn, n, A_KV_HEADS, A_GROUP, HEAD_DIM), qk_g[0])
    ka = rmsnorm(ka.reshape(bn, n, A_KV_HEADS, HEAD_DIM), qk_g[1])
    va = va.reshape(bn, n, A_KV_HEADS, HEAD_DIM)
    qb = rmsnorm(qb.reshape(bn, n, B_HEADS, 2, HEAD_DIM), qk_g[2])
    kb = rmsnorm(kb.reshape(bn, n, B_HEADS, 2, HEAD_DIM), qk_g[3])
    vb = vb.reshape(bn, n, B_HEADS, B_V_DIM)
    if cos is not None:
        qa = apply_rope(qa, cos, sin)
        ka = apply_rope(ka, cos, sin)
        qb = apply_rope(qb, cos, sin)
        kb = apply_rope(kb, cos, sin)
    uc = uc.reshape(bn, n, C_GROUPS, C_GROUP_DIM)
    return qa, ka, va, qb, kb, vb, uc, gl


def gqa_attend(q, k, v):
    s = jnp.einsum('bqhgd,bkhd->bhgqk', q.astype(jnp.float32) * HEAD_DIM ** -0.5, k.astype(jnp.float32))
    p = jax.nn.softmax(s, axis=-1)
    return jnp.einsum('bhgqk,bkhd->bqhgd', p.astype(v.dtype), v)


def diff_attend(q, k, v, lam):
    s = jnp.einsum('bqhmd,bkhmd->bhmqk', q.astype(jnp.float32) * HEAD_DIM ** -0.5, k.astype(jnp.float32))
    p = jax.nn.softmax(s, axis=-1)
    p = p[:, :, 0] - lam * p[:, :, 1]
    return jnp.einsum('bhqk,bkhe->bqhe', p.astype(v.dtype), v)


def sweep_query_blocks(fn, q):
    bn, s = q.shape[:2]
    nb = s // Q_BLOCK
    blocks = jnp.moveaxis(q.reshape((bn, nb, Q_BLOCK) + q.shape[2:]), 1, 0)
    out = jnp.moveaxis(lax.map(fn, blocks), 0, 1)
    return out.reshape((bn, s) + out.shape[3:])


def diff_lambda(lp, lam_init):
    lpf = lp.astype(jnp.float32)
    return jnp.exp(jnp.sum(lpf[0] * lpf[1])) - jnp.exp(jnp.sum(lpf[2] * lpf[3])) + lam_init


def fourier_mix(u):
    f = jnp.fft.fft2(u.astype(jnp.float32), axes=(1, 3), norm='ortho')
    return jnp.real(f).astype(u.dtype)


def merge_branches(ya, yb, yc, gl, w_branch, w_out):
    bn, n = ya.shape[:2]
    br = jnp.stack([ya.reshape(bn, n, BRANCH_W), yb.reshape(bn, n, BRANCH_W), yc.reshape(bn, n, BRANCH_W)], axis=2)
    proj = jnp.einsum('bnie,ied->bnid', br, w_branch)
    gates = jax.nn.sigmoid(gl.reshape(bn, n, N_BRANCH, D_MODEL))
    return jnp.sum(gates * proj, axis=2) @ w_out


def setup_inputs(seed: int = 0) -> dict:
    key = jax.random.key(seed)
    ks = jax.random.split(key, 16)
    f32 = jnp.float32
    d = D_MODEL
    x = jax.random.normal(ks[0], (BATCH, SEQ, d), f32)
    c = jax.random.normal(ks[1], (BATCH, d), f32)
    ctx = jax.random.normal(ks[2], (BATCH, CTX_LEN, d), f32)
    c_ctx = jax.random.normal(ks[3], (d,), f32)
    w_ada = jax.random.normal(ks[4], (DEPTH, d, N_MOD * d), f32) * (0.5 * d ** -0.5)
    b_ada = jax.random.normal(ks[5], (DEPTH, N_MOD * d), f32) * 0.02
    norm_g = 1.0 + 0.05 * jax.random.normal(ks[6], (DEPTH, 3, d), f32)
    ffn_wi = jax.random.normal(ks[7], (DEPTH, 2, d, 2 * D_FF), f32) * d ** -0.5
    ffn_wo = jax.random.normal(ks[8], (DEPTH, 2, D_FF, d), f32) * D_FF ** -0.5
    w_in = jax.random.normal(ks[9], (DEPTH, d, IN_W), f32) * d ** -0.5
    qk_g = 1.0 + 0.05 * jax.random.normal(ks[10], (DEPTH, 4, HEAD_DIM), f32)
    diff_lam = 0.1 * jax.random.normal(ks[11], (DEPTH, 4, HEAD_DIM), f32)
    diff_subln_g = 1.0 + 0.05 * jax.random.normal(ks[12], (DEPTH, B_V_DIM), f32)
    w_branch = jax.random.normal(ks[13], (DEPTH, N_BRANCH, BRANCH_W, d), f32) * BRANCH_W ** -0.5
    w_out = jax.random.normal(ks[14], (DEPTH, d, d), f32) * d ** -0.5
    return {"x": x, "c": c, "ctx": ctx, "c_ctx": c_ctx, "w_ada": w_ada, "b_ada": b_ada,
            "norm_g": norm_g, "ffn_wi": ffn_wi, "ffn_wo": ffn_wo, "w_in": w_in, "qk_g": qk_g,
            "diff_lam": diff_lam, "diff_subln_g": diff_subln_g, "w_branch": w_branch, "w_out": w_out}


def reference(x, c, ctx, c_ctx, w_ada, b_ada, norm_g, ffn_wi, ffn_wo, w_in, qk_g,
              diff_lam, diff_subln_g, w_branch, w_out):
    cos, sin = axial_rope(x.shape[1])
    h, hc = x, ctx
    for l in range(DEPTH):
        last = l == DEPTH - 1
        ml = jnp.split(jax.nn.silu(c) @ w_ada[l] + b_ada[l], N_MOD, axis=-1)
        mc = jnp.split(jax.nn.silu(c_ctx)[None] @ w_ada[l] + b_ada[l], N_MOD, axis=-1)

        h = ffn_half(h, ml, 0, norm_g[l, 0], ffn_wi[l, 0], ffn_wo[l, 0])
        hc = ffn_half(hc, mc, 0, norm_g[l, 0], ffn_wi[l, 0], ffn_wo[l, 0])

        hn = modulate(rmsnorm(h, norm_g[l, 1]), ml[3], ml[4])
        hcn = modulate(rmsnorm(hc, norm_g[l, 1]), mc[3], mc[4])
        qa, ka, va, qb, kb, vb, uc, gl = project_tokens(hn, w_in[l], qk_g[l], cos, sin)
        qa_c, ka_c, va_c, qb_c, kb_c, vb_c, uc_c, gl_c = project_tokens(hcn, w_in[l], qk_g[l], None, None)
        lam_init = 0.8 - 0.6 * math.exp(-0.3 * l)
        lam = diff_lambda(diff_lam[l], lam_init)

        ka_all = jnp.concatenate([ka_c, ka], axis=1)
        va_all = jnp.concatenate([va_c, va], axis=1)
        kb_all = jnp.concatenate([kb_c, kb], axis=1)
        vb_all = jnp.concatenate([vb_c, vb], axis=1)
        ya = sweep_query_blocks(lambda qblk: gqa_attend(qblk, ka_all, va_all), qa)
        yb = sweep_query_blocks(lambda qblk: diff_attend(qblk, kb_all, vb_all, lam), qb)
        yb = rmsnorm(yb, diff_subln_g[l]) * (1.0 - lam_init)
        yc = fourier_mix(uc)
        h = h + ml[5][:, None, :] * merge_branches(ya, yb, yc, gl, w_branch[l], w_out[l])

        if not last:
            ya_c = gqa_attend(qa_c, ka_c, va_c)
            yb_c = rmsnorm(diff_attend(qb_c, kb_c, vb_c, lam), diff_subln_g[l]) * (1.0 - lam_init)
            yc_c = fourier_mix(uc_c)
            hc = hc + mc[5][:, None, :] * merge_branches(ya_c, yb_c, yc_c, gl_c, w_branch[l], w_out[l])

        h = ffn_half(h, ml, 2, norm_g[l, 2], ffn_wi[l, 1], ffn_wo[l, 1])
        if not last:
            hc = ffn_half(hc, mc, 2, norm_g[l, 2], ffn_wi[l, 1], ffn_wo[l, 1])
    return h
```

```cpp
#include <hip/hip_runtime.h>
#include <hip/hip_cooperative_groups.h>
#include <hip/hip_bf16.h>
#include <cstdio>
#include <cstdint>
#include <cmath>
namespace cg = cooperative_groups;

namespace pg8 {
#define PG8_LAS __attribute__((address_space(3)))
typedef unsigned short bf16_t;
typedef short bf16x8 __attribute__((ext_vector_type(8)));
typedef float f32x4 __attribute__((ext_vector_type(4)));
typedef unsigned u32x4 __attribute__((ext_vector_type(4)));
constexpr int BM = 256, BK = 64, HALF = 128, HTB = HALF * BK * 2  , STAGE_BYTES = 8 * HTB, NXCD = 8, WGM = 8;

__host__ __device__ __forceinline__ int lds_byte(int r, int c) { const int st = (r >> 4) * 2 + (c >> 5), rr = r & 15, cc = c & 31, ob = rr * 64 + cc * 2; return st * 1024 + (ob ^ (((ob >> 9) & 1) << 5)); }
__host__ __device__ __forceinline__ void stage_rc(int b, int& R, int& C) { const int st = b / 1024, sb = b % 1024, swz = sb ^ (((sb >> 9) & 1) << 5); R = (st >> 1) * 16 + swz / 64; C = (st & 1) * 32 + (swz % 64) / 2; }
__host__ __device__ __forceinline__ int perm32(int rho) { const int n = rho >> 4, i = rho & 15; return 8 * (i >> 2) + 4 * n + (i & 3); }

struct Unit { int pm, pn; };
struct Gemm { const bf16_t* A; const bf16_t* Bt; int M, N, K, lda, ldb; };

struct StaticOrder {
    int nM, nN, nwg, G, c;
    __host__ __device__ void init(int M, int N, int G_, int c_) { nM = M / BM; nN = N / BM; nwg = nM * nN; G = G_; c = c_; }
    __host__ __device__ bool next(int i, Unit& u) const {
        const long L = (long)i * G + c; if (L >= nwg) return false;
        int wgid = (int)L; { const int q = nwg / NXCD, r = nwg % NXCD, xcd = wgid % NXCD, off = wgid / NXCD; wgid = (xcd < r ? xcd * (q + 1) : r * (q + 1) + (xcd - r) * q) + off; }
        const int nig = WGM * nN, gid = wgid / nig, fm = gid * WGM, gsz = (nM - fm) < WGM ? (nM - fm) : WGM;
        u.pm = fm + ((wgid % nig) % gsz); u.pn = (wgid % nig) / gsz; return true;
    }
    __device__ __forceinline__ void a_ready(const Unit&) const {}
    __device__ __forceinline__ void done(const Unit&) const {}
    __device__ __forceinline__ size_t aoff(const Unit&) const { return 0; }
    __device__ __forceinline__ size_t boff(const Unit&) const { return 0; }
};


__device__ __forceinline__ unsigned cvt_pk_bf16(float lo, float hi) { unsigned r; asm volatile("v_cvt_pk_bf16_f32 %0, %1, %2" : "=v"(r) : "v"(lo), "v"(hi)); return r; }
typedef float f32x2 __attribute__((ext_vector_type(2)));

template <class Epi, class Sched, bool ALIGN_EPI = false, bool SP2 = false>
__device__ __forceinline__ void gemm_phase(PG8_LAS unsigned char* lds, const Gemm g, const Sched& S, const Epi& E) {
    int tid_ = threadIdx.x; asm volatile("" : "+v"(tid_)); const int tid = tid_, wid = __builtin_amdgcn_readfirstlane(tid >> 6), lane = tid & 63, wr = wid >> 2, wc = wid & 3, fr = lane & 15, fq = lane >> 4;
    const int K = g.K, nt = K / BK;
    unsigned voffA[2], voffB[2];
#pragma unroll
    for (int i = 0; i < 2; ++i) { int R, C; stage_rc(tid * 16 + i * 8192, R, C); const int Rb = Epi::PERM ? ((R & ~31) + perm32(R & 31)) : R;
        voffA[i] = (unsigned)(R * g.lda + C) * 2u; voffB[i] = (unsigned)(Rb * g.ldb + C) * 2u; }
    const size_t kstep = (size_t)(BK * 2);
    const size_t hstepA = (size_t)HALF * g.lda * 2, hstepB = (size_t)HALF * g.ldb * 2;
    const size_t tstepA = 2 * hstepA, tstepB = 2 * hstepB;
    const unsigned ldsw = (unsigned)wid * 1024u;
    const int aoff = lds_byte(wr * 64 + fr, fq * 8), boff = lds_byte(wc * 32 + fr, fq * 8);
#define PG8_SA(b, h) (((b) * 2 + (h)) * HTB)
#define PG8_SB(b, h) ((4 + (b) * 2 + (h)) * HTB)
#define PG8_STAGE(bufoff, gbase, voff) do { _Pragma("unroll") for (int _i = 0; _i < 2; ++_i) \
        __builtin_amdgcn_global_load_lds((const unsigned*)((const char*)(gbase) + (voff)[_i]), (PG8_LAS unsigned*)(lds + (bufoff) + ldsw + _i * 8192), 16, 0, 0); } while (0)
#define PG8_LDA(dst, b, h) do { _Pragma("unroll") for (int m = 0; m < 4; ++m) _Pragma("unroll") for (int k = 0; k < 2; ++k) dst[m][k] = *(const PG8_LAS bf16x8*)(lds + PG8_SA(b, h) + aoff + m * 2048 + k * 1024); } while (0)
#define PG8_LDB(dst, b, h) do { _Pragma("unroll") for (int n = 0; n < 2; ++n) _Pragma("unroll") for (int k = 0; k < 2; ++k) dst[n][k] = *(const PG8_LAS bf16x8*)(lds + PG8_SB(b, h) + boff + n * 2048 + k * 1024); } while (0)
#define PG8_MMA(ai, bj, At, Bt) do { __builtin_amdgcn_s_setprio(1); _Pragma("unroll") for (int m = 0; m < 4; ++m) _Pragma("unroll") for (int n = 0; n < 2; ++n) _Pragma("unroll") for (int k = 0; k < 2; ++k) \
        acc[ai][bj][m][n] = __builtin_amdgcn_mfma_f32_16x16x32_bf16(Bt[n][k], At[m][k], acc[ai][bj][m][n], 0, 0, 0); __builtin_amdgcn_s_setprio(0); } while (0)
#define PG8_WAIT_V(n) asm volatile("s_waitcnt vmcnt(" #n ")" ::: "memory")
#define PG8_WAIT_L(n) asm volatile("s_waitcnt lgkmcnt(" #n ")" ::: "memory")
#define PG8_BAR __builtin_amdgcn_s_barrier()
#define PG8_SCHED __builtin_amdgcn_sched_barrier(0)
    Unit cur, nxt; int ui = 0;
    if (!S.next(0, cur)) return;
    f32x4 acc[2][2][4][2];
#pragma unroll
    for (int a = 0; a < 2; ++a)
#pragma unroll
        for (int b = 0; b < 2; ++b)
#pragma unroll
            for (int m = 0; m < 4; ++m)
#pragma unroll
                for (int n = 0; n < 2; ++n) acc[a][b][m][n] = (f32x4){0.f, 0.f, 0.f, 0.f};
    bf16x8 At[4][2], B0[2][2], B1[2][2];
    const char* cA = (const char*)g.A + (size_t)cur.pm * tstepA + S.aoff(cur); const char* cB = (const char*)g.Bt + (size_t)cur.pn * tstepB + S.boff(cur);
    S.a_ready(cur);
    if constexpr (SP2) {
        PG8_STAGE(PG8_SB(0, 0), cB, voffB); PG8_STAGE(PG8_SB(0, 1), cB + hstepB, voffB); PG8_STAGE(PG8_SA(0, 0), cA, voffA); PG8_STAGE(PG8_SA(0, 1), cA + hstepA, voffA);
        if (wr == 1) PG8_BAR;
        PG8_WAIT_V(2); PG8_BAR;
        PG8_STAGE(PG8_SB(1, 0), cB + kstep, voffB); PG8_STAGE(PG8_SA(1, 0), cA + kstep, voffA); PG8_STAGE(PG8_SB(1, 1), cB + hstepB + kstep, voffB);
        PG8_WAIT_V(6); PG8_BAR;
    } else {
        PG8_STAGE(PG8_SB(0, 0), cB, voffB); PG8_STAGE(PG8_SA(0, 0), cA, voffA); PG8_STAGE(PG8_SB(0, 1), cB + hstepB, voffB); PG8_STAGE(PG8_SA(0, 1), cA + hstepA, voffA);
        if (wr == 1) PG8_BAR;
        PG8_WAIT_V(4); PG8_BAR;
        PG8_STAGE(PG8_SB(1, 0), cB + kstep, voffB); PG8_STAGE(PG8_SA(1, 0), cA + kstep, voffA); PG8_STAGE(PG8_SB(1, 1), cB + hstepB + kstep, voffB);
        PG8_WAIT_V(6); PG8_BAR;
    }
    for (;;) {
        const bool has_next = S.next(ui + 1, nxt);
        const char* nA = has_next ? (const char*)g.A + (size_t)nxt.pm * tstepA + S.aoff(nxt) : cA; const char* nB = has_next ? (const char*)g.Bt + (size_t)nxt.pn * tstepB + S.boff(nxt) : cB;
        for (int t = 0; t < nt; t += 2) {
            const bool last = (t == nt - 2);
            const char* a1 = cA + (size_t)(t + 1) * kstep;
            const char* a2 = last ? nA : cA + (size_t)(t + 2) * kstep; const char* b2 = last ? nB : cB + (size_t)(t + 2) * kstep;
            const char* a3 = a2 + kstep; const char* b3 = b2 + kstep;
            if (last && has_next) S.a_ready(nxt);
            if constexpr (SP2) {
            PG8_LDB(B0, 0, 0); PG8_LDB(B1, 0, 1); PG8_SCHED; PG8_LDA(At, 0, 0); PG8_STAGE(PG8_SA(1, 1), a1 + hstepA, voffA);
            PG8_WAIT_V(8); PG8_WAIT_L(0); PG8_BAR; PG8_MMA(0, 0, At, B0); PG8_MMA(0, 1, At, B1); PG8_BAR; PG8_SCHED;
            PG8_LDA(At, 0, 1); PG8_STAGE(PG8_SB(0, 0), b2, voffB); PG8_STAGE(PG8_SB(0, 1), b2 + hstepB, voffB); PG8_STAGE(PG8_SA(0, 0), a2, voffA);
            PG8_WAIT_V(8); PG8_WAIT_L(0); PG8_BAR; PG8_MMA(1, 0, At, B0); PG8_MMA(1, 1, At, B1); PG8_BAR; PG8_SCHED;
            PG8_LDB(B0, 1, 0); PG8_LDB(B1, 1, 1); PG8_SCHED; PG8_LDA(At, 1, 0); PG8_STAGE(PG8_SA(0, 1), a2 + hstepA, voffA);
            PG8_WAIT_V(8); PG8_WAIT_L(0); PG8_BAR; PG8_MMA(0, 0, At, B0); PG8_MMA(0, 1, At, B1); PG8_BAR; PG8_SCHED;
            PG8_LDA(At, 1, 1); PG8_STAGE(PG8_SB(1, 0), b3, voffB); PG8_STAGE(PG8_SB(1, 1), b3 + hstepB, voffB); PG8_STAGE(PG8_SA(1, 0), a3, voffA);
            PG8_WAIT_V(8); PG8_WAIT_L(0); PG8_BAR; PG8_MMA(1, 0, At, B0); PG8_MMA(1, 1, At, B1); PG8_BAR; PG8_SCHED;
            } else {
            PG8_LDB(B0, 0, 0); PG8_SCHED; PG8_LDA(At, 0, 0); PG8_STAGE(PG8_SA(1, 1), a1 + hstepA, voffA);
            PG8_WAIT_L(8); PG8_BAR; PG8_WAIT_L(0); PG8_MMA(0, 0, At, B0); PG8_BAR; PG8_SCHED;
            PG8_LDB(B1, 0, 1); PG8_STAGE(PG8_SB(0, 0), b2, voffB);
            PG8_BAR; PG8_WAIT_L(0); PG8_MMA(0, 1, At, B1); PG8_BAR;
            PG8_LDA(At, 0, 1); PG8_STAGE(PG8_SA(0, 0), a2, voffA);
            PG8_BAR; PG8_WAIT_L(0); PG8_MMA(1, 0, At, B0); PG8_BAR; PG8_SCHED;
            PG8_STAGE(PG8_SB(0, 1), b2 + hstepB, voffB);
            PG8_WAIT_V(6); PG8_BAR; PG8_MMA(1, 1, At, B1); PG8_BAR;
            PG8_LDB(B0, 1, 0); PG8_SCHED; PG8_LDA(At, 1, 0); PG8_STAGE(PG8_SA(0, 1), a2 + hstepA, voffA);
            PG8_WAIT_L(8); PG8_BAR; PG8_WAIT_L(0); PG8_MMA(0, 0, At, B0); PG8_BAR; PG8_SCHED;
            PG8_LDB(B1, 1, 1); PG8_STAGE(PG8_SB(1, 0), b3, voffB);
            PG8_BAR; PG8_WAIT_L(0); PG8_MMA(0, 1, At, B1); PG8_BAR;
            PG8_LDA(At, 1, 1); PG8_STAGE(PG8_SA(1, 0), a3, voffA);
            PG8_BAR; PG8_WAIT_L(0); PG8_MMA(1, 0, At, B0); PG8_BAR; PG8_SCHED;
            PG8_STAGE(PG8_SB(1, 1), b3 + hstepB, voffB);
            PG8_WAIT_V(6); PG8_BAR; PG8_MMA(1, 1, At, B1); PG8_BAR;
            }
        }
        if constexpr (ALIGN_EPI) { if (wr == 0) PG8_BAR; }
        if constexpr (!Epi::AFTER_DRAIN) { E(acc, cur, wr, wc, fr, fq); S.done(cur); }
        if (!has_next) break;
#pragma unroll
        for (int a = 0; a < 2; ++a)
#pragma unroll
            for (int b = 0; b < 2; ++b)
#pragma unroll
                for (int m = 0; m < 4; ++m)
#pragma unroll
                    for (int n = 0; n < 2; ++n) acc[a][b][m][n] = (f32x4){0.f, 0.f, 0.f, 0.f};
        cur = nxt; cA = nA; cB = nB; ++ui;
        if constexpr (ALIGN_EPI) { if (wr == 1) PG8_BAR; }
    }
    PG8_WAIT_V(0);
    if constexpr (!ALIGN_EPI) { if (wr == 0) PG8_BAR; }
    PG8_BAR;
    if constexpr (Epi::AFTER_DRAIN) { E.fused(acc, cur, wr, wc, fr, fq, lds, wid, lane); S.done(cur); }
#undef PG8_SA
#undef PG8_SB
#undef PG8_STAGE
#undef PG8_LDA
#undef PG8_LDB
#undef PG8_MMA
#undef PG8_WAIT_V
#undef PG8_WAIT_L
#undef PG8_BAR
#undef PG8_SCHED
}
}


namespace attn_body {
using bf16=__hip_bfloat16;
using bf16x8=__attribute__((ext_vector_type(8)))short;
using s16x4=__attribute__((ext_vector_type(4)))short;
using f32x16=__attribute__((ext_vector_type(16)))float;
using u32x4=__attribute__((ext_vector_type(4)))unsigned;
constexpr int D=64;
constexpr int NW=8,QBLK=32,QB=QBLK*NW,KVBLK=64;
constexpr int ATTN_UNIT_ROWS=QB;
__device__ __forceinline__ int crow(int r,int hi){return (r&3)+8*(r>>2)+4*hi;}
#define SBAR() __builtin_amdgcn_sched_barrier(0)
constexpr int NSLOT=3, SLOTB=8192;
constexpr int LDS_K=0, LDS_V=NSLOT*SLOTB, LDS_WS=2*NSLOT*SLOTB, LDS_OST=LDS_WS+NW*64*4, LDS_BYTES=LDS_OST+NW*4096;
constexpr float C2=0.125f*1.4426950408889634f;
__device__ __forceinline__ void glds16(const void*gsrc,unsigned lds_dst){unsigned keep;
  asm volatile("s_mov_b32 %0, m0\n\ts_mov_b32 m0, %2\n\ts_nop 0\n\tglobal_load_lds_dwordx4 %1, off\n\ts_mov_b32 m0, %0":"=&s"(keep):"v"(gsrc),"s"(lds_dst):"memory");}
__device__ __forceinline__ float max3f(float a,float b,float c){float r;asm("v_max3_f32 %0, %1, %2, %3":"=v"(r):"v"(a),"v"(b),"v"(c));return r;}
__device__ __forceinline__ float max2f(float a,float b){float r;asm("v_max_f32_e32 %0, %1, %2":"=v"(r):"v"(a),"v"(b));return r;}
__device__ __forceinline__ float fadd_s(float a,float b){float r;asm("v_add_f32_e32 %0, %1, %2":"=v"(r):"v"(a),"v"(b));return r;}
__device__ __forceinline__ float fsub_s(float a,float b){float r;asm("v_sub_f32_e32 %0, %1, %2":"=v"(r):"v"(a),"v"(b));return r;}
typedef float f32x2_t __attribute__((ext_vector_type(2))); typedef __bf16 bf16x2_t __attribute__((ext_vector_type(2)));
__device__ __forceinline__ unsigned cvtpk_s(float lo,float hi){f32x2_t v={lo,hi};bf16x2_t b=__builtin_convertvector(v,bf16x2_t);return __builtin_bit_cast(unsigned,b);}
#define WAIT_BAR(N) asm volatile("s_waitcnt vmcnt(" #N ") lgkmcnt(0)\n\ts_barrier":::"memory")

__device__ __forceinline__ void qkt(f32x16&p0,f32x16&p1,const char*Kslot,const bf16x8*qr,const f32x16&negm,int r32,int hi){
  const char*kb=Kslot+hi*1024+r32*16;
  #pragma unroll
  for(int d0=0;d0<4;++d0){
    const bf16x8 b0=*reinterpret_cast<const bf16x8*>(kb+d0*2048);
    const bf16x8 b1=*reinterpret_cast<const bf16x8*>(kb+d0*2048+512);
    if(d0==0){p0=__builtin_amdgcn_mfma_f32_32x32x16_bf16(b0,qr[0],negm,0,0,0);p1=__builtin_amdgcn_mfma_f32_32x32x16_bf16(b1,qr[0],negm,0,0,0);}
    else{p0=__builtin_amdgcn_mfma_f32_32x32x16_bf16(b0,qr[d0],p0,0,0,0);p1=__builtin_amdgcn_mfma_f32_32x32x16_bf16(b1,qr[d0],p1,0,0,0);}}
}
typedef __attribute__((address_space(3))) const char* lds_cptr;
typedef short v4i16_t __attribute__((ext_vector_type(4)));
__device__ __forceinline__ void kload8(bf16x8*kf,lds_cptr kp){
  kf[0]=*(const __attribute__((address_space(3))) bf16x8*)(kp);      kf[1]=*(const __attribute__((address_space(3))) bf16x8*)(kp+512);
  kf[2]=*(const __attribute__((address_space(3))) bf16x8*)(kp+2048); kf[3]=*(const __attribute__((address_space(3))) bf16x8*)(kp+2560);
  kf[4]=*(const __attribute__((address_space(3))) bf16x8*)(kp+4096); kf[5]=*(const __attribute__((address_space(3))) bf16x8*)(kp+4608);
  kf[6]=*(const __attribute__((address_space(3))) bf16x8*)(kp+6144); kf[7]=*(const __attribute__((address_space(3))) bf16x8*)(kp+6656);
}
__device__ __forceinline__ void kload2(bf16x8*kf,lds_cptr kp,int j){ kf[2*j]=*(const __attribute__((address_space(3))) bf16x8*)(kp+j*2048); kf[2*j+1]=*(const __attribute__((address_space(3))) bf16x8*)(kp+j*2048+512); }
__device__ __forceinline__ s16x4 vtr(lds_cptr p){ return __builtin_bit_cast(s16x4,__builtin_amdgcn_ds_read_tr16_b64_v4i16((__attribute__((address_space(3))) v4i16_t*)p)); }
__device__ __forceinline__ float rowmax(const f32x16&p0,const f32x16&p1){
  float a=max3f(p0[0],p0[1],p1[0]),b=max3f(p0[2],p0[3],p1[1]);a=max3f(a,p1[2],p1[3]);
  #pragma unroll
  for(int r=4;r<16;r+=4){a=max3f(a,p0[r],p0[r+1]);b=max3f(b,p0[r+2],p0[r+3]);a=max3f(a,p1[r],p1[r+1]);b=max3f(b,p1[r+2],p1[r+3]);}
  const float m=max2f(a,b);
  auto rr=__builtin_amdgcn_permlane32_swap(__float_as_uint(m),__float_as_uint(m),false,false);
  return max2f(__uint_as_float(rr[0]),__uint_as_float(rr[1]));
}
__device__ __forceinline__ void pv(f32x16*o,int vb,bf16x8 pa0,bf16x8 pa1,bf16x8 pa2,bf16x8 pa3){
  #pragma unroll
  for(int d0=0;d0<2;++d0){s16x4 lo[4],hi[4];
    #pragma unroll
    for(int ks=0;ks<4;++ks){
      asm volatile("ds_read_b64_tr_b16 %0,%1 offset:%c2":"=&v"(lo[ks]):"v"(vb),"i"(d0*4096+ks*1024):"memory");
      asm volatile("ds_read_b64_tr_b16 %0,%1 offset:%c2":"=&v"(hi[ks]):"v"(vb),"i"(d0*4096+ks*1024+512):"memory");}
    asm volatile("s_waitcnt lgkmcnt(0)":::"memory");SBAR();
    #define PK(k) (bf16x8){lo[k][0],lo[k][1],lo[k][2],lo[k][3],hi[k][0],hi[k][1],hi[k][2],hi[k][3]}
    o[d0]=__builtin_amdgcn_mfma_f32_32x32x16_bf16(pa0,PK(0),o[d0],0,0,0);
    o[d0]=__builtin_amdgcn_mfma_f32_32x32x16_bf16(pa1,PK(1),o[d0],0,0,0);
    o[d0]=__builtin_amdgcn_mfma_f32_32x32x16_bf16(pa2,PK(2),o[d0],0,0,0);
    o[d0]=__builtin_amdgcn_mfma_f32_32x32x16_bf16(pa3,PK(3),o[d0],0,0,0);
    #undef PK
  }
}

#ifndef ATTN_STORE16
#define ATTN_STORE16(p,v) (*(u32x4*)(p)=(v))
#endif
template<int THRL> __device__ __forceinline__ void attn_unit(const bf16*Q0,int ldq,const bf16*__restrict__ Kh,int ldk,const bf16*__restrict__ Vh,int ldv,bf16*O0,int ldo,int NT,char*shm){
  int tid_=threadIdx.x; asm volatile("":"+v"(tid_)); const int tid=tid_,lane=tid&63,r32=lane&31,hi=lane>>5; const int wid=__builtin_amdgcn_readfirstlane(tid>>6);
  const bf16*Qw=Q0+(long)(wid*QBLK)*ldq;
  const unsigned lds0=(unsigned)(uintptr_t)shm;
  float*wsf=(float*)(shm+LDS_WS)+wid*64;
  const bf16*ksrc=Kh+(long)lane*ldk+wid*8;
  const bf16*vsrc=Vh+(long)(16*(wid&3)+(lane>>2))*ldv+(wid>>2)*32+(lane&3)*8;
  const unsigned kdst=lds0+LDS_K+wid*1024, vdst=lds0+LDS_V+wid*1024;
  #define DMA_K(t,slot) glds16(ksrc+(long)(t)*KVBLK*ldk,(unsigned)__builtin_amdgcn_readfirstlane(kdst+(slot)))
  #define DMA_V(t,slot) glds16(vsrc+(long)(t)*KVBLK*ldv,(unsigned)__builtin_amdgcn_readfirstlane(vdst+(slot)))
  const int vb0=(int)(lds0+LDS_V)+((lane>>4)&1)*32+(lane&3)*8+(4*hi+((lane&15)>>2))*64;
  const char*Kbase=shm+LDS_K; bf16x8 kf[8];
  const lds_cptr shm3=(lds_cptr)shm; const lds_cptr kp0=shm3+LDS_K+hi*1024+r32*16; const lds_cptr vp0=shm3+LDS_V+((lane>>4)&1)*32+(lane&3)*8+(4*hi+((lane&15)>>2))*64;
  DMA_K(0,0);DMA_V(0,0);DMA_K(1,SLOTB);
  bf16x8 qr[4];
  #pragma unroll
  for(int d0=0;d0<4;++d0)qr[d0]=*reinterpret_cast<const bf16x8*>(&Qw[(long)r32*ldq+d0*16+hi*8]);
  float mhat=0.f,l_reg=0.f;f32x16 o[2];o[0]=f32x16{};o[1]=f32x16{};f32x16 negm=f32x16{};asm volatile("":"+v"(negm));
  #define CMASK(P0,P1,t) do{}while(0)
  bool resc=false;
  #define START(P0,P1) do{ const float rm=rowmax(P0,P1); resc=false; \
    { const float dl=rm; mhat=fadd_s(mhat,dl); \
      _Pragma("unroll") for(int r=0;r<16;++r){P0[r]=fsub_s(P0[r],dl);P1[r]=fsub_s(P1[r],dl);} \
      _Pragma("unroll") for(int r=0;r<16;++r)negm[r]=-mhat; asm volatile("":"+v"(negm)); } \
    _Pragma("unroll") for(int r=0;r<16;++r)P0[r]=__builtin_amdgcn_exp2f(P0[r]); }while(0)
  #define RESC() do{ if(resc){ asm volatile("s_waitcnt lgkmcnt(0)":::"memory"); \
      _Pragma("unroll") for(int d_=0;d_<2;++d_) _Pragma("unroll") for(int r=0;r<16;++r)o[d_][r]*=wsf[crow(r,hi)]; } }while(0)
  f32x16 pA0,pA1,pB0,pB1;
  int sl_prev=0,sl_cur=0,sl_next=SLOTB;
  #define ROT() do{sl_prev=sl_cur;sl_cur=sl_next;sl_next=(sl_next==(NSLOT-1)*SLOTB)?0:sl_next+SLOTB;}while(0)
  DMA_K(2,2*SLOTB);
  WAIT_BAR(3);
  qkt(pA0,pA1,Kbase,qr,negm,r32,hi);asm volatile("s_nop 15\n\ts_nop 7":"+v"(pA0),"+v"(pA1));CMASK(pA0,pA1,0);
  START(pA0,pA1);
  _Pragma("unroll") for(int r=0;r<16;++r)pA1[r]=__builtin_amdgcn_exp2f(pA1[r]);
  WAIT_BAR(0);
  DMA_K(3,0);DMA_V(1,SLOTB);
  ROT();
  kload8(kf,kp0+sl_cur);
  WAIT_BAR(2);
  s16x4 vlo[8],vhi[8]; u32x4 pw0,pw1,pw2,pw3;
  #define PKW(P,B) cvtpk_s(P[B],P[B+1])
  #define PAF(k) __builtin_bit_cast(bf16x8,pw##k)
  #define VFR(i) (bf16x8){vlo[i][0],vlo[i][1],vlo[i][2],vlo[i][3],vhi[i][0],vhi[i][1],vhi[i][2],vhi[i][3]}
  #define PIN(x) asm volatile("":"+v"(x))
  #define MX3(a,b,c) __builtin_fmaxf(__builtin_fmaxf((a),(b)),(c))
  #define GAPA(MF,A0,A1,A2,A3,W0,W1,PW) do{ MF; sacc+=A0; sacc+=A1; sacc+=A2; sacc+=A3; PIN(sacc); W0; W1; PIN(PW); SBAR(); }while(0)
  #define EX(v) __builtin_amdgcn_exp2f(v)
  #define GAPB(MF,X,B) do{ MF; X[B]=EX(X[B]); X[B+1]=EX(X[B+1]); X[B+2]=EX(X[B+2]); X[B+3]=EX(X[B+3]); PIN(X); SBAR(); }while(0)
  #define VRD(i) do{ vlo[i]=vtr(vp_+(((i)>>2)*4096+((i)&3)*1024)); vhi[i]=vtr(vp_+(((i)>>2)*4096+((i)&3)*1024+512)); }while(0)
  #define KRD(G,j) do{ if(G){ kload2(kf,kp0+sl_next,j); SBAR(); } }while(0)
  #define STEP(C0,C1,P0,P1,t,GK,GV,GL) do{ SBAR(); \
    const lds_cptr vp_=vp0+sl_prev; \
    VRD(0); SBAR(); float sacc=(P0[0]+P0[1]); \
    GAPA(C0=__builtin_amdgcn_mfma_f32_32x32x16_bf16(kf[0],qr[0],negm,0,0,0), P0[2],P0[3],P0[4],P0[5],     pw0[0]=PKW(P0,0), pw0[1]=PKW(P0,2), pw0); \
    VRD(4); SBAR(); GAPA(C1=__builtin_amdgcn_mfma_f32_32x32x16_bf16(kf[1],qr[0],negm,0,0,0), P0[6],P0[7],P0[8],P0[9],     pw0[2]=PKW(P0,4), pw0[3]=PKW(P0,6), pw0); \
    VRD(1); SBAR(); GAPA(C0=__builtin_amdgcn_mfma_f32_32x32x16_bf16(kf[2],qr[1],C0,0,0,0),   P0[10],P0[11],P0[12],P0[13], pw1[0]=PKW(P0,8), pw1[1]=PKW(P0,10), pw1); \
    VRD(5); SBAR(); GAPA(C1=__builtin_amdgcn_mfma_f32_32x32x16_bf16(kf[3],qr[1],C1,0,0,0),   P0[14],P0[15],P1[0],P1[1],   pw1[2]=PKW(P0,12),pw1[3]=PKW(P0,14), pw1); \
    VRD(2); SBAR(); GAPA(C0=__builtin_amdgcn_mfma_f32_32x32x16_bf16(kf[4],qr[2],C0,0,0,0),   P1[2],P1[3],P1[4],P1[5],     pw2[0]=PKW(P1,0), pw2[1]=PKW(P1,2), pw2); \
    VRD(6); SBAR(); GAPA(C1=__builtin_amdgcn_mfma_f32_32x32x16_bf16(kf[5],qr[2],C1,0,0,0),   P1[6],P1[7],P1[8],P1[9],     pw2[2]=PKW(P1,4), pw2[3]=PKW(P1,6), pw2); \
    VRD(3); SBAR(); GAPA(C0=__builtin_amdgcn_mfma_f32_32x32x16_bf16(kf[6],qr[3],C0,0,0,0),   P1[10],P1[11],P1[12],P1[13], pw3[0]=PKW(P1,8), pw3[1]=PKW(P1,10), pw3); \
    VRD(7); SBAR(); GAPA(C1=__builtin_amdgcn_mfma_f32_32x32x16_bf16(kf[7],qr[3],C1,0,0,0),   P1[14],P1[15],0.f,0.f,       pw3[2]=PKW(P1,12),pw3[3]=PKW(P1,14), pw3); \
    l_reg+=sacc; \
    if(GK){DMA_K((t)+3,sl_cur);} if(GV){DMA_V((t)+1,sl_next);} \
    CMASK(C0,C1,t); \
    { float a=MX3(C0[0],C0[1],C1[0]),b=MX3(C0[2],C0[3],C1[1]); a=MX3(a,C1[2],C1[3]); \
      _Pragma("unroll") for(int r=4;r<16;r+=4){a=MX3(a,C0[r],C0[r+1]);b=MX3(b,C0[r+2],C0[r+3]);a=MX3(a,C1[r],C1[r+1]);b=MX3(b,C1[r+2],C1[r+3]);} \
      float rm=__builtin_fmaxf(a,b); { auto rr=__builtin_amdgcn_permlane32_swap(__float_as_uint(rm),__float_as_uint(rm),false,false); rm=__builtin_fmaxf(__uint_as_float(rr[0]),__uint_as_float(rr[1])); } \
      resc=false; \
      if(__builtin_expect(__any(rm>(float)THRL),0)){ const float dl=__builtin_fmaxf(rm,0.f); mhat+=dl; \
        _Pragma("unroll") for(int r=0;r<16;++r){C0[r]-=dl;C1[r]-=dl;} \
        _Pragma("unroll") for(int r=0;r<16;++r)negm[r]=-mhat; asm volatile("":"+v"(negm)); \
        const float f=__builtin_amdgcn_exp2f(-dl); l_reg*=f; if(hi==0)wsf[r32]=f; resc=true; } } \
    SBAR(); \
    GAPB(o[0]=__builtin_amdgcn_mfma_f32_32x32x16_bf16(PAF(0),VFR(0),o[0],0,0,0), C0,0); \
    GAPB(o[1]=__builtin_amdgcn_mfma_f32_32x32x16_bf16(PAF(0),VFR(4),o[1],0,0,0), C0,4); \
    KRD(GL,0); GAPB(o[0]=__builtin_amdgcn_mfma_f32_32x32x16_bf16(PAF(1),VFR(1),o[0],0,0,0), C0,8); \
    KRD(GL,1); GAPB(o[1]=__builtin_amdgcn_mfma_f32_32x32x16_bf16(PAF(1),VFR(5),o[1],0,0,0), C0,12); \
    KRD(GL,2); GAPB(o[0]=__builtin_amdgcn_mfma_f32_32x32x16_bf16(PAF(2),VFR(2),o[0],0,0,0), C1,0); \
    KRD(GL,3); GAPB(o[1]=__builtin_amdgcn_mfma_f32_32x32x16_bf16(PAF(2),VFR(6),o[1],0,0,0), C1,4); \
    GAPB(o[0]=__builtin_amdgcn_mfma_f32_32x32x16_bf16(PAF(3),VFR(3),o[0],0,0,0), C1,8); \
    GAPB(o[1]=__builtin_amdgcn_mfma_f32_32x32x16_bf16(PAF(3),VFR(7),o[1],0,0,0), C1,12); \
    }while(0)
  int t=1;
  #undef CMASK
  #define CMASK(P0,P1,t) do{}while(0)
  for(;t+5<NT;t+=2){
    STEP(pB0,pB1,pA0,pA1,t,true,true,true);     WAIT_BAR(2); RESC(); ROT();
    STEP(pA0,pA1,pB0,pB1,t+1,true,true,true);   WAIT_BAR(2); RESC(); ROT();
  }
  #undef CMASK
  #define CMASK(P0,P1,t) do{}while(0)
  #define ENDW(tt) do{ if((tt)+3<NT){WAIT_BAR(2);} else if((tt)+2<NT){WAIT_BAR(1);} else {WAIT_BAR(0);} }while(0)
  for(;t+1<NT;t+=2){
    STEP(pB0,pB1,pA0,pA1,t,(t+3<NT),(t+1<NT),(t+1<NT));       ENDW(t);   RESC(); ROT();
    STEP(pA0,pA1,pB0,pB1,t+1,(t+4<NT),(t+2<NT),(t+2<NT));     ENDW(t+1); RESC(); ROT();
  }
  STEP(pB0,pB1,pA0,pA1,NT-1,false,false,false); RESC();
  { float sacc=pB0[0]+pB0[1]; _Pragma("unroll") for(int r=2;r<16;++r)sacc+=pB0[r]; _Pragma("unroll") for(int r=0;r<16;++r)sacc+=pB1[r]; l_reg+=sacc;
    pw0=(u32x4){PKW(pB0,0),PKW(pB0,2),PKW(pB0,4),PKW(pB0,6)};pw1=(u32x4){PKW(pB0,8),PKW(pB0,10),PKW(pB0,12),PKW(pB0,14)};pw2=(u32x4){PKW(pB1,0),PKW(pB1,2),PKW(pB1,4),PKW(pB1,6)};pw3=(u32x4){PKW(pB1,8),PKW(pB1,10),PKW(pB1,12),PKW(pB1,14)};
    SBAR(); pv(o,vb0+sl_cur,PAF(0),PAF(1),PAF(2),PAF(3)); }
  #undef PKW
  #undef PAF
  #undef VFR
  #undef PIN
  #undef MX3
  #undef GAPA
  #undef GAPB
  #undef EX
  #undef VRD
  #undef KRD
  #undef STEP
  #undef ENDW
  {auto rr=__builtin_amdgcn_permlane32_swap(__float_as_uint(l_reg),__float_as_uint(l_reg),false,false);l_reg=__uint_as_float(rr[0])+__uint_as_float(rr[1]);}
  if(hi==0)wsf[32+r32]=l_reg;asm volatile("s_waitcnt lgkmcnt(0)":::"memory");
  float rli[16];
  #pragma unroll
  for(int r=0;r<16;++r)rli[r]=__builtin_amdgcn_rcpf(wsf[32+crow(r,hi)]);
  bf16*Ow=O0+(long)(wid*QBLK)*ldo;
  { bf16*stg=(bf16*)(shm+LDS_OST)+wid*2048;
    #pragma unroll
    for(int r=0;r<16;++r){const int orow=crow(r,hi);
      #pragma unroll
      for(int d0=0;d0<2;++d0)stg[orow*64+d0*32+r32]=__float2bfloat16(o[d0][r]*rli[r]);}
    asm volatile("s_waitcnt lgkmcnt(0)":::"memory");
    #pragma unroll
    for(int i=0;i<4;++i){const int row=i*8+(lane>>3),ch=lane&7; const u32x4 v=*(const u32x4*)(stg+row*64+ch*8); ATTN_STORE16(Ow+(long)row*ldo+ch*8,v);} }
  asm volatile("s_waitcnt lgkmcnt(0)\n\ts_barrier":::"memory");
  #undef DMA_K
  #undef DMA_V
  #undef CMASK
  #undef START
  #undef RESC
  #undef ROT
}
constexpr int ATTN_LDS_BYTES=LDS_BYTES;
#undef SBAR
#undef WAIT_BAR
}


constexpr int NWAVES = 8;
constexpr int DMODEL = 1024, NBATCH = 2, SEQL = 8192, CTXL = 256, RPB = SEQL + CTXL, MROWS = NBATCH * RPB, NLAYER = 2;
constexpr int DFF = 2816, NUP = 2 * DFF, INW = 5888, ZW = 5376, NMODV = 9, MODW = NMODV * DMODEL;
constexpr int ZQA = 0, ZKA = 512, ZVA = 640, ZQB = 768, ZKB = 1280, ZVB = 1792, ZGATE = 2304;
constexpr int TPB = RPB / 256;
constexpr float EPSN = 1e-6f;
constexpr int HN = 4096;

constexpr size_t MiB = 1u << 20, KiB = 1024;
constexpr size_t WS_CTL = 0, CTL_ZERO_BYTES = 64 * KiB;
constexpr size_t WS_MOD = 1 * MiB;
constexpr size_t WS_CAS256 = 1 * MiB + 512 * KiB;
constexpr size_t WS_HC = 2 * MiB;
constexpr size_t WS_WUP0 = 4 * MiB, WS_WDN0 = 15 * MiB, WS_WUP1 = 20 * MiB + 512 * KiB, WS_WDN1 = 31 * MiB + 512 * KiB;
constexpr size_t WS_WIN = 37 * MiB, WS_WC = 47 * MiB + 512 * KiB, WS_WBR = 48 * MiB + 512 * KiB, WS_WOUT = 51 * MiB + 512 * KiB;
constexpr size_t WS_HN = 54 * MiB;
constexpr size_t WS_Z = 87 * MiB;
constexpr size_t WS_T1T = 261 * MiB;
constexpr size_t WS_T2 = 278 * MiB;
constexpr size_t WS_PQ = 295 * MiB;
constexpr size_t WS_CAS = 311 * MiB;
constexpr size_t WS_END = 343 * MiB;
static_assert(WS_Z + (size_t)MROWS * ZW * 2 <= WS_T1T && WS_HN + (size_t)MROWS * DMODEL * 2 <= WS_Z && WS_WOUT + 2 * MiB <= WS_HN, "ws map");
constexpr int CW_Q = 1024;

constexpr int LDS_BYTES = 147456, MISC_OFF = 131072 + 320;

#define GAS __attribute__((address_space(1)))
#define LAS __attribute__((address_space(3)))
typedef unsigned short bf16;
typedef unsigned v4u __attribute__((ext_vector_type(4)));
typedef float f32x4 __attribute__((ext_vector_type(4)));
#define LDS_WAIT() asm volatile("s_waitcnt lgkmcnt(0)" ::: "memory")

__device__ __forceinline__ float bf2f(unsigned v) { return __uint_as_float(v << 16); }
__device__ __forceinline__ float bflo(unsigned w) { return __uint_as_float(w << 16); }
__device__ __forceinline__ float bfhi(unsigned w) { return __uint_as_float(w & 0xffff0000u); }
__device__ __forceinline__ unsigned pk2(float lo, float hi) { return pg8::cvt_pk_bf16(lo, hi); }
__device__ __forceinline__ float fexp(float x) { return __builtin_amdgcn_exp2f(x * 1.4426950408889634f); }
__device__ __forceinline__ float sigm(float x) { return __builtin_amdgcn_rcpf(1.0f + fexp(-x)); }
__device__ __forceinline__ float siluf(float x) { return x * sigm(x); }
__device__ __forceinline__ float wave_sum(float v) {
#pragma unroll
    for (int o = 1; o < 64; o <<= 1) v += __shfl_xor(v, o);
    return v;
}

namespace pg8 {
struct EpiStore {
    static constexpr bool PERM = true, AFTER_DRAIN = false;
    bf16_t* O; int ldc; int sig_from; int rbase, rmul;
    __device__ __forceinline__ void operator()(const f32x4 (&acc)[2][2][4][2], const Unit& u, int wr, int wc, int fr, int fq) const {
        const int row0 = u.pm * BM + wr * 64 + fr, col0 = u.pn * BM + wc * 32 + 8 * fq;
        const bool sg = (u.pn * BM) >= sig_from;
#pragma unroll
        for (int ai = 0; ai < 2; ++ai)
#pragma unroll
            for (int m = 0; m < 4; ++m) { const int row = row0 + ai * HALF + m * 16; bf16_t* rowp = O + (size_t)(rbase + row * rmul) * ldc + col0;
#pragma unroll
                for (int bj = 0; bj < 2; ++bj) { f32x4 v0 = acc[ai][bj][m][0], v1 = acc[ai][bj][m][1];
                    if (sg) { v0[0] = sigm(v0[0]); v0[1] = sigm(v0[1]); v0[2] = sigm(v0[2]); v0[3] = sigm(v0[3]); v1[0] = sigm(v1[0]); v1[1] = sigm(v1[1]); v1[2] = sigm(v1[2]); v1[3] = sigm(v1[3]); }
                    u32x4 w; w.x = cvt_pk_bf16(v0[0], v0[1]); w.y = cvt_pk_bf16(v0[2], v0[3]); w.z = cvt_pk_bf16(v1[0], v1[1]); w.w = cvt_pk_bf16(v1[2], v1[3]);
                    *(u32x4*)(rowp + bj * HALF) = w; } }
    }
};
struct EpiSwiGLU {
    static constexpr bool PERM = true, AFTER_DRAIN = false;
    bf16_t* H; int ldc;
    __device__ __forceinline__ void operator()(const f32x4 (&acc)[2][2][4][2], const Unit& u, int wr, int wc, int fr, int fq) const {
        const int row0 = u.pm * BM + wr * 64 + fr, col0 = u.pn * HALF + wc * 32 + 8 * fq;
#pragma unroll
        for (int ai = 0; ai < 2; ++ai)
#pragma unroll
            for (int m = 0; m < 4; ++m) { const int row = row0 + ai * HALF + m * 16; bf16_t* rowp = H + (size_t)row * ldc + col0;
                const f32x4 g0 = acc[ai][0][m][0], g1 = acc[ai][0][m][1], u0 = acc[ai][1][m][0], u1 = acc[ai][1][m][1];
                u32x4 w; w.x = cvt_pk_bf16(siluf(g0[0]) * u0[0], siluf(g0[1]) * u0[1]); w.y = cvt_pk_bf16(siluf(g0[2]) * u0[2], siluf(g0[3]) * u0[3]);
                w.z = cvt_pk_bf16(siluf(g1[0]) * u1[0], siluf(g1[1]) * u1[1]); w.w = cvt_pk_bf16(siluf(g1[2]) * u1[2], siluf(g1[3]) * u1[3]);
                *(u32x4*)rowp = w; }
    }
};
struct EpiResid {
    static constexpr bool PERM = false, AFTER_DRAIN = false;
    const float* base_lat; const float* base_ctx; float* out_lat; float* out_ctx; const float* gate; float scale;
    __device__ __forceinline__ void operator()(const f32x4 (&acc)[2][2][4][2], const Unit& u, int wr, int wc, int fr, int fq) const {
        const int b = u.pm / 33, w = u.pm % 33; const int set = (w == 0) ? 2 : b;
        const size_t toff = (w == 0) ? (size_t)b * 256 * 1024 : ((size_t)b * 8192 + (size_t)(w - 1) * 256) * 1024;
        const float* base = ((w == 0) ? base_ctx : base_lat) + toff; float* out = ((w == 0) ? out_ctx : out_lat) + toff;
        const int col0 = u.pn * BM + wc * 32 + 4 * fq; const float* gp = gate + set * 9216 + col0;
#pragma unroll
        for (int bj = 0; bj < 2; ++bj)
#pragma unroll
            for (int n = 0; n < 2; ++n) { const f32x4 gv = *(const f32x4*)(gp + bj * HALF + n * 16) * scale;
#pragma unroll
                for (int ai = 0; ai < 2; ++ai) {
#pragma unroll
                    for (int m = 0; m < 4; ++m) { const size_t off = (size_t)(ai * HALF + wr * 64 + m * 16 + fr) * 1024 + col0 + bj * HALF + n * 16;
                        const f32x4 bs = *(const f32x4*)(base + off); *(f32x4*)(out + off) = bs + gv * acc[ai][bj][m][n]; }
                    asm volatile("" ::: "memory"); } }
    }
};
struct EpiMerge {
    static constexpr bool PERM = true, AFTER_DRAIN = false;
    const bf16_t* Z; bf16_t* Mo;
    __device__ __forceinline__ void operator()(const f32x4 (&acc)[2][2][4][2], const Unit& u, int wr, int wc, int fr, int fq) const {
        const int br = u.pn >> 2, ct = u.pn & 3;
        const int row0 = u.pm * BM + wr * 64 + fr, col0 = ct * BM + wc * 32 + 8 * fq;
#pragma unroll
        for (int ai = 0; ai < 2; ++ai)
#pragma unroll
            for (int m = 0; m < 4; ++m) { const int row = row0 + ai * HALF + m * 16; const bf16_t* gp = Z + (size_t)row * 5376 + 2304 + br * 1024 + col0; bf16_t* mp = Mo + (size_t)row * 1024 + col0;
#pragma unroll
                for (int bj = 0; bj < 2; ++bj) { const u32x4 gw = *(const u32x4*)(gp + bj * HALF); const f32x4 a0 = acc[ai][bj][m][0], a1 = acc[ai][bj][m][1];
                    float r0 = __uint_as_float(gw.x << 16) * a0[0], r1 = __uint_as_float(gw.x & 0xffff0000u) * a0[1], r2 = __uint_as_float(gw.y << 16) * a0[2], r3 = __uint_as_float(gw.y & 0xffff0000u) * a0[3];
                    float r4 = __uint_as_float(gw.z << 16) * a1[0], r5 = __uint_as_float(gw.z & 0xffff0000u) * a1[1], r6 = __uint_as_float(gw.w << 16) * a1[2], r7 = __uint_as_float(gw.w & 0xffff0000u) * a1[3];
                    if (br > 0) { const u32x4 ow = *(const u32x4*)(mp + bj * HALF);
                        r0 += __uint_as_float(ow.x << 16); r1 += __uint_as_float(ow.x & 0xffff0000u); r2 += __uint_as_float(ow.y << 16); r3 += __uint_as_float(ow.y & 0xffff0000u);
                        r4 += __uint_as_float(ow.z << 16); r5 += __uint_as_float(ow.z & 0xffff0000u); r6 += __uint_as_float(ow.w << 16); r7 += __uint_as_float(ow.w & 0xffff0000u); }
                    u32x4 w; w.x = cvt_pk_bf16(r0, r1); w.y = cvt_pk_bf16(r2, r3); w.z = cvt_pk_bf16(r4, r5); w.w = cvt_pk_bf16(r6, r7);
                    *(u32x4*)(mp + bj * HALF) = w; } }
    }
};
struct MergeOrder {
    int G, c;
    __device__ bool next(int i, Unit& u) const { const int grp = (i / 3) * G + c; if (grp >= 264) return false; u.pm = grp >> 2; u.pn = (grp & 3) + 4 * (i % 3); return true; }
    __device__ __forceinline__ void a_ready(const Unit&) const {}
    __device__ __forceinline__ void done(const Unit&) const {}
    __device__ __forceinline__ size_t aoff(const Unit& u) const { const int br = u.pn >> 2; return (size_t)(br == 0 ? 0 : (br == 1 ? 768 : 1280)) * 2; }
    __device__ __forceinline__ size_t boff(const Unit&) const { return 0; }
};
struct OneUnit {
    int pm, pn;
    __device__ bool next(int i, Unit& u) const { if (i) return false; u.pm = pm; u.pn = pn; return true; }
    __device__ __forceinline__ void a_ready(const Unit&) const {}
    __device__ __forceinline__ void done(const Unit&) const {}
    __device__ __forceinline__ size_t aoff(const Unit&) const { return 0; }
    __device__ __forceinline__ size_t boff(const Unit&) const { return 0; }
};
}

struct Frame {
    LAS unsigned char* lds; volatile LAS unsigned* MISC; unsigned* ctl;
    int tid, lane, wave, G, bid;
    const float *x, *c, *ctx, *cctx, *w_ada, *b_ada, *norm_g, *ffn_wi, *ffn_wo, *w_in, *qk_g, *diff_lam, *subln_g, *w_branch, *w_out;
    float* out; unsigned char* ws;
};
#define WSP(T, off) ((T*)(F.ws + (off)))

__device__ __forceinline__ void transpose_item(const float* W, int N, bf16* WT, int ldt, int k0, int n0, int dst_row0, LAS float* scr, int lane) {
#pragma unroll 8
    for (int i = 0; i < 32; ++i) { const int kk = 2 * i + (lane >> 5); scr[kk * 33 + (lane & 31)] = W[(size_t)(k0 + kk) * N + n0 + (lane & 31)]; }
    LDS_WAIT(); asm volatile("" ::: "memory");
    const int c = lane & 7;
#pragma unroll
    for (int j = 0; j < 4; ++j) { const int n = (lane >> 3) + 8 * j; const LAS float* s = scr + (8 * c) * 33 + n;
        v4u o; o.x = pk2(s[0 * 33], s[1 * 33]); o.y = pk2(s[2 * 33], s[3 * 33]); o.z = pk2(s[4 * 33], s[5 * 33]); o.w = pk2(s[6 * 33], s[7 * 33]);
        *(v4u*)(WT + (size_t)(dst_row0 + n) * ldt + k0 + 8 * c) = o; }
    LDS_WAIT(); asm volatile("" ::: "memory");
}
__device__ __forceinline__ void convert_weights(Frame& F, int l) {
    LAS float* scr = (LAS float*)(F.lds + F.wave * 16384);
    const int gw = F.bid * NWAVES + F.wave, NGW = F.G * NWAVES;
    constexpr int I_UP = 16 * 176, I_DN = 44 * 32, I_IN = 16 * 184, I_BR = 8 * 32, I_OUT = 16 * 32;
    constexpr int NITEMS = 2 * I_UP + 2 * I_DN + I_IN + 3 * I_BR + I_OUT;
    const float* wi = F.ffn_wi + (size_t)l * 2 * 1024 * NUP; const float* wo = F.ffn_wo + (size_t)l * 2 * DFF * 1024;
    const float* win = F.w_in + (size_t)l * 1024 * INW; const float* wbr = F.w_branch + (size_t)l * 3 * 512 * 1024; const float* wout = F.w_out + (size_t)l * 1024 * 1024;
    for (int it = gw; it < NITEMS; it += NGW) {
        int r = it;
        if (r < 2 * I_UP) { const int h = r / I_UP; r -= h * I_UP; const int kb = r / 176, nb = r % 176; int n0 = nb * 32; const int isu = n0 >= DFF; const int nn = n0 - isu * DFF;
            transpose_item(wi + (size_t)h * 1024 * NUP, NUP, WSP(bf16, h ? WS_WUP1 : WS_WUP0), 1024, kb * 64, n0, (nn / 128) * 256 + isu * 128 + (nn % 128), scr, F.lane); continue; }
        r -= 2 * I_UP;
        if (r < 2 * I_DN) { const int h = r / I_DN; r -= h * I_DN; const int kb = r / 32, nb = r % 32;
            transpose_item(wo + (size_t)h * DFF * 1024, 1024, WSP(bf16, h ? WS_WDN1 : WS_WDN0), DFF, kb * 64, nb * 32, nb * 32, scr, F.lane); continue; }
        r -= 2 * I_DN;
        if (r < I_IN) { const int kb = r / 184, nb = r % 184; const int n0 = nb * 32;
            if (n0 >= 2304 && n0 < 2816) continue;
            transpose_item(win, INW, WSP(bf16, WS_WIN), 1024, kb * 64, n0, n0 < 2304 ? n0 : n0 - 512, scr, F.lane); continue; }
        r -= I_IN;
        if (r < 3 * I_BR) { const int i = r / I_BR; r -= i * I_BR; const int kb = r / 32, nb = r % 32;
            transpose_item(wbr + (size_t)i * 512 * 1024, 1024, WSP(bf16, WS_WBR), 512, kb * 64, nb * 32, i * 1024 + nb * 32, scr, F.lane); continue; }
        r -= 3 * I_BR;
        { const int kb = r / 32, nb = r % 32; transpose_item(wout, 1024, WSP(bf16, WS_WOUT), 1024, kb * 64, nb * 32, nb * 32, scr, F.lane); }
    }
    {
        const int t = F.bid * 512 + F.tid;
        if (t < 65536) {
            const int jl = t & 63, rest = t >> 6, kc = rest & 127, rj = rest >> 7; const int row = rj * 64 + jl, g = row >> 7, j = row & 127;
            float a[8];
#pragma unroll
            for (int e = 0; e < 8; ++e) a[e] = 0.f;
            const float* wp = win + (size_t)(kc * 8) * INW + 2304 + g * 128;
            for (int c4 = 0; c4 < 32; ++c4) {
                float cs[4];
#pragma unroll
                for (int q = 0; q < 4; ++q) { const int idx = ((c4 * 4 + q) * j) & 127; float sn, co; sincospif((float)idx * (1.0f / 64.0f), &sn, &co); cs[q] = sn + co; }
#pragma unroll
                for (int e = 0; e < 8; ++e) { const f32x4 w = *(const f32x4*)(wp + (size_t)e * INW + c4 * 4); a[e] += w[0] * cs[0] + w[1] * cs[1] + w[2] * cs[2] + w[3] * cs[3]; }
            }
            v4u o; o.x = pk2(a[0], a[1]); o.y = pk2(a[2], a[3]); o.z = pk2(a[4], a[5]); o.w = pk2(a[6], a[7]);
            *(v4u*)(WSP(bf16, WS_WC) + (size_t)row * 1024 + kc * 8) = o;
        }
    }
}
__device__ __forceinline__ void make_cas(Frame& F) {
    const int t0 = F.bid * 512 + F.tid, NT_ = F.G * 512;
    for (int it = t0; it < HN * HN / 8; it += NT_) { const int k = it >> 9, n0 = (it & 511) * 8; float v[8];
#pragma unroll
        for (int e = 0; e < 8; ++e) { const int idx = (k * (n0 + e)) & (HN - 1); float sn, co; sincospif((float)idx * (2.0f / HN), &sn, &co); v[e] = sn + co; }
        v4u o; o.x = pk2(v[0], v[1]); o.y = pk2(v[2], v[3]); o.z = pk2(v[4], v[5]); o.w = pk2(v[6], v[7]);
        *(v4u*)(WSP(bf16, WS_CAS) + (size_t)k * HN + n0) = o; }
    for (int it = t0; it < 256 * 256 / 8; it += NT_) { const int k = it >> 5, n0 = (it & 31) * 8; float v[8];
#pragma unroll
        for (int e = 0; e < 8; ++e) { const int idx = (k * (n0 + e)) & 255; float sn, co; sincospif((float)idx * (1.0f / 128.0f), &sn, &co); v[e] = sn + co; }
        v4u o; o.x = pk2(v[0], v[1]); o.y = pk2(v[2], v[3]); o.z = pk2(v[4], v[5]); o.w = pk2(v[6], v[7]);
        *(v4u*)(WSP(bf16, WS_CAS256) + (size_t)k * 256 + n0) = o; }
}
__device__ __forceinline__ void make_mod(Frame& F) {
    LAS float* red = (LAS float*)F.lds;
    for (int item = F.bid; item < 288; item += F.G) {
        const int l = item / 144, cb = item % 144;
        const int c4 = F.lane & 15, ks = F.lane >> 4, slice = F.wave * 4 + ks;
        const float* W = F.w_ada + (size_t)l * 1024 * MODW + cb * 64 + c4 * 4;
        f32x4 a0 = {0.f, 0.f, 0.f, 0.f}, a1 = a0, a2 = a0;
        for (int r = 0; r < 32; ++r) { const int k = slice * 32 + r; const f32x4 w = *(const f32x4*)(W + (size_t)k * MODW);
            const float s0 = siluf(F.c[k]), s1 = siluf(F.c[1024 + k]), s2 = siluf(F.cctx[k]); a0 += w * s0; a1 += w * s1; a2 += w * s2; }
#pragma unroll
        for (int q = 0; q < 4; ++q) { red[(slice * 3 + 0) * 64 + c4 * 4 + q] = a0[q]; red[(slice * 3 + 1) * 64 + c4 * 4 + q] = a1[q]; red[(slice * 3 + 2) * 64 + c4 * 4 + q] = a2[q]; }
        __syncthreads();
        if (F.tid < 192) { const int set = F.tid >> 6, col = F.tid & 63; float s = 0.f;
            for (int sl = 0; sl < 32; ++sl) s += red[(sl * 3 + set) * 64 + col];
            WSP(float, WS_MOD)[((size_t)l * 3 + set) * MODW + cb * 64 + col] = s + F.b_ada[(size_t)l * MODW + cb * 64 + col]; }
        __syncthreads();
    }
}
__device__ __forceinline__ const float* hrow_ptr(const float* lat, const float* ctxp, int row, int& set) {
    const int b = row / RPB, w = row % RPB;
    if (w < CTXL) { set = 2; return ctxp + ((size_t)b * CTXL + w) * 1024; }
    set = b; return lat + ((size_t)b * SEQL + (w - CTXL)) * 1024;
}
__device__ __forceinline__ void norm_mod(Frame& F, const float* lat, const float* ctxp, const float* g, const float* modl  , int ishift) {
    const int gw = F.bid * NWAVES + F.wave, NGW = F.G * NWAVES;
    for (int row = gw; row < MROWS; row += NGW) {
        int set; const float* hr = hrow_ptr(lat, ctxp, row, set);
        const float* sh = modl + (size_t)set * MODW + ishift * 1024; const float* sc = sh + 1024;
        f32x4 v[4]; float ss = 0.f;
#pragma unroll
        for (int j = 0; j < 4; ++j) { v[j] = *((const f32x4*)hr + F.lane + 64 * j); ss += (v[j][0] * v[j][0] + v[j][1] * v[j][1]) + (v[j][2] * v[j][2] + v[j][3] * v[j][3]); }
        const float rstd = 1.0f / sqrtf(wave_sum(ss) * (1.0f / 1024.0f) + EPSN);
        unsigned long long* o8 = (unsigned long long*)(WSP(bf16, WS_HN) + (size_t)row * 1024) + F.lane;
#pragma unroll
        for (int j = 0; j < 4; ++j) { const f32x4 gg = *((const f32x4*)g + F.lane + 64 * j), s1 = *((const f32x4*)sc + F.lane + 64 * j), s0 = *((const f32x4*)sh + F.lane + 64 * j);
            const f32x4 y = v[j] * rstd * gg * (s1 + 1.0f) + s0;
            o8[64 * j] = (unsigned long long)pk2(y[0], y[1]) | ((unsigned long long)pk2(y[2], y[3]) << 32); }
    }
}
__device__ __forceinline__ void qk_rope(Frame& F, int l) {
    const int gw = F.bid * NWAVES + F.wave, NGW = F.G * NWAVES;
    const float* qg = F.qk_g + (size_t)l * 256;
    const int i = F.lane & 31, half = F.lane >> 5;
    const float inv = exp2f(-(float)(i & 15) * (13.287712379549449f / 16.0f));
    for (int row = gw; row < MROWS; row += NGW) {
        const int w = row % RPB; float cs = 1.f, sn = 0.f;
        if (w >= CTXL) { const int s = w - CTXL; const float pos = (float)((i < 16) ? (s >> 6) : (s & 63)); sincosf(pos * inv, &sn, &cs); }
        bf16* zr = WSP(bf16, WS_Z) + (size_t)row * ZW;
        for (int j = 0; j < 13; ++j) {
            const int hv = 2 * j + half; int col, gsel; bool isq;
            if (hv < 8) { col = ZQA + hv * 64; gsel = 0; isq = true; } else if (hv < 10) { col = ZKA + (hv - 8) * 64; gsel = 1; isq = false; }
            else if (hv < 18) { col = ZQB + (hv - 10) * 64; gsel = 2; isq = true; } else { col = ZKB + (hv - 18) * 64; gsel = 3; isq = false; }
            const float x1 = bf2f(zr[col + i]), x2 = bf2f(zr[col + i + 32]);
            float ss = x1 * x1 + x2 * x2;
#pragma unroll
            for (int o = 1; o < 32; o <<= 1) ss += __shfl_xor(ss, o);
            const float rstd = 1.0f / sqrtf(ss * (1.0f / 64.0f) + EPSN);
            const float y1 = x1 * rstd * qg[gsel * 64 + i], y2 = x2 * rstd * qg[gsel * 64 + i + 32];
            float o1 = y1 * cs - y2 * sn, o2 = y1 * sn + y2 * cs;
            if (isq) { o1 *= attn_body::C2; o2 *= attn_body::C2; }
            const unsigned pw = pk2(o1, o2);
            zr[col + i] = (bf16)(pw & 0xffffu); zr[col + i + 32] = (bf16)(pw >> 16);
        }
    }
}
__device__ __forceinline__ void make_pq(Frame& F) {
    const int t0 = F.bid * 512 + F.tid, NT_ = F.G * 512;
    const bf16* T1 = WSP(bf16, WS_T1T); bf16* PQ = WSP(bf16, WS_PQ);
    for (int it = t0; it < 2 * 512 * HN; it += NT_) {
        const int n = it & (HN - 1), col = (it >> 12) & 511, b = it >> 21;
        const bf16* xr = T1 + (size_t)col * MROWS + b * RPB + CTXL;
        const int nm = (HN - n) & (HN - 1);
        const float x0 = bf2f(xr[n]), x1 = bf2f(xr[n + HN]), y0 = bf2f(xr[nm]), y1 = bf2f(xr[nm + HN]);
        float sn, co, snm, com; sincospif((float)n * (1.0f / HN), &sn, &co); sincospif((float)nm * (1.0f / HN), &snm, &com);
        const float p = x0 + x1, q = (x0 - x1) * co + (y0 - y1) * snm;
        PQ[((size_t)(b * 2 + 0) * 512 + col) * HN + n] = (bf16)(pk2(p, 0.f) & 0xffffu);
        PQ[((size_t)(b * 2 + 1) * 512 + col) * HN + n] = (bf16)(pk2(q, 0.f) & 0xffffu);
    }
}
__device__ __forceinline__ void post_mix(Frame& F, int l) {
    const int gw = F.bid * NWAVES + F.wave, NGW = F.G * NWAVES;
    const float lam_init = 0.8f - 0.6f * expf(-0.3f * (float)l);
    const float* dl = F.diff_lam + (size_t)l * 256;
    const float s1 = wave_sum(dl[F.lane] * dl[64 + F.lane]), s2 = wave_sum(dl[128 + F.lane] * dl[192 + F.lane]);
    const float lam = expf(s1) - expf(s2) + lam_init;
    const float* sg = F.subln_g + (size_t)l * 128 + (F.lane & 15) * 8;
    float gsc[8];
#pragma unroll
    for (int e = 0; e < 8; ++e) gsc[e] = sg[e] * (1.0f - lam_init);
    const bf16* OB = WSP(bf16, WS_HN); const bf16* T2 = WSP(bf16, WS_T2); bf16* Z = WSP(bf16, WS_Z);
    for (int row = gw; row < MROWS; row += NGW) {
        const int b = row / RPB, w = row % RPB;
        {
            const v4u a = *(const v4u*)(OB + (size_t)row * 1024 + F.lane * 8), c2 = *(const v4u*)(OB + (size_t)row * 1024 + 512 + F.lane * 8);
            float d[8];
            d[0] = bflo(a.x) - lam * bflo(c2.x); d[1] = bfhi(a.x) - lam * bfhi(c2.x); d[2] = bflo(a.y) - lam * bflo(c2.y); d[3] = bfhi(a.y) - lam * bfhi(c2.y);
            d[4] = bflo(a.z) - lam * bflo(c2.z); d[5] = bfhi(a.z) - lam * bfhi(c2.z); d[6] = bflo(a.w) - lam * bflo(c2.w); d[7] = bfhi(a.w) - lam * bfhi(c2.w);
            float ss = 0.f;
#pragma unroll
            for (int e = 0; e < 8; ++e) ss += d[e] * d[e];
#pragma unroll
            for (int o = 1; o < 16; o <<= 1) ss += __shfl_xor(ss, o);
            const float rstd = 1.0f / sqrtf(ss * (1.0f / 128.0f) + EPSN);
            v4u o; o.x = pk2(d[0] * rstd * gsc[0], d[1] * rstd * gsc[1]); o.y = pk2(d[2] * rstd * gsc[2], d[3] * rstd * gsc[3]);
            o.z = pk2(d[4] * rstd * gsc[4], d[5] * rstd * gsc[5]); o.w = pk2(d[6] * rstd * gsc[6], d[7] * rstd * gsc[7]);
            *(v4u*)(Z + (size_t)row * ZW + ZQB + F.lane * 8) = o;
        }
        {
            int mrow; float sc;
            if (w < CTXL) { mrow = b * RPB + ((CTXL - w) & (CTXL - 1)); sc = 0.5f * 0.005524271728019903f; }
            else { const int s = w - CTXL; mrow = b * RPB + CTXL + ((SEQL - s) & (SEQL - 1)); sc = 1.0f / 2048.0f; }
            const int g = F.lane >> 4, j0 = (F.lane & 15) * 8;
            const bf16* rk = T2 + (size_t)row * 512 + g * 128; const v4u mv = *(const v4u*)(T2 + (size_t)mrow * 512 + g * 128 + j0);
            float r[8];
#pragma unroll
            for (int e = 0; e < 8; ++e) r[e] = bf2f(rk[(128 - (j0 + e)) & 127]);
            v4u o; o.x = pk2((r[0] + bflo(mv.x)) * sc, (r[1] + bfhi(mv.x)) * sc); o.y = pk2((r[2] + bflo(mv.y)) * sc, (r[3] + bfhi(mv.y)) * sc);
            o.z = pk2((r[4] + bflo(mv.z)) * sc, (r[5] + bfhi(mv.z)) * sc); o.w = pk2((r[6] + bflo(mv.w)) * sc, (r[7] + bfhi(mv.w)) * sc);
            *(v4u*)(Z + (size_t)row * ZW + ZKB + F.lane * 8) = o;
        }
    }
}
__device__ __forceinline__ void mixer_phase(Frame& F, int l) {
    constexpr int NHL = 128, NHC = 4, NAL = NBATCH * 24 * 32, NAC = NBATCH * 24, TOTAL = NHL + NHC + NAL + NAC;
    unsigned* qctr = F.ctl + CW_Q + 64 * l;
    bf16* Z = WSP(bf16, WS_Z);
    for (;;) {
        if (F.tid == 0) F.MISC[0] = __hip_atomic_fetch_add(qctr, 1u, __ATOMIC_RELAXED, __HIP_MEMORY_SCOPE_AGENT);
        __syncthreads();
        const int it = (int)F.MISC[0];
        __syncthreads();
        if (it >= TOTAL) break;
        if (it < NHL) {
            const int b = it >> 6, r = it & 63, par = r >> 5, r2 = r & 31;
            pg8::Gemm g{WSP(bf16, WS_CAS), WSP(bf16, WS_PQ) + (size_t)(b * 2 + par) * 512 * HN, HN, 512, HN, HN, HN};
            pg8::OneUnit S{r2 >> 1, r2 & 1};
            pg8::EpiStore E{WSP(bf16, WS_T2), 512, 1 << 30, b * RPB + CTXL + par, 2};
            pg8::gemm_phase<pg8::EpiStore, pg8::OneUnit, true, true>(F.lds, g, S, E);
        } else if (it < NHL + NHC) {
            const int r = it - NHL, b = r >> 1;
            pg8::Gemm g{WSP(bf16, WS_CAS256), WSP(bf16, WS_T1T) + (size_t)b * RPB, 256, 512, 256, 256, MROWS};
            pg8::OneUnit S{0, r & 1};
            pg8::EpiStore E{WSP(bf16, WS_T2), 512, 1 << 30, b * RPB, 1};
            pg8::gemm_phase<pg8::EpiStore, pg8::OneUnit, true, true>(F.lds, g, S, E);
        } else {
            int r = it - NHL - NHC, b, hu, qrow, nt;
            if (r < NAL) { const int qb = r & 31; r >>= 5; hu = r % 24; b = r / 24; qrow = b * RPB + CTXL + qb * 256; nt = RPB / 64; }
            else { r -= NAL; hu = r % 24; b = r / 24; qrow = b * RPB; nt = CTXL / 64; }
            const bf16 *Qp, *Kp, *Vp; bf16* Op; int po;
            if (hu < 8) { Qp = Z + ZQA + hu * 64; Kp = Z + ZKA + (hu >> 2) * 64; Vp = Z + ZVA + (hu >> 2) * 64; Op = Z + ZQA + hu * 64; po = ZW; }
            else { const int j = hu - 8, h = j >> 2, mm = (j >> 1) & 1, vh = j & 1; Qp = Z + ZQB + (h * 2 + mm) * 64; Kp = Z + ZKB + (h * 2 + mm) * 64; Vp = Z + ZVB + h * 128 + vh * 64;
                   Op = WSP(bf16, WS_HN) + mm * 512 + h * 128 + vh * 64; po = 1024; }
            const size_t kv0 = (size_t)b * RPB;
            attn_body::attn_unit<8>((const attn_body::bf16*)(Qp + (size_t)qrow * ZW), ZW, (const attn_body::bf16*)(Kp + kv0 * ZW), ZW, (const attn_body::bf16*)(Vp + kv0 * ZW), ZW,
                                    (attn_body::bf16*)(Op + (size_t)qrow * po), po, nt, (char*)F.lds);
        }
    }
}

#ifndef MK_PER_PHASE
#define MK_PER_PHASE 0
#endif
constexpr int NPHASE = 1 + 13 * NLAYER;
struct Args { const float* in[15]; float* out; unsigned char* ws; int ph_lo, ph_hi; };
__device__ __forceinline__ void load_frame(Frame& F) {
    const __attribute__((address_space(4))) Args* a = (const __attribute__((address_space(4))) Args*)__builtin_amdgcn_kernarg_segment_ptr();
    asm volatile("" : "+s"(a));
    extern __shared__ __attribute__((aligned(16))) unsigned char lds_raw[];
    F.lds = (LAS unsigned char*)lds_raw; F.MISC = (volatile LAS unsigned*)(F.lds + MISC_OFF);
    int t = threadIdx.x; asm volatile("" : "+v"(t));
    F.tid = t; F.lane = t & 63; F.wave = __builtin_amdgcn_readfirstlane(t >> 6); F.G = gridDim.x; F.bid = blockIdx.x;
    F.x = a->in[0]; F.c = a->in[1]; F.ctx = a->in[2]; F.cctx = a->in[3]; F.w_ada = a->in[4]; F.b_ada = a->in[5]; F.norm_g = a->in[6]; F.ffn_wi = a->in[7];
    F.ffn_wo = a->in[8]; F.w_in = a->in[9]; F.qk_g = a->in[10]; F.diff_lam = a->in[11]; F.subln_g = a->in[12]; F.w_branch = a->in[13]; F.w_out = a->in[14];
    F.out = a->out; F.ws = a->ws; F.ctl = (unsigned*)(a->ws + WS_CTL);
}
#ifndef MK_MASK
#define MK_MASK 0xffffffffu
#endif
#define EN(j) (((MK_MASK) >> (j)) & 1u)
#define LF() Frame F; load_frame(F); float* hlat = F.out; float* hctx = WSP(float, WS_HC); const float* modl = WSP(float, WS_MOD) + (size_t)l * 3 * MODW; const float* ng = F.norm_g + (size_t)l * 3 * 1024; \
    const float* slat = (l == 0) ? F.x : hlat; const float* sctx = (l == 0) ? F.ctx : hctx; (void)hlat; (void)hctx; (void)modl; (void)ng; (void)slat; (void)sctx
__global__ void __launch_bounds__(NWAVES * 64, 2) mk_fwd(Args args) {
    cg::grid_group grid = cg::this_grid();
    const int lo = args.ph_lo, hi = args.ph_hi;
#define IN(k) (lo <= (k) && (k) < hi)
#define SEAM(k) do { if (IN(k) && IN((k) + 1)) grid.sync(); } while (0)
    if (EN(0) && IN(0)) { const int l = 0; LF(); make_mod(F); convert_weights(F, 0); make_cas(F); }
    SEAM(0);
    for (int l = 0; l < NLAYER; ++l) {
        const int p0 = 1 + 13 * l;
        if (EN(1) && IN(p0 + 0)) { LF(); if (l > 0) convert_weights(F, l); norm_mod(F, slat, sctx, ng, modl, 0); }
        SEAM(p0 + 0);
        if (EN(2) && IN(p0 + 1)) { LF(); pg8::Gemm g{WSP(bf16, WS_HN), WSP(bf16, WS_WUP0), MROWS, NUP, 1024, 1024, 1024}; pg8::StaticOrder S; S.init(MROWS, NUP, F.G, F.bid);
            pg8::EpiSwiGLU E{WSP(bf16, WS_Z), DFF}; pg8::gemm_phase<pg8::EpiSwiGLU, pg8::StaticOrder, true, true>(F.lds, g, S, E); }
        SEAM(p0 + 1);
        if (EN(3) && IN(p0 + 2)) { LF(); pg8::Gemm g{WSP(bf16, WS_Z), WSP(bf16, WS_WDN0), MROWS, 1024, DFF, DFF, DFF}; pg8::StaticOrder S; S.init(MROWS, 1024, F.G, F.bid);
            pg8::EpiResid E{slat, sctx, hlat, hctx, modl + 2 * 1024, 0.5f}; pg8::gemm_phase<pg8::EpiResid, pg8::StaticOrder, true, true>(F.lds, g, S, E); }
        SEAM(p0 + 2);
        if (EN(4) && IN(p0 + 3)) { LF(); norm_mod(F, hlat, hctx, ng + 1024, modl, 3); }
        SEAM(p0 + 3);
        if (EN(5) && IN(p0 + 4)) { LF();
            { pg8::Gemm g{WSP(bf16, WS_HN), WSP(bf16, WS_WIN), MROWS, ZW, 1024, 1024, 1024}; pg8::StaticOrder S; S.init(MROWS, ZW, F.G, F.bid);
              pg8::EpiStore E{WSP(bf16, WS_Z), ZW, ZGATE, 0, 1}; pg8::gemm_phase<pg8::EpiStore, pg8::StaticOrder, true, true>(F.lds, g, S, E); }
            { pg8::Gemm g{WSP(bf16, WS_WC), WSP(bf16, WS_HN), 512, MROWS, 1024, 1024, 1024}; pg8::StaticOrder S; S.init(512, MROWS, F.G, F.G - 1 - F.bid);
              pg8::EpiStore E{WSP(bf16, WS_T1T), MROWS, 1 << 30, 0, 1}; pg8::gemm_phase<pg8::EpiStore, pg8::StaticOrder, true, true>(F.lds, g, S, E); }
        }
        SEAM(p0 + 4);
        if (EN(6) && IN(p0 + 5)) { LF(); qk_rope(F, l); make_pq(F); }
        SEAM(p0 + 5);
        if (EN(7) && IN(p0 + 6)) { LF(); mixer_phase(F, l); }
        SEAM(p0 + 6);
        if (EN(8) && IN(p0 + 7)) { LF(); post_mix(F, l); }
        SEAM(p0 + 7);
        if (EN(9) && IN(p0 + 8)) { LF(); pg8::Gemm g{WSP(bf16, WS_Z), WSP(bf16, WS_WBR), MROWS, 3072, 512, ZW, 512}; pg8::MergeOrder S{F.G, F.bid};
            pg8::EpiMerge E{WSP(bf16, WS_Z), WSP(bf16, WS_HN)}; pg8::gemm_phase<pg8::EpiMerge, pg8::MergeOrder, true, true>(F.lds, g, S, E); }
        SEAM(p0 + 8);
        if (EN(10) && IN(p0 + 9)) { LF(); pg8::Gemm g{WSP(bf16, WS_HN), WSP(bf16, WS_WOUT), MROWS, 1024, 1024, 1024, 1024}; pg8::StaticOrder S; S.init(MROWS, 1024, F.G, F.bid);
            pg8::EpiResid E{hlat, hctx, hlat, hctx, modl + 5 * 1024, 1.0f}; pg8::gemm_phase<pg8::EpiResid, pg8::StaticOrder, true, true>(F.lds, g, S, E); }
        SEAM(p0 + 9);
        if (EN(11) && IN(p0 + 10)) { LF(); norm_mod(F, hlat, hctx, ng + 2048, modl, 6); }
        SEAM(p0 + 10);
        if (EN(12) && IN(p0 + 11)) { LF(); pg8::Gemm g{WSP(bf16, WS_HN), WSP(bf16, WS_WUP1), MROWS, NUP, 1024, 1024, 1024}; pg8::StaticOrder S; S.init(MROWS, NUP, F.G, F.bid);
            pg8::EpiSwiGLU E{WSP(bf16, WS_Z), DFF}; pg8::gemm_phase<pg8::EpiSwiGLU, pg8::StaticOrder, true, true>(F.lds, g, S, E); }
        SEAM(p0 + 11);
        if (EN(13) && IN(p0 + 12)) { LF(); pg8::Gemm g{WSP(bf16, WS_Z), WSP(bf16, WS_WDN1), MROWS, 1024, DFF, DFF, DFF}; pg8::StaticOrder S; S.init(MROWS, 1024, F.G, F.bid);
            pg8::EpiResid E{hlat, hctx, hlat, hctx, modl + 8 * 1024, 0.5f}; pg8::gemm_phase<pg8::EpiResid, pg8::StaticOrder, true, true>(F.lds, g, S, E); }
        SEAM(p0 + 12);
    }
#undef IN
#undef SEAM
}

extern "C" void kernel_launch(void* const* d_in, const int* in_sizes, int n_in, void* d_out, int out_size, void* d_ws, size_t ws_size, hipStream_t stream) {
    static int grid = 0;
    if (grid == 0) {
        if (n_in != 15 || ws_size < WS_END) { fprintf(stderr, "kernel_launch: need 15 inputs and >= %zu bytes of workspace; got n_in %d, ws %zu\n", (size_t)WS_END, n_in, ws_size); grid = -1; return; }
        int dev = 0, cus = 0, per_cu = 0;
        if (hipGetDevice(&dev) != hipSuccess || hipDeviceGetAttribute(&cus, hipDeviceAttributeMultiprocessorCount, dev) != hipSuccess) { grid = -1; return; }
        if (hipFuncSetAttribute((const void*)mk_fwd, hipFuncAttributeMaxDynamicSharedMemorySize, LDS_BYTES) != hipSuccess) { fprintf(stderr, "kernel_launch: hipFuncSetAttribute failed\n"); grid = -1; return; }
        if (hipOccupancyMaxActiveBlocksPerMultiprocessor(&per_cu, (const void*)mk_fwd, NWAVES * 64, LDS_BYTES) != hipSuccess || per_cu < 1) { fprintf(stderr, "kernel_launch: occupancy query says %d\n", per_cu); per_cu = 1; }
        (void)hipGetLastError();
        grid = cus * per_cu;
    }
    if (grid < 0) return;
    (void)hipMemsetAsync((char*)d_ws + WS_CTL, 0, CTL_ZERO_BYTES, stream);
    Args a{};
    for (int i = 0; i < 15; ++i) a.in[i] = (const float*)d_in[i];
    a.out = (float*)d_out; a.ws = (unsigned char*)d_ws;
#if MK_PER_PHASE
    for (int p = 0; p < NPHASE; ++p) { a.ph_lo = p; a.ph_hi = p + 1; hipLaunchKernelGGL(mk_fwd, dim3(grid), dim3(NWAVES * 64), LDS_BYTES, stream, a); }
#else
    a.ph_lo = 0; a.ph_hi = NPHASE;
    void* kargs[] = {&a};
    hipError_t e = hipLaunchCooperativeKernel((const void*)mk_fwd, dim3(grid), dim3(NWAVES * 64), kargs, LDS_BYTES, stream);
    if (e != hipSuccess) fprintf(stderr, "kernel_launch: cooperative launch failed: %s (grid %d)\n", hipGetErrorString(e), grid);
#endif
}
```

```cpp
#include <hip/hip_runtime.h>
#include <hip/hip_cooperative_groups.h>
#include <hip/hip_bf16.h>
#include <cstdio>
#include <cstdint>
#include <cmath>
namespace cg = cooperative_groups;

namespace pg8 {
#define PG8_LAS __attribute__((address_space(3)))
typedef unsigned short bf16_t;
typedef short bf16x8 __attribute__((ext_vector_type(8)));
typedef float f32x4 __attribute__((ext_vector_type(4)));
typedef unsigned u32x4 __attribute__((ext_vector_type(4)));
constexpr int BM = 256, BK = 64, HALF = 128, HTB = HALF * BK * 2  , STAGE_BYTES = 8 * HTB, NXCD = 8, WGM = 8;

__host__ __device__ __forceinline__ int lds_byte(int r, int c) { const int st = (r >> 4) * 2 + (c >> 5), rr = r & 15, cc = c & 31, ob = rr * 64 + cc * 2; return st * 1024 + (ob ^ (((ob >> 9) & 1) << 5)); }
__host__ __device__ __forceinline__ void stage_rc(int b, int& R, int& C) { const int st = b / 1024, sb = b % 1024, swz = sb ^ (((sb >> 9) & 1) << 5); R = (st >> 1) * 16 + swz / 64; C = (st & 1) * 32 + (swz % 64) / 2; }
__host__ __device__ __forceinline__ int perm32(int rho) { const int n = rho >> 4, i = rho & 15; return 8 * (i >> 2) + 4 * n + (i & 3); }

struct Unit { int pm, pn; };
struct Gemm { const bf16_t* A; const bf16_t* Bt; int M, N, K, lda, ldb; };

struct StaticOrder {
    int nM, nN, nwg, G, c;
    __host__ __device__ void init(int M, int N, int G_, int c_) { nM = M / BM; nN = N / BM; nwg = nM * nN; G = G_; c = c_; }
    __host__ __device__ bool next(int i, Unit& u) const {
        const long L = (long)i * G + c; if (L >= nwg) return false;
        int wgid = (int)L; { const int q = nwg / NXCD, r = nwg % NXCD, xcd = wgid % NXCD, off = wgid / NXCD; wgid = (xcd < r ? xcd * (q + 1) : r * (q + 1) + (xcd - r) * q) + off; }
        const int nig = WGM * nN, gid = wgid / nig, fm = gid * WGM, gsz = (nM - fm) < WGM ? (nM - fm) : WGM;
        u.pm = fm + ((wgid % nig) % gsz); u.pn = (wgid % nig) / gsz; return true;
    }
    __device__ __forceinline__ void a_ready(const Unit&) const {}
    __device__ __forceinline__ void done(const Unit&) const {}
    __device__ __forceinline__ size_t aoff(const Unit&) const { return 0; }
    __device__ __forceinline__ size_t boff(const Unit&) const { return 0; }
};


__device__ __forceinline__ unsigned cvt_pk_bf16(float lo, float hi) { unsigned r; asm volatile("v_cvt_pk_bf16_f32 %0, %1, %2" : "=v"(r) : "v"(lo), "v"(hi)); return r; }
typedef float f32x2 __attribute__((ext_vector_type(2)));

template <class Epi, class Sched, bool ALIGN_EPI = false, bool SP2 = false>
__device__ __forceinline__ void gemm_phase(PG8_LAS unsigned char* lds, const Gemm g, const Sched& S, const Epi& E) {
    int tid_ = threadIdx.x; asm volatile("" : "+v"(tid_)); const int tid = tid_, wid = __builtin_amdgcn_readfirstlane(tid >> 6), lane = tid & 63, wr = wid >> 2, wc = wid & 3, fr = lane & 15, fq = lane >> 4;
    const int K = g.K, nt = K / BK;
    unsigned voffA[2], voffB[2];
#pragma unroll
    for (int i = 0; i < 2; ++i) { int R, C; stage_rc(tid * 16 + i * 8192, R, C); const int Rb = Epi::PERM ? ((R & ~31) + perm32(R & 31)) : R;
        voffA[i] = (unsigned)(R * g.lda + C) * 2u; voffB[i] = (unsigned)(Rb * g.ldb + C) * 2u; }
    const size_t kstep = (size_t)(BK * 2);
    const size_t hstepA = (size_t)HALF * g.lda * 2, hstepB = (size_t)HALF * g.ldb * 2;
    const size_t tstepA = 2 * hstepA, tstepB = 2 * hstepB;
    const unsigned ldsw = (unsigned)wid * 1024u;
    const int aoff = lds_byte(wr * 64 + fr, fq * 8), boff = lds_byte(wc * 32 + fr, fq * 8);
#define PG8_SA(b, h) (((b) * 2 + (h)) * HTB)
#define PG8_SB(b, h) ((4 + (b) * 2 + (h)) * HTB)
#define PG8_STAGE(bufoff, gbase, voff) do { _Pragma("unroll") for (int _i = 0; _i < 2; ++_i) \
        __builtin_amdgcn_global_load_lds((const unsigned*)((const char*)(gbase) + (voff)[_i]), (PG8_LAS unsigned*)(lds + (bufoff) + ldsw + _i * 8192), 16, 0, 0); } while (0)
#define PG8_LDA(dst, b, h) do { _Pragma("unroll") for (int m = 0; m < 4; ++m) _Pragma("unroll") for (int k = 0; k < 2; ++k) dst[m][k] = *(const PG8_LAS bf16x8*)(lds + PG8_SA(b, h) + aoff + m * 2048 + k * 1024); } while (0)
#define PG8_LDB(dst, b, h) do { _Pragma("unroll") for (int n = 0; n < 2; ++n) _Pragma("unroll") for (int k = 0; k < 2; ++k) dst[n][k] = *(const PG8_LAS bf16x8*)(lds + PG8_SB(b, h) + boff + n * 2048 + k * 1024); } while (0)
#define PG8_MMA(ai, bj, At, Bt) do { __builtin_amdgcn_s_setprio(1); _Pragma("unroll") for (int m = 0; m < 4; ++m) _Pragma("unroll") for (int n = 0; n < 2; ++n) _Pragma("unroll") for (int k = 0; k < 2; ++k) \
        acc[ai][bj][m][n] = __builtin_amdgcn_mfma_f32_16x16x32_bf16(Bt[n][k], At[m][k], acc[ai][bj][m][n], 0, 0, 0); __builtin_amdgcn_s_setprio(0); } while (0)
#define PG8_WAIT_V(n) asm volatile("s_waitcnt vmcnt(" #n ")" ::: "memory")
#define PG8_WAIT_L(n) asm volatile("s_waitcnt lgkmcnt(" #n ")" ::: "memory")
#define PG8_BAR __builtin_amdgcn_s_barrier()
#define PG8_SCHED __builtin_amdgcn_sched_barrier(0)
    Unit cur, nxt; int ui = 0;
    if (!S.next(0, cur)) return;
    f32x4 acc[2][2][4][2];
#pragma unroll
    for (int a = 0; a < 2; ++a)
#pragma unroll
        for (int b = 0; b < 2; ++b)
#pragma unroll
            for (int m = 0; m < 4; ++m)
#pragma unroll
                for (int n = 0; n < 2; ++n) acc[a][b][m][n] = (f32x4){0.f, 0.f, 0.f, 0.f};
    bf16x8 At[4][2], B0[2][2], B1[2][2];
    const char* cA = (const char*)g.A + (size_t)cur.pm * tstepA + S.aoff(cur); const char* cB = (const char*)g.Bt + (size_t)cur.pn * tstepB + S.boff(cur);
    S.a_ready(cur);
    if constexpr (SP2) {
        PG8_STAGE(PG8_SB(0, 0), cB, voffB); PG8_STAGE(PG8_SB(0, 1), cB + hstepB, voffB); PG8_STAGE(PG8_SA(0, 0), cA, voffA); PG8_STAGE(PG8_SA(0, 1), cA + hstepA, voffA);
        if (wr == 1) PG8_BAR;
        PG8_WAIT_V(2); PG8_BAR;
        PG8_STAGE(PG8_SB(1, 0), cB + kstep, voffB); PG8_STAGE(PG8_SA(1, 0), cA + kstep, voffA); PG8_STAGE(PG8_SB(1, 1), cB + hstepB + kstep, voffB);
        PG8_WAIT_V(6); PG8_BAR;
    } else {
        PG8_STAGE(PG8_SB(0, 0), cB, voffB); PG8_STAGE(PG8_SA(0, 0), cA, voffA); PG8_STAGE(PG8_SB(0, 1), cB + hstepB, voffB); PG8_STAGE(PG8_SA(0, 1), cA + hstepA, voffA);
        if (wr == 1) PG8_BAR;
        PG8_WAIT_V(4); PG8_BAR;
        PG8_STAGE(PG8_SB(1, 0), cB + kstep, voffB); PG8_STAGE(PG8_SA(1, 0), cA + kstep, voffA); PG8_STAGE(PG8_SB(1, 1), cB + hstepB + kstep, voffB);
        PG8_WAIT_V(6); PG8_BAR;
    }
    for (;;) {
        const bool has_next = S.next(ui + 1, nxt);
        const char* nA = has_next ? (const char*)g.A + (size_t)nxt.pm * tstepA + S.aoff(nxt) : cA; const char* nB = has_next ? (const char*)g.Bt + (size_t)nxt.pn * tstepB + S.boff(nxt) : cB;
        for (int t = 0; t < nt; t += 2) {
            const bool last = (t == nt - 2);
            const char* a1 = cA + (size_t)(t + 1) * kstep;
            const char* a2 = last ? nA : cA + (size_t)(t + 2) * kstep; const char* b2 = last ? nB : cB + (size_t)(t + 2) * kstep;
            const char* a3 = a2 + kstep; const char* b3 = b2 + kstep;
            if (last && has_next) S.a_ready(nxt);
            if constexpr (SP2) {
            PG8_LDB(B0, 0, 0); PG8_LDB(B1, 0, 1); PG8_SCHED; PG8_LDA(At, 0, 0); PG8_STAGE(PG8_SA(1, 1), a1 + hstepA, voffA);
            PG8_WAIT_V(8); PG8_WAIT_L(0); PG8_BAR; PG8_MMA(0, 0, At, B0); PG8_MMA(0, 1, At, B1); PG8_BAR; PG8_SCHED;
            PG8_LDA(At, 0, 1); PG8_STAGE(PG8_SB(0, 0), b2, voffB); PG8_STAGE(PG8_SB(0, 1), b2 + hstepB, voffB); PG8_STAGE(PG8_SA(0, 0), a2, voffA);
            PG8_WAIT_V(8); PG8_WAIT_L(0); PG8_BAR; PG8_MMA(1, 0, At, B0); PG8_MMA(1, 1, At, B1); PG8_BAR; PG8_SCHED;
            PG8_LDB(B0, 1, 0); PG8_LDB(B1, 1, 1); PG8_SCHED; PG8_LDA(At, 1, 0); PG8_STAGE(PG8_SA(0, 1), a2 + hstepA, voffA);
            PG8_WAIT_V(8); PG8_WAIT_L(0); PG8_BAR; PG8_MMA(0, 0, At, B0); PG8_MMA(0, 1, At, B1); PG8_BAR; PG8_SCHED;
            PG8_LDA(At, 1, 1); PG8_STAGE(PG8_SB(1, 0), b3, voffB); PG8_STAGE(PG8_SB(1, 1), b3 + hstepB, voffB); PG8_STAGE(PG8_SA(1, 0), a3, voffA);
            PG8_WAIT_V(8); PG8_WAIT_L(0); PG8_BAR; PG8_MMA(1, 0, At, B0); PG8_MMA(1, 1, At, B1); PG8_BAR; PG8_SCHED;
            } else {
            PG8_LDB(B0, 0, 0); PG8_SCHED; PG8_LDA(At, 0, 0); PG8_STAGE(PG8_SA(1, 1), a1 + hstepA, voffA);
            PG8_WAIT_L(8); PG8_BAR; PG8_WAIT_L(0); PG8_MMA(0, 0, At, B0); PG8_BAR; PG8_SCHED;
            PG8_LDB(B1, 0, 1); PG8_STAGE(PG8_SB(0, 0), b2, voffB);
            PG8_BAR; PG8_WAIT_L(0); PG8_MMA(0, 1, At, B1); PG8_BAR;
            PG8_LDA(At, 0, 1); PG8_STAGE(PG8_SA(0, 0), a2, voffA);
            PG8_BAR; PG8_WAIT_L(0); PG8_MMA(1, 0, At, B0); PG8_BAR; PG8_SCHED;
            PG8_STAGE(PG8_SB(0, 1), b2 + hstepB, voffB);
            PG8_WAIT_V(6); PG8_BAR; PG8_MMA(1, 1, At, B1); PG8_BAR;
            PG8_LDB(B0, 1, 0); PG8_SCHED; PG8_LDA(At, 1, 0); PG8_STAGE(PG8_SA(0, 1), a2 + hstepA, voffA);
            PG8_WAIT_L(8); PG8_BAR; PG8_WAIT_L(0); PG8_MMA(0, 0, At, B0); PG8_BAR; PG8_SCHED;
            PG8_LDB(B1, 1, 1); PG8_STAGE(PG8_SB(1, 0), b3, voffB);
            PG8_BAR; PG8_WAIT_L(0); PG8_MMA(0, 1, At, B1); PG8_BAR;
            PG8_LDA(At, 1, 1); PG8_STAGE(PG8_SA(1, 0), a3, voffA);
            PG8_BAR; PG8_WAIT_L(0); PG8_MMA(1, 0, At, B0); PG8_BAR; PG8_SCHED;
            PG8_STAGE(PG8_SB(1, 1), b3 + hstepB, voffB);
            PG8_WAIT_V(6); PG8_BAR; PG8_MMA(1, 1, At, B1); PG8_BAR;
            }
        }
        if constexpr (ALIGN_EPI) { if (wr == 0) PG8_BAR; }
        if constexpr (!Epi::AFTER_DRAIN) { E(acc, cur, wr, wc, fr, fq); S.done(cur); }
        if (!has_next) break;
#pragma unroll
        for (int a = 0; a < 2; ++a)
#pragma unroll
            for (int b = 0; b < 2; ++b)
#pragma unroll
                for (int m = 0; m < 4; ++m)
#pragma unroll
                    for (int n = 0; n < 2; ++n) acc[a][b][m][n] = (f32x4){0.f, 0.f, 0.f, 0.f};
        cur = nxt; cA = nA; cB = nB; ++ui;
        if constexpr (ALIGN_EPI) { if (wr == 1) PG8_BAR; }
    }
    PG8_WAIT_V(0);
    if constexpr (!ALIGN_EPI) { if (wr == 0) PG8_BAR; }
    PG8_BAR;
    if constexpr (Epi::AFTER_DRAIN) { E.fused(acc, cur, wr, wc, fr, fq, lds, wid, lane); S.done(cur); }
#undef PG8_SA
#undef PG8_SB
#undef PG8_STAGE
#undef PG8_LDA
#undef PG8_LDB
#undef PG8_MMA
#undef PG8_WAIT_V
#undef PG8_WAIT_L
#undef PG8_BAR
#undef PG8_SCHED
}
}


namespace attn_body {
using bf16=__hip_bfloat16;
using bf16x8=__attribute__((ext_vector_type(8)))short;
using s16x4=__attribute__((ext_vector_type(4)))short;
using f32x16=__attribute__((ext_vector_type(16)))float;
using u32x4=__attribute__((ext_vector_type(4)))unsigned;
constexpr int D=64;
constexpr int NW=8,QBLK=32,QB=QBLK*NW,KVBLK=64;
constexpr int ATTN_UNIT_ROWS=QB;
__device__ __forceinline__ int crow(int r,int hi){return (r&3)+8*(r>>2)+4*hi;}
#define SBAR() __builtin_amdgcn_sched_barrier(0)
constexpr int NSLOT=3, SLOTB=8192;
constexpr int LDS_K=0, LDS_V=NSLOT*SLOTB, LDS_WS=2*NSLOT*SLOTB, LDS_OST=LDS_WS+NW*64*4, LDS_BYTES=LDS_OST+NW*4096;
constexpr float C2=0.125f*1.4426950408889634f;
__device__ __forceinline__ void glds16(const void*gsrc,unsigned lds_dst){unsigned keep;
  asm volatile("s_mov_b32 %0, m0\n\ts_mov_b32 m0, %2\n\ts_nop 0\n\tglobal_load_lds_dwordx4 %1, off\n\ts_mov_b32 m0, %0":"=&s"(keep):"v"(gsrc),"s"(lds_dst):"memory");}
__device__ __forceinline__ float max3f(float a,float b,float c){float r;asm("v_max3_f32 %0, %1, %2, %3":"=v"(r):"v"(a),"v"(b),"v"(c));return r;}
__device__ __forceinline__ float max2f(float a,float b){float r;asm("v_max_f32_e32 %0, %1, %2":"=v"(r):"v"(a),"v"(b));return r;}
__device__ __forceinline__ float fadd_s(float a,float b){float r;asm("v_add_f32_e32 %0, %1, %2":"=v"(r):"v"(a),"v"(b));return r;}
__device__ __forceinline__ float fsub_s(float a,float b){float r;asm("v_sub_f32_e32 %0, %1, %2":"=v"(r):"v"(a),"v"(b));return r;}
typedef float f32x2_t __attribute__((ext_vector_type(2))); typedef __bf16 bf16x2_t __attribute__((ext_vector_type(2)));
__device__ __forceinline__ unsigned cvtpk_s(float lo,float hi){f32x2_t v={lo,hi};bf16x2_t b=__builtin_convertvector(v,bf16x2_t);return __builtin_bit_cast(unsigned,b);}
#define WAIT_BAR(N) asm volatile("s_waitcnt vmcnt(" #N ") lgkmcnt(0)\n\ts_barrier":::"memory")

__device__ __forceinline__ void qkt(f32x16&p0,f32x16&p1,const char*Kslot,const bf16x8*qr,const f32x16&negm,int r32,int hi){
  const char*kb=Kslot+hi*1024+r32*16;
  #pragma unroll
  for(int d0=0;d0<4;++d0){
    const bf16x8 b0=*reinterpret_cast<const bf16x8*>(kb+d0*2048);
    const bf16x8 b1=*reinterpret_cast<const bf16x8*>(kb+d0*2048+512);
    if(d0==0){p0=__builtin_amdgcn_mfma_f32_32x32x16_bf16(b0,qr[0],negm,0,0,0);p1=__builtin_amdgcn_mfma_f32_32x32x16_bf16(b1,qr[0],negm,0,0,0);}
    else{p0=__builtin_amdgcn_mfma_f32_32x32x16_bf16(b0,qr[d0],p0,0,0,0);p1=__builtin_amdgcn_mfma_f32_32x32x16_bf16(b1,qr[d0],p1,0,0,0);}}
}
typedef __attribute__((address_space(3))) const char* lds_cptr;
typedef short v4i16_t __attribute__((ext_vector_type(4)));
__device__ __forceinline__ void kload8(bf16x8*kf,lds_cptr kp){
  kf[0]=*(const __attribute__((address_space(3))) bf16x8*)(kp);      kf[1]=*(const __attribute__((address_space(3))) bf16x8*)(kp+512);
  kf[2]=*(const __attribute__((address_space(3))) bf16x8*)(kp+2048); kf[3]=*(const __attribute__((address_space(3))) bf16x8*)(kp+2560);
  kf[4]=*(const __attribute__((address_space(3))) bf16x8*)(kp+4096); kf[5]=*(const __attribute__((address_space(3))) bf16x8*)(kp+4608);
  kf[6]=*(const __attribute__((address_space(3))) bf16x8*)(kp+6144); kf[7]=*(const __attribute__((address_space(3))) bf16x8*)(kp+6656);
}
__device__ __forceinline__ void kload2(bf16x8*kf,lds_cptr kp,int j){ kf[2*j]=*(const __attribute__((address_space(3))) bf16x8*)(kp+j*2048); kf[2*j+1]=*(const __attribute__((address_space(3))) bf16x8*)(kp+j*2048+512); }
__device__ __forceinline__ s16x4 vtr(lds_cptr p){ return __builtin_bit_cast(s16x4,__builtin_amdgcn_ds_read_tr16_b64_v4i16((__attribute__((address_space(3))) v4i16_t*)p)); }
__device__ __forceinline__ float rowmax(const f32x16&p0,const f32x16&p1){
  float a=max3f(p0[0],p0[1],p1[0]),b=max3f(p0[2],p0[3],p1[1]);a=max3f(a,p1[2],p1[3]);
  #pragma unroll
  for(int r=4;r<16;r+=4){a=max3f(a,p0[r],p0[r+1]);b=max3f(b,p0[r+2],p0[r+3]);a=max3f(a,p1[r],p1[r+1]);b=max3f(b,p1[r+2],p1[r+3]);}
  const float m=max2f(a,b);
  auto rr=__builtin_amdgcn_permlane32_swap(__float_as_uint(m),__float_as_uint(m),false,false);
  return max2f(__uint_as_float(rr[0]),__uint_as_float(rr[1]));
}
__device__ __forceinline__ void pv(f32x16*o,int vb,bf16x8 pa0,bf16x8 pa1,bf16x8 pa2,bf16x8 pa3){
  #pragma unroll
  for(int d0=0;d0<2;++d0){s16x4 lo[4],hi[4];
    #pragma unroll
    for(int ks=0;ks<4;++ks){
      asm volatile("ds_read_b64_tr_b16 %0,%1 offset:%c2":"=&v"(lo[ks]):"v"(vb),"i"(d0*4096+ks*1024):"memory");
      asm volatile("ds_read_b64_tr_b16 %0,%1 offset:%c2":"=&v"(hi[ks]):"v"(vb),"i"(d0*4096+ks*1024+512):"memory");}
    asm volatile("s_waitcnt lgkmcnt(0)":::"memory");SBAR();
    #define PK(k) (bf16x8){lo[k][0],lo[k][1],lo[k][2],lo[k][3],hi[k][0],hi[k][1],hi[k][2],hi[k][3]}
    o[d0]=__builtin_amdgcn_mfma_f32_32x32x16_bf16(pa0,PK(0),o[d0],0,0,0);
    o[d0]=__builtin_amdgcn_mfma_f32_32x32x16_bf16(pa1,PK(1),o[d0],0,0,0);
    o[d0]=__builtin_amdgcn_mfma_f32_32x32x16_bf16(pa2,PK(2),o[d0],0,0,0);
    o[d0]=__builtin_amdgcn_mfma_f32_32x32x16_bf16(pa3,PK(3),o[d0],0,0,0);
    #undef PK
  }
}

#ifndef ATTN_STORE16
#define ATTN_STORE16(p,v) (*(u32x4*)(p)=(v))
#endif
template<int THRL> __device__ __forceinline__ void attn_unit(const bf16*Q0,int ldq,const bf16*__restrict__ Kh,int ldk,const bf16*__restrict__ Vh,int ldv,bf16*O0,int ldo,int NT,char*shm){
  int tid_=threadIdx.x; asm volatile("":"+v"(tid_)); const int tid=tid_,lane=tid&63,r32=lane&31,hi=lane>>5; const int wid=__builtin_amdgcn_readfirstlane(tid>>6);
  const bf16*Qw=Q0+(long)(wid*QBLK)*ldq;
  const unsigned lds0=(unsigned)(uintptr_t)shm;
  float*wsf=(float*)(shm+LDS_WS)+wid*64;
  const bf16*ksrc=Kh+(long)lane*ldk+wid*8;
  const bf16*vsrc=Vh+(long)(16*(wid&3)+(lane>>2))*ldv+(wid>>2)*32+(lane&3)*8;
  const unsigned kdst=lds0+LDS_K+wid*1024, vdst=lds0+LDS_V+wid*1024;
  #define DMA_K(t,slot) glds16(ksrc+(long)(t)*KVBLK*ldk,(unsigned)__builtin_amdgcn_readfirstlane(kdst+(slot)))
  #define DMA_V(t,slot) glds16(vsrc+(long)(t)*KVBLK*ldv,(unsigned)__builtin_amdgcn_readfirstlane(vdst+(slot)))
  const int vb0=(int)(lds0+LDS_V)+((lane>>4)&1)*32+(lane&3)*8+(4*hi+((lane&15)>>2))*64;
  const char*Kbase=shm+LDS_K; bf16x8 kf[8];
  const lds_cptr shm3=(lds_cptr)shm; const lds_cptr kp0=shm3+LDS_K+hi*1024+r32*16; const lds_cptr vp0=shm3+LDS_V+((lane>>4)&1)*32+(lane&3)*8+(4*hi+((lane&15)>>2))*64;
  DMA_K(0,0);DMA_V(0,0);DMA_K(1,SLOTB);
  bf16x8 qr[4];
  #pragma unroll
  for(int d0=0;d0<4;++d0)qr[d0]=*reinterpret_cast<const bf16x8*>(&Qw[(long)r32*ldq+d0*16+hi*8]);
  float mhat=0.f,l_reg=0.f;f32x16 o[2];o[0]=f32x16{};o[1]=f32x16{};f32x16 negm=f32x16{};asm volatile("":"+v"(negm));
  #define CMASK(P0,P1,t) do{}while(0)
  bool resc=false;
  #define START(P0,P1) do{ const float rm=rowmax(P0,P1); resc=false; \
    { const float dl=rm; mhat=fadd_s(mhat,dl); \
      _Pragma("unroll") for(int r=0;r<16;++r){P0[r]=fsub_s(P0[r],dl);P1[r]=fsub_s(P1[r],dl);} \
      _Pragma("unroll") for(int r=0;r<16;++r)negm[r]=-mhat; asm volatile("":"+v"(negm)); } \
    _Pragma("unroll") for(int r=0;r<16;++r)P0[r]=__builtin_amdgcn_exp2f(P0[r]); }while(0)
  #define RESC() do{ if(resc){ asm volatile("s_waitcnt lgkmcnt(0)":::"memory"); \
      _Pragma("unroll") for(int d_=0;d_<2;++d_) _Pragma("unroll") for(int r=0;r<16;++r)o[d_][r]*=wsf[crow(r,hi)]; } }while(0)
  f32x16 pA0,pA1,pB0,pB1;
  int sl_prev=0,sl_cur=0,sl_next=SLOTB;
  #define ROT() do{sl_prev=sl_cur;sl_cur=sl_next;sl_next=(sl_next==(NSLOT-1)*SLOTB)?0:sl_next+SLOTB;}while(0)
  DMA_K(2,2*SLOTB);
  WAIT_BAR(3);
  qkt(pA0,pA1,Kbase,qr,negm,r32,hi);asm volatile("s_nop 15\n\ts_nop 7":"+v"(pA0),"+v"(pA1));CMASK(pA0,pA1,0);
  START(pA0,pA1);
  _Pragma("unroll") for(int r=0;r<16;++r)pA1[r]=__builtin_amdgcn_exp2f(pA1[r]);
  WAIT_BAR(0);
  DMA_K(3,0);DMA_V(1,SLOTB);
  ROT();
  kload8(kf,kp0+sl_cur);
  WAIT_BAR(2);
  s16x4 vlo[8],vhi[8]; u32x4 pw0,pw1,pw2,pw3;
  #define PKW(P,B) cvtpk_s(P[B],P[B+1])
  #define PAF(k) __builtin_bit_cast(bf16x8,pw##k)
  #define VFR(i) (bf16x8){vlo[i][0],vlo[i][1],vlo[i][2],vlo[i][3],vhi[i][0],vhi[i][1],vhi[i][2],vhi[i][3]}
  #define PIN(x) asm volatile("":"+v"(x))
  #define MX3(a,b,c) __builtin_fmaxf(__builtin_fmaxf((a),(b)),(c))
  #define GAPA(MF,A0,A1,A2,A3,W0,W1,PW) do{ MF; sacc+=A0; sacc+=A1; sacc+=A2; sacc+=A3; PIN(sacc); W0; W1; PIN(PW); SBAR(); }while(0)
  #define EX(v) __builtin_amdgcn_exp2f(v)
  #define GAPB(MF,X,B) do{ MF; X[B]=EX(X[B]); X[B+1]=EX(X[B+1]); X[B+2]=EX(X[B+2]); X[B+3]=EX(X[B+3]); PIN(X); SBAR(); }while(0)
  #define VRD(i) do{ vlo[i]=vtr(vp_+(((i)>>2)*4096+((i)&3)*1024)); vhi[i]=vtr(vp_+(((i)>>2)*4096+((i)&3)*1024+512)); }while(0)
  #define KRD(G,j) do{ if(G){ kload2(kf,kp0+sl_next,j); SBAR(); } }while(0)
  #define STEP(C0,C1,P0,P1,t,GK,GV,GL) do{ SBAR(); \
    const lds_cptr vp_=vp0+sl_prev; \
    VRD(0); SBAR(); float sacc=(P0[0]+P0[1]); \
    GAPA(C0=__builtin_amdgcn_mfma_f32_32x32x16_bf16(kf[0],qr[0],negm,0,0,0), P0[2],P0[3],P0[4],P0[5],     pw0[0]=PKW(P0,0), pw0[1]=PKW(P0,2), pw0); \
    VRD(4); SBAR(); GAPA(C1=__builtin_amdgcn_mfma_f32_32x32x16_bf16(kf[1],qr[0],negm,0,0,0), P0[6],P0[7],P0[8],P0[9],     pw0[2]=PKW(P0,4), pw0[3]=PKW(P0,6), pw0); \
    VRD(1); SBAR(); GAPA(C0=__builtin_amdgcn_mfma_f32_32x32x16_bf16(kf[2],qr[1],C0,0,0,0),   P0[10],P0[11],P0[12],P0[13], pw1[0]=PKW(P0,8), pw1[1]=PKW(P0,10), pw1); \
    VRD(5); SBAR(); GAPA(C1=__builtin_amdgcn_mfma_f32_32x32x16_bf16(kf[3],qr[1],C1,0,0,0),   P0[14],P0[15],P1[0],P1[1],   pw1[2]=PKW(P0,12),pw1[3]=PKW(P0,14), pw1); \
    VRD(2); SBAR(); GAPA(C0=__builtin_amdgcn_mfma_f32_32x32x16_bf16(kf[4],qr[2],C0,0,0,0),   P1[2],P1[3],P1[4],P1[5],     pw2[0]=PKW(P1,0), pw2[1]=PKW(P1,2), pw2); \
    VRD(6); SBAR(); GAPA(C1=__builtin_amdgcn_mfma_f32_32x32x16_bf16(kf[5],qr[2],C1,0,0,0),   P1[6],P1[7],P1[8],P1[9],     pw2[2]=PKW(P1,4), pw2[3]=PKW(P1,6), pw2); \
    VRD(3); SBAR(); GAPA(C0=__builtin_amdgcn_mfma_f32_32x32x16_bf16(kf[6],qr[3],C0,0,0,0),   P1[10],P1[11],P1[12],P1[13], pw3[0]=PKW(P1,8), pw3[1]=PKW(P1,10), pw3); \
    VRD(7); SBAR(); GAPA(C1=__builtin_amdgcn_mfma_f32_32x32x16_bf16(kf[7],qr[3],C1,0,0,0),   P1[14],P1[15],0.f,0.f,       pw3[2]=PKW(P1,12),pw3[3]=PKW(P1,14), pw3); \
    l_reg+=sacc; \
    if(GK){DMA_K((t)+3,sl_cur);} if(GV){DMA_V((t)+1,sl_next);} \
    CMASK(C0,C1,t); \
    { float a=MX3(C0[0],C0[1],C1[0]),b=MX3(C0[2],C0[3],C1[1]); a=MX3(a,C1[2],C1[3]); \
      _Pragma("unroll") for(int r=4;r<16;r+=4){a=MX3(a,C0[r],C0[r+1]);b=MX3(b,C0[r+2],C0[r+3]);a=MX3(a,C1[r],C1[r+1]);b=MX3(b,C1[r+2],C1[r+3]);} \
      float rm=__builtin_fmaxf(a,b); { auto rr=__builtin_amdgcn_permlane32_swap(__float_as_uint(rm),__float_as_uint(rm),false,false); rm=__builtin_fmaxf(__uint_as_float(rr[0]),__uint_as_float(rr[1])); } \
      resc=false; \
      if(__builtin_expect(__any(rm>(float)THRL),0)){ const float dl=__builtin_fmaxf(rm,0.f); mhat+=dl; \
        _Pragma("unroll") for(int r=0;r<16;++r){C0[r]-=dl;C1[r]-=dl;} \
        _Pragma("unroll") for(int r=0;r<16;++r)negm[r]=-mhat; asm volatile("":"+v"(negm)); \
        const float f=__builtin_amdgcn_exp2f(-dl); l_reg*=f; if(hi==0)wsf[r32]=f; resc=true; } } \
    SBAR(); \
    GAPB(o[0]=__builtin_amdgcn_mfma_f32_32x32x16_bf16(PAF(0),VFR(0),o[0],0,0,0), C0,0); \
    GAPB(o[1]=__builtin_amdgcn_mfma_f32_32x32x16_bf16(PAF(0),VFR(4),o[1],0,0,0), C0,4); \
    KRD(GL,0); GAPB(o[0]=__builtin_amdgcn_mfma_f32_32x32x16_bf16(PAF(1),VFR(1),o[0],0,0,0), C0,8); \
    KRD(GL,1); GAPB(o[1]=__builtin_amdgcn_mfma_f32_32x32x16_bf16(PAF(1),VFR(5),o[1],0,0,0), C0,12); \
    KRD(GL,2); GAPB(o[0]=__builtin_amdgcn_mfma_f32_32x32x16_bf16(PAF(2),VFR(2),o[0],0,0,0), C1,0); \
    KRD(GL,3); GAPB(o[1]=__builtin_amdgcn_mfma_f32_32x32x16_bf16(PAF(2),VFR(6),o[1],0,0,0), C1,4); \
    GAPB(o[0]=__builtin_amdgcn_mfma_f32_32x32x16_bf16(PAF(3),VFR(3),o[0],0,0,0), C1,8); \
    GAPB(o[1]=__builtin_amdgcn_mfma_f32_32x32x16_bf16(PAF(3),VFR(7),o[1],0,0,0), C1,12); \
    }while(0)
  int t=1;
  #undef CMASK
  #define CMASK(P0,P1,t) do{}while(0)
  for(;t+5<NT;t+=2){
    STEP(pB0,pB1,pA0,pA1,t,true,true,true);     WAIT_BAR(2); RESC(); ROT();
    STEP(pA0,pA1,pB0,pB1,t+1,true,true,true);   WAIT_BAR(2); RESC(); ROT();
  }
  #undef CMASK
  #define CMASK(P0,P1,t) do{}while(0)
  #define ENDW(tt) do{ if((tt)+3<NT){WAIT_BAR(2);} else if((tt)+2<NT){WAIT_BAR(1);} else {WAIT_BAR(0);} }while(0)
  for(;t+1<NT;t+=2){
    STEP(pB0,pB1,pA0,pA1,t,(t+3<NT),(t+1<NT),(t+1<NT));       ENDW(t);   RESC(); ROT();
    STEP(pA0,pA1,pB0,pB1,t+1,(t+4<NT),(t+2<NT),(t+2<NT));     ENDW(t+1); RESC(); ROT();
  }
  STEP(pB0,pB1,pA0,pA1,NT-1,false,false,false); RESC();
  { float sacc=pB0[0]+pB0[1]; _Pragma("unroll") for(int r=2;r<16;++r)sacc+=pB0[r]; _Pragma("unroll") for(int r=0;r<16;++r)sacc+=pB1[r]; l_reg+=sacc;
    pw0=(u32x4){PKW(pB0,0),PKW(pB0,2),PKW(pB0,4),PKW(pB0,6)};pw1=(u32x4){PKW(pB0,8),PKW(pB0,10),PKW(pB0,12),PKW(pB0,14)};pw2=(u32x4){PKW(pB1,0),PKW(pB1,2),PKW(pB1,4),PKW(pB1,6)};pw3=(u32x4){PKW(pB1,8),PKW(pB1,10),PKW(pB1,12),PKW(pB1,14)};
    SBAR(); pv(o,vb0+sl_cur,PAF(0),PAF(1),PAF(2),PAF(3)); }
  #undef PKW
  #undef PAF
  #undef VFR
  #undef PIN
  #undef MX3
  #undef GAPA
  #undef GAPB
  #undef EX
  #undef VRD
  #undef KRD
  #undef STEP
  #undef ENDW
  {auto rr=__builtin_amdgcn_permlane32_swap(__float_as_uint(l_reg),__float_as_uint(l_reg),false,false);l_reg=__uint_as_float(rr[0])+__uint_as_float(rr[1]);}
  if(hi==0)wsf[32+r32]=l_reg;asm volatile("s_waitcnt lgkmcnt(0)":::"memory");
  float rli[16];
  #pragma unroll
  for(int r=0;r<16;++r)rli[r]=__builtin_amdgcn_rcpf(wsf[32+crow(r,hi)]);
  bf16*Ow=O0+(long)(wid*QBLK)*ldo;
  { bf16*stg=(bf16*)(shm+LDS_OST)+wid*2048;
    #pragma unroll
    for(int r=0;r<16;++r){const int orow=crow(r,hi);
      #pragma unroll
      for(int d0=0;d0<2;++d0)stg[orow*64+d0*32+r32]=__float2bfloat16(o[d0][r]*rli[r]);}
    asm volatile("s_waitcnt lgkmcnt(0)":::"memory");
    #pragma unroll
    for(int i=0;i<4;++i){const int row=i*8+(lane>>3),ch=lane&7; const u32x4 v=*(const u32x4*)(stg+row*64+ch*8); ATTN_STORE16(Ow+(long)row*ldo+ch*8,v);} }
  asm volatile("s_waitcnt lgkmcnt(0)\n\ts_barrier":::"memory");
  #undef DMA_K
  #undef DMA_V
  #undef CMASK
  #undef START
  #undef RESC
  #undef ROT
}
constexpr int ATTN_LDS_BYTES=LDS_BYTES;
#undef SBAR
#undef WAIT_BAR
}


constexpr int NWAVES = 8;
constexpr int DMODEL = 1024, NBATCH = 2, SEQL = 8192, CTXL = 256, RPB = SEQL + CTXL, MROWS = NBATCH * RPB, NLAYER = 2;
constexpr int DFF = 2816, NUP = 2 * DFF, INW = 5888, ZW = 5376, NMODV = 9, MODW = NMODV * DMODEL;
constexpr int ZQA = 0, ZKA = 512, ZVA = 640, ZQB = 768, ZKB = 1280, ZVB = 1792, ZGATE = 2304;
constexpr int TPB = RPB / 256;
constexpr float EPSN = 1e-6f;
constexpr int HN = 4096;

constexpr size_t MiB = 1u << 20, KiB = 1024;
constexpr size_t WS_CTL = 0, CTL_ZERO_BYTES = 64 * KiB;
constexpr size_t WS_MOD = 1 * MiB;
constexpr size_t WS_CAS256 = 1 * MiB + 512 * KiB;
constexpr size_t WS_HC = 2 * MiB;
constexpr size_t WS_WUP0 = 4 * MiB, WS_WDN0 = 15 * MiB, WS_WUP1 = 20 * MiB + 512 * KiB, WS_WDN1 = 31 * MiB + 512 * KiB;
constexpr size_t WS_WIN = 37 * MiB, WS_WC = 47 * MiB + 512 * KiB, WS_WBR = 48 * MiB + 512 * KiB, WS_WOUT = 51 * MiB + 512 * KiB;
constexpr size_t WS_HN = 54 * MiB;
constexpr size_t WS_Z = 87 * MiB;
constexpr size_t WS_T1T = 261 * MiB;
constexpr size_t WS_T2 = 278 * MiB;
constexpr size_t WS_PQ = 295 * MiB;
constexpr size_t WS_CAS = 311 * MiB;
constexpr size_t WS_END = 343 * MiB;
static_assert(WS_Z + (size_t)MROWS * ZW * 2 <= WS_T1T && WS_HN + (size_t)MROWS * DMODEL * 2 <= WS_Z && WS_WOUT + 2 * MiB <= WS_HN, "ws map");
constexpr int CW_BAR = 4096;
constexpr int CW_Q = 1024;

constexpr int LDS_BYTES = 147456, MISC_OFF = 131072 + 320;

#define GAS __attribute__((address_space(1)))
#define LAS __attribute__((address_space(3)))
typedef unsigned short bf16;
typedef unsigned v4u __attribute__((ext_vector_type(4)));
typedef float f32x4 __attribute__((ext_vector_type(4)));
#define LDS_WAIT() asm volatile("s_waitcnt lgkmcnt(0)" ::: "memory")

__device__ __forceinline__ float bf2f(unsigned v) { return __uint_as_float(v << 16); }
__device__ __forceinline__ float bflo(unsigned w) { return __uint_as_float(w << 16); }
__device__ __forceinline__ float bfhi(unsigned w) { return __uint_as_float(w & 0xffff0000u); }
__device__ __forceinline__ unsigned pk2(float lo, float hi) { return pg8::cvt_pk_bf16(lo, hi); }
__device__ __forceinline__ float fexp(float x) { return __builtin_amdgcn_exp2f(x * 1.4426950408889634f); }
__device__ __forceinline__ float sigm(float x) { return __builtin_amdgcn_rcpf(1.0f + fexp(-x)); }
__device__ __forceinline__ float siluf(float x) { return x * sigm(x); }
__device__ __forceinline__ float wave_sum(float v) {
#pragma unroll
    for (int o = 1; o < 64; o <<= 1) v += __shfl_xor(v, o);
    return v;
}

namespace pg8 {
struct EpiStore {
    static constexpr bool PERM = true, AFTER_DRAIN = false;
    bf16_t* O; int ldc; int sig_from; int rbase, rmul;
    __device__ __forceinline__ void operator()(const f32x4 (&acc)[2][2][4][2], const Unit& u, int wr, int wc, int fr, int fq) const {
        const int row0 = u.pm * BM + wr * 64 + fr, col0 = u.pn * BM + wc * 32 + 8 * fq;
        const bool sg = (u.pn * BM) >= sig_from;
#pragma unroll
        for (int ai = 0; ai < 2; ++ai)
#pragma unroll
            for (int m = 0; m < 4; ++m) { const int row = row0 + ai * HALF + m * 16; bf16_t* rowp = O + (size_t)(rbase + row * rmul) * ldc + col0;
#pragma unroll
                for (int bj = 0; bj < 2; ++bj) { f32x4 v0 = acc[ai][bj][m][0], v1 = acc[ai][bj][m][1];
                    if (sg) { v0[0] = sigm(v0[0]); v0[1] = sigm(v0[1]); v0[2] = sigm(v0[2]); v0[3] = sigm(v0[3]); v1[0] = sigm(v1[0]); v1[1] = sigm(v1[1]); v1[2] = sigm(v1[2]); v1[3] = sigm(v1[3]); }
                    u32x4 w; w.x = cvt_pk_bf16(v0[0], v0[1]); w.y = cvt_pk_bf16(v0[2], v0[3]); w.z = cvt_pk_bf16(v1[0], v1[1]); w.w = cvt_pk_bf16(v1[2], v1[3]);
                    *(u32x4*)(rowp + bj * HALF) = w; } }
    }
};
struct EpiSwiGLU {
    static constexpr bool PERM = true, AFTER_DRAIN = false;
    bf16_t* H; int ldc;
    __device__ __forceinline__ void operator()(const f32x4 (&acc)[2][2][4][2], const Unit& u, int wr, int wc, int fr, int fq) const {
        const int row0 = u.pm * BM + wr * 64 + fr, col0 = u.pn * HALF + wc * 32 + 8 * fq;
#pragma unroll
        for (int ai = 0; ai < 2; ++ai)
#pragma unroll
            for (int m = 0; m < 4; ++m) { const int row = row0 + ai * HALF + m * 16; bf16_t* rowp = H + (size_t)row * ldc + col0;
                const f32x4 g0 = acc[ai][0][m][0], g1 = acc[ai][0][m][1], u0 = acc[ai][1][m][0], u1 = acc[ai][1][m][1];
                u32x4 w; w.x = cvt_pk_bf16(siluf(g0[0]) * u0[0], siluf(g0[1]) * u0[1]); w.y = cvt_pk_bf16(siluf(g0[2]) * u0[2], siluf(g0[3]) * u0[3]);
                w.z = cvt_pk_bf16(siluf(g1[0]) * u1[0], siluf(g1[1]) * u1[1]); w.w = cvt_pk_bf16(siluf(g1[2]) * u1[2], siluf(g1[3]) * u1[3]);
                *(u32x4*)rowp = w; }
    }
};
struct EpiResid {
    static constexpr bool PERM = false, AFTER_DRAIN = false;
    const float* base_lat; const float* base_ctx; float* out_lat; float* out_ctx; const float* gate; float scale;
    __device__ __forceinline__ void operator()(const f32x4 (&acc)[2][2][4][2], const Unit& u, int wr, int wc, int fr, int fq) const {
        const int b = u.pm / 33, w = u.pm % 33; const int set = (w == 0) ? 2 : b;
        const size_t toff = (w == 0) ? (size_t)b * 256 * 1024 : ((size_t)b * 8192 + (size_t)(w - 1) * 256) * 1024;
        const float* base = ((w == 0) ? base_ctx : base_lat) + toff; float* out = ((w == 0) ? out_ctx : out_lat) + toff;
        const int col0 = u.pn * BM + wc * 32 + 4 * fq; const float* gp = gate + set * 9216 + col0;
#pragma unroll
        for (int bj = 0; bj < 2; ++bj)
#pragma unroll
            for (int n = 0; n < 2; ++n) { const f32x4 gv = *(const f32x4*)(gp + bj * HALF + n * 16) * scale;
#pragma unroll
                for (int ai = 0; ai < 2; ++ai) {
#pragma unroll
                    for (int m = 0; m < 4; ++m) { const size_t off = (size_t)(ai * HALF + wr * 64 + m * 16 + fr) * 1024 + col0 + bj * HALF + n * 16;
                        const f32x4 bs = *(const f32x4*)(base + off); *(f32x4*)(out + off) = bs + gv * acc[ai][bj][m][n]; }
                    asm volatile("" ::: "memory"); } }
    }
};
struct EpiMerge {
    static constexpr bool PERM = true, AFTER_DRAIN = false;
    const bf16_t* Z; bf16_t* Mo;
    __device__ __forceinline__ void operator()(const f32x4 (&acc)[2][2][4][2], const Unit& u, int wr, int wc, int fr, int fq) const {
        const int br = u.pn >> 2, ct = u.pn & 3;
        const int row0 = u.pm * BM + wr * 64 + fr, col0 = ct * BM + wc * 32 + 8 * fq;
#pragma unroll
        for (int ai = 0; ai < 2; ++ai)
#pragma unroll
            for (int m = 0; m < 4; ++m) { const int row = row0 + ai * HALF + m * 16; const bf16_t* gp = Z + (size_t)row * 5376 + 2304 + br * 1024 + col0; bf16_t* mp = Mo + (size_t)row * 1024 + col0;
#pragma unroll
                for (int bj = 0; bj < 2; ++bj) { const u32x4 gw = *(const u32x4*)(gp + bj * HALF); const f32x4 a0 = acc[ai][bj][m][0], a1 = acc[ai][bj][m][1];
                    float r0 = __uint_as_float(gw.x << 16) * a0[0], r1 = __uint_as_float(gw.x & 0xffff0000u) * a0[1], r2 = __uint_as_float(gw.y << 16) * a0[2], r3 = __uint_as_float(gw.y & 0xffff0000u) * a0[3];
                    float r4 = __uint_as_float(gw.z << 16) * a1[0], r5 = __uint_as_float(gw.z & 0xffff0000u) * a1[1], r6 = __uint_as_float(gw.w << 16) * a1[2], r7 = __uint_as_float(gw.w & 0xffff0000u) * a1[3];
                    if (br > 0) { const u32x4 ow = *(const u32x4*)(mp + bj * HALF);
                        r0 += __uint_as_float(ow.x << 16); r1 += __uint_as_float(ow.x & 0xffff0000u); r2 += __uint_as_float(ow.y << 16); r3 += __uint_as_float(ow.y & 0xffff0000u);
                        r4 += __uint_as_float(ow.z << 16); r5 += __uint_as_float(ow.z & 0xffff0000u); r6 += __uint_as_float(ow.w << 16); r7 += __uint_as_float(ow.w & 0xffff0000u); }
                    u32x4 w; w.x = cvt_pk_bf16(r0, r1); w.y = cvt_pk_bf16(r2, r3); w.z = cvt_pk_bf16(r4, r5); w.w = cvt_pk_bf16(r6, r7);
                    *(u32x4*)(mp + bj * HALF) = w; } }
    }
};
struct MergeOrder {
    int G, c;
    __device__ bool next(int i, Unit& u) const { const int grp = (i / 3) * G + c; if (grp >= 264) return false; u.pm = grp >> 2; u.pn = (grp & 3) + 4 * (i % 3); return true; }
    __device__ __forceinline__ void a_ready(const Unit&) const {}
    __device__ __forceinline__ void done(const Unit&) const {}
    __device__ __forceinline__ size_t aoff(const Unit& u) const { const int br = u.pn >> 2; return (size_t)(br == 0 ? 0 : (br == 1 ? 768 : 1280)) * 2; }
    __device__ __forceinline__ size_t boff(const Unit&) const { return 0; }
};
struct OneUnit {
    int pm, pn;
    __device__ bool next(int i, Unit& u) const { if (i) return false; u.pm = pm; u.pn = pn; return true; }
    __device__ __forceinline__ void a_ready(const Unit&) const {}
    __device__ __forceinline__ void done(const Unit&) const {}
    __device__ __forceinline__ size_t aoff(const Unit&) const { return 0; }
    __device__ __forceinline__ size_t boff(const Unit&) const { return 0; }
};
}

#define XB_TMO      128
#define XB_XCNT(j)  (256  + 64 * (j))
#define XB_XSUB(j)  (1280 + 64 * (j))
#define XB_XGEN(j)  (2304 + 64 * (j))
#define XB_TOP      3328
#define XB_TOPGEN   3392
#define XCD_BAR_WORDS 3456
#define XB_SPIN_CAP (1u << 18)

__device__ __forceinline__ unsigned xb_ld(unsigned* p)              { return __hip_atomic_load(p, __ATOMIC_RELAXED, __HIP_MEMORY_SCOPE_AGENT); }
__device__ __forceinline__ unsigned xb_add(unsigned* p, unsigned v) { return __hip_atomic_fetch_add(p, v, __ATOMIC_RELAXED, __HIP_MEMORY_SCOPE_AGENT); }
__device__ __forceinline__ unsigned xb_xcc_id() { return (unsigned)__builtin_amdgcn_s_getreg((3 << 11) | 20) & 0xFu; }
#define XB_SPIN(cond, bar) do { unsigned _sp = 0; while (cond) { __builtin_amdgcn_s_sleep(1); \
    if ((++_sp & 255u) == 0u) { if (xb_ld(&(bar)[XB_TMO])) break; if (_sp > XB_SPIN_CAP) { atomicAdd(&(bar)[XB_TMO], 1u); break; } } } } while (0)

struct XcdBarrier {
    unsigned* bar; unsigned x;
    volatile LAS unsigned* st;
};

__device__ __forceinline__ XcdBarrier xcd_barrier_post(unsigned* bar, volatile LAS unsigned* st) {
    XcdBarrier b; b.bar = bar; b.x = xb_xcc_id(); b.st = st;
    if (threadIdx.x == 0) (void)xb_add(&bar[XB_XCNT(b.x)], 1u);
    return b;
}
__device__ __forceinline__ void xcd_barrier_complete(unsigned* bar, unsigned x, unsigned& nloc, unsigned& nx) {
    const unsigned G = gridDim.x * gridDim.y * gridDim.z;
    unsigned sum, cnt, mine, sp = 0u;
    for (;;) {
        sum = 0u; cnt = 0u; mine = 0u;
#pragma unroll
        for (unsigned j = 0; j < 16; ++j) { const unsigned c = xb_ld(&bar[XB_XCNT(j)]); sum += c; cnt += (c > 0u) ? 1u : 0u; mine = (j == x) ? c : mine; }
        if (sum == G) break;
        __builtin_amdgcn_s_sleep(1);
        if ((++sp & 255u) == 0u) { if (xb_ld(&bar[XB_TMO])) break; if (sp > XB_SPIN_CAP) { atomicAdd(&bar[XB_TMO], 1u); break; } }
    }
    nloc = mine > 0u ? mine : 1u; nx = cnt > 0u ? cnt : 1u;
}

__device__ __forceinline__ void xcd_barrier(const XcdBarrier& b) {
    asm volatile("s_waitcnt vmcnt(0)" ::: "memory");
    __syncthreads();
    if (threadIdx.x == 0) {
        unsigned* bar = b.bar;
        __builtin_amdgcn_s_waitcnt(0);
        unsigned nloc = b.st[0], nx = b.st[1];
        if (nloc == 0u) { xcd_barrier_complete(bar, b.x, nloc, nx); b.st[0] = nloc; b.st[1] = nx; }
        const unsigned old = xb_add(&bar[XB_XSUB(b.x)], 1u);
        const unsigned gen = old / nloc;
        if (old + 1u == (gen + 1u) * nloc) {
            __builtin_amdgcn_fence(__ATOMIC_RELEASE, "agent");
            asm volatile("s_waitcnt vmcnt(0)" ::: "memory");
            const unsigned og = xb_add(&bar[XB_TOP], 1u);
            const unsigned tg = og / nx;
            if (og + 1u == (tg + 1u) * nx) xb_add(&bar[XB_TOPGEN], 1u);
            else XB_SPIN(xb_ld(&bar[XB_TOPGEN]) == tg, bar);
            __builtin_amdgcn_fence(__ATOMIC_ACQUIRE, "agent");
            xb_add(&bar[XB_XGEN(b.x)], 1u);
            asm volatile("s_waitcnt vmcnt(0)" ::: "memory");
        } else {
            XB_SPIN(xb_ld(&bar[XB_XGEN(b.x)]) == gen, bar);
            __builtin_amdgcn_fence(__ATOMIC_ACQUIRE, "agent");
            asm volatile("s_waitcnt vmcnt(0)" ::: "memory");
        }
    }
    __syncthreads();
}

struct Frame {
    LAS unsigned char* lds; volatile LAS unsigned* MISC; unsigned* ctl;
    int tid, lane, wave, G, bid;
    const float *x, *c, *ctx, *cctx, *w_ada, *b_ada, *norm_g, *ffn_wi, *ffn_wo, *w_in, *qk_g, *diff_lam, *subln_g, *w_branch, *w_out;
    float* out; unsigned char* ws;
};
#define WSP(T, off) ((T*)(F.ws + (off)))

__device__ __forceinline__ void transpose_item(const float* W, int N, bf16* WT, int ldt, int k0, int n0, int dst_row0, LAS float* scr, int lane) {
#pragma unroll 8
    for (int i = 0; i < 32; ++i) { const int kk = 2 * i + (lane >> 5); scr[kk * 33 + (lane & 31)] = W[(size_t)(k0 + kk) * N + n0 + (lane & 31)]; }
    LDS_WAIT(); asm volatile("" ::: "memory");
    const int c = lane & 7;
#pragma unroll
    for (int j = 0; j < 4; ++j) { const int n = (lane >> 3) + 8 * j; const LAS float* s = scr + (8 * c) * 33 + n;
        v4u o; o.x = pk2(s[0 * 33], s[1 * 33]); o.y = pk2(s[2 * 33], s[3 * 33]); o.z = pk2(s[4 * 33], s[5 * 33]); o.w = pk2(s[6 * 33], s[7 * 33]);
        *(v4u*)(WT + (size_t)(dst_row0 + n) * ldt + k0 + 8 * c) = o; }
    LDS_WAIT(); asm volatile("" ::: "memory");
}
__device__ __forceinline__ void convert_weights(Frame& F, int l) {
    LAS float* scr = (LAS float*)(F.lds + F.wave * 16384);
    const int gw = F.bid * NWAVES + F.wave, NGW = F.G * NWAVES;
    constexpr int I_UP = 16 * 176, I_DN = 44 * 32, I_IN = 16 * 184, I_BR = 8 * 32, I_OUT = 16 * 32;
    constexpr int NITEMS = 2 * I_UP + 2 * I_DN + I_IN + 3 * I_BR + I_OUT;
    const float* wi = F.ffn_wi + (size_t)l * 2 * 1024 * NUP; const float* wo = F.ffn_wo + (size_t)l * 2 * DFF * 1024;
    const float* win = F.w_in + (size_t)l * 1024 * INW; const float* wbr = F.w_branch + (size_t)l * 3 * 512 * 1024; const float* wout = F.w_out + (size_t)l * 1024 * 1024;
    for (int it = gw; it < NITEMS; it += NGW) {
        int r = it;
        if (r < 2 * I_UP) { const int h = r / I_UP; r -= h * I_UP; const int kb = r / 176, nb = r % 176; int n0 = nb * 32; const int isu = n0 >= DFF; const int nn = n0 - isu * DFF;
            transpose_item(wi + (size_t)h * 1024 * NUP, NUP, WSP(bf16, h ? WS_WUP1 : WS_WUP0), 1024, kb * 64, n0, (nn / 128) * 256 + isu * 128 + (nn % 128), scr, F.lane); continue; }
        r -= 2 * I_UP;
        if (r < 2 * I_DN) { const int h = r / I_DN; r -= h * I_DN; const int kb = r / 32, nb = r % 32;
            transpose_item(wo + (size_t)h * DFF * 1024, 1024, WSP(bf16, h ? WS_WDN1 : WS_WDN0), DFF, kb * 64, nb * 32, nb * 32, scr, F.lane); continue; }
        r -= 2 * I_DN;
        if (r < I_IN) { const int kb = r / 184, nb = r % 184; const int n0 = nb * 32;
            if (n0 >= 2304 && n0 < 2816) continue;
            transpose_item(win, INW, WSP(bf16, WS_WIN), 1024, kb * 64, n0, n0 < 2304 ? n0 : n0 - 512, scr, F.lane); continue; }
        r -= I_IN;
        if (r < 3 * I_BR) { const int i = r / I_BR; r -= i * I_BR; const int kb = r / 32, nb = r % 32;
            transpose_item(wbr + (size_t)i * 512 * 1024, 1024, WSP(bf16, WS_WBR), 512, kb * 64, nb * 32, i * 1024 + nb * 32, scr, F.lane); continue; }
        r -= 3 * I_BR;
        { const int kb = r / 32, nb = r % 32; transpose_item(wout, 1024, WSP(bf16, WS_WOUT), 1024, kb * 64, nb * 32, nb * 32, scr, F.lane); }
    }
    {
        const int t = F.bid * 512 + F.tid;
        if (t < 65536) {
            const int jl = t & 63, rest = t >> 6, kc = rest & 127, rj = rest >> 7; const int row = rj * 64 + jl, g = row >> 7, j = row & 127;
            float a[8];
#pragma unroll
            for (int e = 0; e < 8; ++e) a[e] = 0.f;
            const float* wp = win + (size_t)(kc * 8) * INW + 2304 + g * 128;
            for (int c4 = 0; c4 < 32; ++c4) {
                float cs[4];
#pragma unroll
                for (int q = 0; q < 4; ++q) { const int idx = ((c4 * 4 + q) * j) & 127; float sn, co; sincospif((float)idx * (1.0f / 64.0f), &sn, &co); cs[q] = sn + co; }
#pragma unroll
                for (int e = 0; e < 8; ++e) { const f32x4 w = *(const f32x4*)(wp + (size_t)e * INW + c4 * 4); a[e] += w[0] * cs[0] + w[1] * cs[1] + w[2] * cs[2] + w[3] * cs[3]; }
            }
            v4u o; o.x = pk2(a[0], a[1]); o.y = pk2(a[2], a[3]); o.z = pk2(a[4], a[5]); o.w = pk2(a[6], a[7]);
            *(v4u*)(WSP(bf16, WS_WC) + (size_t)row * 1024 + kc * 8) = o;
        }
    }
}
__device__ __forceinline__ void make_cas(Frame& F) {
    const int t0 = F.bid * 512 + F.tid, NT_ = F.G * 512;
    for (int it = t0; it < HN * HN / 8; it += NT_) { const int k = it >> 9, n0 = (it & 511) * 8; float v[8];
#pragma unroll
        for (int e = 0; e < 8; ++e) { const int idx = (k * (n0 + e)) & (HN - 1); float sn, co; sincospif((float)idx * (2.0f / HN), &sn, &co); v[e] = sn + co; }
        v4u o; o.x = pk2(v[0], v[1]); o.y = pk2(v[2], v[3]); o.z = pk2(v[4], v[5]); o.w = pk2(v[6], v[7]);
        *(v4u*)(WSP(bf16, WS_CAS) + (size_t)k * HN + n0) = o; }
    for (int it = t0; it < 256 * 256 / 8; it += NT_) { const int k = it >> 5, n0 = (it & 31) * 8; float v[8];
#pragma unroll
        for (int e = 0; e < 8; ++e) { const int idx = (k * (n0 + e)) & 255; float sn, co; sincospif((float)idx * (1.0f / 128.0f), &sn, &co); v[e] = sn + co; }
        v4u o; o.x = pk2(v[0], v[1]); o.y = pk2(v[2], v[3]); o.z = pk2(v[4], v[5]); o.w = pk2(v[6], v[7]);
        *(v4u*)(WSP(bf16, WS_CAS256) + (size_t)k * 256 + n0) = o; }
}
__device__ __forceinline__ void make_mod(Frame& F) {
    LAS float* red = (LAS float*)F.lds;
    for (int item = F.bid; item < 288; item += F.G) {
        const int l = item / 144, cb = item % 144;
        const int c4 = F.lane & 15, ks = F.lane >> 4, slice = F.wave * 4 + ks;
        const float* W = F.w_ada + (size_t)l * 1024 * MODW + cb * 64 + c4 * 4;
        f32x4 a0 = {0.f, 0.f, 0.f, 0.f}, a1 = a0, a2 = a0;
        for (int r = 0; r < 32; ++r) { const int k = slice * 32 + r; const f32x4 w = *(const f32x4*)(W + (size_t)k * MODW);
            const float s0 = siluf(F.c[k]), s1 = siluf(F.c[1024 + k]), s2 = siluf(F.cctx[k]); a0 += w * s0; a1 += w * s1; a2 += w * s2; }
#pragma unroll
        for (int q = 0; q < 4; ++q) { red[(slice * 3 + 0) * 64 + c4 * 4 + q] = a0[q]; red[(slice * 3 + 1) * 64 + c4 * 4 + q] = a1[q]; red[(slice * 3 + 2) * 64 + c4 * 4 + q] = a2[q]; }
        __syncthreads();
        if (F.tid < 192) { const int set = F.tid >> 6, col = F.tid & 63; float s = 0.f;
            for (int sl = 0; sl < 32; ++sl) s += red[(sl * 3 + set) * 64 + col];
            WSP(float, WS_MOD)[((size_t)l * 3 + set) * MODW + cb * 64 + col] = s + F.b_ada[(size_t)l * MODW + cb * 64 + col]; }
        __syncthreads();
    }
}
__device__ __forceinline__ const float* hrow_ptr(const float* lat, const float* ctxp, int row, int& set) {
    const int b = row / RPB, w = row % RPB;
    if (w < CTXL) { set = 2; return ctxp + ((size_t)b * CTXL + w) * 1024; }
    set = b; return lat + ((size_t)b * SEQL + (w - CTXL)) * 1024;
}
__device__ __forceinline__ void norm_mod(Frame& F, const float* lat, const float* ctxp, const float* g, const float* modl  , int ishift) {
    const int gw = F.bid * NWAVES + F.wave, NGW = F.G * NWAVES;
    for (int row = gw; row < MROWS; row += NGW) {
        int set; const float* hr = hrow_ptr(lat, ctxp, row, set);
        const float* sh = modl + (size_t)set * MODW + ishift * 1024; const float* sc = sh + 1024;
        f32x4 v[4]; float ss = 0.f;
#pragma unroll
        for (int j = 0; j < 4; ++j) { v[j] = *((const f32x4*)hr + F.lane + 64 * j); ss += (v[j][0] * v[j][0] + v[j][1] * v[j][1]) + (v[j][2] * v[j][2] + v[j][3] * v[j][3]); }
        const float rstd = 1.0f / sqrtf(wave_sum(ss) * (1.0f / 1024.0f) + EPSN);
        unsigned long long* o8 = (unsigned long long*)(WSP(bf16, WS_HN) + (size_t)row * 1024) + F.lane;
#pragma unroll
        for (int j = 0; j < 4; ++j) { const f32x4 gg = *((const f32x4*)g + F.lane + 64 * j), s1 = *((const f32x4*)sc + F.lane + 64 * j), s0 = *((const f32x4*)sh + F.lane + 64 * j);
            const f32x4 y = v[j] * rstd * gg * (s1 + 1.0f) + s0;
            o8[64 * j] = (unsigned long long)pk2(y[0], y[1]) | ((unsigned long long)pk2(y[2], y[3]) << 32); }
    }
}
__device__ __forceinline__ void qk_rope(Frame& F, int l) {
    const int gw = F.bid * NWAVES + F.wave, NGW = F.G * NWAVES;
    const float* qg = F.qk_g + (size_t)l * 256;
    const int i = F.lane & 31, half = F.lane >> 5;
    const float inv = exp2f(-(float)(i & 15) * (13.287712379549449f / 16.0f));
    for (int row = gw; row < MROWS; row += NGW) {
        const int w = row % RPB; float cs = 1.f, sn = 0.f;
        if (w >= CTXL) { const int s = w - CTXL; const float pos = (float)((i < 16) ? (s >> 6) : (s & 63)); sincosf(pos * inv, &sn, &cs); }
        bf16* zr = WSP(bf16, WS_Z) + (size_t)row * ZW;
        for (int j = 0; j < 13; ++j) {
            const int hv = 2 * j + half; int col, gsel; bool isq;
            if (hv < 8) { col = ZQA + hv * 64; gsel = 0; isq = true; } else if (hv < 10) { col = ZKA + (hv - 8) * 64; gsel = 1; isq = false; }
            else if (hv < 18) { col = ZQB + (hv - 10) * 64; gsel = 2; isq = true; } else { col = ZKB + (hv - 18) * 64; gsel = 3; isq = false; }
            const float x1 = bf2f(zr[col + i]), x2 = bf2f(zr[col + i + 32]);
            float ss = x1 * x1 + x2 * x2;
#pragma unroll
            for (int o = 1; o < 32; o <<= 1) ss += __shfl_xor(ss, o);
            const float rstd = 1.0f / sqrtf(ss * (1.0f / 64.0f) + EPSN);
            const float y1 = x1 * rstd * qg[gsel * 64 + i], y2 = x2 * rstd * qg[gsel * 64 + i + 32];
            float o1 = y1 * cs - y2 * sn, o2 = y1 * sn + y2 * cs;
            if (isq) { o1 *= attn_body::C2; o2 *= attn_body::C2; }
            const unsigned pw = pk2(o1, o2);
            zr[col + i] = (bf16)(pw & 0xffffu); zr[col + i + 32] = (bf16)(pw >> 16);
        }
    }
}
__device__ __forceinline__ void make_pq(Frame& F) {
    const int t0 = F.bid * 512 + F.tid, NT_ = F.G * 512;
    const bf16* T1 = WSP(bf16, WS_T1T); bf16* PQ = WSP(bf16, WS_PQ);
    for (int it = t0; it < 2 * 512 * HN; it += NT_) {
        const int n = it & (HN - 1), col = (it >> 12) & 511, b = it >> 21;
        const bf16* xr = T1 + (size_t)col * MROWS + b * RPB + CTXL;
        const int nm = (HN - n) & (HN - 1);
        const float x0 = bf2f(xr[n]), x1 = bf2f(xr[n + HN]), y0 = bf2f(xr[nm]), y1 = bf2f(xr[nm + HN]);
        float sn, co, snm, com; sincospif((float)n * (1.0f / HN), &sn, &co); sincospif((float)nm * (1.0f / HN), &snm, &com);
        const float p = x0 + x1, q = (x0 - x1) * co + (y0 - y1) * snm;
        PQ[((size_t)(b * 2 + 0) * 512 + col) * HN + n] = (bf16)(pk2(p, 0.f) & 0xffffu);
        PQ[((size_t)(b * 2 + 1) * 512 + col) * HN + n] = (bf16)(pk2(q, 0.f) & 0xffffu);
    }
}
__device__ __forceinline__ void post_mix(Frame& F, int l) {
    const int gw = F.bid * NWAVES + F.wave, NGW = F.G * NWAVES;
    const float lam_init = 0.8f - 0.6f * expf(-0.3f * (float)l);
    const float* dl = F.diff_lam + (size_t)l * 256;
    const float s1 = wave_sum(dl[F.lane] * dl[64 + F.lane]), s2 = wave_sum(dl[128 + F.lane] * dl[192 + F.lane]);
    const float lam = expf(s1) - expf(s2) + lam_init;
    const float* sg = F.subln_g + (size_t)l * 128 + (F.lane & 15) * 8;
    float gsc[8];
#pragma unroll
    for (int e = 0; e < 8; ++e) gsc[e] = sg[e] * (1.0f - lam_init);
    const bf16* OB = WSP(bf16, WS_HN); const bf16* T2 = WSP(bf16, WS_T2); bf16* Z = WSP(bf16, WS_Z);
    for (int row = gw; row < MROWS; row += NGW) {
        const int b = row / RPB, w = row % RPB;
        {
            const v4u a = *(const v4u*)(OB + (size_t)row * 1024 + F.lane * 8), c2 = *(const v4u*)(OB + (size_t)row * 1024 + 512 + F.lane * 8);
            float d[8];
            d[0] = bflo(a.x) - lam * bflo(c2.x); d[1] = bfhi(a.x) - lam * bfhi(c2.x); d[2] = bflo(a.y) - lam * bflo(c2.y); d[3] = bfhi(a.y) - lam * bfhi(c2.y);
            d[4] = bflo(a.z) - lam * bflo(c2.z); d[5] = bfhi(a.z) - lam * bfhi(c2.z); d[6] = bflo(a.w) - lam * bflo(c2.w); d[7] = bfhi(a.w) - lam * bfhi(c2.w);
            float ss = 0.f;
#pragma unroll
            for (int e = 0; e < 8; ++e) ss += d[e] * d[e];
#pragma unroll
            for (int o = 1; o < 16; o <<= 1) ss += __shfl_xor(ss, o);
            const float rstd = 1.0f / sqrtf(ss * (1.0f / 128.0f) + EPSN);
            v4u o; o.x = pk2(d[0] * rstd * gsc[0], d[1] * rstd * gsc[1]); o.y = pk2(d[2] * rstd * gsc[2], d[3] * rstd * gsc[3]);
            o.z = pk2(d[4] * rstd * gsc[4], d[5] * rstd * gsc[5]); o.w = pk2(d[6] * rstd * gsc[6], d[7] * rstd * gsc[7]);
            *(v4u*)(Z + (size_t)row * ZW + ZQB + F.lane * 8) = o;
        }
        {
            int mrow; float sc;
            if (w < CTXL) { mrow = b * RPB + ((CTXL - w) & (CTXL - 1)); sc = 0.5f * 0.005524271728019903f; }
            else { const int s = w - CTXL; mrow = b * RPB + CTXL + ((SEQL - s) & (SEQL - 1)); sc = 1.0f / 2048.0f; }
            const int g = F.lane >> 4, j0 = (F.lane & 15) * 8;
            const bf16* rk = T2 + (size_t)row * 512 + g * 128; const v4u mv = *(const v4u*)(T2 + (size_t)mrow * 512 + g * 128 + j0);
            float r[8];
#pragma unroll
            for (int e = 0; e < 8; ++e) r[e] = bf2f(rk[(128 - (j0 + e)) & 127]);
            v4u o; o.x = pk2((r[0] + bflo(mv.x)) * sc, (r[1] + bfhi(mv.x)) * sc); o.y = pk2((r[2] + bflo(mv.y)) * sc, (r[3] + bfhi(mv.y)) * sc);
            o.z = pk2((r[4] + bflo(mv.z)) * sc, (r[5] + bfhi(mv.z)) * sc); o.w = pk2((r[6] + bflo(mv.w)) * sc, (r[7] + bfhi(mv.w)) * sc);
            *(v4u*)(Z + (size_t)row * ZW + ZKB + F.lane * 8) = o;
        }
    }
}
__device__ __forceinline__ void mixer_phase(Frame& F, int l) {
    constexpr int NHL = 128, NHC = 4, NAL = NBATCH * 24 * 32, NAC = NBATCH * 24, TOTAL = NHL + NHC + NAL + NAC;
    unsigned* qctr = F.ctl + CW_Q + 64 * l;
    bf16* Z = WSP(bf16, WS_Z);
    for (;;) {
        if (F.tid == 0) F.MISC[0] = __hip_atomic_fetch_add(qctr, 1u, __ATOMIC_RELAXED, __HIP_MEMORY_SCOPE_AGENT);
        __syncthreads();
        const int it = (int)F.MISC[0];
        __syncthreads();
        if (it >= TOTAL) break;
        if (it < NHL) {
            const int b = it >> 6, r = it & 63, par = r >> 5, r2 = r & 31;
            pg8::Gemm g{WSP(bf16, WS_CAS), WSP(bf16, WS_PQ) + (size_t)(b * 2 + par) * 512 * HN, HN, 512, HN, HN, HN};
            pg8::OneUnit S{r2 >> 1, r2 & 1};
            pg8::EpiStore E{WSP(bf16, WS_T2), 512, 1 << 30, b * RPB + CTXL + par, 2};
            pg8::gemm_phase<pg8::EpiStore, pg8::OneUnit, true, true>(F.lds, g, S, E);
        } else if (it < NHL + NHC) {
            const int r = it - NHL, b = r >> 1;
            pg8::Gemm g{WSP(bf16, WS_CAS256), WSP(bf16, WS_T1T) + (size_t)b * RPB, 256, 512, 256, 256, MROWS};
            pg8::OneUnit S{0, r & 1};
            pg8::EpiStore E{WSP(bf16, WS_T2), 512, 1 << 30, b * RPB, 1};
            pg8::gemm_phase<pg8::EpiStore, pg8::OneUnit, true, true>(F.lds, g, S, E);
        } else {
            int r = it - NHL - NHC, b, hu, qrow, nt;
            if (r < NAL) { const int qb = r & 31; r >>= 5; hu = r % 24; b = r / 24; qrow = b * RPB + CTXL + qb * 256; nt = RPB / 64; }
            else { r -= NAL; hu = r % 24; b = r / 24; qrow = b * RPB; nt = CTXL / 64; }
            const bf16 *Qp, *Kp, *Vp; bf16* Op; int po;
            if (hu < 8) { Qp = Z + ZQA + hu * 64; Kp = Z + ZKA + (hu >> 2) * 64; Vp = Z + ZVA + (hu >> 2) * 64; Op = Z + ZQA + hu * 64; po = ZW; }
            else { const int j = hu - 8, h = j >> 2, mm = (j >> 1) & 1, vh = j & 1; Qp = Z + ZQB + (h * 2 + mm) * 64; Kp = Z + ZKB + (h * 2 + mm) * 64; Vp = Z + ZVB + h * 128 + vh * 64;
                   Op = WSP(bf16, WS_HN) + mm * 512 + h * 128 + vh * 64; po = 1024; }
            const size_t kv0 = (size_t)b * RPB;
            attn_body::attn_unit<8>((const attn_body::bf16*)(Qp + (size_t)qrow * ZW), ZW, (const attn_body::bf16*)(Kp + kv0 * ZW), ZW, (const attn_body::bf16*)(Vp + kv0 * ZW), ZW,
                                    (attn_body::bf16*)(Op + (size_t)qrow * po), po, nt, (char*)F.lds);
        }
    }
}

#ifndef MK_PER_PHASE
#define MK_PER_PHASE 0
#endif
constexpr int NPHASE = 1 + 13 * NLAYER;
struct Args { const float* in[15]; float* out; unsigned char* ws; int ph_lo, ph_hi; };
__device__ __forceinline__ void load_frame(Frame& F) {
    const __attribute__((address_space(4))) Args* a = (const __attribute__((address_space(4))) Args*)__builtin_amdgcn_kernarg_segment_ptr();
    asm volatile("" : "+s"(a));
    extern __shared__ __attribute__((aligned(16))) unsigned char lds_raw[];
    F.lds = (LAS unsigned char*)lds_raw; F.MISC = (volatile LAS unsigned*)(F.lds + MISC_OFF);
    int t = threadIdx.x; asm volatile("" : "+v"(t));
    F.tid = t; F.lane = t & 63; F.wave = __builtin_amdgcn_readfirstlane(t >> 6); F.G = gridDim.x; F.bid = blockIdx.x;
    F.x = a->in[0]; F.c = a->in[1]; F.ctx = a->in[2]; F.cctx = a->in[3]; F.w_ada = a->in[4]; F.b_ada = a->in[5]; F.norm_g = a->in[6]; F.ffn_wi = a->in[7];
    F.ffn_wo = a->in[8]; F.w_in = a->in[9]; F.qk_g = a->in[10]; F.diff_lam = a->in[11]; F.subln_g = a->in[12]; F.w_branch = a->in[13]; F.w_out = a->in[14];
    F.out = a->out; F.ws = a->ws; F.ctl = (unsigned*)(a->ws + WS_CTL);
}
#ifndef MK_MASK
#define MK_MASK 0xffffffffu
#endif
#define EN(j) (((MK_MASK) >> (j)) & 1u)
__device__ __forceinline__ void seam_barrier() {
    const __attribute__((address_space(4))) Args* a = (const __attribute__((address_space(4))) Args*)__builtin_amdgcn_kernarg_segment_ptr();
    asm volatile("" : "+s"(a));
    extern __shared__ __attribute__((aligned(16))) unsigned char lds_raw[];
    XcdBarrier b; b.bar = (unsigned*)(a->ws + WS_CTL) + CW_BAR; b.x = xb_xcc_id(); b.st = (volatile LAS unsigned*)((LAS unsigned char*)lds_raw + MISC_OFF) + 8;
    xcd_barrier(b);
}
#define LF() Frame F; load_frame(F); float* hlat = F.out; float* hctx = WSP(float, WS_HC); const float* modl = WSP(float, WS_MOD) + (size_t)l * 3 * MODW; const float* ng = F.norm_g + (size_t)l * 3 * 1024; \
    const float* slat = (l == 0) ? F.x : hlat; const float* sctx = (l == 0) ? F.ctx : hctx; (void)hlat; (void)hctx; (void)modl; (void)ng; (void)slat; (void)sctx
__global__ void __launch_bounds__(NWAVES * 64, 2) mk_fwd(Args args) {
    cg::grid_group grid = cg::this_grid();
    const int lo = args.ph_lo, hi = args.ph_hi;
    if (hi - lo > 1) {
        extern __shared__ __attribute__((aligned(16))) unsigned char lds_raw[];
        volatile LAS unsigned* misc = (volatile LAS unsigned*)((LAS unsigned char*)lds_raw + MISC_OFF);
        if (threadIdx.x < 32) misc[threadIdx.x] = 0u;
        __syncthreads();
        (void)xcd_barrier_post((unsigned*)(args.ws + WS_CTL) + CW_BAR, misc + 8);
    }
#define IN(k) (lo <= (k) && (k) < hi)
#define SEAM(k) do { if (IN(k) && IN((k) + 1)) { if ((k) == 0) grid.sync(); else seam_barrier(); } } while (0)
    if (EN(0) && IN(0)) { const int l = 0; LF(); make_mod(F); convert_weights(F, 0); make_cas(F); }
    SEAM(0);
    for (int l = 0; l < NLAYER; ++l) {
        const int p0 = 1 + 13 * l;
        if (EN(1) && IN(p0 + 0)) { LF(); if (l > 0) convert_weights(F, l); norm_mod(F, slat, sctx, ng, modl, 0); }
        SEAM(p0 + 0);
        if (EN(2) && IN(p0 + 1)) { LF(); pg8::Gemm g{WSP(bf16, WS_HN), WSP(bf16, WS_WUP0), MROWS, NUP, 1024, 1024, 1024}; pg8::StaticOrder S; S.init(MROWS, NUP, F.G, F.bid);
            pg8::EpiSwiGLU E{WSP(bf16, WS_Z), DFF}; pg8::gemm_phase<pg8::EpiSwiGLU, pg8::StaticOrder, true, true>(F.lds, g, S, E); }
        SEAM(p0 + 1);
        if (EN(3) && IN(p0 + 2)) { LF(); pg8::Gemm g{WSP(bf16, WS_Z), WSP(bf16, WS_WDN0), MROWS, 1024, DFF, DFF, DFF}; pg8::StaticOrder S; S.init(MROWS, 1024, F.G, F.bid);
            pg8::EpiResid E{slat, sctx, hlat, hctx, modl + 2 * 1024, 0.5f}; pg8::gemm_phase<pg8::EpiResid, pg8::StaticOrder, true, true>(F.lds, g, S, E); }
        SEAM(p0 + 2);
        if (EN(4) && IN(p0 + 3)) { LF(); norm_mod(F, hlat, hctx, ng + 1024, modl, 3); }
        SEAM(p0 + 3);
        if (EN(5) && IN(p0 + 4)) { LF();
            { pg8::Gemm g{WSP(bf16, WS_HN), WSP(bf16, WS_WIN), MROWS, ZW, 1024, 1024, 1024}; pg8::StaticOrder S; S.init(MROWS, ZW, F.G, F.bid);
              pg8::EpiStore E{WSP(bf16, WS_Z), ZW, ZGATE, 0, 1}; pg8::gemm_phase<pg8::EpiStore, pg8::StaticOrder, true, true>(F.lds, g, S, E); }
            { pg8::Gemm g{WSP(bf16, WS_WC), WSP(bf16, WS_HN), 512, MROWS, 1024, 1024, 1024}; pg8::StaticOrder S; S.init(512, MROWS, F.G, F.G - 1 - F.bid);
              pg8::EpiStore E{WSP(bf16, WS_T1T), MROWS, 1 << 30, 0, 1}; pg8::gemm_phase<pg8::EpiStore, pg8::StaticOrder, true, true>(F.lds, g, S, E); }
        }
        SEAM(p0 + 4);
        if (EN(6) && IN(p0 + 5)) { LF(); qk_rope(F, l); make_pq(F); }
        SEAM(p0 + 5);
        if (EN(7) && IN(p0 + 6)) { LF(); mixer_phase(F, l); }
        SEAM(p0 + 6);
        if (EN(8) && IN(p0 + 7)) { LF(); post_mix(F, l); }
        SEAM(p0 + 7);
        if (EN(9) && IN(p0 + 8)) { LF(); pg8::Gemm g{WSP(bf16, WS_Z), WSP(bf16, WS_WBR), MROWS, 3072, 512, ZW, 512}; pg8::MergeOrder S{F.G, F.bid};
            pg8::EpiMerge E{WSP(bf16, WS_Z), WSP(bf16, WS_HN)}; pg8::gemm_phase<pg8::EpiMerge, pg8::MergeOrder, true, true>(F.lds, g, S, E); }
        SEAM(p0 + 8);
        if (EN(10) && IN(p0 + 9)) { LF(); pg8::Gemm g{WSP(bf16, WS_HN), WSP(bf16, WS_WOUT), MROWS, 1024, 1024, 1024, 1024}; pg8::StaticOrder S; S.init(MROWS, 1024, F.G, F.bid);
            pg8::EpiResid E{hlat, hctx, hlat, hctx, modl + 5 * 1024, 1.0f}; pg8::gemm_phase<pg8::EpiResid, pg8::StaticOrder, true, true>(F.lds, g, S, E); }
        SEAM(p0 + 9);
        if (EN(11) && IN(p0 + 10)) { LF(); norm_mod(F, hlat, hctx, ng + 2048, modl, 6); }
        SEAM(p0 + 10);
        if (EN(12) && IN(p0 + 11)) { LF(); pg8::Gemm g{WSP(bf16, WS_HN), WSP(bf16, WS_WUP1), MROWS, NUP, 1024, 1024, 1024}; pg8::StaticOrder S; S.init(MROWS, NUP, F.G, F.bid);
            pg8::EpiSwiGLU E{WSP(bf16, WS_Z), DFF}; pg8::gemm_phase<pg8::EpiSwiGLU, pg8::StaticOrder, true, true>(F.lds, g, S, E); }
        SEAM(p0 + 11);
        if (EN(13) && IN(p0 + 12)) { LF(); pg8::Gemm g{WSP(bf16, WS_Z), WSP(bf16, WS_WDN1), MROWS, 1024, DFF, DFF, DFF}; pg8::StaticOrder S; S.init(MROWS, 1024, F.G, F.bid);
            pg8::EpiResid E{hlat, hctx, hlat, hctx, modl + 8 * 1024, 0.5f}; pg8::gemm_phase<pg8::EpiResid, pg8::StaticOrder, true, true>(F.lds, g, S, E); }
        SEAM(p0 + 12);
    }
#undef IN
#undef SEAM
}

extern "C" void kernel_launch(void* const* d_in, const int* in_sizes, int n_in, void* d_out, int out_size, void* d_ws, size_t ws_size, hipStream_t stream) {
    static int grid = 0;
    if (grid == 0) {
        if (n_in != 15 || ws_size < WS_END) { fprintf(stderr, "kernel_launch: need 15 inputs and >= %zu bytes of workspace; got n_in %d, ws %zu\n", (size_t)WS_END, n_in, ws_size); grid = -1; return; }
        int dev = 0, cus = 0, per_cu = 0;
        if (hipGetDevice(&dev) != hipSuccess || hipDeviceGetAttribute(&cus, hipDeviceAttributeMultiprocessorCount, dev) != hipSuccess) { grid = -1; return; }
        if (hipFuncSetAttribute((const void*)mk_fwd, hipFuncAttributeMaxDynamicSharedMemorySize, LDS_BYTES) != hipSuccess) { fprintf(stderr, "kernel_launch: hipFuncSetAttribute failed\n"); grid = -1; return; }
        if (hipOccupancyMaxActiveBlocksPerMultiprocessor(&per_cu, (const void*)mk_fwd, NWAVES * 64, LDS_BYTES) != hipSuccess || per_cu < 1) { fprintf(stderr, "kernel_launch: occupancy query says %d\n", per_cu); per_cu = 1; }
        (void)hipGetLastError();
        grid = cus * per_cu;
    }
    if (grid < 0) return;
    (void)hipMemsetAsync((char*)d_ws + WS_CTL, 0, CTL_ZERO_BYTES, stream);
    Args a{};
    for (int i = 0; i < 15; ++i) a.in[i] = (const float*)d_in[i];
    a.out = (float*)d_out; a.ws = (unsigned char*)d_ws;
#if MK_PER_PHASE
    for (int p = 0; p < NPHASE; ++p) { a.ph_lo = p; a.ph_hi = p + 1; hipLaunchKernelGGL(mk_fwd, dim3(grid), dim3(NWAVES * 64), LDS_BYTES, stream, a); }
#else
    a.ph_lo = 0; a.ph_hi = NPHASE;
    void* kargs[] = {&a};
    hipError_t e = hipLaunchCooperativeKernel((const void*)mk_fwd, dim3(grid), dim3(NWAVES * 64), kargs, LDS_BYTES, stream);
    if (e != hipSuccess) fprintf(stderr, "kernel_launch: cooperative launch failed: %s (grid %d)\n", hipGetErrorString(e), grid);
#endif
}
```

```cpp
#include <hip/hip_runtime.h>
#include <hip/hip_cooperative_groups.h>
#include <hip/hip_bf16.h>
#include <cstdio>
#include <cstdint>
#include <cmath>
namespace cg = cooperative_groups;

#define LAS __attribute__((address_space(3)))
constexpr int LDS_BYTES = 147456, MISC_OFF = 131072 + 320, WTAB_OFF = MISC_OFF + 128;
__device__ __forceinline__ int lane_id() { int l; asm volatile("v_mbcnt_lo_u32_b32 %0, -1, 0\n\tv_mbcnt_hi_u32_b32 %0, -1, %0" : "=&v"(l)); return l; }
__device__ __forceinline__ unsigned hw_slot() { return (unsigned)__builtin_amdgcn_s_getreg((5 << 11) | 4) & 63u; }
__device__ __forceinline__ int my_tid() {
    extern __shared__ __attribute__((aligned(16))) unsigned char lds_raw[];
    const int w = ((volatile LAS int*)((LAS unsigned char*)lds_raw + WTAB_OFF))[hw_slot()];
    return __builtin_amdgcn_readfirstlane(w) * 64 + lane_id();
}

namespace pg8 {
#define PG8_LAS __attribute__((address_space(3)))
typedef unsigned short bf16_t;
typedef short bf16x8 __attribute__((ext_vector_type(8)));
typedef float f32x4 __attribute__((ext_vector_type(4)));
typedef unsigned u32x4 __attribute__((ext_vector_type(4)));
constexpr int BM = 256, BK = 64, HALF = 128, HTB = HALF * BK * 2  , STAGE_BYTES = 8 * HTB, NXCD = 8, WGM = 8;

__host__ __device__ __forceinline__ int lds_byte(int r, int c) { const int st = (r >> 4) * 2 + (c >> 5), rr = r & 15, cc = c & 31, ob = rr * 64 + cc * 2; return st * 1024 + (ob ^ (((ob >> 9) & 1) << 5)); }
__host__ __device__ __forceinline__ void stage_rc(int b, int& R, int& C) { const int st = b / 1024, sb = b % 1024, swz = sb ^ (((sb >> 9) & 1) << 5); R = (st >> 1) * 16 + swz / 64; C = (st & 1) * 32 + (swz % 64) / 2; }
__host__ __device__ __forceinline__ int perm32(int rho) { const int n = rho >> 4, i = rho & 15; return 8 * (i >> 2) + 4 * n + (i & 3); }

struct Unit { int pm, pn, kp; };
struct Gemm { const bf16_t* A; const bf16_t* Bt; int M, N, K, lda, ldb; };

struct StaticOrder {
    int nM, nN, nwg, G, c;
    __host__ __device__ void init(int M, int N, int G_, int c_) { nM = M / BM; nN = N / BM; nwg = nM * nN; G = G_; c = c_; }
    __host__ __device__ bool next(int i, Unit& u) const {
        const long L = (long)i * G + c; if (L >= nwg) return false;
        int wgid = (int)L; { const int q = nwg / NXCD, r = nwg % NXCD, xcd = wgid % NXCD, off = wgid / NXCD; wgid = (xcd < r ? xcd * (q + 1) : r * (q + 1) + (xcd - r) * q) + off; }
        const int nig = WGM * nN, gid = wgid / nig, fm = gid * WGM, gsz = (nM - fm) < WGM ? (nM - fm) : WGM;
        u.pm = fm + ((wgid % nig) % gsz); u.pn = (wgid % nig) / gsz; return true;
    }
    __device__ __forceinline__ void a_ready(const Unit&) const {}
    __device__ __forceinline__ void done(const Unit&) const {}
    __device__ __forceinline__ size_t aoff(const Unit&) const { return 0; }
    __device__ __forceinline__ size_t boff(const Unit&) const { return 0; }
};


__device__ __forceinline__ unsigned cvt_pk_bf16(float lo, float hi) { unsigned r; asm volatile("v_cvt_pk_bf16_f32 %0, %1, %2" : "=v"(r) : "v"(lo), "v"(hi)); return r; }
typedef float f32x2 __attribute__((ext_vector_type(2)));

template <class Epi, class Sched, bool ALIGN_EPI, bool SP2, int TK, int TLDA, int TLDB>
__device__ __forceinline__ void gemm_phase(PG8_LAS unsigned char* lds, const Gemm g, const Sched& S, const Epi& E) {
    int tid_ = my_tid(); asm volatile("" : "+v"(tid_)); const int tid = tid_, wid = __builtin_amdgcn_readfirstlane(tid >> 6), lane = tid & 63, wr = wid >> 2, wc = wid & 3, fr = lane & 15, fq = lane >> 4;
    constexpr int K = TK, nt = K / BK;
    unsigned voffA[2], voffB[2];
#pragma unroll
    for (int i = 0; i < 2; ++i) { int R, C; stage_rc(tid * 16 + i * 8192, R, C); const int Rb = Epi::PERM ? ((R & ~31) + perm32(R & 31)) : R;
        voffA[i] = (unsigned)(R * TLDA + C) * 2u; voffB[i] = (unsigned)(Rb * TLDB + C) * 2u; }
    const size_t kstep = (size_t)(BK * 2);
    const size_t hstepA = (size_t)HALF * TLDA * 2, hstepB = (size_t)HALF * TLDB * 2;
    const size_t tstepA = 2 * hstepA, tstepB = 2 * hstepB;
    const unsigned ldsw = (unsigned)wid * 1024u;
    const int aoff = lds_byte(wr * 64 + fr, fq * 8), boff = lds_byte(wc * 32 + fr, fq * 8);
#define PG8_SA(b, h) (((b) * 2 + (h)) * HTB)
#define PG8_SB(b, h) ((4 + (b) * 2 + (h)) * HTB)
#define PG8_STAGE(bufoff, gbase, voff) do { _Pragma("unroll") for (int _i = 0; _i < 2; ++_i) \
        __builtin_amdgcn_global_load_lds((const unsigned*)((const char*)(gbase) + (voff)[_i]), (PG8_LAS unsigned*)(lds + (bufoff) + ldsw + _i * 8192), 16, 0, 0); } while (0)
#define PG8_LDA(dst, b, h) do { _Pragma("unroll") for (int m = 0; m < 4; ++m) _Pragma("unroll") for (int k = 0; k < 2; ++k) dst[m][k] = *(const PG8_LAS bf16x8*)(lds + PG8_SA(b, h) + aoff + m * 2048 + k * 1024); } while (0)
#define PG8_LDB(dst, b, h) do { _Pragma("unroll") for (int n = 0; n < 2; ++n) _Pragma("unroll") for (int k = 0; k < 2; ++k) dst[n][k] = *(const PG8_LAS bf16x8*)(lds + PG8_SB(b, h) + boff + n * 2048 + k * 1024); } while (0)
#define PG8_MMA(ai, bj, At, Bt) do { __builtin_amdgcn_s_setprio(1); _Pragma("unroll") for (int m = 0; m < 4; ++m) _Pragma("unroll") for (int n = 0; n < 2; ++n) _Pragma("unroll") for (int k = 0; k < 2; ++k) \
        acc[ai][bj][m][n] = __builtin_amdgcn_mfma_f32_16x16x32_bf16(Bt[n][k], At[m][k], acc[ai][bj][m][n], 0, 0, 0); __builtin_amdgcn_s_setprio(0); } while (0)
#define PG8_WAIT_V(n) asm volatile("s_waitcnt vmcnt(" #n ")" ::: "memory")
#define PG8_WAIT_L(n) asm volatile("s_waitcnt lgkmcnt(" #n ")" ::: "memory")
#define PG8_BAR __builtin_amdgcn_s_barrier()
#define PG8_SCHED __builtin_amdgcn_sched_barrier(0)
    Unit cur, nxt; int ui = 0;
    if (!S.next(0, cur)) return;
    f32x4 acc[2][2][4][2];
#pragma unroll
    for (int a = 0; a < 2; ++a)
#pragma unroll
        for (int b = 0; b < 2; ++b)
#pragma unroll
            for (int m = 0; m < 4; ++m)
#pragma unroll
                for (int n = 0; n < 2; ++n) acc[a][b][m][n] = (f32x4){0.f, 0.f, 0.f, 0.f};
    bf16x8 At[4][2], B0[2][2], B1[2][2];
    const char* cA = (const char*)g.A + (size_t)cur.pm * tstepA + S.aoff(cur); const char* cB = (const char*)g.Bt + (size_t)cur.pn * tstepB + S.boff(cur);
    S.a_ready(cur);
    if constexpr (SP2) {
        PG8_STAGE(PG8_SB(0, 0), cB, voffB); PG8_STAGE(PG8_SB(0, 1), cB + hstepB, voffB); PG8_STAGE(PG8_SA(0, 0), cA, voffA); PG8_STAGE(PG8_SA(0, 1), cA + hstepA, voffA);
        if (wr == 1) PG8_BAR;
        PG8_WAIT_V(2); PG8_BAR;
        PG8_STAGE(PG8_SB(1, 0), cB + kstep, voffB); PG8_STAGE(PG8_SA(1, 0), cA + kstep, voffA); PG8_STAGE(PG8_SB(1, 1), cB + hstepB + kstep, voffB);
        PG8_WAIT_V(6); PG8_BAR;
    } else {
        PG8_STAGE(PG8_SB(0, 0), cB, voffB); PG8_STAGE(PG8_SA(0, 0), cA, voffA); PG8_STAGE(PG8_SB(0, 1), cB + hstepB, voffB); PG8_STAGE(PG8_SA(0, 1), cA + hstepA, voffA);
        if (wr == 1) PG8_BAR;
        PG8_WAIT_V(4); PG8_BAR;
        PG8_STAGE(PG8_SB(1, 0), cB + kstep, voffB); PG8_STAGE(PG8_SA(1, 0), cA + kstep, voffA); PG8_STAGE(PG8_SB(1, 1), cB + hstepB + kstep, voffB);
        PG8_WAIT_V(6); PG8_BAR;
    }
    for (;;) {
        const bool has_next = S.next(ui + 1, nxt);
        const char* nA = has_next ? (const char*)g.A + (size_t)nxt.pm * tstepA + S.aoff(nxt) : cA; const char* nB = has_next ? (const char*)g.Bt + (size_t)nxt.pn * tstepB + S.boff(nxt) : cB;
        for (int t = 0; t < nt; t += 2) {
            const bool last = (t == nt - 2);
            const char* a1 = cA + (size_t)(t + 1) * kstep;
            const char* a2 = last ? nA : cA + (size_t)(t + 2) * kstep; const char* b2 = last ? nB : cB + (size_t)(t + 2) * kstep;
            const char* a3 = a2 + kstep; const char* b3 = b2 + kstep;
            if (last && has_next) S.a_ready(nxt);
            if constexpr (SP2) {
            PG8_LDB(B0, 0, 0); PG8_LDB(B1, 0, 1); PG8_SCHED; PG8_LDA(At, 0, 0); PG8_STAGE(PG8_SA(1, 1), a1 + hstepA, voffA);
            PG8_WAIT_V(8); PG8_WAIT_L(0); PG8_BAR; PG8_MMA(0, 0, At, B0); PG8_MMA(0, 1, At, B1); PG8_BAR; PG8_SCHED;
            PG8_LDA(At, 0, 1); PG8_STAGE(PG8_SB(0, 0), b2, voffB); PG8_STAGE(PG8_SB(0, 1), b2 + hstepB, voffB); PG8_STAGE(PG8_SA(0, 0), a2, voffA);
            PG8_WAIT_V(8); PG8_WAIT_L(0); PG8_BAR; PG8_MMA(1, 0, At, B0); PG8_MMA(1, 1, At, B1); PG8_BAR; PG8_SCHED;
            PG8_LDB(B0, 1, 0); PG8_LDB(B1, 1, 1); PG8_SCHED; PG8_LDA(At, 1, 0); PG8_STAGE(PG8_SA(0, 1), a2 + hstepA, voffA);
            PG8_WAIT_V(8); PG8_WAIT_L(0); PG8_BAR; PG8_MMA(0, 0, At, B0); PG8_MMA(0, 1, At, B1); PG8_BAR; PG8_SCHED;
            PG8_LDA(At, 1, 1); PG8_STAGE(PG8_SB(1, 0), b3, voffB); PG8_STAGE(PG8_SB(1, 1), b3 + hstepB, voffB); PG8_STAGE(PG8_SA(1, 0), a3, voffA);
            PG8_WAIT_V(8); PG8_WAIT_L(0); PG8_BAR; PG8_MMA(1, 0, At, B0); PG8_MMA(1, 1, At, B1); PG8_BAR; PG8_SCHED;
            } else {
            PG8_LDB(B0, 0, 0); PG8_SCHED; PG8_LDA(At, 0, 0); PG8_STAGE(PG8_SA(1, 1), a1 + hstepA, voffA);
            PG8_WAIT_L(8); PG8_BAR; PG8_WAIT_L(0); PG8_MMA(0, 0, At, B0); PG8_BAR; PG8_SCHED;
            PG8_LDB(B1, 0, 1); PG8_STAGE(PG8_SB(0, 0), b2, voffB);
            PG8_BAR; PG8_WAIT_L(0); PG8_MMA(0, 1, At, B1); PG8_BAR;
            PG8_LDA(At, 0, 1); PG8_STAGE(PG8_SA(0, 0), a2, voffA);
            PG8_BAR; PG8_WAIT_L(0); PG8_MMA(1, 0, At, B0); PG8_BAR; PG8_SCHED;
            PG8_STAGE(PG8_SB(0, 1), b2 + hstepB, voffB);
            PG8_WAIT_V(6); PG8_BAR; PG8_MMA(1, 1, At, B1); PG8_BAR;
            PG8_LDB(B0, 1, 0); PG8_SCHED; PG8_LDA(At, 1, 0); PG8_STAGE(PG8_SA(0, 1), a2 + hstepA, voffA);
            PG8_WAIT_L(8); PG8_BAR; PG8_WAIT_L(0); PG8_MMA(0, 0, At, B0); PG8_BAR; PG8_SCHED;
            PG8_LDB(B1, 1, 1); PG8_STAGE(PG8_SB(1, 0), b3, voffB);
            PG8_BAR; PG8_WAIT_L(0); PG8_MMA(0, 1, At, B1); PG8_BAR;
            PG8_LDA(At, 1, 1); PG8_STAGE(PG8_SA(1, 0), a3, voffA);
            PG8_BAR; PG8_WAIT_L(0); PG8_MMA(1, 0, At, B0); PG8_BAR; PG8_SCHED;
            PG8_STAGE(PG8_SB(1, 1), b3 + hstepB, voffB);
            PG8_WAIT_V(6); PG8_BAR; PG8_MMA(1, 1, At, B1); PG8_BAR;
            }
        }
        if constexpr (ALIGN_EPI) { if (wr == 0) PG8_BAR; }
        if constexpr (!Epi::AFTER_DRAIN) { E(acc, cur, wr, wc, fr, fq); S.done(cur); }
        if (!has_next) break;
#pragma unroll
        for (int a = 0; a < 2; ++a)
#pragma unroll
            for (int b = 0; b < 2; ++b)
#pragma unroll
                for (int m = 0; m < 4; ++m)
#pragma unroll
                    for (int n = 0; n < 2; ++n) acc[a][b][m][n] = (f32x4){0.f, 0.f, 0.f, 0.f};
        cur = nxt; cA = nA; cB = nB; ++ui;
        if constexpr (ALIGN_EPI) { if (wr == 1) PG8_BAR; }
    }
    PG8_WAIT_V(0);
    if constexpr (!ALIGN_EPI) { if (wr == 0) PG8_BAR; }
    PG8_BAR;
    if constexpr (Epi::AFTER_DRAIN) { E.fused(acc, cur, wr, wc, fr, fq, lds, wid, lane); S.done(cur); }
#undef PG8_SA
#undef PG8_SB
#undef PG8_STAGE
#undef PG8_LDA
#undef PG8_LDB
#undef PG8_MMA
#undef PG8_WAIT_V
#undef PG8_WAIT_L
#undef PG8_BAR
#undef PG8_SCHED
}
}


namespace attn_body {
using bf16=__hip_bfloat16;
using bf16x8=__attribute__((ext_vector_type(8)))short;
using s16x4=__attribute__((ext_vector_type(4)))short;
using f32x16=__attribute__((ext_vector_type(16)))float;
using u32x4=__attribute__((ext_vector_type(4)))unsigned;
constexpr int D=64;
constexpr int NW=8,QBLK=32,QB=QBLK*NW,KVBLK=64;
constexpr int ATTN_UNIT_ROWS=QB;
__device__ __forceinline__ int crow(int r,int hi){return (r&3)+8*(r>>2)+4*hi;}
#define SBAR() __builtin_amdgcn_sched_barrier(0)
constexpr int NSLOT=3, SLOTB=8192;
constexpr int LDS_K=0, LDS_V=NSLOT*SLOTB, LDS_WS=2*NSLOT*SLOTB, LDS_OST=LDS_WS+NW*64*4, LDS_BYTES=LDS_OST+NW*4096;
constexpr float C2=0.125f*1.4426950408889634f;
__device__ __forceinline__ void glds16(const void*gsrc,unsigned lds_dst){unsigned keep;
  asm volatile("s_mov_b32 %0, m0\n\ts_mov_b32 m0, %2\n\ts_nop 0\n\tglobal_load_lds_dwordx4 %1, off\n\ts_mov_b32 m0, %0":"=&s"(keep):"v"(gsrc),"s"(lds_dst):"memory");}
__device__ __forceinline__ float max3f(float a,float b,float c){float r;asm("v_max3_f32 %0, %1, %2, %3":"=v"(r):"v"(a),"v"(b),"v"(c));return r;}
__device__ __forceinline__ float max2f(float a,float b){float r;asm("v_max_f32_e32 %0, %1, %2":"=v"(r):"v"(a),"v"(b));return r;}
__device__ __forceinline__ float fadd_s(float a,float b){float r;asm("v_add_f32_e32 %0, %1, %2":"=v"(r):"v"(a),"v"(b));return r;}
__device__ __forceinline__ float fsub_s(float a,float b){float r;asm("v_sub_f32_e32 %0, %1, %2":"=v"(r):"v"(a),"v"(b));return r;}
typedef float f32x2_t __attribute__((ext_vector_type(2))); typedef __bf16 bf16x2_t __attribute__((ext_vector_type(2)));
__device__ __forceinline__ unsigned cvtpk_s(float lo,float hi){f32x2_t v={lo,hi};bf16x2_t b=__builtin_convertvector(v,bf16x2_t);return __builtin_bit_cast(unsigned,b);}
#define WAIT_BAR(N) asm volatile("s_waitcnt vmcnt(" #N ") lgkmcnt(0)\n\ts_barrier":::"memory")

__device__ __forceinline__ void qkt(f32x16&p0,f32x16&p1,const char*Kslot,const bf16x8*qr,const f32x16&negm,int r32,int hi){
  const char*kb=Kslot+hi*1024+r32*16;
  #pragma unroll
  for(int d0=0;d0<4;++d0){
    const bf16x8 b0=*reinterpret_cast<const bf16x8*>(kb+d0*2048);
    const bf16x8 b1=*reinterpret_cast<const bf16x8*>(kb+d0*2048+512);
    if(d0==0){p0=__builtin_amdgcn_mfma_f32_32x32x16_bf16(b0,qr[0],negm,0,0,0);p1=__builtin_amdgcn_mfma_f32_32x32x16_bf16(b1,qr[0],negm,0,0,0);}
    else{p0=__builtin_amdgcn_mfma_f32_32x32x16_bf16(b0,qr[d0],p0,0,0,0);p1=__builtin_amdgcn_mfma_f32_32x32x16_bf16(b1,qr[d0],p1,0,0,0);}}
}
typedef __attribute__((address_space(3))) const char* lds_cptr;
typedef short v4i16_t __attribute__((ext_vector_type(4)));
__device__ __forceinline__ void kload8(bf16x8*kf,lds_cptr kp){
  kf[0]=*(const __attribute__((address_space(3))) bf16x8*)(kp);      kf[1]=*(const __attribute__((address_space(3))) bf16x8*)(kp+512);
  kf[2]=*(const __attribute__((address_space(3))) bf16x8*)(kp+2048); kf[3]=*(const __attribute__((address_space(3))) bf16x8*)(kp+2560);
  kf[4]=*(const __attribute__((address_space(3))) bf16x8*)(kp+4096); kf[5]=*(const __attribute__((address_space(3))) bf16x8*)(kp+4608);
  kf[6]=*(const __attribute__((address_space(3))) bf16x8*)(kp+6144); kf[7]=*(const __attribute__((address_space(3))) bf16x8*)(kp+6656);
}
__device__ __forceinline__ void kload2(bf16x8*kf,lds_cptr kp,int j){ kf[2*j]=*(const __attribute__((address_space(3))) bf16x8*)(kp+j*2048); kf[2*j+1]=*(const __attribute__((address_space(3))) bf16x8*)(kp+j*2048+512); }
__device__ __forceinline__ s16x4 vtr(lds_cptr p){ return __builtin_bit_cast(s16x4,__builtin_amdgcn_ds_read_tr16_b64_v4i16((__attribute__((address_space(3))) v4i16_t*)p)); }
__device__ __forceinline__ float rowmax(const f32x16&p0,const f32x16&p1){
  float a=max3f(p0[0],p0[1],p1[0]),b=max3f(p0[2],p0[3],p1[1]);a=max3f(a,p1[2],p1[3]);
  #pragma unroll
  for(int r=4;r<16;r+=4){a=max3f(a,p0[r],p0[r+1]);b=max3f(b,p0[r+2],p0[r+3]);a=max3f(a,p1[r],p1[r+1]);b=max3f(b,p1[r+2],p1[r+3]);}
  const float m=max2f(a,b);
  auto rr=__builtin_amdgcn_permlane32_swap(__float_as_uint(m),__float_as_uint(m),false,false);
  return max2f(__uint_as_float(rr[0]),__uint_as_float(rr[1]));
}
__device__ __forceinline__ void pv(f32x16*o,int vb,bf16x8 pa0,bf16x8 pa1,bf16x8 pa2,bf16x8 pa3){
  #pragma unroll
  for(int d0=0;d0<2;++d0){s16x4 lo[4],hi[4];
    #pragma unroll
    for(int ks=0;ks<4;++ks){
      asm volatile("ds_read_b64_tr_b16 %0,%1 offset:%c2":"=&v"(lo[ks]):"v"(vb),"i"(d0*4096+ks*1024):"memory");
      asm volatile("ds_read_b64_tr_b16 %0,%1 offset:%c2":"=&v"(hi[ks]):"v"(vb),"i"(d0*4096+ks*1024+512):"memory");}
    asm volatile("s_waitcnt lgkmcnt(0)":::"memory");SBAR();
    #define PK(k) (bf16x8){lo[k][0],lo[k][1],lo[k][2],lo[k][3],hi[k][0],hi[k][1],hi[k][2],hi[k][3]}
    o[d0]=__builtin_amdgcn_mfma_f32_32x32x16_bf16(pa0,PK(0),o[d0],0,0,0);
    o[d0]=__builtin_amdgcn_mfma_f32_32x32x16_bf16(pa1,PK(1),o[d0],0,0,0);
    o[d0]=__builtin_amdgcn_mfma_f32_32x32x16_bf16(pa2,PK(2),o[d0],0,0,0);
    o[d0]=__builtin_amdgcn_mfma_f32_32x32x16_bf16(pa3,PK(3),o[d0],0,0,0);
    #undef PK
  }
}

#ifndef ATTN_STORE16
#define ATTN_STORE16(p,v) (*(u32x4*)(p)=(v))
#endif
template<int THRL> __device__ __forceinline__ void attn_unit(const bf16*Q0,int ldq,const bf16*__restrict__ Kh,int ldk,const bf16*__restrict__ Vh,int ldv,bf16*O0,int ldo,int NT,char*shm){
  int tid_=my_tid(); asm volatile("":"+v"(tid_)); const int tid=tid_,lane=tid&63,r32=lane&31,hi=lane>>5; const int wid=__builtin_amdgcn_readfirstlane(tid>>6);
  const bf16*Qw=Q0+(long)(wid*QBLK)*ldq;
  const unsigned lds0=(unsigned)(uintptr_t)shm;
  float*wsf=(float*)(shm+LDS_WS)+wid*64;
  const bf16*ksrc=Kh+(long)lane*ldk+wid*8;
  const bf16*vsrc=Vh+(long)(16*(wid&3)+(lane>>2))*ldv+(wid>>2)*32+(lane&3)*8;
  const unsigned kdst=lds0+LDS_K+wid*1024, vdst=lds0+LDS_V+wid*1024;
  #define DMA_K(t,slot) glds16(ksrc+(long)(t)*KVBLK*ldk,(unsigned)__builtin_amdgcn_readfirstlane(kdst+(slot)))
  #define DMA_V(t,slot) glds16(vsrc+(long)(t)*KVBLK*ldv,(unsigned)__builtin_amdgcn_readfirstlane(vdst+(slot)))
  const int vb0=(int)(lds0+LDS_V)+((lane>>4)&1)*32+(lane&3)*8+(4*hi+((lane&15)>>2))*64;
  const char*Kbase=shm+LDS_K; bf16x8 kf[8];
  const lds_cptr shm3=(lds_cptr)shm; const lds_cptr kp0=shm3+LDS_K+hi*1024+r32*16; const lds_cptr vp0=shm3+LDS_V+((lane>>4)&1)*32+(lane&3)*8+(4*hi+((lane&15)>>2))*64;
  DMA_K(0,0);DMA_V(0,0);DMA_K(1,SLOTB);
  bf16x8 qr[4];
  #pragma unroll
  for(int d0=0;d0<4;++d0)qr[d0]=*reinterpret_cast<const bf16x8*>(&Qw[(long)r32*ldq+d0*16+hi*8]);
  float mhat=0.f,l_reg=0.f;f32x16 o[2];o[0]=f32x16{};o[1]=f32x16{};f32x16 negm=f32x16{};asm volatile("":"+v"(negm));
  #define CMASK(P0,P1,t) do{}while(0)
  bool resc=false;
  #define START(P0,P1) do{ const float rm=rowmax(P0,P1); resc=false; \
    { const float dl=rm; mhat=fadd_s(mhat,dl); \
      _Pragma("unroll") for(int r=0;r<16;++r){P0[r]=fsub_s(P0[r],dl);P1[r]=fsub_s(P1[r],dl);} \
      _Pragma("unroll") for(int r=0;r<16;++r)negm[r]=-mhat; asm volatile("":"+v"(negm)); } \
    _Pragma("unroll") for(int r=0;r<16;++r)P0[r]=__builtin_amdgcn_exp2f(P0[r]); }while(0)
  #define RESC() do{ if(resc){ asm volatile("s_waitcnt lgkmcnt(0)":::"memory"); \
      _Pragma("unroll") for(int d_=0;d_<2;++d_) _Pragma("unroll") for(int r=0;r<16;++r)o[d_][r]*=wsf[crow(r,hi)]; } }while(0)
  f32x16 pA0,pA1,pB0,pB1;
  int sl_prev=0,sl_cur=0,sl_next=SLOTB;
  #define ROT() do{sl_prev=sl_cur;sl_cur=sl_next;sl_next=(sl_next==(NSLOT-1)*SLOTB)?0:sl_next+SLOTB;}while(0)
  DMA_K(2,2*SLOTB);
  WAIT_BAR(3);
  qkt(pA0,pA1,Kbase,qr,negm,r32,hi);asm volatile("s_nop 15\n\ts_nop 7":"+v"(pA0),"+v"(pA1));CMASK(pA0,pA1,0);
  START(pA0,pA1);
  _Pragma("unroll") for(int r=0;r<16;++r)pA1[r]=__builtin_amdgcn_exp2f(pA1[r]);
  WAIT_BAR(0);
  DMA_K(3,0);DMA_V(1,SLOTB);
  ROT();
  kload8(kf,kp0+sl_cur);
  WAIT_BAR(2);
  s16x4 vlo[8],vhi[8]; u32x4 pw0,pw1,pw2,pw3;
  #define PKW(P,B) cvtpk_s(P[B],P[B+1])
  #define PAF(k) __builtin_bit_cast(bf16x8,pw##k)
  #define VFR(i) (bf16x8){vlo[i][0],vlo[i][1],vlo[i][2],vlo[i][3],vhi[i][0],vhi[i][1],vhi[i][2],vhi[i][3]}
  #define PIN(x) asm volatile("":"+v"(x))
  #define MX3(a,b,c) __builtin_fmaxf(__builtin_fmaxf((a),(b)),(c))
  #define GAPA(MF,A0,A1,A2,A3,W0,W1,PW) do{ MF; sacc+=A0; sacc+=A1; sacc+=A2; sacc+=A3; PIN(sacc); W0; W1; PIN(PW); SBAR(); }while(0)
  #define EX(v) __builtin_amdgcn_exp2f(v)
  #define GAPB(MF,X,B) do{ MF; X[B]=EX(X[B]); X[B+1]=EX(X[B+1]); X[B+2]=EX(X[B+2]); X[B+3]=EX(X[B+3]); PIN(X); SBAR(); }while(0)
  #define VRD(i) do{ vlo[i]=vtr(vp_+(((i)>>2)*4096+((i)&3)*1024)); vhi[i]=vtr(vp_+(((i)>>2)*4096+((i)&3)*1024+512)); }while(0)
  #define KRD(G,j) do{ if(G){ kload2(kf,kp0+sl_next,j); SBAR(); } }while(0)
  #define STEP(C0,C1,P0,P1,t,GK,GV,GL) do{ SBAR(); \
    const lds_cptr vp_=vp0+sl_prev; \
    VRD(0); SBAR(); float sacc=(P0[0]+P0[1]); \
    GAPA(C0=__builtin_amdgcn_mfma_f32_32x32x16_bf16(kf[0],qr[0],negm,0,0,0), P0[2],P0[3],P0[4],P0[5],     pw0[0]=PKW(P0,0), pw0[1]=PKW(P0,2), pw0); \
    VRD(4); SBAR(); GAPA(C1=__builtin_amdgcn_mfma_f32_32x32x16_bf16(kf[1],qr[0],negm,0,0,0), P0[6],P0[7],P0[8],P0[9],     pw0[2]=PKW(P0,4), pw0[3]=PKW(P0,6), pw0); \
    VRD(1); SBAR(); GAPA(C0=__builtin_amdgcn_mfma_f32_32x32x16_bf16(kf[2],qr[1],C0,0,0,0),   P0[10],P0[11],P0[12],P0[13], pw1[0]=PKW(P0,8), pw1[1]=PKW(P0,10), pw1); \
    VRD(5); SBAR(); GAPA(C1=__builtin_amdgcn_mfma_f32_32x32x16_bf16(kf[3],qr[1],C1,0,0,0),   P0[14],P0[15],P1[0],P1[1],   pw1[2]=PKW(P0,12),pw1[3]=PKW(P0,14), pw1); \
    VRD(2); SBAR(); GAPA(C0=__builtin_amdgcn_mfma_f32_32x32x16_bf16(kf[4],qr[2],C0,0,0,0),   P1[2],P1[3],P1[4],P1[5],     pw2[0]=PKW(P1,0), pw2[1]=PKW(P1,2), pw2); \
    VRD(6); SBAR(); GAPA(C1=__builtin_amdgcn_mfma_f32_32x32x16_bf16(kf[5],qr[2],C1,0,0,0),   P1[6],P1[7],P1[8],P1[9],     pw2[2]=PKW(P1,4), pw2[3]=PKW(P1,6), pw2); \
    VRD(3); SBAR(); GAPA(C0=__builtin_amdgcn_mfma_f32_32x32x16_bf16(kf[6],qr[3],C0,0,0,0),   P1[10],P1[11],P1[12],P1[13], pw3[0]=PKW(P1,8), pw3[1]=PKW(P1,10), pw3); \
    VRD(7); SBAR(); GAPA(C1=__builtin_amdgcn_mfma_f32_32x32x16_bf16(kf[7],qr[3],C1,0,0,0),   P1[14],P1[15],0.f,0.f,       pw3[2]=PKW(P1,12),pw3[3]=PKW(P1,14), pw3); \
    l_reg+=sacc; \
    if(GK){DMA_K((t)+3,sl_cur);} if(GV){DMA_V((t)+1,sl_next);} \
    CMASK(C0,C1,t); \
    { float a=MX3(C0[0],C0[1],C1[0]),b=MX3(C0[2],C0[3],C1[1]); a=MX3(a,C1[2],C1[3]); \
      _Pragma("unroll") for(int r=4;r<16;r+=4){a=MX3(a,C0[r],C0[r+1]);b=MX3(b,C0[r+2],C0[r+3]);a=MX3(a,C1[r],C1[r+1]);b=MX3(b,C1[r+2],C1[r+3]);} \
      float rm=__builtin_fmaxf(a,b); { auto rr=__builtin_amdgcn_permlane32_swap(__float_as_uint(rm),__float_as_uint(rm),false,false); rm=__builtin_fmaxf(__uint_as_float(rr[0]),__uint_as_float(rr[1])); } \
      resc=false; \
      if(__builtin_expect(__any(rm>(float)THRL),0)){ const float dl=__builtin_fmaxf(rm,0.f); mhat+=dl; \
        _Pragma("unroll") for(int r=0;r<16;++r){C0[r]-=dl;C1[r]-=dl;} \
        _Pragma("unroll") for(int r=0;r<16;++r)negm[r]=-mhat; asm volatile("":"+v"(negm)); \
        const float f=__builtin_amdgcn_exp2f(-dl); l_reg*=f; if(hi==0)wsf[r32]=f; resc=true; } } \
    SBAR(); \
    GAPB(o[0]=__builtin_amdgcn_mfma_f32_32x32x16_bf16(PAF(0),VFR(0),o[0],0,0,0), C0,0); \
    GAPB(o[1]=__builtin_amdgcn_mfma_f32_32x32x16_bf16(PAF(0),VFR(4),o[1],0,0,0), C0,4); \
    KRD(GL,0); GAPB(o[0]=__builtin_amdgcn_mfma_f32_32x32x16_bf16(PAF(1),VFR(1),o[0],0,0,0), C0,8); \
    KRD(GL,1); GAPB(o[1]=__builtin_amdgcn_mfma_f32_32x32x16_bf16(PAF(1),VFR(5),o[1],0,0,0), C0,12); \
    KRD(GL,2); GAPB(o[0]=__builtin_amdgcn_mfma_f32_32x32x16_bf16(PAF(2),VFR(2),o[0],0,0,0), C1,0); \
    KRD(GL,3); GAPB(o[1]=__builtin_amdgcn_mfma_f32_32x32x16_bf16(PAF(2),VFR(6),o[1],0,0,0), C1,4); \
    GAPB(o[0]=__builtin_amdgcn_mfma_f32_32x32x16_bf16(PAF(3),VFR(3),o[0],0,0,0), C1,8); \
    GAPB(o[1]=__builtin_amdgcn_mfma_f32_32x32x16_bf16(PAF(3),VFR(7),o[1],0,0,0), C1,12); \
    }while(0)
  int t=1;
  #undef CMASK
  #define CMASK(P0,P1,t) do{}while(0)
  for(;t+5<NT;t+=2){
    STEP(pB0,pB1,pA0,pA1,t,true,true,true);     WAIT_BAR(2); RESC(); ROT();
    STEP(pA0,pA1,pB0,pB1,t+1,true,true,true);   WAIT_BAR(2); RESC(); ROT();
  }
  #undef CMASK
  #define CMASK(P0,P1,t) do{}while(0)
  #define ENDW(tt) do{ if((tt)+3<NT){WAIT_BAR(2);} else if((tt)+2<NT){WAIT_BAR(1);} else {WAIT_BAR(0);} }while(0)
  for(;t+1<NT;t+=2){
    STEP(pB0,pB1,pA0,pA1,t,(t+3<NT),(t+1<NT),(t+1<NT));       ENDW(t);   RESC(); ROT();
    STEP(pA0,pA1,pB0,pB1,t+1,(t+4<NT),(t+2<NT),(t+2<NT));     ENDW(t+1); RESC(); ROT();
  }
  STEP(pB0,pB1,pA0,pA1,NT-1,false,false,false); RESC();
  { float sacc=pB0[0]+pB0[1]; _Pragma("unroll") for(int r=2;r<16;++r)sacc+=pB0[r]; _Pragma("unroll") for(int r=0;r<16;++r)sacc+=pB1[r]; l_reg+=sacc;
    pw0=(u32x4){PKW(pB0,0),PKW(pB0,2),PKW(pB0,4),PKW(pB0,6)};pw1=(u32x4){PKW(pB0,8),PKW(pB0,10),PKW(pB0,12),PKW(pB0,14)};pw2=(u32x4){PKW(pB1,0),PKW(pB1,2),PKW(pB1,4),PKW(pB1,6)};pw3=(u32x4){PKW(pB1,8),PKW(pB1,10),PKW(pB1,12),PKW(pB1,14)};
    SBAR(); pv(o,vb0+sl_cur,PAF(0),PAF(1),PAF(2),PAF(3)); }
  #undef PKW
  #undef PAF
  #undef VFR
  #undef PIN
  #undef MX3
  #undef GAPA
  #undef GAPB
  #undef EX
  #undef VRD
  #undef KRD
  #undef STEP
  #undef ENDW
  {auto rr=__builtin_amdgcn_permlane32_swap(__float_as_uint(l_reg),__float_as_uint(l_reg),false,false);l_reg=__uint_as_float(rr[0])+__uint_as_float(rr[1]);}
  if(hi==0)wsf[32+r32]=l_reg;asm volatile("s_waitcnt lgkmcnt(0)":::"memory");
  float rli[16];
  #pragma unroll
  for(int r=0;r<16;++r)rli[r]=__builtin_amdgcn_rcpf(wsf[32+crow(r,hi)]);
  bf16*Ow=O0+(long)(wid*QBLK)*ldo;
  { bf16*stg=(bf16*)(shm+LDS_OST)+wid*2048;
    #pragma unroll
    for(int r=0;r<16;++r){const int orow=crow(r,hi);
      #pragma unroll
      for(int d0=0;d0<2;++d0)stg[orow*64+d0*32+r32]=__float2bfloat16(o[d0][r]*rli[r]);}
    asm volatile("s_waitcnt lgkmcnt(0)":::"memory");
    #pragma unroll
    for(int i=0;i<4;++i){const int row=i*8+(lane>>3),ch=lane&7; const u32x4 v=*(const u32x4*)(stg+row*64+ch*8); ATTN_STORE16(Ow+(long)row*ldo+ch*8,v);} }
  asm volatile("s_waitcnt lgkmcnt(0)\n\ts_barrier":::"memory");
  #undef DMA_K
  #undef DMA_V
  #undef CMASK
  #undef START
  #undef RESC
  #undef ROT
}
constexpr int ATTN_LDS_BYTES=LDS_BYTES;
#undef SBAR
#undef WAIT_BAR
}


constexpr int NWAVES = 8;
constexpr int DMODEL = 1024, NBATCH = 2, SEQL = 8192, CTXL = 256, RPB = SEQL + CTXL, MROWS = NBATCH * RPB, NLAYER = 2;
constexpr int DFF = 2816, NUP = 2 * DFF, INW = 5888, ZW = 5376, NMODV = 9, MODW = NMODV * DMODEL;
constexpr int ZQA = 0, ZKA = 512, ZVA = 640, ZQB = 768, ZKB = 1280, ZVB = 1792, ZGATE = 2304;
constexpr int TPB = RPB / 256;
constexpr float EPSN = 1e-6f;
constexpr int HN = 4096;

constexpr size_t MiB = 1u << 20, KiB = 1024;
constexpr size_t WS_CTL = 0, CTL_ZERO_BYTES = 64 * KiB;
constexpr size_t WS_MOD = 1 * MiB;
constexpr size_t WS_CAS256 = 1 * MiB + 512 * KiB;
constexpr size_t WS_HC = 2 * MiB;
constexpr size_t WS_WUP0 = 4 * MiB, WS_WDN0 = 15 * MiB, WS_WUP1 = 20 * MiB + 512 * KiB, WS_WDN1 = 31 * MiB + 512 * KiB;
constexpr size_t WS_WIN = 37 * MiB, WS_WC = 47 * MiB + 512 * KiB, WS_WBR = 48 * MiB + 512 * KiB, WS_WOUT = 51 * MiB + 512 * KiB;
constexpr size_t WS_HN = 54 * MiB;
constexpr size_t WS_Z = 87 * MiB;
constexpr size_t WS_T1T = 261 * MiB;
constexpr size_t WS_T2 = 278 * MiB;
constexpr size_t WS_PQ = 295 * MiB;
constexpr size_t WS_CAS = 311 * MiB;
constexpr size_t WS_ROPE = 343 * MiB;
constexpr size_t WS_END = 345 * MiB;
static_assert(WS_Z + (size_t)MROWS * ZW * 2 <= WS_T1T && WS_HN + (size_t)MROWS * DMODEL * 2 <= WS_Z && WS_WOUT + 2 * MiB <= WS_HN, "ws map");
constexpr int CW_BAR = 4096;
constexpr int CW_Q = 1024;


#define GAS __attribute__((address_space(1)))
typedef unsigned short bf16;
typedef unsigned v4u __attribute__((ext_vector_type(4)));
typedef float f32x4 __attribute__((ext_vector_type(4)));
#define LDS_WAIT() asm volatile("s_waitcnt lgkmcnt(0)" ::: "memory")

__device__ __forceinline__ float bf2f(unsigned v) { return __uint_as_float(v << 16); }
__device__ __forceinline__ float bflo(unsigned w) { return __uint_as_float(w << 16); }
__device__ __forceinline__ float bfhi(unsigned w) { return __uint_as_float(w & 0xffff0000u); }
__device__ __forceinline__ unsigned pk2(float lo, float hi) { return pg8::cvt_pk_bf16(lo, hi); }
__device__ __forceinline__ float fexp(float x) { return __builtin_amdgcn_exp2f(x * 1.4426950408889634f); }
__device__ __forceinline__ float sigm(float x) { return __builtin_amdgcn_rcpf(1.0f + fexp(-x)); }
__device__ __forceinline__ float siluf(float x) { return x * sigm(x); }
__device__ __forceinline__ float shfl_xor(float v, int o) { return __builtin_bit_cast(float, __builtin_amdgcn_ds_bpermute((lane_id() ^ o) << 2, __builtin_bit_cast(int, v))); }
__device__ __forceinline__ float wave_sum(float v) {
#pragma unroll
    for (int o = 1; o < 64; o <<= 1) v += shfl_xor(v, o);
    return v;
}

namespace pg8 {
struct EpiStore {
    static constexpr bool PERM = true, AFTER_DRAIN = false;
    bf16_t* O; int ldc; int sig_from; int rbase, rmul;
    __device__ __forceinline__ void operator()(const f32x4 (&acc)[2][2][4][2], const Unit& u, int wr, int wc, int fr_, int fq_) const {
        (void)fr_; (void)fq_; const int ln_ = lane_id(); const int fr = ln_ & 15, fq = ln_ >> 4;
        const int row0 = u.pm * BM + wr * 64 + fr, col0 = u.pn * BM + wc * 32 + 8 * fq;
        const bool sg = (u.pn * BM) >= sig_from;
#pragma unroll
        for (int ai = 0; ai < 2; ++ai)
#pragma unroll
            for (int m = 0; m < 4; ++m) { const int row = row0 + ai * HALF + m * 16; bf16_t* rowp = O + (size_t)(rbase + row * rmul) * ldc + col0;
#pragma unroll
                for (int bj = 0; bj < 2; ++bj) { f32x4 v0 = acc[ai][bj][m][0], v1 = acc[ai][bj][m][1];
                    if (sg) { v0[0] = sigm(v0[0]); v0[1] = sigm(v0[1]); v0[2] = sigm(v0[2]); v0[3] = sigm(v0[3]); v1[0] = sigm(v1[0]); v1[1] = sigm(v1[1]); v1[2] = sigm(v1[2]); v1[3] = sigm(v1[3]); }
                    u32x4 w; w.x = cvt_pk_bf16(v0[0], v0[1]); w.y = cvt_pk_bf16(v0[2], v0[3]); w.z = cvt_pk_bf16(v1[0], v1[1]); w.w = cvt_pk_bf16(v1[2], v1[3]);
                    *(u32x4*)(rowp + bj * HALF) = w; } }
    }
};
struct EpiSwiGLU {
    static constexpr bool PERM = true, AFTER_DRAIN = false;
    bf16_t* H; int ldc;
    __device__ __forceinline__ void operator()(const f32x4 (&acc)[2][2][4][2], const Unit& u, int wr, int wc, int fr_, int fq_) const {
        (void)fr_; (void)fq_; const int ln_ = lane_id(); const int fr = ln_ & 15, fq = ln_ >> 4;
        const int row0 = u.pm * BM + wr * 64 + fr, col0 = u.pn * HALF + wc * 32 + 8 * fq;
#pragma unroll
        for (int ai = 0; ai < 2; ++ai)
#pragma unroll
            for (int m = 0; m < 4; ++m) { const int row = row0 + ai * HALF + m * 16; bf16_t* rowp = H + (size_t)row * ldc + col0;
                const f32x4 g0 = acc[ai][0][m][0], g1 = acc[ai][0][m][1], u0 = acc[ai][1][m][0], u1 = acc[ai][1][m][1];
                u32x4 w; w.x = cvt_pk_bf16(siluf(g0[0]) * u0[0], siluf(g0[1]) * u0[1]); w.y = cvt_pk_bf16(siluf(g0[2]) * u0[2], siluf(g0[3]) * u0[3]);
                w.z = cvt_pk_bf16(siluf(g1[0]) * u1[0], siluf(g1[1]) * u1[1]); w.w = cvt_pk_bf16(siluf(g1[2]) * u1[2], siluf(g1[3]) * u1[3]);
                *(u32x4*)rowp = w; }
    }
};
template <bool ATOMIC> struct EpiResidT {
    static constexpr bool PERM = false, AFTER_DRAIN = false;
    const float* base_lat; const float* base_ctx; float* out_lat; float* out_ctx; const float* gate; float scale;
    __device__ __forceinline__ void operator()(const f32x4 (&acc)[2][2][4][2], const Unit& u, int wr, int wc, int fr_, int fq_) const {
        (void)fr_; (void)fq_; const int ln_ = lane_id(); const int fr = ln_ & 15, fq = ln_ >> 4;
        const int b = u.pm / 33, w = u.pm % 33; const int set = (w == 0) ? 2 : b;
        const size_t toff = (w == 0) ? (size_t)b * 256 * 1024 : ((size_t)b * 8192 + (size_t)(w - 1) * 256) * 1024;
        const float* base = ((w == 0) ? base_ctx : base_lat) + toff; float* out = ((w == 0) ? out_ctx : out_lat) + toff;
        const int frr = fr;
        const int col0 = u.pn * BM + wc * 32 + 4 * fq; const float* gp = gate + set * 9216 + col0;
#pragma unroll
        for (int bj = 0; bj < 2; ++bj)
#pragma unroll
            for (int n = 0; n < 2; ++n) { const f32x4 gv = *(const f32x4*)(gp + bj * HALF + n * 16) * scale;
#pragma unroll
                for (int ai = 0; ai < 2; ++ai) {
#pragma unroll
                    for (int m = 0; m < 4; ++m) { const unsigned off = (unsigned)(ai * HALF + wr * 64 + m * 16 + frr) * 1024u + (unsigned)(col0 + bj * HALF + n * 16);
                        if constexpr (ATOMIC) { float one = 1.0f; asm volatile("" : "+v"(one) :: "memory"); const f32x4 v = (gv * one) * acc[ai][bj][m][n]; __attribute__((address_space(1))) float* ap = (__attribute__((address_space(1))) float*)(out + off); (void)__builtin_amdgcn_global_atomic_fadd_f32(ap, v[0]); (void)__builtin_amdgcn_global_atomic_fadd_f32(ap + 1, v[1]); (void)__builtin_amdgcn_global_atomic_fadd_f32(ap + 2, v[2]); (void)__builtin_amdgcn_global_atomic_fadd_f32(ap + 3, v[3]); asm volatile("" ::: "memory"); }
                        else { const f32x4 bs = *(const f32x4*)(base + off); *(f32x4*)(out + off) = bs + gv * acc[ai][bj][m][n]; } }
                    asm volatile("" ::: "memory"); } }
    }
};
typedef EpiResidT<false> EpiResid;
struct EpiResidA {
    static constexpr bool PERM = false, AFTER_DRAIN = false;
    float* out_ctx; const float* gate; float scale;
    __device__ __forceinline__ void operator()(const f32x4 (&acc)[2][2][4][2], const Unit& u, int wr, int wc, int fr_, int fq_) const {
        (void)fr_; (void)fq_; const int ln_ = lane_id(); const int fr = ln_ & 15, fq = ln_ >> 4;
        const int frr = fr;
        const int col0 = u.pn * BM + wc * 32 + 4 * fq;
        __attribute__((address_space(1))) float* out = (__attribute__((address_space(1))) float*)(out_ctx + (size_t)(u.pm ? 1 : 0) * 256 * 1024) + (unsigned)((wr * 64 + frr) * 1024 + col0);
#pragma unroll
        for (int bj = 0; bj < 2; ++bj)
#pragma unroll
            for (int n = 0; n < 2; ++n) { const f32x4 gv = *(const f32x4*)(gate + col0 + bj * HALF + n * 16) * scale;
#pragma unroll
                for (int ai = 0; ai < 2; ++ai)
#pragma unroll
                    for (int m = 0; m < 4; ++m) { const f32x4 v = gv * acc[ai][bj][m][n]; __attribute__((address_space(1))) float* ap = out + (ai * HALF + m * 16) * 1024 + bj * HALF + n * 16;
                        (void)__builtin_amdgcn_global_atomic_fadd_f32(ap, v[0]); (void)__builtin_amdgcn_global_atomic_fadd_f32(ap + 1, v[1]); (void)__builtin_amdgcn_global_atomic_fadd_f32(ap + 2, v[2]); (void)__builtin_amdgcn_global_atomic_fadd_f32(ap + 3, v[3]); } }
    }
};
struct EpiMerge {
    static constexpr bool PERM = true, AFTER_DRAIN = false;
    const bf16_t* Z; bf16_t* Mo;
    __device__ __forceinline__ void operator()(const f32x4 (&acc)[2][2][4][2], const Unit& u, int wr, int wc, int fr_, int fq_) const {
        (void)fr_; (void)fq_; const int ln_ = lane_id(); const int fr = ln_ & 15, fq = ln_ >> 4;
        const int br = u.pn >> 2, ct = u.pn & 3;
        const int row0 = u.pm * BM + wr * 64 + fr, col0 = ct * BM + wc * 32 + 8 * fq;
#pragma unroll
        for (int ai = 0; ai < 2; ++ai)
#pragma unroll
            for (int m = 0; m < 4; ++m) { const int row = row0 + ai * HALF + m * 16; const bf16_t* gp = Z + (size_t)row * 5376 + 2304 + br * 1024 + col0; bf16_t* mp = Mo + (size_t)row * 1024 + col0;
#pragma unroll
                for (int bj = 0; bj < 2; ++bj) { const u32x4 gw = *(const u32x4*)(gp + bj * HALF); const f32x4 a0 = acc[ai][bj][m][0], a1 = acc[ai][bj][m][1];
                    float r0 = __uint_as_float(gw.x << 16) * a0[0], r1 = __uint_as_float(gw.x & 0xffff0000u) * a0[1], r2 = __uint_as_float(gw.y << 16) * a0[2], r3 = __uint_as_float(gw.y & 0xffff0000u) * a0[3];
                    float r4 = __uint_as_float(gw.z << 16) * a1[0], r5 = __uint_as_float(gw.z & 0xffff0000u) * a1[1], r6 = __uint_as_float(gw.w << 16) * a1[2], r7 = __uint_as_float(gw.w & 0xffff0000u) * a1[3];
                    if (br > 0) { const u32x4 ow = *(const u32x4*)(mp + bj * HALF);
                        r0 += __uint_as_float(ow.x << 16); r1 += __uint_as_float(ow.x & 0xffff0000u); r2 += __uint_as_float(ow.y << 16); r3 += __uint_as_float(ow.y & 0xffff0000u);
                        r4 += __uint_as_float(ow.z << 16); r5 += __uint_as_float(ow.z & 0xffff0000u); r6 += __uint_as_float(ow.w << 16); r7 += __uint_as_float(ow.w & 0xffff0000u); }
                    u32x4 w; w.x = cvt_pk_bf16(r0, r1); w.y = cvt_pk_bf16(r2, r3); w.z = cvt_pk_bf16(r4, r5); w.w = cvt_pk_bf16(r6, r7);
                    *(u32x4*)(mp + bj * HALF) = w; } }
    }
};
struct MergeOrder {
    int G, c, lat;
    __device__ bool next(int i, Unit& u) const { const int grp = (i / 3) * G + c; if (grp >= (lat ? 256 : 264)) return false; int pm = grp >> 2; if (lat) pm = pm + 1 + (pm >= 32); u.pm = pm; u.pn = (grp & 3) + 4 * (i % 3); return true; }
    __device__ __forceinline__ void a_ready(const Unit&) const {}
    __device__ __forceinline__ void done(const Unit&) const {}
    __device__ __forceinline__ size_t aoff(const Unit& u) const { const int br = u.pn >> 2; return (size_t)(br == 0 ? 0 : (br == 1 ? 768 : 1280)) * 2; }
    __device__ __forceinline__ size_t boff(const Unit&) const { return 0; }
};
struct LatOrder {
    StaticOrder so;
    __device__ void init(int N, int G_, int c_) { so.init(64 * BM, N, G_, c_); }
    __device__ bool next(int i, Unit& u) const { if (!so.next(i, u)) return false; u.pm = u.pm + 1 + (u.pm >= 32); return true; }
    __device__ __forceinline__ void a_ready(const Unit&) const {}
    __device__ __forceinline__ void done(const Unit&) const {}
    __device__ __forceinline__ size_t aoff(const Unit&) const { return 0; }
    __device__ __forceinline__ size_t boff(const Unit&) const { return 0; }
};
struct CtxSplit {
    int G, c, KP;
    __device__ bool next(int i, Unit& u) const { const int s = i * G + c; if (s >= 8 * KP) return false; const int t = s / KP; u.pn = t & 3; u.kp = s % KP; u.pm = (t >> 2) * 33; return true; }
    __device__ __forceinline__ void a_ready(const Unit&) const {}
    __device__ __forceinline__ void done(const Unit&) const {}
    __device__ __forceinline__ size_t aoff(const Unit& u) const { return (size_t)u.kp * 512; }
    __device__ __forceinline__ size_t boff(const Unit& u) const { return (size_t)u.kp * 512; }
};
struct OneUnit {
    int pm, pn;
    __device__ bool next(int i, Unit& u) const { if (i) return false; u.pm = pm; u.pn = pn; return true; }
    __device__ __forceinline__ void a_ready(const Unit&) const {}
    __device__ __forceinline__ void done(const Unit&) const {}
    __device__ __forceinline__ size_t aoff(const Unit&) const { return 0; }
    __device__ __forceinline__ size_t boff(const Unit&) const { return 0; }
};
}

#define XB_TMO      128
#define XB_XCNT(j)  (256  + 64 * (j))
#define XB_XSUB(j)  (1280 + 64 * (j))
#define XB_XGEN(j)  (2304 + 64 * (j))
#define XB_TOP      3328
#define XB_TOPGEN   3392
#define XCD_BAR_WORDS 3456
#define XB_SPIN_CAP (1u << 18)

__device__ __forceinline__ unsigned xb_ld(unsigned* p)              { return __hip_atomic_load(p, __ATOMIC_RELAXED, __HIP_MEMORY_SCOPE_AGENT); }
__device__ __forceinline__ unsigned xb_add(unsigned* p, unsigned v) { return __hip_atomic_fetch_add(p, v, __ATOMIC_RELAXED, __HIP_MEMORY_SCOPE_AGENT); }
__device__ __forceinline__ unsigned xb_xcc_id() { return (unsigned)__builtin_amdgcn_s_getreg((3 << 11) | 20) & 0xFu; }
#define XB_SPIN(cond, bar) do { unsigned _sp = 0; while (cond) { __builtin_amdgcn_s_sleep(1); \
    if ((++_sp & 255u) == 0u) { if (xb_ld(&(bar)[XB_TMO])) break; if (_sp > XB_SPIN_CAP) { atomicAdd(&(bar)[XB_TMO], 1u); break; } } } } while (0)

struct XcdBarrier {
    unsigned* bar; unsigned x;
    volatile LAS unsigned* st;
};

__device__ __forceinline__ XcdBarrier xcd_barrier_post(unsigned* bar, volatile LAS unsigned* st) {
    XcdBarrier b; b.bar = bar; b.x = xb_xcc_id(); b.st = st;
    if (my_tid() == 0) (void)xb_add(&bar[XB_XCNT(b.x)], 1u);
    return b;
}
__device__ __forceinline__ void xcd_barrier_complete(unsigned* bar, unsigned x, unsigned& nloc, unsigned& nx) {
    const unsigned G = gridDim.x * gridDim.y * gridDim.z;
    unsigned sum, cnt, mine, sp = 0u;
    for (;;) {
        sum = 0u; cnt = 0u; mine = 0u;
#pragma unroll
        for (unsigned j = 0; j < 16; ++j) { const unsigned c = xb_ld(&bar[XB_XCNT(j)]); sum += c; cnt += (c > 0u) ? 1u : 0u; mine = (j == x) ? c : mine; }
        if (sum == G) break;
        __builtin_amdgcn_s_sleep(1);
        if ((++sp & 255u) == 0u) { if (xb_ld(&bar[XB_TMO])) break; if (sp > XB_SPIN_CAP) { atomicAdd(&bar[XB_TMO], 1u); break; } }
    }
    nloc = mine > 0u ? mine : 1u; nx = cnt > 0u ? cnt : 1u;
}

__device__ __forceinline__ void xcd_barrier(const XcdBarrier& b) {
    asm volatile("s_waitcnt vmcnt(0)" ::: "memory");
    __syncthreads();
    if (my_tid() == 0) {
        unsigned* bar = b.bar;
        __builtin_amdgcn_s_waitcnt(0);
        unsigned nloc = b.st[0], nx = b.st[1];
        if (nloc == 0u) { xcd_barrier_complete(bar, b.x, nloc, nx); b.st[0] = nloc; b.st[1] = nx; }
        const unsigned old = xb_add(&bar[XB_XSUB(b.x)], 1u);
        const unsigned gen = old / nloc;
        if (old + 1u == (gen + 1u) * nloc) {
            __builtin_amdgcn_fence(__ATOMIC_RELEASE, "agent");
            asm volatile("s_waitcnt vmcnt(0)" ::: "memory");
            const unsigned og = xb_add(&bar[XB_TOP], 1u);
            const unsigned tg = og / nx;
            if (og + 1u == (tg + 1u) * nx) xb_add(&bar[XB_TOPGEN], 1u);
            else XB_SPIN(xb_ld(&bar[XB_TOPGEN]) == tg, bar);
            __builtin_amdgcn_fence(__ATOMIC_ACQUIRE, "agent");
            xb_add(&bar[XB_XGEN(b.x)], 1u);
            asm volatile("s_waitcnt vmcnt(0)" ::: "memory");
        } else {
            XB_SPIN(xb_ld(&bar[XB_XGEN(b.x)]) == gen, bar);
            __builtin_amdgcn_fence(__ATOMIC_ACQUIRE, "agent");
            asm volatile("s_waitcnt vmcnt(0)" ::: "memory");
        }
    }
    __syncthreads();
}

struct Frame {
    LAS unsigned char* lds; volatile LAS unsigned* MISC; unsigned* ctl;
    int tid, lane, wave, G, bid;
    const float *x, *c, *ctx, *cctx, *w_ada, *b_ada, *norm_g, *ffn_wi, *ffn_wo, *w_in, *qk_g, *diff_lam, *subln_g, *w_branch, *w_out;
    float* out; unsigned char* ws;
};
#define WSP(T, off) ((T*)(F.ws + (off)))

__device__ __forceinline__ void transpose_item(const float* W, int N, bf16* WT, int ldt, int k0, int n0, int dst_row0, LAS float* scr, int lane) {
#pragma unroll 8
    for (int i = 0; i < 32; ++i) { const int kk = 2 * i + (lane >> 5); scr[kk * 33 + (lane & 31)] = W[(size_t)(k0 + kk) * N + n0 + (lane & 31)]; }
    LDS_WAIT(); asm volatile("" ::: "memory");
    const int c = lane & 7;
#pragma unroll
    for (int j = 0; j < 4; ++j) { const int n = (lane >> 3) + 8 * j; const LAS float* s = scr + (8 * c) * 33 + n;
        v4u o; o.x = pk2(s[0 * 33], s[1 * 33]); o.y = pk2(s[2 * 33], s[3 * 33]); o.z = pk2(s[4 * 33], s[5 * 33]); o.w = pk2(s[6 * 33], s[7 * 33]);
        *(v4u*)(WT + (size_t)(dst_row0 + n) * ldt + k0 + 8 * c) = o; }
    LDS_WAIT(); asm volatile("" ::: "memory");
}
__device__ __forceinline__ void convert_weights(Frame& F, int l) {
    LAS float* scr = (LAS float*)(F.lds + F.wave * 16384);
    const int gw = F.bid * NWAVES + F.wave, NGW = F.G * NWAVES;
    constexpr int I_UP = 16 * 176, I_DN = 44 * 32, I_IN = 16 * 184, I_BR = 8 * 32, I_OUT = 16 * 32;
    constexpr int NITEMS = 2 * I_UP + 2 * I_DN + I_IN + 3 * I_BR + I_OUT;
    const float* wi = F.ffn_wi + (size_t)l * 2 * 1024 * NUP; const float* wo = F.ffn_wo + (size_t)l * 2 * DFF * 1024;
    const float* win = F.w_in + (size_t)l * 1024 * INW; const float* wbr = F.w_branch + (size_t)l * 3 * 512 * 1024; const float* wout = F.w_out + (size_t)l * 1024 * 1024;
    for (int it = gw; it < NITEMS; it += NGW) {
        int r = it;
        if (r < 2 * I_UP) { const int h = r / I_UP; r -= h * I_UP; const int kb = r / 176, nb = r % 176; int n0 = nb * 32; const int isu = n0 >= DFF; const int nn = n0 - isu * DFF;
            transpose_item(wi + (size_t)h * 1024 * NUP, NUP, WSP(bf16, h ? WS_WUP1 : WS_WUP0), 1024, kb * 64, n0, (nn / 128) * 256 + isu * 128 + (nn % 128), scr, F.lane); continue; }
        r -= 2 * I_UP;
        if (r < 2 * I_DN) { const int h = r / I_DN; r -= h * I_DN; const int kb = r / 32, nb = r % 32;
            transpose_item(wo + (size_t)h * DFF * 1024, 1024, WSP(bf16, h ? WS_WDN1 : WS_WDN0), DFF, kb * 64, nb * 32, nb * 32, scr, F.lane); continue; }
        r -= 2 * I_DN;
        if (r < I_IN) { const int kb = r / 184, nb = r % 184; const int n0 = nb * 32;
            if (n0 >= 2304 && n0 < 2816) continue;
            transpose_item(win, INW, WSP(bf16, WS_WIN), 1024, kb * 64, n0, n0 < 2304 ? n0 : n0 - 512, scr, F.lane); continue; }
        r -= I_IN;
        if (r < 3 * I_BR) { const int i = r / I_BR; r -= i * I_BR; const int kb = r / 32, nb = r % 32;
            transpose_item(wbr + (size_t)i * 512 * 1024, 1024, WSP(bf16, WS_WBR), 512, kb * 64, nb * 32, i * 1024 + nb * 32, scr, F.lane); continue; }
        r -= 3 * I_BR;
        { const int kb = r / 32, nb = r % 32; transpose_item(wout, 1024, WSP(bf16, WS_WOUT), 1024, kb * 64, nb * 32, nb * 32, scr, F.lane); }
    }
    {
        const int t = F.bid * 512 + F.tid;
        if (t < 65536) {
            const int jl = t & 63, rest = t >> 6, kc = rest & 127, rj = rest >> 7; const int row = rj * 64 + jl, g = row >> 7, j = row & 127;
            float a[8];
#pragma unroll
            for (int e = 0; e < 8; ++e) a[e] = 0.f;
            const float* wp = win + (size_t)(kc * 8) * INW + 2304 + g * 128;
            for (int c4 = 0; c4 < 32; ++c4) {
                float cs[4];
#pragma unroll
                for (int q = 0; q < 4; ++q) { const int idx = ((c4 * 4 + q) * j) & 127; float sn, co; sincospif((float)idx * (1.0f / 64.0f), &sn, &co); cs[q] = sn + co; }
#pragma unroll
                for (int e = 0; e < 8; ++e) { const f32x4 w = *(const f32x4*)(wp + (size_t)e * INW + c4 * 4); a[e] += w[0] * cs[0] + w[1] * cs[1] + w[2] * cs[2] + w[3] * cs[3]; }
            }
            v4u o; o.x = pk2(a[0], a[1]); o.y = pk2(a[2], a[3]); o.z = pk2(a[4], a[5]); o.w = pk2(a[6], a[7]);
            *(v4u*)(WSP(bf16, WS_WC) + (size_t)row * 1024 + kc * 8) = o;
        }
    }
}
__device__ __forceinline__ void make_cas(Frame& F) {
    const int t0 = F.bid * 512 + F.tid, NT_ = F.G * 512;
    for (int it = t0; it < HN * HN / 8; it += NT_) { const int k = it >> 9, n0 = (it & 511) * 8; float v[8];
#pragma unroll
        for (int e = 0; e < 8; ++e) { const int idx = (k * (n0 + e)) & (HN - 1); float sn, co; sincospif((float)idx * (2.0f / HN), &sn, &co); v[e] = sn + co; }
        v4u o; o.x = pk2(v[0], v[1]); o.y = pk2(v[2], v[3]); o.z = pk2(v[4], v[5]); o.w = pk2(v[6], v[7]);
        *(v4u*)(WSP(bf16, WS_CAS) + (size_t)k * HN + n0) = o; }
    for (int it = t0; it < 256 * 256 / 8; it += NT_) { const int k = it >> 5, n0 = (it & 31) * 8; float v[8];
#pragma unroll
        for (int e = 0; e < 8; ++e) { const int idx = (k * (n0 + e)) & 255; float sn, co; sincospif((float)idx * (1.0f / 128.0f), &sn, &co); v[e] = sn + co; }
        v4u o; o.x = pk2(v[0], v[1]); o.y = pk2(v[2], v[3]); o.z = pk2(v[4], v[5]); o.w = pk2(v[6], v[7]);
        *(v4u*)(WSP(bf16, WS_CAS256) + (size_t)k * 256 + n0) = o; }
}
__device__ __forceinline__ void make_mod(Frame& F) {
    LAS float* red = (LAS float*)F.lds;
    for (int item = F.bid; item < 288; item += F.G) {
        const int l = item / 144, cb = item % 144;
        const int c4 = F.lane & 15, ks = F.lane >> 4, slice = F.wave * 4 + ks;
        const float* W = F.w_ada + (size_t)l * 1024 * MODW + cb * 64 + c4 * 4;
        f32x4 a0 = {0.f, 0.f, 0.f, 0.f}, a1 = a0, a2 = a0;
        for (int r = 0; r < 32; ++r) { const int k = slice * 32 + r; const f32x4 w = *(const f32x4*)(W + (size_t)k * MODW);
            const float s0 = siluf(F.c[k]), s1 = siluf(F.c[1024 + k]), s2 = siluf(F.cctx[k]); a0 += w * s0; a1 += w * s1; a2 += w * s2; }
#pragma unroll
        for (int q = 0; q < 4; ++q) { red[(slice * 3 + 0) * 64 + c4 * 4 + q] = a0[q]; red[(slice * 3 + 1) * 64 + c4 * 4 + q] = a1[q]; red[(slice * 3 + 2) * 64 + c4 * 4 + q] = a2[q]; }
        __syncthreads();
        if (F.tid < 192) { const int set = F.tid >> 6, col = F.tid & 63; float s = 0.f;
            for (int sl = 0; sl < 32; ++sl) s += red[(sl * 3 + set) * 64 + col];
            WSP(float, WS_MOD)[((size_t)l * 3 + set) * MODW + cb * 64 + col] = s + F.b_ada[(size_t)l * MODW + cb * 64 + col]; }
        __syncthreads();
    }
}
__device__ __forceinline__ const float* hrow_ptr(const float* lat, const float* ctxp, int row, int& set) {
    const int b = row / RPB, w = row % RPB;
    if (w < CTXL) { set = 2; return ctxp + ((size_t)b * CTXL + w) * 1024; }
    set = b; return lat + ((size_t)b * SEQL + (w - CTXL)) * 1024;
}
__device__ __forceinline__ void norm_mod(Frame& F, const float* lat, const float* ctxp, const float* g, const float* modl  , int ishift, float* copy_ctx = nullptr) {
    const int gw = F.bid * NWAVES + F.wave, NGW = F.G * NWAVES;
    for (int row = gw; row < MROWS; row += NGW) {
        int set; const float* hr = hrow_ptr(lat, ctxp, row, set);
        const float* sh = modl + (size_t)set * MODW + ishift * 1024; const float* sc = sh + 1024;
        f32x4 v[4]; float ss = 0.f;
#pragma unroll
        for (int j = 0; j < 4; ++j) { v[j] = *((const f32x4*)hr + F.lane + 64 * j); ss += (v[j][0] * v[j][0] + v[j][1] * v[j][1]) + (v[j][2] * v[j][2] + v[j][3] * v[j][3]); }
        const float rstd = 1.0f / sqrtf(wave_sum(ss) * (1.0f / 1024.0f) + EPSN);
        if (copy_ctx != nullptr && set == 2) { f32x4* cp = (f32x4*)(copy_ctx + (hr - ctxp)) + F.lane;
#pragma unroll
            for (int j = 0; j < 4; ++j) cp[64 * j] = v[j]; }
        unsigned long long* o8 = (unsigned long long*)(WSP(bf16, WS_HN) + (size_t)row * 1024) + F.lane;
#pragma unroll
        for (int j = 0; j < 4; ++j) { const f32x4 gg = *((const f32x4*)g + F.lane + 64 * j), s1 = *((const f32x4*)sc + F.lane + 64 * j), s0 = *((const f32x4*)sh + F.lane + 64 * j);
            const f32x4 y = v[j] * rstd * gg * (s1 + 1.0f) + s0;
            o8[64 * j] = (unsigned long long)pk2(y[0], y[1]) | ((unsigned long long)pk2(y[2], y[3]) << 32); }
    }
}
__device__ __forceinline__ void make_rope(Frame& F) {
    const int t0 = F.bid * 512 + F.tid, NT_ = F.G * 512;
    float* ct = WSP(float, WS_ROPE); float* st = ct + SEQL * 32;
    for (int it = t0; it < SEQL * 32; it += NT_) { const int s = it >> 5, i = it & 31;
        const float inv = exp2f(-(float)(i & 15) * (13.287712379549449f / 16.0f));
        const float pos = (float)((i < 16) ? (s >> 6) : (s & 63)); float sn, cs; sincosf(pos * inv, &sn, &cs); ct[it] = cs; st[it] = sn; }
}
__device__ __forceinline__ void qk_rope(Frame& F, int l) {
    const int gw = F.bid * NWAVES + F.wave, NGW = F.G * NWAVES;
    const float* qg = F.qk_g + (size_t)l * 256;
    const float* ct = WSP(float, WS_ROPE); const float* st = ct + SEQL * 32;
    for (int row = gw; row < MROWS; row += NGW) {
        const int w = row % RPB; bf16* zr = WSP(bf16, WS_Z) + (size_t)row * ZW;
#pragma unroll
        for (int pass = 0; pass < 2; ++pass) {
            const int q = pass * 64 + F.lane; const bool act = q < 104; const int hv = act ? (q >> 2) : 0, c = q & 3;
            int col, gsel; bool isq;
            if (hv < 8) { col = ZQA + hv * 64; gsel = 0; isq = true; } else if (hv < 10) { col = ZKA + (hv - 8) * 64; gsel = 1; isq = false; }
            else if (hv < 18) { col = ZQB + (hv - 10) * 64; gsel = 2; isq = true; } else { col = ZKB + (hv - 18) * 64; gsel = 3; isq = false; }
            const v4u lo = *(const v4u*)(zr + col + 8 * c), hi = *(const v4u*)(zr + col + 32 + 8 * c);
            float x1[8], x2[8];
            x1[0] = bflo(lo.x); x1[1] = bfhi(lo.x); x1[2] = bflo(lo.y); x1[3] = bfhi(lo.y); x1[4] = bflo(lo.z); x1[5] = bfhi(lo.z); x1[6] = bflo(lo.w); x1[7] = bfhi(lo.w);
            x2[0] = bflo(hi.x); x2[1] = bfhi(hi.x); x2[2] = bflo(hi.y); x2[3] = bfhi(hi.y); x2[4] = bflo(hi.z); x2[5] = bfhi(hi.z); x2[6] = bflo(hi.w); x2[7] = bfhi(hi.w);
            float ss = 0.f;
#pragma unroll
            for (int e = 0; e < 8; ++e) ss += x1[e] * x1[e] + x2[e] * x2[e];
            ss += shfl_xor(ss, 1); ss += shfl_xor(ss, 2);
            const float rstd = 1.0f / sqrtf(ss * (1.0f / 64.0f) + EPSN);
            const float sc = isq ? attn_body::C2 : 1.0f;
            const f32x4 ga = *(const f32x4*)(qg + gsel * 64 + 8 * c), gb = *(const f32x4*)(qg + gsel * 64 + 8 * c + 4), gc = *(const f32x4*)(qg + gsel * 64 + 32 + 8 * c), gd = *(const f32x4*)(qg + gsel * 64 + 36 + 8 * c);
            f32x4 ca = {1.f, 1.f, 1.f, 1.f}, cb = ca, sa = {0.f, 0.f, 0.f, 0.f}, sb = sa;
            if (w >= CTXL) { const int s = w - CTXL; ca = *(const f32x4*)(ct + s * 32 + 8 * c); cb = *(const f32x4*)(ct + s * 32 + 8 * c + 4); sa = *(const f32x4*)(st + s * 32 + 8 * c); sb = *(const f32x4*)(st + s * 32 + 8 * c + 4); }
            float o1[8], o2[8];
#pragma unroll
            for (int e = 0; e < 8; ++e) { const float g1 = e < 4 ? ga[e & 3] : gb[e & 3], g2 = e < 4 ? gc[e & 3] : gd[e & 3], cs = e < 4 ? ca[e & 3] : cb[e & 3], sn = e < 4 ? sa[e & 3] : sb[e & 3];
                const float y1 = x1[e] * rstd * g1, y2 = x2[e] * rstd * g2; o1[e] = (y1 * cs - y2 * sn) * sc; o2[e] = (y1 * sn + y2 * cs) * sc; }
            if (act) { v4u a, b2; a.x = pk2(o1[0], o1[1]); a.y = pk2(o1[2], o1[3]); a.z = pk2(o1[4], o1[5]); a.w = pk2(o1[6], o1[7]);
                b2.x = pk2(o2[0], o2[1]); b2.y = pk2(o2[2], o2[3]); b2.z = pk2(o2[4], o2[5]); b2.w = pk2(o2[6], o2[7]);
                *(v4u*)(zr + col + 8 * c) = a; *(v4u*)(zr + col + 32 + 8 * c) = b2; }
        }
    }
}
__device__ __forceinline__ void make_pq(Frame& F) {
    const int t0 = F.bid * 512 + F.tid, NT_ = F.G * 512;
    const bf16* T1 = WSP(bf16, WS_T1T); bf16* PQ = WSP(bf16, WS_PQ);
    for (int it = t0; it < 2 * 512 * HN; it += NT_) {
        const int n = it & (HN - 1), col = (it >> 12) & 511, b = it >> 21;
        const bf16* xr = T1 + (size_t)col * MROWS + b * RPB + CTXL;
        const int nm = (HN - n) & (HN - 1);
        const float x0 = bf2f(xr[n]), x1 = bf2f(xr[n + HN]), y0 = bf2f(xr[nm]), y1 = bf2f(xr[nm + HN]);
        float sn, co, snm, com; sincospif((float)n * (1.0f / HN), &sn, &co); sincospif((float)nm * (1.0f / HN), &snm, &com);
        const float p = x0 + x1, q = (x0 - x1) * co + (y0 - y1) * snm;
        PQ[((size_t)(b * 2 + 0) * 512 + col) * HN + n] = (bf16)(pk2(p, 0.f) & 0xffffu);
        PQ[((size_t)(b * 2 + 1) * 512 + col) * HN + n] = (bf16)(pk2(q, 0.f) & 0xffffu);
    }
}
__device__ __forceinline__ void post_mix(Frame& F, int l) {
    const int gw = F.bid * NWAVES + F.wave, NGW = F.G * NWAVES;
    const float lam_init = 0.8f - 0.6f * expf(-0.3f * (float)l);
    const float* dl = F.diff_lam + (size_t)l * 256;
    const float s1 = wave_sum(dl[F.lane] * dl[64 + F.lane]), s2 = wave_sum(dl[128 + F.lane] * dl[192 + F.lane]);
    const float lam = expf(s1) - expf(s2) + lam_init;
    const float* sg = F.subln_g + (size_t)l * 128 + (F.lane & 15) * 8;
    float gsc[8];
#pragma unroll
    for (int e = 0; e < 8; ++e) gsc[e] = sg[e] * (1.0f - lam_init);
    const bf16* OB = WSP(bf16, WS_HN); const bf16* T2 = WSP(bf16, WS_T2); bf16* Z = WSP(bf16, WS_Z);
    for (int row = gw; row < MROWS; row += NGW) {
        const int b = row / RPB, w = row % RPB;
        {
            const v4u a = *(const v4u*)(OB + (size_t)row * 1024 + F.lane * 8), c2 = *(const v4u*)(OB + (size_t)row * 1024 + 512 + F.lane * 8);
            float d[8];
            d[0] = bflo(a.x) - lam * bflo(c2.x); d[1] = bfhi(a.x) - lam * bfhi(c2.x); d[2] = bflo(a.y) - lam * bflo(c2.y); d[3] = bfhi(a.y) - lam * bfhi(c2.y);
            d[4] = bflo(a.z) - lam * bflo(c2.z); d[5] = bfhi(a.z) - lam * bfhi(c2.z); d[6] = bflo(a.w) - lam * bflo(c2.w); d[7] = bfhi(a.w) - lam * bfhi(c2.w);
            float ss = 0.f;
#pragma unroll
            for (int e = 0; e < 8; ++e) ss += d[e] * d[e];
#pragma unroll
            for (int o = 1; o < 16; o <<= 1) ss += shfl_xor(ss, o);
            const float rstd = 1.0f / sqrtf(ss * (1.0f / 128.0f) + EPSN);
            v4u o; o.x = pk2(d[0] * rstd * gsc[0], d[1] * rstd * gsc[1]); o.y = pk2(d[2] * rstd * gsc[2], d[3] * rstd * gsc[3]);
            o.z = pk2(d[4] * rstd * gsc[4], d[5] * rstd * gsc[5]); o.w = pk2(d[6] * rstd * gsc[6], d[7] * rstd * gsc[7]);
            *(v4u*)(Z + (size_t)row * ZW + ZQB + F.lane * 8) = o;
        }
        {
            int mrow; float sc;
            if (w < CTXL) { mrow = b * RPB + ((CTXL - w) & (CTXL - 1)); sc = 0.5f * 0.005524271728019903f; }
            else { const int s = w - CTXL; mrow = b * RPB + CTXL + ((SEQL - s) & (SEQL - 1)); sc = 1.0f / 2048.0f; }
            const int g = F.lane >> 4, j0 = (F.lane & 15) * 8;
            const bf16* rk = T2 + (size_t)row * 512 + g * 128; const v4u mv = *(const v4u*)(T2 + (size_t)mrow * 512 + g * 128 + j0);
            float r[8];
#pragma unroll
            for (int e = 0; e < 8; ++e) r[e] = bf2f(rk[(128 - (j0 + e)) & 127]);
            v4u o; o.x = pk2((r[0] + bflo(mv.x)) * sc, (r[1] + bfhi(mv.x)) * sc); o.y = pk2((r[2] + bflo(mv.y)) * sc, (r[3] + bfhi(mv.y)) * sc);
            o.z = pk2((r[4] + bflo(mv.z)) * sc, (r[5] + bfhi(mv.z)) * sc); o.w = pk2((r[6] + bflo(mv.w)) * sc, (r[7] + bfhi(mv.w)) * sc);
            *(v4u*)(Z + (size_t)row * ZW + ZKB + F.lane * 8) = o;
        }
    }
}
__device__ __forceinline__ void mixer_phase(Frame& F, int l) {
    constexpr int NHL = 128, NHC = 4, NAL = NBATCH * 24 * 32, NAC = NBATCH * 24;
    const int TOTAL = (l == NLAYER - 1) ? NHL + NAL : NHL + NAL + NHC + NAC;
    unsigned* qctr = F.ctl + CW_Q + 64 * l;
    bf16* Z = WSP(bf16, WS_Z);
    for (;;) {
        if (F.tid == 0) F.MISC[0] = __hip_atomic_fetch_add(qctr, 1u, __ATOMIC_RELAXED, __HIP_MEMORY_SCOPE_AGENT);
        __syncthreads();
        const int it = (int)F.MISC[0];
        __syncthreads();
        if (it >= TOTAL) break;
        if (it < NHL) {
            const int b = it >> 6, r = it & 63, par = r >> 5, r2 = r & 31;
            pg8::Gemm g{WSP(bf16, WS_CAS), WSP(bf16, WS_PQ) + (size_t)(b * 2 + par) * 512 * HN, HN, 512, HN, HN, HN};
            pg8::OneUnit S{r2 >> 1, r2 & 1};
            pg8::EpiStore E{WSP(bf16, WS_T2), 512, 1 << 30, b * RPB + CTXL + par, 2};
            pg8::gemm_phase<pg8::EpiStore, pg8::OneUnit, true, true, HN, HN, HN>(F.lds, g, S, E);
        } else if (it >= NHL + NAL && it < NHL + NAL + NHC) {
            const int r = it - NHL - NAL, b = r >> 1;
            pg8::Gemm g{WSP(bf16, WS_CAS256), WSP(bf16, WS_T1T) + (size_t)b * RPB, 256, 512, 256, 256, MROWS};
            pg8::OneUnit S{0, r & 1};
            pg8::EpiStore E{WSP(bf16, WS_T2), 512, 1 << 30, b * RPB, 1};
            pg8::gemm_phase<pg8::EpiStore, pg8::OneUnit, true, true, 256, 256, MROWS>(F.lds, g, S, E);
        } else {
            int r = it - NHL, b, hu, qrow, nt;
            if (r < NAL) { const int qb = r & 31; r >>= 5; hu = r % 24; b = r / 24; qrow = b * RPB + CTXL + qb * 256; nt = RPB / 64; }
            else { r -= NAL + NHC; hu = r % 24; b = r / 24; qrow = b * RPB; nt = CTXL / 64; }
            const bf16 *Qp, *Kp, *Vp; bf16* Op; int po;
            if (hu < 8) { Qp = Z + ZQA + hu * 64; Kp = Z + ZKA + (hu >> 2) * 64; Vp = Z + ZVA + (hu >> 2) * 64; Op = Z + ZQA + hu * 64; po = ZW; }
            else { const int j = hu - 8, h = j >> 2, mm = (j >> 1) & 1, vh = j & 1; Qp = Z + ZQB + (h * 2 + mm) * 64; Kp = Z + ZKB + (h * 2 + mm) * 64; Vp = Z + ZVB + h * 128 + vh * 64;
                   Op = WSP(bf16, WS_HN) + mm * 512 + h * 128 + vh * 64; po = 1024; }
            const size_t kv0 = (size_t)b * RPB;
            attn_body::attn_unit<8>((const attn_body::bf16*)(Qp + (size_t)qrow * ZW), ZW, (const attn_body::bf16*)(Kp + kv0 * ZW), ZW, (const attn_body::bf16*)(Vp + kv0 * ZW), ZW,
                                    (attn_body::bf16*)(Op + (size_t)qrow * po), po, nt, (char*)F.lds);
        }
    }
}

#ifndef MK_PER_PHASE
#define MK_PER_PHASE 0
#endif
constexpr int NPHASE = 1 + 13 * NLAYER;
struct Args { const float* in[15]; float* out; unsigned char* ws; int ph_lo, ph_hi; };
__device__ __forceinline__ void load_frame(Frame& F) {
    const __attribute__((address_space(4))) Args* a = (const __attribute__((address_space(4))) Args*)__builtin_amdgcn_kernarg_segment_ptr();
    asm volatile("" : "+s"(a));
    extern __shared__ __attribute__((aligned(16))) unsigned char lds_raw[];
    F.lds = (LAS unsigned char*)lds_raw; F.MISC = (volatile LAS unsigned*)(F.lds + MISC_OFF);
    int t = my_tid(); asm volatile("" : "+v"(t));
    F.tid = t; F.lane = t & 63; F.wave = __builtin_amdgcn_readfirstlane(t >> 6); F.G = gridDim.x; F.bid = blockIdx.x;
    F.x = a->in[0]; F.c = a->in[1]; F.ctx = a->in[2]; F.cctx = a->in[3]; F.w_ada = a->in[4]; F.b_ada = a->in[5]; F.norm_g = a->in[6]; F.ffn_wi = a->in[7];
    F.ffn_wo = a->in[8]; F.w_in = a->in[9]; F.qk_g = a->in[10]; F.diff_lam = a->in[11]; F.subln_g = a->in[12]; F.w_branch = a->in[13]; F.w_out = a->in[14];
    F.out = a->out; F.ws = a->ws; F.ctl = (unsigned*)(a->ws + WS_CTL);
}
#ifndef MK_MASK
#define MK_MASK 0xffffffffu
#endif
#define EN(j) (((MK_MASK) >> (j)) & 1u)
__device__ __forceinline__ void seam_barrier() {
    const __attribute__((address_space(4))) Args* a = (const __attribute__((address_space(4))) Args*)__builtin_amdgcn_kernarg_segment_ptr();
    asm volatile("" : "+s"(a));
    extern __shared__ __attribute__((aligned(16))) unsigned char lds_raw[];
    XcdBarrier b; b.bar = (unsigned*)(a->ws + WS_CTL) + CW_BAR; b.x = xb_xcc_id(); b.st = (volatile LAS unsigned*)((LAS unsigned char*)lds_raw + MISC_OFF) + 8;
    xcd_barrier(b);
}
#define LF() Frame F; load_frame(F); float* hlat = F.out; float* hctx = WSP(float, WS_HC); const float* modl = WSP(float, WS_MOD) + (size_t)l * 3 * MODW; const float* ng = F.norm_g + (size_t)l * 3 * 1024; \
    const float* slat = (l == 0) ? F.x : hlat; const float* sctx = (l == 0) ? F.ctx : hctx; (void)hlat; (void)hctx; (void)modl; (void)ng; (void)slat; (void)sctx
__global__ void __launch_bounds__(NWAVES * 64, 2) mk_fwd(Args args) {
    cg::grid_group grid = cg::this_grid();
    const int lo = args.ph_lo, hi = args.ph_hi;
    {
        extern __shared__ __attribute__((aligned(16))) unsigned char lds_raw[];
        volatile LAS unsigned* misc = (volatile LAS unsigned*)((LAS unsigned char*)lds_raw + MISC_OFF);
        const int t0 = threadIdx.x;
        if (t0 < 32) misc[t0] = 0u;
        if ((t0 & 63) == 0) ((volatile LAS int*)((LAS unsigned char*)lds_raw + WTAB_OFF))[hw_slot()] = t0 >> 6;
        __syncthreads();
        if (hi - lo > 1) (void)xcd_barrier_post((unsigned*)(args.ws + WS_CTL) + CW_BAR, misc + 8);
    }
#define IN(k) (lo <= (k) && (k) < hi)
#define SEAM(k) do { if (IN(k) && IN((k) + 1)) { if ((k) == 0) grid.sync(); else seam_barrier(); } } while (0)
    if (EN(0) && IN(0)) { const int l = 0; LF(); make_mod(F); convert_weights(F, 0); make_cas(F); make_rope(F); }
    SEAM(0);
    for (int l = 0; l < NLAYER; ++l) {
        const int p0 = 1 + 13 * l;
        if (EN(1) && IN(p0 + 0)) { LF(); if (l > 0) convert_weights(F, l); norm_mod(F, slat, sctx, ng, modl, 0, (l == 0) ? hctx : nullptr); }
        SEAM(p0 + 0);
        if (EN(2) && IN(p0 + 1)) { LF(); pg8::Gemm g{WSP(bf16, WS_HN), WSP(bf16, WS_WUP0), MROWS, NUP, 1024, 1024, 1024}; pg8::StaticOrder S; S.init(MROWS, NUP, F.G, F.bid);
            pg8::EpiSwiGLU E{WSP(bf16, WS_Z), DFF}; pg8::gemm_phase<pg8::EpiSwiGLU, pg8::StaticOrder, true, true, 1024, 1024, 1024>(F.lds, g, S, E); }
        SEAM(p0 + 1);
        if (EN(3) && IN(p0 + 2)) { LF();
            { pg8::Gemm g{WSP(bf16, WS_Z), WSP(bf16, WS_WDN0), MROWS, 1024, DFF, DFF, DFF}; pg8::LatOrder S; S.init(1024, F.G, F.bid);
              pg8::EpiResid E{slat, sctx, hlat, hctx, modl + 2 * 1024, 0.5f}; pg8::gemm_phase<pg8::EpiResid, pg8::LatOrder, true, true, DFF, DFF, DFF>(F.lds, g, S, E); }
            { pg8::Gemm g{WSP(bf16, WS_Z), WSP(bf16, WS_WDN0), MROWS, 1024, 256, DFF, DFF}; pg8::CtxSplit S{F.G, F.G - 1 - F.bid, DFF / 256};
              pg8::EpiResidA E{hctx, modl + 2 * MODW + 2 * 1024, 0.5f}; pg8::gemm_phase<pg8::EpiResidA, pg8::CtxSplit, true, true, 256, DFF, DFF>(F.lds, g, S, E); } }
        SEAM(p0 + 2);
        if (EN(4) && IN(p0 + 3)) { LF(); norm_mod(F, hlat, hctx, ng + 1024, modl, 3); }
        SEAM(p0 + 3);
        if (EN(5) && IN(p0 + 4)) { LF();
            { pg8::Gemm g{WSP(bf16, WS_HN), WSP(bf16, WS_WIN), MROWS, ZW, 1024, 1024, 1024}; pg8::StaticOrder S; S.init(MROWS, ZW, F.G, F.bid);
              pg8::EpiStore E{WSP(bf16, WS_Z), ZW, ZGATE, 0, 1}; pg8::gemm_phase<pg8::EpiStore, pg8::StaticOrder, true, true, 1024, 1024, 1024>(F.lds, g, S, E); }
            { pg8::Gemm g{WSP(bf16, WS_WC), WSP(bf16, WS_HN), 512, MROWS, 1024, 1024, 1024}; pg8::StaticOrder S; S.init(512, MROWS, F.G, F.G - 1 - F.bid);
              pg8::EpiStore E{WSP(bf16, WS_T1T), MROWS, 1 << 30, 0, 1}; pg8::gemm_phase<pg8::EpiStore, pg8::StaticOrder, true, true, 1024, 1024, 1024>(F.lds, g, S, E); }
        }
        SEAM(p0 + 4);
        if (EN(6) && IN(p0 + 5)) { LF(); qk_rope(F, l); make_pq(F); }
        SEAM(p0 + 5);
        if (EN(7) && IN(p0 + 6)) { LF(); mixer_phase(F, l); }
        SEAM(p0 + 6);
        if (EN(8) && IN(p0 + 7)) { LF(); post_mix(F, l); }
        SEAM(p0 + 7);
        if (EN(9) && IN(p0 + 8)) { LF(); pg8::Gemm g{WSP(bf16, WS_Z), WSP(bf16, WS_WBR), MROWS, 3072, 512, ZW, 512}; pg8::MergeOrder S{F.G, F.bid, l == NLAYER - 1};
            pg8::EpiMerge E{WSP(bf16, WS_Z), WSP(bf16, WS_HN)}; pg8::gemm_phase<pg8::EpiMerge, pg8::MergeOrder, true, true, 512, ZW, 512>(F.lds, g, S, E); }
        SEAM(p0 + 8);
        if (EN(10) && IN(p0 + 9)) { LF();
            { pg8::Gemm g{WSP(bf16, WS_HN), WSP(bf16, WS_WOUT), MROWS, 1024, 1024, 1024, 1024}; pg8::LatOrder S; S.init(1024, F.G, F.bid);
              pg8::EpiResid E{hlat, hctx, hlat, hctx, modl + 5 * 1024, 1.0f}; pg8::gemm_phase<pg8::EpiResid, pg8::LatOrder, true, true, 1024, 1024, 1024>(F.lds, g, S, E); }
            if (l < NLAYER - 1) { pg8::Gemm g{WSP(bf16, WS_HN), WSP(bf16, WS_WOUT), MROWS, 1024, 256, 1024, 1024}; pg8::CtxSplit S{F.G, F.G - 1 - F.bid, 4};
              pg8::EpiResidA E{hctx, modl + 2 * MODW + 5 * 1024, 1.0f}; pg8::gemm_phase<pg8::EpiResidA, pg8::CtxSplit, true, true, 256, 1024, 1024>(F.lds, g, S, E); } }
        SEAM(p0 + 9);
        if (EN(11) && IN(p0 + 10)) { LF(); norm_mod(F, hlat, hctx, ng + 2048, modl, 6); }
        SEAM(p0 + 10);
        if (EN(12) && IN(p0 + 11)) { LF(); pg8::Gemm g{WSP(bf16, WS_HN), WSP(bf16, WS_WUP1), MROWS, NUP, 1024, 1024, 1024}; pg8::StaticOrder S; S.init(MROWS, NUP, F.G, F.bid);
            pg8::EpiSwiGLU E{WSP(bf16, WS_Z), DFF}; pg8::gemm_phase<pg8::EpiSwiGLU, pg8::StaticOrder, true, true, 1024, 1024, 1024>(F.lds, g, S, E); }
        SEAM(p0 + 11);
        if (EN(13) && IN(p0 + 12)) { LF();
            { pg8::Gemm g{WSP(bf16, WS_Z), WSP(bf16, WS_WDN1), MROWS, 1024, DFF, DFF, DFF}; pg8::LatOrder S; S.init(1024, F.G, F.bid);
              pg8::EpiResid E{hlat, hctx, hlat, hctx, modl + 8 * 1024, 0.5f}; pg8::gemm_phase<pg8::EpiResid, pg8::LatOrder, true, true, DFF, DFF, DFF>(F.lds, g, S, E); }
            if (l < NLAYER - 1) { pg8::Gemm g{WSP(bf16, WS_Z), WSP(bf16, WS_WDN1), MROWS, 1024, 256, DFF, DFF}; pg8::CtxSplit S{F.G, F.G - 1 - F.bid, DFF / 256};
              pg8::EpiResidA E{hctx, modl + 2 * MODW + 8 * 1024, 0.5f}; pg8::gemm_phase<pg8::EpiResidA, pg8::CtxSplit, true, true, 256, DFF, DFF>(F.lds, g, S, E); } }
        SEAM(p0 + 12);
    }
#undef IN
#undef SEAM
}

extern "C" void kernel_launch(void* const* d_in, const int* in_sizes, int n_in, void* d_out, int out_size, void* d_ws, size_t ws_size, hipStream_t stream) {
    static int grid = 0;
    if (grid == 0) {
        if (n_in != 15 || ws_size < WS_END) { fprintf(stderr, "kernel_launch: need 15 inputs and >= %zu bytes of workspace; got n_in %d, ws %zu\n", (size_t)WS_END, n_in, ws_size); grid = -1; return; }
        int dev = 0, cus = 0, per_cu = 0;
        if (hipGetDevice(&dev) != hipSuccess || hipDeviceGetAttribute(&cus, hipDeviceAttributeMultiprocessorCount, dev) != hipSuccess) { grid = -1; return; }
        if (hipFuncSetAttribute((const void*)mk_fwd, hipFuncAttributeMaxDynamicSharedMemorySize, LDS_BYTES) != hipSuccess) { fprintf(stderr, "kernel_launch: hipFuncSetAttribute failed\n"); grid = -1; return; }
        if (hipOccupancyMaxActiveBlocksPerMultiprocessor(&per_cu, (const void*)mk_fwd, NWAVES * 64, LDS_BYTES) != hipSuccess || per_cu < 1) { fprintf(stderr, "kernel_launch: occupancy query says %d\n", per_cu); per_cu = 1; }
        (void)hipGetLastError();
        grid = cus * per_cu;
    }
    if (grid < 0) return;
    (void)hipMemsetAsync((char*)d_ws + WS_CTL, 0, CTL_ZERO_BYTES, stream);
    Args a{};
    for (int i = 0; i < 15; ++i) a.in[i] = (const float*)d_in[i];
    a.out = (float*)d_out; a.ws = (unsigned char*)d_ws;
#if MK_PER_PHASE
    for (int p = 0; p < NPHASE; ++p) { a.ph_lo = p; a.ph_hi = p + 1; hipLaunchKernelGGL(mk_fwd, dim3(grid), dim3(NWAVES * 64), LDS_BYTES, stream, a); }
#else
    a.ph_lo = 0; a.ph_hi = NPHASE;
    void* kargs[] = {&a};
    hipError_t e = hipLaunchCooperativeKernel((const void*)mk_fwd, dim3(grid), dim3(NWAVES * 64), kargs, LDS_BYTES, stream);
    if (e != hipSuccess) fprintf(stderr, "kernel_launch: cooperative launch failed: %s (grid %d)\n", hipGetErrorString(e), grid);
#endif
}
```

```cpp
#include <hip/hip_runtime.h>
#include <hip/hip_cooperative_groups.h>
#include <hip/hip_bf16.h>
#include <cstdio>
#include <cstdint>
#include <cmath>
namespace cg = cooperative_groups;

#define LAS __attribute__((address_space(3)))
constexpr int LDS_BYTES = 147456, MISC_OFF = 131072 + 320, WTAB_OFF = MISC_OFF + 128;
__device__ __forceinline__ int lane_id() { int l; asm volatile("v_mbcnt_lo_u32_b32 %0, -1, 0\n\tv_mbcnt_hi_u32_b32 %0, -1, %0" : "=&v"(l)); return l; }
__device__ __forceinline__ unsigned hw_slot() { return (unsigned)__builtin_amdgcn_s_getreg((5 << 11) | 4) & 63u; }
__device__ __forceinline__ int my_tid() {
    extern __shared__ __attribute__((aligned(16))) unsigned char lds_raw[];
    const int w = ((volatile LAS int*)((LAS unsigned char*)lds_raw + WTAB_OFF))[hw_slot()];
    return __builtin_amdgcn_readfirstlane(w) * 64 + lane_id();
}

namespace pg8 {
#define PG8_LAS __attribute__((address_space(3)))
typedef unsigned short bf16_t;
typedef short bf16x8 __attribute__((ext_vector_type(8)));
typedef float f32x4 __attribute__((ext_vector_type(4)));
typedef unsigned u32x4 __attribute__((ext_vector_type(4)));
constexpr int BM = 256, BK = 64, HALF = 128, HTB = HALF * BK * 2  , STAGE_BYTES = 8 * HTB, NXCD = 8, WGM = 8;

__host__ __device__ __forceinline__ int lds_byte(int r, int c) { const int st = (r >> 4) * 2 + (c >> 5), rr = r & 15, cc = c & 31, ob = rr * 64 + cc * 2; return st * 1024 + (ob ^ (((ob >> 9) & 1) << 5)); }
__host__ __device__ __forceinline__ void stage_rc(int b, int& R, int& C) { const int st = b / 1024, sb = b % 1024, swz = sb ^ (((sb >> 9) & 1) << 5); R = (st >> 1) * 16 + swz / 64; C = (st & 1) * 32 + (swz % 64) / 2; }
__host__ __device__ __forceinline__ int perm32(int rho) { const int n = rho >> 4, i = rho & 15; return 8 * (i >> 2) + 4 * n + (i & 3); }

struct Unit { int pm, pn, kp; };
struct Gemm { const bf16_t* A; const bf16_t* Bt; int M, N, K, lda, ldb; };

struct StaticOrder {
    int nM, nN, nwg, G, c;
    __host__ __device__ void init(int M, int N, int G_, int c_) { nM = M / BM; nN = N / BM; nwg = nM * nN; G = G_; c = c_; }
    __host__ __device__ bool next(int i, Unit& u) const {
        const long L = (long)i * G + c; if (L >= nwg) return false;
        int wgid = (int)L; { const int q = nwg / NXCD, r = nwg % NXCD, xcd = wgid % NXCD, off = wgid / NXCD; wgid = (xcd < r ? xcd * (q + 1) : r * (q + 1) + (xcd - r) * q) + off; }
        const int nig = WGM * nN, gid = wgid / nig, fm = gid * WGM, gsz = (nM - fm) < WGM ? (nM - fm) : WGM;
        u.pm = fm + ((wgid % nig) % gsz); u.pn = (wgid % nig) / gsz; return true;
    }
    __device__ __forceinline__ void a_ready(const Unit&) const {}
    __device__ __forceinline__ void done(const Unit&) const {}
    __device__ __forceinline__ size_t aoff(const Unit&) const { return 0; }
    __device__ __forceinline__ size_t boff(const Unit&) const { return 0; }
};


__device__ __forceinline__ unsigned cvt_pk_bf16(float lo, float hi) { unsigned r; asm volatile("v_cvt_pk_bf16_f32 %0, %1, %2" : "=v"(r) : "v"(lo), "v"(hi)); return r; }
typedef float f32x2 __attribute__((ext_vector_type(2)));

template <class Epi, class Sched, bool ALIGN_EPI, bool SP2, int TK, int TLDA, int TLDB>
__device__ __forceinline__ void gemm_phase(PG8_LAS unsigned char* lds, const Gemm g, const Sched& S, const Epi& E) {
    int tid_ = my_tid(); asm volatile("" : "+v"(tid_)); const int tid = tid_, wid = __builtin_amdgcn_readfirstlane(tid >> 6), lane = tid & 63, wr = wid >> 2, wc = wid & 3, fr = lane & 15, fq = lane >> 4;
    constexpr int K = TK, nt = K / BK;
    unsigned voffA[2], voffB[2];
#pragma unroll
    for (int i = 0; i < 2; ++i) { int R, C; stage_rc(tid * 16 + i * 8192, R, C); const int Rb = Epi::PERM ? ((R & ~31) + perm32(R & 31)) : R;
        voffA[i] = (unsigned)(R * TLDA + C) * 2u; voffB[i] = (unsigned)(Rb * TLDB + C) * 2u; }
    const size_t kstep = (size_t)(BK * 2);
    const size_t hstepA = (size_t)HALF * TLDA * 2, hstepB = (size_t)HALF * TLDB * 2;
    const size_t tstepA = 2 * hstepA, tstepB = 2 * hstepB;
    const unsigned ldsw = (unsigned)wid * 1024u;
    const int aoff = lds_byte(wr * 64 + fr, fq * 8), boff = lds_byte(wc * 32 + fr, fq * 8);
#define PG8_SA(b, h) (((b) * 2 + (h)) * HTB)
#define PG8_SB(b, h) ((4 + (b) * 2 + (h)) * HTB)
#define PG8_STAGE(bufoff, gbase, voff) do { _Pragma("unroll") for (int _i = 0; _i < 2; ++_i) \
        __builtin_amdgcn_global_load_lds((const unsigned*)((const char*)(gbase) + (voff)[_i]), (PG8_LAS unsigned*)(lds + (bufoff) + ldsw + _i * 8192), 16, 0, 0); } while (0)
#define PG8_LDA(dst, b, h) do { _Pragma("unroll") for (int m = 0; m < 4; ++m) _Pragma("unroll") for (int k = 0; k < 2; ++k) dst[m][k] = *(const PG8_LAS bf16x8*)(lds + PG8_SA(b, h) + aoff + m * 2048 + k * 1024); } while (0)
#define PG8_LDB(dst, b, h) do { _Pragma("unroll") for (int n = 0; n < 2; ++n) _Pragma("unroll") for (int k = 0; k < 2; ++k) dst[n][k] = *(const PG8_LAS bf16x8*)(lds + PG8_SB(b, h) + boff + n * 2048 + k * 1024); } while (0)
#define PG8_MMA(ai, bj, At, Bt) do { __builtin_amdgcn_s_setprio(1); _Pragma("unroll") for (int m = 0; m < 4; ++m) _Pragma("unroll") for (int n = 0; n < 2; ++n) _Pragma("unroll") for (int k = 0; k < 2; ++k) \
        acc[ai][bj][m][n] = __builtin_amdgcn_mfma_f32_16x16x32_bf16(Bt[n][k], At[m][k], acc[ai][bj][m][n], 0, 0, 0); __builtin_amdgcn_s_setprio(0); } while (0)
#define PG8_WAIT_V(n) asm volatile("s_waitcnt vmcnt(" #n ")" ::: "memory")
#define PG8_WAIT_L(n) asm volatile("s_waitcnt lgkmcnt(" #n ")" ::: "memory")
#define PG8_BAR __builtin_amdgcn_s_barrier()
#define PG8_SCHED __builtin_amdgcn_sched_barrier(0)
    Unit cur, nxt; int ui = 0;
    if (!S.next(0, cur)) return;
    f32x4 acc[2][2][4][2];
#pragma unroll
    for (int a = 0; a < 2; ++a)
#pragma unroll
        for (int b = 0; b < 2; ++b)
#pragma unroll
            for (int m = 0; m < 4; ++m)
#pragma unroll
                for (int n = 0; n < 2; ++n) acc[a][b][m][n] = (f32x4){0.f, 0.f, 0.f, 0.f};
    bf16x8 At[4][2], B0[2][2], B1[2][2];
    const char* cA = (const char*)g.A + (size_t)cur.pm * tstepA + S.aoff(cur); const char* cB = (const char*)g.Bt + (size_t)cur.pn * tstepB + S.boff(cur);
    S.a_ready(cur);
    if constexpr (SP2) {
        PG8_STAGE(PG8_SB(0, 0), cB, voffB); PG8_STAGE(PG8_SB(0, 1), cB + hstepB, voffB); PG8_STAGE(PG8_SA(0, 0), cA, voffA); PG8_STAGE(PG8_SA(0, 1), cA + hstepA, voffA);
        if (wr == 1) PG8_BAR;
        PG8_WAIT_V(2); PG8_BAR;
        PG8_STAGE(PG8_SB(1, 0), cB + kstep, voffB); PG8_STAGE(PG8_SA(1, 0), cA + kstep, voffA); PG8_STAGE(PG8_SB(1, 1), cB + hstepB + kstep, voffB);
        PG8_WAIT_V(6); PG8_BAR;
    } else {
        PG8_STAGE(PG8_SB(0, 0), cB, voffB); PG8_STAGE(PG8_SA(0, 0), cA, voffA); PG8_STAGE(PG8_SB(0, 1), cB + hstepB, voffB); PG8_STAGE(PG8_SA(0, 1), cA + hstepA, voffA);
        if (wr == 1) PG8_BAR;
        PG8_WAIT_V(4); PG8_BAR;
        PG8_STAGE(PG8_SB(1, 0), cB + kstep, voffB); PG8_STAGE(PG8_SA(1, 0), cA + kstep, voffA); PG8_STAGE(PG8_SB(1, 1), cB + hstepB + kstep, voffB);
        PG8_WAIT_V(6); PG8_BAR;
    }
    for (;;) {
        const bool has_next = S.next(ui + 1, nxt);
        const char* nA = has_next ? (const char*)g.A + (size_t)nxt.pm * tstepA + S.aoff(nxt) : cA; const char* nB = has_next ? (const char*)g.Bt + (size_t)nxt.pn * tstepB + S.boff(nxt) : cB;
        for (int t = 0; t < nt; t += 2) {
            const bool last = (t == nt - 2);
            const char* a1 = cA + (size_t)(t + 1) * kstep;
            const char* a2 = last ? nA : cA + (size_t)(t + 2) * kstep; const char* b2 = last ? nB : cB + (size_t)(t + 2) * kstep;
            const char* a3 = a2 + kstep; const char* b3 = b2 + kstep;
            if (last && has_next) S.a_ready(nxt);
            if constexpr (SP2) {
            PG8_LDB(B0, 0, 0); PG8_LDB(B1, 0, 1); PG8_SCHED; PG8_LDA(At, 0, 0); PG8_STAGE(PG8_SA(1, 1), a1 + hstepA, voffA);
            PG8_WAIT_V(8); PG8_WAIT_L(0); PG8_BAR; PG8_MMA(0, 0, At, B0); PG8_MMA(0, 1, At, B1); PG8_BAR; PG8_SCHED;
            PG8_LDA(At, 0, 1); PG8_STAGE(PG8_SB(0, 0), b2, voffB); PG8_STAGE(PG8_SB(0, 1), b2 + hstepB, voffB); PG8_STAGE(PG8_SA(0, 0), a2, voffA);
            PG8_WAIT_V(8); PG8_WAIT_L(0); PG8_BAR; PG8_MMA(1, 0, At, B0); PG8_MMA(1, 1, At, B1); PG8_BAR; PG8_SCHED;
            PG8_LDB(B0, 1, 0); PG8_LDB(B1, 1, 1); PG8_SCHED; PG8_LDA(At, 1, 0); PG8_STAGE(PG8_SA(0, 1), a2 + hstepA, voffA);
            PG8_WAIT_V(8); PG8_WAIT_L(0); PG8_BAR; PG8_MMA(0, 0, At, B0); PG8_MMA(0, 1, At, B1); PG8_BAR; PG8_SCHED;
            PG8_LDA(At, 1, 1); PG8_STAGE(PG8_SB(1, 0), b3, voffB); PG8_STAGE(PG8_SB(1, 1), b3 + hstepB, voffB); PG8_STAGE(PG8_SA(1, 0), a3, voffA);
            PG8_WAIT_V(8); PG8_WAIT_L(0); PG8_BAR; PG8_MMA(1, 0, At, B0); PG8_MMA(1, 1, At, B1); PG8_BAR; PG8_SCHED;
            } else {
            PG8_LDB(B0, 0, 0); PG8_SCHED; PG8_LDA(At, 0, 0); PG8_STAGE(PG8_SA(1, 1), a1 + hstepA, voffA);
            PG8_WAIT_L(8); PG8_BAR; PG8_WAIT_L(0); PG8_MMA(0, 0, At, B0); PG8_BAR; PG8_SCHED;
            PG8_LDB(B1, 0, 1); PG8_STAGE(PG8_SB(0, 0), b2, voffB);
            PG8_BAR; PG8_WAIT_L(0); PG8_MMA(0, 1, At, B1); PG8_BAR;
            PG8_LDA(At, 0, 1); PG8_STAGE(PG8_SA(0, 0), a2, voffA);
            PG8_BAR; PG8_WAIT_L(0); PG8_MMA(1, 0, At, B0); PG8_BAR; PG8_SCHED;
            PG8_STAGE(PG8_SB(0, 1), b2 + hstepB, voffB);
            PG8_WAIT_V(6); PG8_BAR; PG8_MMA(1, 1, At, B1); PG8_BAR;
            PG8_LDB(B0, 1, 0); PG8_SCHED; PG8_LDA(At, 1, 0); PG8_STAGE(PG8_SA(0, 1), a2 + hstepA, voffA);
            PG8_WAIT_L(8); PG8_BAR; PG8_WAIT_L(0); PG8_MMA(0, 0, At, B0); PG8_BAR; PG8_SCHED;
            PG8_LDB(B1, 1, 1); PG8_STAGE(PG8_SB(1, 0), b3, voffB);
            PG8_BAR; PG8_WAIT_L(0); PG8_MMA(0, 1, At, B1); PG8_BAR;
            PG8_LDA(At, 1, 1); PG8_STAGE(PG8_SA(1, 0), a3, voffA);
            PG8_BAR; PG8_WAIT_L(0); PG8_MMA(1, 0, At, B0); PG8_BAR; PG8_SCHED;
            PG8_STAGE(PG8_SB(1, 1), b3 + hstepB, voffB);
            PG8_WAIT_V(6); PG8_BAR; PG8_MMA(1, 1, At, B1); PG8_BAR;
            }
        }
        if constexpr (ALIGN_EPI) { if (wr == 0) PG8_BAR; }
        if constexpr (!Epi::AFTER_DRAIN) { E(acc, cur, wr, wc, fr, fq); S.done(cur); }
        if (!has_next) break;
#pragma unroll
        for (int a = 0; a < 2; ++a)
#pragma unroll
            for (int b = 0; b < 2; ++b)
#pragma unroll
                for (int m = 0; m < 4; ++m)
#pragma unroll
                    for (int n = 0; n < 2; ++n) acc[a][b][m][n] = (f32x4){0.f, 0.f, 0.f, 0.f};
        cur = nxt; cA = nA; cB = nB; ++ui;
        if constexpr (ALIGN_EPI) { if (wr == 1) PG8_BAR; }
    }
    PG8_WAIT_V(0);
    if constexpr (!ALIGN_EPI) { if (wr == 0) PG8_BAR; }
    PG8_BAR;
    if constexpr (Epi::AFTER_DRAIN) { E.fused(acc, cur, wr, wc, fr, fq, lds, wid, lane); S.done(cur); }
#undef PG8_SA
#undef PG8_SB
#undef PG8_STAGE
#undef PG8_LDA
#undef PG8_LDB
#undef PG8_MMA
#undef PG8_WAIT_V
#undef PG8_WAIT_L
#undef PG8_BAR
#undef PG8_SCHED
}
}


namespace attn_body {
using bf16=__hip_bfloat16;
using bf16x8=__attribute__((ext_vector_type(8)))short;
using s16x4=__attribute__((ext_vector_type(4)))short;
using f32x16=__attribute__((ext_vector_type(16)))float;
using u32x4=__attribute__((ext_vector_type(4)))unsigned;
constexpr int D=64;
constexpr int NW=8,QBLK=32,QB=QBLK*NW,KVBLK=64;
constexpr int ATTN_UNIT_ROWS=QB;
__device__ __forceinline__ int crow(int r,int hi){return (r&3)+8*(r>>2)+4*hi;}
#define SBAR() __builtin_amdgcn_sched_barrier(0)
constexpr int NSLOT=3, SLOTB=8192;
constexpr int LDS_K=0, LDS_V=NSLOT*SLOTB, LDS_WS=2*NSLOT*SLOTB, LDS_OST=LDS_WS+NW*64*4, LDS_BYTES=LDS_OST+NW*4096;
constexpr float C2=0.125f*1.4426950408889634f;
__device__ __forceinline__ void glds16(const void*gsrc,unsigned lds_dst){unsigned keep;
  asm volatile("s_mov_b32 %0, m0\n\ts_mov_b32 m0, %2\n\ts_nop 0\n\tglobal_load_lds_dwordx4 %1, off\n\ts_mov_b32 m0, %0":"=&s"(keep):"v"(gsrc),"s"(lds_dst):"memory");}
__device__ __forceinline__ float max3f(float a,float b,float c){float r;asm("v_max3_f32 %0, %1, %2, %3":"=v"(r):"v"(a),"v"(b),"v"(c));return r;}
__device__ __forceinline__ float max2f(float a,float b){float r;asm("v_max_f32_e32 %0, %1, %2":"=v"(r):"v"(a),"v"(b));return r;}
__device__ __forceinline__ float fadd_s(float a,float b){float r;asm("v_add_f32_e32 %0, %1, %2":"=v"(r):"v"(a),"v"(b));return r;}
__device__ __forceinline__ float fsub_s(float a,float b){float r;asm("v_sub_f32_e32 %0, %1, %2":"=v"(r):"v"(a),"v"(b));return r;}
typedef float f32x2_t __attribute__((ext_vector_type(2))); typedef __bf16 bf16x2_t __attribute__((ext_vector_type(2)));
__device__ __forceinline__ unsigned cvtpk_s(float lo,float hi){f32x2_t v={lo,hi};bf16x2_t b=__builtin_convertvector(v,bf16x2_t);return __builtin_bit_cast(unsigned,b);}
#define WAIT_BAR(N) asm volatile("s_waitcnt vmcnt(" #N ") lgkmcnt(0)\n\ts_barrier":::"memory")

__device__ __forceinline__ void qkt(f32x16&p0,f32x16&p1,const char*Kslot,const bf16x8*qr,const f32x16&negm,int r32,int hi){
  const char*kb=Kslot+hi*1024+r32*16;
  #pragma unroll
  for(int d0=0;d0<4;++d0){
    const bf16x8 b0=*reinterpret_cast<const bf16x8*>(kb+d0*2048);
    const bf16x8 b1=*reinterpret_cast<const bf16x8*>(kb+d0*2048+512);
    if(d0==0){p0=__builtin_amdgcn_mfma_f32_32x32x16_bf16(b0,qr[0],negm,0,0,0);p1=__builtin_amdgcn_mfma_f32_32x32x16_bf16(b1,qr[0],negm,0,0,0);}
    else{p0=__builtin_amdgcn_mfma_f32_32x32x16_bf16(b0,qr[d0],p0,0,0,0);p1=__builtin_amdgcn_mfma_f32_32x32x16_bf16(b1,qr[d0],p1,0,0,0);}}
}
typedef __attribute__((address_space(3))) const char* lds_cptr;
typedef short v4i16_t __attribute__((ext_vector_type(4)));
__device__ __forceinline__ void kload8(bf16x8*kf,lds_cptr kp){
  kf[0]=*(const __attribute__((address_space(3))) bf16x8*)(kp);      kf[1]=*(const __attribute__((address_space(3))) bf16x8*)(kp+512);
  kf[2]=*(const __attribute__((address_space(3))) bf16x8*)(kp+2048); kf[3]=*(const __attribute__((address_space(3))) bf16x8*)(kp+2560);
  kf[4]=*(const __attribute__((address_space(3))) bf16x8*)(kp+4096); kf[5]=*(const __attribute__((address_space(3))) bf16x8*)(kp+4608);
  kf[6]=*(const __attribute__((address_space(3))) bf16x8*)(kp+6144); kf[7]=*(const __attribute__((address_space(3))) bf16x8*)(kp+6656);
}
__device__ __forceinline__ void kload2(bf16x8*kf,lds_cptr kp,int j){ kf[2*j]=*(const __attribute__((address_space(3))) bf16x8*)(kp+j*2048); kf[2*j+1]=*(const __attribute__((address_space(3))) bf16x8*)(kp+j*2048+512); }
__device__ __forceinline__ s16x4 vtr(lds_cptr p){ return __builtin_bit_cast(s16x4,__builtin_amdgcn_ds_read_tr16_b64_v4i16((__attribute__((address_space(3))) v4i16_t*)p)); }
__device__ __forceinline__ float rowmax(const f32x16&p0,const f32x16&p1){
  float a=max3f(p0[0],p0[1],p1[0]),b=max3f(p0[2],p0[3],p1[1]);a=max3f(a,p1[2],p1[3]);
  #pragma unroll
  for(int r=4;r<16;r+=4){a=max3f(a,p0[r],p0[r+1]);b=max3f(b,p0[r+2],p0[r+3]);a=max3f(a,p1[r],p1[r+1]);b=max3f(b,p1[r+2],p1[r+3]);}
  const float m=max2f(a,b);
  auto rr=__builtin_amdgcn_permlane32_swap(__float_as_uint(m),__float_as_uint(m),false,false);
  return max2f(__uint_as_float(rr[0]),__uint_as_float(rr[1]));
}
__device__ __forceinline__ void pv(f32x16*o,int vb,bf16x8 pa0,bf16x8 pa1,bf16x8 pa2,bf16x8 pa3){
  #pragma unroll
  for(int d0=0;d0<2;++d0){s16x4 lo[4],hi[4];
    #pragma unroll
    for(int ks=0;ks<4;++ks){
      asm volatile("ds_read_b64_tr_b16 %0,%1 offset:%c2":"=&v"(lo[ks]):"v"(vb),"i"(d0*4096+ks*1024):"memory");
      asm volatile("ds_read_b64_tr_b16 %0,%1 offset:%c2":"=&v"(hi[ks]):"v"(vb),"i"(d0*4096+ks*1024+512):"memory");}
    asm volatile("s_waitcnt lgkmcnt(0)":::"memory");SBAR();
    #define PK(k) (bf16x8){lo[k][0],lo[k][1],lo[k][2],lo[k][3],hi[k][0],hi[k][1],hi[k][2],hi[k][3]}
    o[d0]=__builtin_amdgcn_mfma_f32_32x32x16_bf16(pa0,PK(0),o[d0],0,0,0);
    o[d0]=__builtin_amdgcn_mfma_f32_32x32x16_bf16(pa1,PK(1),o[d0],0,0,0);
    o[d0]=__builtin_amdgcn_mfma_f32_32x32x16_bf16(pa2,PK(2),o[d0],0,0,0);
    o[d0]=__builtin_amdgcn_mfma_f32_32x32x16_bf16(pa3,PK(3),o[d0],0,0,0);
    #undef PK
  }
}

#ifndef ATTN_STORE16
#define ATTN_STORE16(p,v) (*(u32x4*)(p)=(v))
#endif
template<int THRL> __device__ __forceinline__ void attn_unit(const bf16*Q0,int ldq,const bf16*__restrict__ Kh,int ldk,const bf16*__restrict__ Vh,int ldv,bf16*O0,int ldo,int NT,char*shm){
  int tid_=my_tid(); asm volatile("":"+v"(tid_)); const int tid=tid_,lane=tid&63,r32=lane&31,hi=lane>>5; const int wid=__builtin_amdgcn_readfirstlane(tid>>6);
  const bf16*Qw=Q0+(long)(wid*QBLK)*ldq;
  const unsigned lds0=(unsigned)(uintptr_t)shm;
  float*wsf=(float*)(shm+LDS_WS)+wid*64;
  const bf16*ksrc=Kh+(long)lane*ldk+wid*8;
  const bf16*vsrc=Vh+(long)(16*(wid&3)+(lane>>2))*ldv+(wid>>2)*32+(lane&3)*8;
  const unsigned kdst=lds0+LDS_K+wid*1024, vdst=lds0+LDS_V+wid*1024;
  #define DMA_K(t,slot) glds16(ksrc+(long)(t)*KVBLK*ldk,(unsigned)__builtin_amdgcn_readfirstlane(kdst+(slot)))
  #define DMA_V(t,slot) glds16(vsrc+(long)(t)*KVBLK*ldv,(unsigned)__builtin_amdgcn_readfirstlane(vdst+(slot)))
  const int vb0=(int)(lds0+LDS_V)+((lane>>4)&1)*32+(lane&3)*8+(4*hi+((lane&15)>>2))*64;
  const char*Kbase=shm+LDS_K; bf16x8 kf[8];
  const lds_cptr shm3=(lds_cptr)shm; const lds_cptr kp0=shm3+LDS_K+hi*1024+r32*16; const lds_cptr vp0=shm3+LDS_V+((lane>>4)&1)*32+(lane&3)*8+(4*hi+((lane&15)>>2))*64;
  DMA_K(0,0);DMA_V(0,0);DMA_K(1,SLOTB);
  bf16x8 qr[4];
  #pragma unroll
  for(int d0=0;d0<4;++d0)qr[d0]=*reinterpret_cast<const bf16x8*>(&Qw[(long)r32*ldq+d0*16+hi*8]);
  float mhat=0.f,l_reg=0.f;f32x16 o[2];o[0]=f32x16{};o[1]=f32x16{};f32x16 negm=f32x16{};asm volatile("":"+v"(negm));
  #define CMASK(P0,P1,t) do{}while(0)
  bool resc=false;
  #define START(P0,P1) do{ const float rm=rowmax(P0,P1); resc=false; \
    { const float dl=rm; mhat=fadd_s(mhat,dl); \
      _Pragma("unroll") for(int r=0;r<16;++r){P0[r]=fsub_s(P0[r],dl);P1[r]=fsub_s(P1[r],dl);} \
      _Pragma("unroll") for(int r=0;r<16;++r)negm[r]=-mhat; asm volatile("":"+v"(negm)); } \
    _Pragma("unroll") for(int r=0;r<16;++r)P0[r]=__builtin_amdgcn_exp2f(P0[r]); }while(0)
  #define RESC() do{ if(resc){ asm volatile("s_waitcnt lgkmcnt(0)":::"memory"); \
      _Pragma("unroll") for(int d_=0;d_<2;++d_) _Pragma("unroll") for(int r=0;r<16;++r)o[d_][r]*=wsf[crow(r,hi)]; } }while(0)
  f32x16 pA0,pA1,pB0,pB1;
  int sl_prev=0,sl_cur=0,sl_next=SLOTB;
  #define ROT() do{sl_prev=sl_cur;sl_cur=sl_next;sl_next=(sl_next==(NSLOT-1)*SLOTB)?0:sl_next+SLOTB;}while(0)
  DMA_K(2,2*SLOTB);
  WAIT_BAR(3);
  qkt(pA0,pA1,Kbase,qr,negm,r32,hi);asm volatile("s_nop 15\n\ts_nop 7":"+v"(pA0),"+v"(pA1));CMASK(pA0,pA1,0);
  START(pA0,pA1);
  _Pragma("unroll") for(int r=0;r<16;++r)pA1[r]=__builtin_amdgcn_exp2f(pA1[r]);
  WAIT_BAR(0);
  DMA_K(3,0);DMA_V(1,SLOTB);
  ROT();
  kload8(kf,kp0+sl_cur);
  WAIT_BAR(2);
  s16x4 vlo[8],vhi[8]; u32x4 pw0,pw1,pw2,pw3;
  #define PKW(P,B) cvtpk_s(P[B],P[B+1])
  #define PAF(k) __builtin_bit_cast(bf16x8,pw##k)
  #define VFR(i) (bf16x8){vlo[i][0],vlo[i][1],vlo[i][2],vlo[i][3],vhi[i][0],vhi[i][1],vhi[i][2],vhi[i][3]}
  #define PIN(x) asm volatile("":"+v"(x))
  #define MX3(a,b,c) __builtin_fmaxf(__builtin_fmaxf((a),(b)),(c))
  #define GAPA(MF,A0,A1,A2,A3,W0,W1,PW) do{ MF; sacc+=A0; sacc+=A1; sacc+=A2; sacc+=A3; PIN(sacc); W0; W1; PIN(PW); SBAR(); }while(0)
  #define EX(v) __builtin_amdgcn_exp2f(v)
  #define GAPB(MF,X,B) do{ MF; X[B]=EX(X[B]); X[B+1]=EX(X[B+1]); X[B+2]=EX(X[B+2]); X[B+3]=EX(X[B+3]); PIN(X); SBAR(); }while(0)
  #define VRD(i) do{ vlo[i]=vtr(vp_+(((i)>>2)*4096+((i)&3)*1024)); vhi[i]=vtr(vp_+(((i)>>2)*4096+((i)&3)*1024+512)); }while(0)
  #define KRD(G,j) do{ if(G){ kload2(kf,kp0+sl_next,j); SBAR(); } }while(0)
  #define STEP(C0,C1,P0,P1,t,GK,GV,GL) do{ SBAR(); \
    const lds_cptr vp_=vp0+sl_prev; \
    VRD(0); SBAR(); float sacc=(P0[0]+P0[1]); \
    GAPA(C0=__builtin_amdgcn_mfma_f32_32x32x16_bf16(kf[0],qr[0],negm,0,0,0), P0[2],P0[3],P0[4],P0[5],     pw0[0]=PKW(P0,0), pw0[1]=PKW(P0,2), pw0); \
    VRD(4); SBAR(); GAPA(C1=__builtin_amdgcn_mfma_f32_32x32x16_bf16(kf[1],qr[0],negm,0,0,0), P0[6],P0[7],P0[8],P0[9],     pw0[2]=PKW(P0,4), pw0[3]=PKW(P0,6), pw0); \
    VRD(1); SBAR(); GAPA(C0=__builtin_amdgcn_mfma_f32_32x32x16_bf16(kf[2],qr[1],C0,0,0,0),   P0[10],P0[11],P0[12],P0[13], pw1[0]=PKW(P0,8), pw1[1]=PKW(P0,10), pw1); \
    VRD(5); SBAR(); GAPA(C1=__builtin_amdgcn_mfma_f32_32x32x16_bf16(kf[3],qr[1],C1,0,0,0),   P0[14],P0[15],P1[0],P1[1],   pw1[2]=PKW(P0,12),pw1[3]=PKW(P0,14), pw1); \
    VRD(2); SBAR(); GAPA(C0=__builtin_amdgcn_mfma_f32_32x32x16_bf16(kf[4],qr[2],C0,0,0,0),   P1[2],P1[3],P1[4],P1[5],     pw2[0]=PKW(P1,0), pw2[1]=PKW(P1,2), pw2); \
    VRD(6); SBAR(); GAPA(C1=__builtin_amdgcn_mfma_f32_32x32x16_bf16(kf[5],qr[2],C1,0,0,0),   P1[6],P1[7],P1[8],P1[9],     pw2[2]=PKW(P1,4), pw2[3]=PKW(P1,6), pw2); \
    VRD(3); SBAR(); GAPA(C0=__builtin_amdgcn_mfma_f32_32x32x16_bf16(kf[6],qr[3],C0,0,0,0),   P1[10],P1[11],P1[12],P1[13], pw3[0]=PKW(P1,8), pw3[1]=PKW(P1,10), pw3); \
    VRD(7); SBAR(); GAPA(C1=__builtin_amdgcn_mfma_f32_32x32x16_bf16(kf[7],qr[3],C1,0,0,0),   P1[14],P1[15],0.f,0.f,       pw3[2]=PKW(P1,12),pw3[3]=PKW(P1,14), pw3); \
    l_reg+=sacc; \
    if(GK){DMA_K((t)+3,sl_cur);} if(GV){DMA_V((t)+1,sl_next);} \
    CMASK(C0,C1,t); \
    { float a=MX3(C0[0],C0[1],C1[0]),b=MX3(C0[2],C0[3],C1[1]); a=MX3(a,C1[2],C1[3]); \
      _Pragma("unroll") for(int r=4;r<16;r+=4){a=MX3(a,C0[r],C0[r+1]);b=MX3(b,C0[r+2],C0[r+3]);a=MX3(a,C1[r],C1[r+1]);b=MX3(b,C1[r+2],C1[r+3]);} \
      float rm=__builtin_fmaxf(a,b); { auto rr=__builtin_amdgcn_permlane32_swap(__float_as_uint(rm),__float_as_uint(rm),false,false); rm=__builtin_fmaxf(__uint_as_float(rr[0]),__uint_as_float(rr[1])); } \
      resc=false; \
      if(__builtin_expect(__any(rm>(float)THRL),0)){ const float dl=__builtin_fmaxf(rm,0.f); mhat+=dl; \
        _Pragma("unroll") for(int r=0;r<16;++r){C0[r]-=dl;C1[r]-=dl;} \
        _Pragma("unroll") for(int r=0;r<16;++r)negm[r]=-mhat; asm volatile("":"+v"(negm)); \
        const float f=__builtin_amdgcn_exp2f(-dl); l_reg*=f; if(hi==0)wsf[r32]=f; resc=true; } } \
    SBAR(); \
    GAPB(o[0]=__builtin_amdgcn_mfma_f32_32x32x16_bf16(PAF(0),VFR(0),o[0],0,0,0), C0,0); \
    GAPB(o[1]=__builtin_amdgcn_mfma_f32_32x32x16_bf16(PAF(0),VFR(4),o[1],0,0,0), C0,4); \
    KRD(GL,0); GAPB(o[0]=__builtin_amdgcn_mfma_f32_32x32x16_bf16(PAF(1),VFR(1),o[0],0,0,0), C0,8); \
    KRD(GL,1); GAPB(o[1]=__builtin_amdgcn_mfma_f32_32x32x16_bf16(PAF(1),VFR(5),o[1],0,0,0), C0,12); \
    KRD(GL,2); GAPB(o[0]=__builtin_amdgcn_mfma_f32_32x32x16_bf16(PAF(2),VFR(2),o[0],0,0,0), C1,0); \
    KRD(GL,3); GAPB(o[1]=__builtin_amdgcn_mfma_f32_32x32x16_bf16(PAF(2),VFR(6),o[1],0,0,0), C1,4); \
    GAPB(o[0]=__builtin_amdgcn_mfma_f32_32x32x16_bf16(PAF(3),VFR(3),o[0],0,0,0), C1,8); \
    GAPB(o[1]=__builtin_amdgcn_mfma_f32_32x32x16_bf16(PAF(3),VFR(7),o[1],0,0,0), C1,12); \
    }while(0)
  int t=1;
  #undef CMASK
  #define CMASK(P0,P1,t) do{}while(0)
  for(;t+5<NT;t+=2){
    STEP(pB0,pB1,pA0,pA1,t,true,true,true);     WAIT_BAR(2); RESC(); ROT();
    STEP(pA0,pA1,pB0,pB1,t+1,true,true,true);   WAIT_BAR(2); RESC(); ROT();
  }
  #undef CMASK
  #define CMASK(P0,P1,t) do{}while(0)
  #define ENDW(tt) do{ if((tt)+3<NT){WAIT_BAR(2);} else if((tt)+2<NT){WAIT_BAR(1);} else {WAIT_BAR(0);} }while(0)
  for(;t+1<NT;t+=2){
    STEP(pB0,pB1,pA0,pA1,t,(t+3<NT),(t+1<NT),(t+1<NT));       ENDW(t);   RESC(); ROT();
    STEP(pA0,pA1,pB0,pB1,t+1,(t+4<NT),(t+2<NT),(t+2<NT));     ENDW(t+1); RESC(); ROT();
  }
  STEP(pB0,pB1,pA0,pA1,NT-1,false,false,false); RESC();
  { float sacc=pB0[0]+pB0[1]; _Pragma("unroll") for(int r=2;r<16;++r)sacc+=pB0[r]; _Pragma("unroll") for(int r=0;r<16;++r)sacc+=pB1[r]; l_reg+=sacc;
    pw0=(u32x4){PKW(pB0,0),PKW(pB0,2),PKW(pB0,4),PKW(pB0,6)};pw1=(u32x4){PKW(pB0,8),PKW(pB0,10),PKW(pB0,12),PKW(pB0,14)};pw2=(u32x4){PKW(pB1,0),PKW(pB1,2),PKW(pB1,4),PKW(pB1,6)};pw3=(u32x4){PKW(pB1,8),PKW(pB1,10),PKW(pB1,12),PKW(pB1,14)};
    SBAR(); pv(o,vb0+sl_cur,PAF(0),PAF(1),PAF(2),PAF(3)); }
  #undef PKW
  #undef PAF
  #undef VFR
  #undef PIN
  #undef MX3
  #undef GAPA
  #undef GAPB
  #undef EX
  #undef VRD
  #undef KRD
  #undef STEP
  #undef ENDW
  {auto rr=__builtin_amdgcn_permlane32_swap(__float_as_uint(l_reg),__float_as_uint(l_reg),false,false);l_reg=__uint_as_float(rr[0])+__uint_as_float(rr[1]);}
  if(hi==0)wsf[32+r32]=l_reg;asm volatile("s_waitcnt lgkmcnt(0)":::"memory");
  float rli[16];
  #pragma unroll
  for(int r=0;r<16;++r)rli[r]=__builtin_amdgcn_rcpf(wsf[32+crow(r,hi)]);
  bf16*Ow=O0+(long)(wid*QBLK)*ldo;
  { bf16*stg=(bf16*)(shm+LDS_OST)+wid*2048;
    #pragma unroll
    for(int r=0;r<16;++r){const int orow=crow(r,hi);
      #pragma unroll
      for(int d0=0;d0<2;++d0)stg[orow*64+d0*32+r32]=__float2bfloat16(o[d0][r]*rli[r]);}
    asm volatile("s_waitcnt lgkmcnt(0)":::"memory");
    #pragma unroll
    for(int i=0;i<4;++i){const int row=i*8+(lane>>3),ch=lane&7; const u32x4 v=*(const u32x4*)(stg+row*64+ch*8); ATTN_STORE16(Ow+(long)row*ldo+ch*8,v);} }
  asm volatile("s_waitcnt lgkmcnt(0)\n\ts_barrier":::"memory");
  #undef DMA_K
  #undef DMA_V
  #undef CMASK
  #undef START
  #undef RESC
  #undef ROT
}
constexpr int ATTN_LDS_BYTES=LDS_BYTES;
#undef SBAR
#undef WAIT_BAR
}


constexpr int NWAVES = 8;
constexpr int DMODEL = 1024, NBATCH = 2, SEQL = 8192, CTXL = 256, RPB = SEQL + CTXL, MROWS = NBATCH * RPB, NLAYER = 2;
constexpr int DFF = 2816, NUP = 2 * DFF, INW = 5888, ZW = 5376, NMODV = 9, MODW = NMODV * DMODEL;
constexpr int ZQA = 0, ZKA = 512, ZVA = 640, ZQB = 768, ZKB = 1280, ZVB = 1792, ZGATE = 2304;
constexpr int TPB = RPB / 256;
constexpr float EPSN = 1e-6f;
constexpr int HN = 4096;

constexpr size_t MiB = 1u << 20, KiB = 1024;
constexpr size_t WS_CTL = 0, CTL_ZERO_BYTES = 64 * KiB;
constexpr size_t WS_MOD = 1 * MiB;
constexpr size_t WS_CAS256 = 1 * MiB + 512 * KiB;
constexpr size_t WS_HC = 2 * MiB;
constexpr size_t WS_WUP0 = 4 * MiB, WS_WDN0 = 15 * MiB, WS_WUP1 = 20 * MiB + 512 * KiB, WS_WDN1 = 31 * MiB + 512 * KiB;
constexpr size_t WS_WIN = 37 * MiB, WS_WC = 47 * MiB + 512 * KiB, WS_WBR = 48 * MiB + 512 * KiB, WS_WOUT = 51 * MiB + 512 * KiB;
constexpr size_t WS_HN = 54 * MiB;
constexpr size_t WS_Z = 87 * MiB;
constexpr size_t WS_T1T = 261 * MiB;
constexpr size_t WS_PART = WS_T1T;
constexpr size_t WS_T2 = 278 * MiB;
constexpr size_t WS_PQ = 295 * MiB;
constexpr size_t WS_CAS = 311 * MiB;
constexpr size_t WS_ROPE = 343 * MiB;
constexpr size_t WS_END = 345 * MiB;
static_assert(WS_Z + (size_t)MROWS * ZW * 2 <= WS_T1T && WS_HN + (size_t)MROWS * DMODEL * 2 <= WS_Z && WS_WOUT + 2 * MiB <= WS_HN, "ws map");
constexpr int CW_BAR = 4096;
constexpr int CW_Q = 1024;


#define GAS __attribute__((address_space(1)))
typedef unsigned short bf16;
typedef unsigned v4u __attribute__((ext_vector_type(4)));
typedef float f32x4 __attribute__((ext_vector_type(4)));
#define LDS_WAIT() asm volatile("s_waitcnt lgkmcnt(0)" ::: "memory")

__device__ __forceinline__ float bf2f(unsigned v) { return __uint_as_float(v << 16); }
__device__ __forceinline__ float bflo(unsigned w) { return __uint_as_float(w << 16); }
__device__ __forceinline__ float bfhi(unsigned w) { return __uint_as_float(w & 0xffff0000u); }
__device__ __forceinline__ unsigned pk2(float lo, float hi) { return pg8::cvt_pk_bf16(lo, hi); }
__device__ __forceinline__ float fexp(float x) { return __builtin_amdgcn_exp2f(x * 1.4426950408889634f); }
__device__ __forceinline__ float sigm(float x) { return __builtin_amdgcn_rcpf(1.0f + fexp(-x)); }
__device__ __forceinline__ float siluf(float x) { return x * sigm(x); }
__device__ __forceinline__ float shfl_xor(float v, int o) { return __builtin_bit_cast(float, __builtin_amdgcn_ds_bpermute((lane_id() ^ o) << 2, __builtin_bit_cast(int, v))); }
__device__ __forceinline__ float wave_sum(float v) {
#pragma unroll
    for (int o = 1; o < 64; o <<= 1) v += shfl_xor(v, o);
    return v;
}

namespace pg8 {
struct EpiStore {
    static constexpr bool PERM = true, AFTER_DRAIN = false;
    bf16_t* O; int ldc; int sig_from; int rbase, rmul;
    __device__ __forceinline__ void operator()(const f32x4 (&acc)[2][2][4][2], const Unit& u, int wr, int wc, int fr_, int fq_) const {
        (void)fr_; (void)fq_; const int ln_ = lane_id(); const int fr = ln_ & 15, fq = ln_ >> 4;
        const int row0 = u.pm * BM + wr * 64 + fr, col0 = u.pn * BM + wc * 32 + 8 * fq;
        const bool sg = (u.pn * BM) >= sig_from;
#pragma unroll
        for (int ai = 0; ai < 2; ++ai)
#pragma unroll
            for (int m = 0; m < 4; ++m) { const int row = row0 + ai * HALF + m * 16; bf16_t* rowp = O + (size_t)(rbase + row * rmul) * ldc + col0;
#pragma unroll
                for (int bj = 0; bj < 2; ++bj) { f32x4 v0 = acc[ai][bj][m][0], v1 = acc[ai][bj][m][1];
                    if (sg) { v0[0] = sigm(v0[0]); v0[1] = sigm(v0[1]); v0[2] = sigm(v0[2]); v0[3] = sigm(v0[3]); v1[0] = sigm(v1[0]); v1[1] = sigm(v1[1]); v1[2] = sigm(v1[2]); v1[3] = sigm(v1[3]); }
                    u32x4 w; w.x = cvt_pk_bf16(v0[0], v0[1]); w.y = cvt_pk_bf16(v0[2], v0[3]); w.z = cvt_pk_bf16(v1[0], v1[1]); w.w = cvt_pk_bf16(v1[2], v1[3]);
                    *(u32x4*)(rowp + bj * HALF) = w; } }
    }
};
struct EpiSwiGLU {
    static constexpr bool PERM = true, AFTER_DRAIN = false;
    bf16_t* H; int ldc;
    __device__ __forceinline__ void operator()(const f32x4 (&acc)[2][2][4][2], const Unit& u, int wr, int wc, int fr_, int fq_) const {
        (void)fr_; (void)fq_; const int ln_ = lane_id(); const int fr = ln_ & 15, fq = ln_ >> 4;
        const int row0 = u.pm * BM + wr * 64 + fr, col0 = u.pn * HALF + wc * 32 + 8 * fq;
#pragma unroll
        for (int ai = 0; ai < 2; ++ai)
#pragma unroll
            for (int m = 0; m < 4; ++m) { const int row = row0 + ai * HALF + m * 16; bf16_t* rowp = H + (size_t)row * ldc + col0;
                const f32x4 g0 = acc[ai][0][m][0], g1 = acc[ai][0][m][1], u0 = acc[ai][1][m][0], u1 = acc[ai][1][m][1];
                u32x4 w; w.x = cvt_pk_bf16(siluf(g0[0]) * u0[0], siluf(g0[1]) * u0[1]); w.y = cvt_pk_bf16(siluf(g0[2]) * u0[2], siluf(g0[3]) * u0[3]);
                w.z = cvt_pk_bf16(siluf(g1[0]) * u1[0], siluf(g1[1]) * u1[1]); w.w = cvt_pk_bf16(siluf(g1[2]) * u1[2], siluf(g1[3]) * u1[3]);
                *(u32x4*)rowp = w; }
    }
};
template <bool ATOMIC> struct EpiResidT {
    static constexpr bool PERM = false, AFTER_DRAIN = false;
    const float* base_lat; const float* base_ctx; float* out_lat; float* out_ctx; const float* gate; float scale;
    __device__ __forceinline__ void operator()(const f32x4 (&acc)[2][2][4][2], const Unit& u, int wr, int wc, int fr_, int fq_) const {
        (void)fr_; (void)fq_; const int ln_ = lane_id(); const int fr = ln_ & 15, fq = ln_ >> 4;
        const int b = u.pm / 33, w = u.pm % 33; const int set = (w == 0) ? 2 : b;
        const size_t toff = (w == 0) ? (size_t)b * 256 * 1024 : ((size_t)b * 8192 + (size_t)(w - 1) * 256) * 1024;
        const float* base = ((w == 0) ? base_ctx : base_lat) + toff; float* out = ((w == 0) ? out_ctx : out_lat) + toff;
        const int frr = fr;
        const int col0 = u.pn * BM + wc * 32 + 4 * fq; const float* gp = gate + set * 9216 + col0;
#pragma unroll
        for (int bj = 0; bj < 2; ++bj)
#pragma unroll
            for (int n = 0; n < 2; ++n) { const f32x4 gv = *(const f32x4*)(gp + bj * HALF + n * 16) * scale;
#pragma unroll
                for (int ai = 0; ai < 2; ++ai) {
#pragma unroll
                    for (int m = 0; m < 4; ++m) { const unsigned off = (unsigned)(ai * HALF + wr * 64 + m * 16 + frr) * 1024u + (unsigned)(col0 + bj * HALF + n * 16);
                        if constexpr (ATOMIC) { float one = 1.0f; asm volatile("" : "+v"(one) :: "memory"); const f32x4 v = (gv * one) * acc[ai][bj][m][n]; __attribute__((address_space(1))) float* ap = (__attribute__((address_space(1))) float*)(out + off); (void)__builtin_amdgcn_global_atomic_fadd_f32(ap, v[0]); (void)__builtin_amdgcn_global_atomic_fadd_f32(ap + 1, v[1]); (void)__builtin_amdgcn_global_atomic_fadd_f32(ap + 2, v[2]); (void)__builtin_amdgcn_global_atomic_fadd_f32(ap + 3, v[3]); asm volatile("" ::: "memory"); }
                        else { const f32x4 bs = *(const f32x4*)(base + off); *(f32x4*)(out + off) = bs + gv * acc[ai][bj][m][n]; } }
                    asm volatile("" ::: "memory"); } }
    }
};
typedef EpiResidT<false> EpiResid;
struct EpiResidA {
    static constexpr bool PERM = false, AFTER_DRAIN = false;
    float* part; const float* gate; float scale;
    __device__ __forceinline__ void operator()(const f32x4 (&acc)[2][2][4][2], const Unit& u, int wr, int wc, int fr_, int fq_) const {
        (void)fr_; (void)fq_; const int ln_ = lane_id(); const int fr = ln_ & 15, fq = ln_ >> 4;
        const int col0 = u.pn * BM + wc * 32 + 4 * fq;
        float* out = part + ((size_t)u.kp * 512 + (u.pm ? 256 : 0)) * 1024 + (unsigned)((wr * 64 + fr) * 1024 + col0);
#pragma unroll
        for (int bj = 0; bj < 2; ++bj)
#pragma unroll
            for (int n = 0; n < 2; ++n) { const f32x4 gv = *(const f32x4*)(gate + col0 + bj * HALF + n * 16) * scale;
#pragma unroll
                for (int ai = 0; ai < 2; ++ai) {
#pragma unroll
                    for (int m = 0; m < 4; ++m) *(f32x4*)(out + (ai * HALF + m * 16) * 1024 + bj * HALF + n * 16) = gv * acc[ai][bj][m][n];
                    asm volatile("" ::: "memory"); } }
    }
};
struct EpiMerge {
    static constexpr bool PERM = true, AFTER_DRAIN = false;
    const bf16_t* Z; bf16_t* Mo;
    __device__ __forceinline__ void operator()(const f32x4 (&acc)[2][2][4][2], const Unit& u, int wr, int wc, int fr_, int fq_) const {
        (void)fr_; (void)fq_; const int ln_ = lane_id(); const int fr = ln_ & 15, fq = ln_ >> 4;
        const int br = u.pn >> 2, ct = u.pn & 3;
        const int row0 = u.pm * BM + wr * 64 + fr, col0 = ct * BM + wc * 32 + 8 * fq;
#pragma unroll
        for (int ai = 0; ai < 2; ++ai)
#pragma unroll
            for (int m = 0; m < 4; ++m) { const int row = row0 + ai * HALF + m * 16; const bf16_t* gp = Z + (size_t)row * 5376 + 2304 + br * 1024 + col0; bf16_t* mp = Mo + (size_t)row * 1024 + col0;
#pragma unroll
                for (int bj = 0; bj < 2; ++bj) { const u32x4 gw = *(const u32x4*)(gp + bj * HALF); const f32x4 a0 = acc[ai][bj][m][0], a1 = acc[ai][bj][m][1];
                    float r0 = __uint_as_float(gw.x << 16) * a0[0], r1 = __uint_as_float(gw.x & 0xffff0000u) * a0[1], r2 = __uint_as_float(gw.y << 16) * a0[2], r3 = __uint_as_float(gw.y & 0xffff0000u) * a0[3];
                    float r4 = __uint_as_float(gw.z << 16) * a1[0], r5 = __uint_as_float(gw.z & 0xffff0000u) * a1[1], r6 = __uint_as_float(gw.w << 16) * a1[2], r7 = __uint_as_float(gw.w & 0xffff0000u) * a1[3];
                    if (br > 0) { const u32x4 ow = *(const u32x4*)(mp + bj * HALF);
                        r0 += __uint_as_float(ow.x << 16); r1 += __uint_as_float(ow.x & 0xffff0000u); r2 += __uint_as_float(ow.y << 16); r3 += __uint_as_float(ow.y & 0xffff0000u);
                        r4 += __uint_as_float(ow.z << 16); r5 += __uint_as_float(ow.z & 0xffff0000u); r6 += __uint_as_float(ow.w << 16); r7 += __uint_as_float(ow.w & 0xffff0000u); }
                    u32x4 w; w.x = cvt_pk_bf16(r0, r1); w.y = cvt_pk_bf16(r2, r3); w.z = cvt_pk_bf16(r4, r5); w.w = cvt_pk_bf16(r6, r7);
                    *(u32x4*)(mp + bj * HALF) = w; } }
    }
};
struct MergeOrder {
    int G, c, lat;
    __device__ bool next(int i, Unit& u) const { const int grp = (i / 3) * G + c; if (grp >= (lat ? 256 : 264)) return false; int pm = grp >> 2; if (lat) pm = pm + 1 + (pm >= 32); u.pm = pm; u.pn = (grp & 3) + 4 * (i % 3); return true; }
    __device__ __forceinline__ void a_ready(const Unit&) const {}
    __device__ __forceinline__ void done(const Unit&) const {}
    __device__ __forceinline__ size_t aoff(const Unit& u) const { const int br = u.pn >> 2; return (size_t)(br == 0 ? 0 : (br == 1 ? 768 : 1280)) * 2; }
    __device__ __forceinline__ size_t boff(const Unit&) const { return 0; }
};
struct LatOrder {
    StaticOrder so;
    __device__ void init(int N, int G_, int c_) { so.init(64 * BM, N, G_, c_); }
    __device__ bool next(int i, Unit& u) const { if (!so.next(i, u)) return false; u.pm = u.pm + 1 + (u.pm >= 32); return true; }
    __device__ __forceinline__ void a_ready(const Unit&) const {}
    __device__ __forceinline__ void done(const Unit&) const {}
    __device__ __forceinline__ size_t aoff(const Unit&) const { return 0; }
    __device__ __forceinline__ size_t boff(const Unit&) const { return 0; }
};
struct CtxSplit {
    int G, c, KP;
    __device__ bool next(int i, Unit& u) const { const int s = i * G + c; if (s >= 8 * KP) return false; const int t = s / KP; u.pn = t & 3; u.kp = s % KP; u.pm = (t >> 2) * 33; return true; }
    __device__ __forceinline__ void a_ready(const Unit&) const {}
    __device__ __forceinline__ void done(const Unit&) const {}
    __device__ __forceinline__ size_t aoff(const Unit& u) const { return (size_t)u.kp * 512; }
    __device__ __forceinline__ size_t boff(const Unit& u) const { return (size_t)u.kp * 512; }
};
struct OneUnit {
    int pm, pn;
    __device__ bool next(int i, Unit& u) const { if (i) return false; u.pm = pm; u.pn = pn; return true; }
    __device__ __forceinline__ void a_ready(const Unit&) const {}
    __device__ __forceinline__ void done(const Unit&) const {}
    __device__ __forceinline__ size_t aoff(const Unit&) const { return 0; }
    __device__ __forceinline__ size_t boff(const Unit&) const { return 0; }
};
}

#define XB_TMO      128
#define XB_XCNT(j)  (256  + 64 * (j))
#define XB_XSUB(j)  (1280 + 64 * (j))
#define XB_XGEN(j)  (2304 + 64 * (j))
#define XB_TOP      3328
#define XB_TOPGEN   3392
#define XCD_BAR_WORDS 3456
#define XB_SPIN_CAP (1u << 18)

__device__ __forceinline__ unsigned xb_ld(unsigned* p)              { return __hip_atomic_load(p, __ATOMIC_RELAXED, __HIP_MEMORY_SCOPE_AGENT); }
__device__ __forceinline__ unsigned xb_add(unsigned* p, unsigned v) { return __hip_atomic_fetch_add(p, v, __ATOMIC_RELAXED, __HIP_MEMORY_SCOPE_AGENT); }
__device__ __forceinline__ unsigned xb_xcc_id() { return (unsigned)__builtin_amdgcn_s_getreg((3 << 11) | 20) & 0xFu; }
#define XB_SPIN(cond, bar) do { unsigned _sp = 0; while (cond) { __builtin_amdgcn_s_sleep(1); \
    if ((++_sp & 255u) == 0u) { if (xb_ld(&(bar)[XB_TMO])) break; if (_sp > XB_SPIN_CAP) { atomicAdd(&(bar)[XB_TMO], 1u); break; } } } } while (0)

struct XcdBarrier {
    unsigned* bar; unsigned x;
    volatile LAS unsigned* st;
};

__device__ __forceinline__ XcdBarrier xcd_barrier_post(unsigned* bar, volatile LAS unsigned* st) {
    XcdBarrier b; b.bar = bar; b.x = xb_xcc_id(); b.st = st;
    if (my_tid() == 0) (void)xb_add(&bar[XB_XCNT(b.x)], 1u);
    return b;
}
__device__ __forceinline__ void xcd_barrier_complete(unsigned* bar, unsigned x, unsigned& nloc, unsigned& nx) {
    const unsigned G = gridDim.x * gridDim.y * gridDim.z;
    unsigned sum, cnt, mine, sp = 0u;
    for (;;) {
        sum = 0u; cnt = 0u; mine = 0u;
#pragma unroll
        for (unsigned j = 0; j < 16; ++j) { const unsigned c = xb_ld(&bar[XB_XCNT(j)]); sum += c; cnt += (c > 0u) ? 1u : 0u; mine = (j == x) ? c : mine; }
        if (sum == G) break;
        __builtin_amdgcn_s_sleep(1);
        if ((++sp & 255u) == 0u) { if (xb_ld(&bar[XB_TMO])) break; if (sp > XB_SPIN_CAP) { atomicAdd(&bar[XB_TMO], 1u); break; } }
    }
    nloc = mine > 0u ? mine : 1u; nx = cnt > 0u ? cnt : 1u;
}

__device__ __forceinline__ void xcd_barrier(const XcdBarrier& b) {
    asm volatile("s_waitcnt vmcnt(0)" ::: "memory");
    __syncthreads();
    if (my_tid() == 0) {
        unsigned* bar = b.bar;
        __builtin_amdgcn_s_waitcnt(0);
        unsigned nloc = b.st[0], nx = b.st[1];
        if (nloc == 0u) { xcd_barrier_complete(bar, b.x, nloc, nx); b.st[0] = nloc; b.st[1] = nx; }
        const unsigned old = xb_add(&bar[XB_XSUB(b.x)], 1u);
        const unsigned gen = old / nloc;
        if (old + 1u == (gen + 1u) * nloc) {
            __builtin_amdgcn_fence(__ATOMIC_RELEASE, "agent");
            asm volatile("s_waitcnt vmcnt(0)" ::: "memory");
            const unsigned og = xb_add(&bar[XB_TOP], 1u);
            const unsigned tg = og / nx;
            if (og + 1u == (tg + 1u) * nx) xb_add(&bar[XB_TOPGEN], 1u);
            else XB_SPIN(xb_ld(&bar[XB_TOPGEN]) == tg, bar);
            __builtin_amdgcn_fence(__ATOMIC_ACQUIRE, "agent");
            xb_add(&bar[XB_XGEN(b.x)], 1u);
            asm volatile("s_waitcnt vmcnt(0)" ::: "memory");
        } else {
            XB_SPIN(xb_ld(&bar[XB_XGEN(b.x)]) == gen, bar);
            __builtin_amdgcn_fence(__ATOMIC_ACQUIRE, "agent");
            asm volatile("s_waitcnt vmcnt(0)" ::: "memory");
        }
    }
    __syncthreads();
}

struct Frame {
    LAS unsigned char* lds; volatile LAS unsigned* MISC; unsigned* ctl;
    int tid, lane, wave, G, bid;
    const float *x, *c, *ctx, *cctx, *w_ada, *b_ada, *norm_g, *ffn_wi, *ffn_wo, *w_in, *qk_g, *diff_lam, *subln_g, *w_branch, *w_out;
    float* out; unsigned char* ws;
};
#define WSP(T, off) ((T*)(F.ws + (off)))

__device__ __forceinline__ void transpose_item(const float* W, int N, bf16* WT, int ldt, int k0, int n0, int dst_row0, LAS float* scr, int lane) {
#pragma unroll 8
    for (int i = 0; i < 32; ++i) { const int kk = 2 * i + (lane >> 5); scr[kk * 33 + (lane & 31)] = W[(size_t)(k0 + kk) * N + n0 + (lane & 31)]; }
    LDS_WAIT(); asm volatile("" ::: "memory");
    const int c = lane & 7;
#pragma unroll
    for (int j = 0; j < 4; ++j) { const int n = (lane >> 3) + 8 * j; const LAS float* s = scr + (8 * c) * 33 + n;
        v4u o; o.x = pk2(s[0 * 33], s[1 * 33]); o.y = pk2(s[2 * 33], s[3 * 33]); o.z = pk2(s[4 * 33], s[5 * 33]); o.w = pk2(s[6 * 33], s[7 * 33]);
        *(v4u*)(WT + (size_t)(dst_row0 + n) * ldt + k0 + 8 * c) = o; }
    LDS_WAIT(); asm volatile("" ::: "memory");
}
__device__ __forceinline__ void convert_weights(Frame& F, int l) {
    LAS float* scr = (LAS float*)(F.lds + F.wave * 16384);
    const int gw = F.bid * NWAVES + F.wave, NGW = F.G * NWAVES;
    constexpr int I_UP = 16 * 176, I_DN = 44 * 32, I_IN = 16 * 184, I_BR = 8 * 32, I_OUT = 16 * 32;
    constexpr int NITEMS = 2 * I_UP + 2 * I_DN + I_IN + 3 * I_BR + I_OUT;
    const float* wi = F.ffn_wi + (size_t)l * 2 * 1024 * NUP; const float* wo = F.ffn_wo + (size_t)l * 2 * DFF * 1024;
    const float* win = F.w_in + (size_t)l * 1024 * INW; const float* wbr = F.w_branch + (size_t)l * 3 * 512 * 1024; const float* wout = F.w_out + (size_t)l * 1024 * 1024;
    for (int it = gw; it < NITEMS; it += NGW) {
        int r = it;
        if (r < 2 * I_UP) { const int h = r / I_UP; r -= h * I_UP; const int kb = r / 176, nb = r % 176; int n0 = nb * 32; const int isu = n0 >= DFF; const int nn = n0 - isu * DFF;
            transpose_item(wi + (size_t)h * 1024 * NUP, NUP, WSP(bf16, h ? WS_WUP1 : WS_WUP0), 1024, kb * 64, n0, (nn / 128) * 256 + isu * 128 + (nn % 128), scr, F.lane); continue; }
        r -= 2 * I_UP;
        if (r < 2 * I_DN) { const int h = r / I_DN; r -= h * I_DN; const int kb = r / 32, nb = r % 32;
            transpose_item(wo + (size_t)h * DFF * 1024, 1024, WSP(bf16, h ? WS_WDN1 : WS_WDN0), DFF, kb * 64, nb * 32, nb * 32, scr, F.lane); continue; }
        r -= 2 * I_DN;
        if (r < I_IN) { const int kb = r / 184, nb = r % 184; const int n0 = nb * 32;
            if (n0 >= 2304 && n0 < 2816) continue;
            transpose_item(win, INW, WSP(bf16, WS_WIN), 1024, kb * 64, n0, n0 < 2304 ? n0 : n0 - 512, scr, F.lane); continue; }
        r -= I_IN;
        if (r < 3 * I_BR) { const int i = r / I_BR; r -= i * I_BR; const int kb = r / 32, nb = r % 32;
            transpose_item(wbr + (size_t)i * 512 * 1024, 1024, WSP(bf16, WS_WBR), 512, kb * 64, nb * 32, i * 1024 + nb * 32, scr, F.lane); continue; }
        r -= 3 * I_BR;
        { const int kb = r / 32, nb = r % 32; transpose_item(wout, 1024, WSP(bf16, WS_WOUT), 1024, kb * 64, nb * 32, nb * 32, scr, F.lane); }
    }
    {
        const int t = F.bid * 512 + F.tid;
        if (t < 65536) {
            const int jl = t & 63, rest = t >> 6, kc = rest & 127, rj = rest >> 7; const int row = rj * 64 + jl, g = row >> 7, j = row & 127;
            float a[8];
#pragma unroll
            for (int e = 0; e < 8; ++e) a[e] = 0.f;
            const float* wp = win + (size_t)(kc * 8) * INW + 2304 + g * 128;
            for (int c4 = 0; c4 < 32; ++c4) {
                float cs[4];
#pragma unroll
                for (int q = 0; q < 4; ++q) { const int idx = ((c4 * 4 + q) * j) & 127; float sn, co; sincospif((float)idx * (1.0f / 64.0f), &sn, &co); cs[q] = sn + co; }
#pragma unroll
                for (int e = 0; e < 8; ++e) { const f32x4 w = *(const f32x4*)(wp + (size_t)e * INW + c4 * 4); a[e] += w[0] * cs[0] + w[1] * cs[1] + w[2] * cs[2] + w[3] * cs[3]; }
            }
            v4u o; o.x = pk2(a[0], a[1]); o.y = pk2(a[2], a[3]); o.z = pk2(a[4], a[5]); o.w = pk2(a[6], a[7]);
            *(v4u*)(WSP(bf16, WS_WC) + (size_t)row * 1024 + kc * 8) = o;
        }
    }
}
__device__ __forceinline__ void make_cas(Frame& F) {
    const int t0 = F.bid * 512 + F.tid, NT_ = F.G * 512;
    for (int it = t0; it < HN * HN / 8; it += NT_) { const int k = it >> 9, n0 = (it & 511) * 8; float v[8];
#pragma unroll
        for (int e = 0; e < 8; ++e) { const int idx = (k * (n0 + e)) & (HN - 1); float sn, co; sincospif((float)idx * (2.0f / HN), &sn, &co); v[e] = sn + co; }
        v4u o; o.x = pk2(v[0], v[1]); o.y = pk2(v[2], v[3]); o.z = pk2(v[4], v[5]); o.w = pk2(v[6], v[7]);
        *(v4u*)(WSP(bf16, WS_CAS) + (size_t)k * HN + n0) = o; }
    for (int it = t0; it < 256 * 256 / 8; it += NT_) { const int k = it >> 5, n0 = (it & 31) * 8; float v[8];
#pragma unroll
        for (int e = 0; e < 8; ++e) { const int idx = (k * (n0 + e)) & 255; float sn, co; sincospif((float)idx * (1.0f / 128.0f), &sn, &co); v[e] = sn + co; }
        v4u o; o.x = pk2(v[0], v[1]); o.y = pk2(v[2], v[3]); o.z = pk2(v[4], v[5]); o.w = pk2(v[6], v[7]);
        *(v4u*)(WSP(bf16, WS_CAS256) + (size_t)k * 256 + n0) = o; }
}
__device__ __forceinline__ void make_mod(Frame& F) {
    LAS float* red = (LAS float*)F.lds;
    for (int item = F.bid; item < 288; item += F.G) {
        const int l = item / 144, cb = item % 144;
        const int c4 = F.lane & 15, ks = F.lane >> 4, slice = F.wave * 4 + ks;
        const float* W = F.w_ada + (size_t)l * 1024 * MODW + cb * 64 + c4 * 4;
        f32x4 a0 = {0.f, 0.f, 0.f, 0.f}, a1 = a0, a2 = a0;
        for (int r = 0; r < 32; ++r) { const int k = slice * 32 + r; const f32x4 w = *(const f32x4*)(W + (size_t)k * MODW);
            const float s0 = siluf(F.c[k]), s1 = siluf(F.c[1024 + k]), s2 = siluf(F.cctx[k]); a0 += w * s0; a1 += w * s1; a2 += w * s2; }
#pragma unroll
        for (int q = 0; q < 4; ++q) { red[(slice * 3 + 0) * 64 + c4 * 4 + q] = a0[q]; red[(slice * 3 + 1) * 64 + c4 * 4 + q] = a1[q]; red[(slice * 3 + 2) * 64 + c4 * 4 + q] = a2[q]; }
        __syncthreads();
        if (F.tid < 192) { const int set = F.tid >> 6, col = F.tid & 63; float s = 0.f;
            for (int sl = 0; sl < 32; ++sl) s += red[(sl * 3 + set) * 64 + col];
            WSP(float, WS_MOD)[((size_t)l * 3 + set) * MODW + cb * 64 + col] = s + F.b_ada[(size_t)l * MODW + cb * 64 + col]; }
        __syncthreads();
    }
}
__device__ __forceinline__ const float* hrow_ptr(const float* lat, const float* ctxp, int row, int& set) {
    const int b = row / RPB, w = row % RPB;
    if (w < CTXL) { set = 2; return ctxp + ((size_t)b * CTXL + w) * 1024; }
    set = b; return lat + ((size_t)b * SEQL + (w - CTXL)) * 1024;
}
__device__ __forceinline__ void norm_mod(Frame& F, const float* lat, const float* ctxp, const float* g, const float* modl  , int ishift, float* copy_ctx, const float* parts, int nparts) {
    const int gw = F.bid * NWAVES + F.wave, NGW = F.G * NWAVES;
    for (int row = gw; row < MROWS; row += NGW) {
        int set; const float* hr = hrow_ptr(lat, ctxp, row, set);
        const float* sh = modl + (size_t)set * MODW + ishift * 1024; const float* sc = sh + 1024;
        f32x4 v[4]; float ss = 0.f;
#pragma unroll
        for (int j = 0; j < 4; ++j) v[j] = *((const f32x4*)hr + F.lane + 64 * j);
        if (set == 2 && parts != nullptr) { const float* pr = parts + (hr - ctxp);
            for (int p = 0; p < nparts; ++p) {
#pragma unroll
                for (int j = 0; j < 4; ++j) v[j] += *((const f32x4*)(pr + (size_t)p * 512 * 1024) + F.lane + 64 * j); } }
#pragma unroll
        for (int j = 0; j < 4; ++j) ss += (v[j][0] * v[j][0] + v[j][1] * v[j][1]) + (v[j][2] * v[j][2] + v[j][3] * v[j][3]);
        const float rstd = 1.0f / sqrtf(wave_sum(ss) * (1.0f / 1024.0f) + EPSN);
        if (copy_ctx != nullptr && set == 2) { f32x4* cp = (f32x4*)(copy_ctx + (hr - ctxp)) + F.lane;
#pragma unroll
            for (int j = 0; j < 4; ++j) cp[64 * j] = v[j]; }
        unsigned long long* o8 = (unsigned long long*)(WSP(bf16, WS_HN) + (size_t)row * 1024) + F.lane;
#pragma unroll
        for (int j = 0; j < 4; ++j) { const f32x4 gg = *((const f32x4*)g + F.lane + 64 * j), s1 = *((const f32x4*)sc + F.lane + 64 * j), s0 = *((const f32x4*)sh + F.lane + 64 * j);
            const f32x4 y = v[j] * rstd * gg * (s1 + 1.0f) + s0;
            o8[64 * j] = (unsigned long long)pk2(y[0], y[1]) | ((unsigned long long)pk2(y[2], y[3]) << 32); }
    }
}
__device__ __forceinline__ void make_rope(Frame& F) {
    const int t0 = F.bid * 512 + F.tid, NT_ = F.G * 512;
    float* ct = WSP(float, WS_ROPE); float* st = ct + SEQL * 32;
    for (int it = t0; it < SEQL * 32; it += NT_) { const int s = it >> 5, i = it & 31;
        const float inv = exp2f(-(float)(i & 15) * (13.287712379549449f / 16.0f));
        const float pos = (float)((i < 16) ? (s >> 6) : (s & 63)); float sn, cs; sincosf(pos * inv, &sn, &cs); ct[it] = cs; st[it] = sn; }
}
__device__ __forceinline__ void qk_rope(Frame& F, int l) {
    const int gw = F.bid * NWAVES + F.wave, NGW = F.G * NWAVES;
    const float* qg = F.qk_g + (size_t)l * 256;
    const float* ct = WSP(float, WS_ROPE); const float* st = ct + SEQL * 32;
    for (int row = gw; row < MROWS; row += NGW) {
        const int w = row % RPB; bf16* zr = WSP(bf16, WS_Z) + (size_t)row * ZW;
#pragma unroll
        for (int pass = 0; pass < 2; ++pass) {
            const int q = pass * 64 + F.lane; const bool act = q < 104; const int hv = act ? (q >> 2) : 0, c = q & 3;
            int col, gsel; bool isq;
            if (hv < 8) { col = ZQA + hv * 64; gsel = 0; isq = true; } else if (hv < 10) { col = ZKA + (hv - 8) * 64; gsel = 1; isq = false; }
            else if (hv < 18) { col = ZQB + (hv - 10) * 64; gsel = 2; isq = true; } else { col = ZKB + (hv - 18) * 64; gsel = 3; isq = false; }
            const v4u lo = *(const v4u*)(zr + col + 8 * c), hi = *(const v4u*)(zr + col + 32 + 8 * c);
            float x1[8], x2[8];
            x1[0] = bflo(lo.x); x1[1] = bfhi(lo.x); x1[2] = bflo(lo.y); x1[3] = bfhi(lo.y); x1[4] = bflo(lo.z); x1[5] = bfhi(lo.z); x1[6] = bflo(lo.w); x1[7] = bfhi(lo.w);
            x2[0] = bflo(hi.x); x2[1] = bfhi(hi.x); x2[2] = bflo(hi.y); x2[3] = bfhi(hi.y); x2[4] = bflo(hi.z); x2[5] = bfhi(hi.z); x2[6] = bflo(hi.w); x2[7] = bfhi(hi.w);
            float ss = 0.f;
#pragma unroll
            for (int e = 0; e < 8; ++e) ss += x1[e] * x1[e] + x2[e] * x2[e];
            ss += shfl_xor(ss, 1); ss += shfl_xor(ss, 2);
            const float rstd = 1.0f / sqrtf(ss * (1.0f / 64.0f) + EPSN);
            const float sc = isq ? attn_body::C2 : 1.0f;
            const f32x4 ga = *(const f32x4*)(qg + gsel * 64 + 8 * c), gb = *(const f32x4*)(qg + gsel * 64 + 8 * c + 4), gc = *(const f32x4*)(qg + gsel * 64 + 32 + 8 * c), gd = *(const f32x4*)(qg + gsel * 64 + 36 + 8 * c);
            f32x4 ca = {1.f, 1.f, 1.f, 1.f}, cb = ca, sa = {0.f, 0.f, 0.f, 0.f}, sb = sa;
            if (w >= CTXL) { const int s = w - CTXL; ca = *(const f32x4*)(ct + s * 32 + 8 * c); cb = *(const f32x4*)(ct + s * 32 + 8 * c + 4); sa = *(const f32x4*)(st + s * 32 + 8 * c); sb = *(const f32x4*)(st + s * 32 + 8 * c + 4); }
            float o1[8], o2[8];
#pragma unroll
            for (int e = 0; e < 8; ++e) { const float g1 = e < 4 ? ga[e & 3] : gb[e & 3], g2 = e < 4 ? gc[e & 3] : gd[e & 3], cs = e < 4 ? ca[e & 3] : cb[e & 3], sn = e < 4 ? sa[e & 3] : sb[e & 3];
                const float y1 = x1[e] * rstd * g1, y2 = x2[e] * rstd * g2; o1[e] = (y1 * cs - y2 * sn) * sc; o2[e] = (y1 * sn + y2 * cs) * sc; }
            if (act) { v4u a, b2; a.x = pk2(o1[0], o1[1]); a.y = pk2(o1[2], o1[3]); a.z = pk2(o1[4], o1[5]); a.w = pk2(o1[6], o1[7]);
                b2.x = pk2(o2[0], o2[1]); b2.y = pk2(o2[2], o2[3]); b2.z = pk2(o2[4], o2[5]); b2.w = pk2(o2[6], o2[7]);
                *(v4u*)(zr + col + 8 * c) = a; *(v4u*)(zr + col + 32 + 8 * c) = b2; }
        }
    }
}
__device__ __forceinline__ void make_pq(Frame& F) {
    const int t0 = F.bid * 512 + F.tid, NT_ = F.G * 512;
    const bf16* T1 = WSP(bf16, WS_T1T); bf16* PQ = WSP(bf16, WS_PQ);
    for (int it = t0; it < 2 * 512 * HN; it += NT_) {
        const int n = it & (HN - 1), col = (it >> 12) & 511, b = it >> 21;
        const bf16* xr = T1 + (size_t)col * MROWS + b * RPB + CTXL;
        const int nm = (HN - n) & (HN - 1);
        const float x0 = bf2f(xr[n]), x1 = bf2f(xr[n + HN]), y0 = bf2f(xr[nm]), y1 = bf2f(xr[nm + HN]);
        float sn, co, snm, com; sincospif((float)n * (1.0f / HN), &sn, &co); sincospif((float)nm * (1.0f / HN), &snm, &com);
        const float p = x0 + x1, q = (x0 - x1) * co + (y0 - y1) * snm;
        PQ[((size_t)(b * 2 + 0) * 512 + col) * HN + n] = (bf16)(pk2(p, 0.f) & 0xffffu);
        PQ[((size_t)(b * 2 + 1) * 512 + col) * HN + n] = (bf16)(pk2(q, 0.f) & 0xffffu);
    }
}
__device__ __forceinline__ void post_mix(Frame& F, int l) {
    const int gw = F.bid * NWAVES + F.wave, NGW = F.G * NWAVES;
    const float lam_init = 0.8f - 0.6f * expf(-0.3f * (float)l);
    const float* dl = F.diff_lam + (size_t)l * 256;
    const float s1 = wave_sum(dl[F.lane] * dl[64 + F.lane]), s2 = wave_sum(dl[128 + F.lane] * dl[192 + F.lane]);
    const float lam = expf(s1) - expf(s2) + lam_init;
    const float* sg = F.subln_g + (size_t)l * 128 + (F.lane & 15) * 8;
    float gsc[8];
#pragma unroll
    for (int e = 0; e < 8; ++e) gsc[e] = sg[e] * (1.0f - lam_init);
    const bf16* OB = WSP(bf16, WS_HN); const bf16* T2 = WSP(bf16, WS_T2); bf16* Z = WSP(bf16, WS_Z);
    for (int row = gw; row < MROWS; row += NGW) {
        const int b = row / RPB, w = row % RPB;
        {
            const v4u a = *(const v4u*)(OB + (size_t)row * 1024 + F.lane * 8), c2 = *(const v4u*)(OB + (size_t)row * 1024 + 512 + F.lane * 8);
            float d[8];
            d[0] = bflo(a.x) - lam * bflo(c2.x); d[1] = bfhi(a.x) - lam * bfhi(c2.x); d[2] = bflo(a.y) - lam * bflo(c2.y); d[3] = bfhi(a.y) - lam * bfhi(c2.y);
            d[4] = bflo(a.z) - lam * bflo(c2.z); d[5] = bfhi(a.z) - lam * bfhi(c2.z); d[6] = bflo(a.w) - lam * bflo(c2.w); d[7] = bfhi(a.w) - lam * bfhi(c2.w);
            float ss = 0.f;
#pragma unroll
            for (int e = 0; e < 8; ++e) ss += d[e] * d[e];
#pragma unroll
            for (int o = 1; o < 16; o <<= 1) ss += shfl_xor(ss, o);
            const float rstd = 1.0f / sqrtf(ss * (1.0f / 128.0f) + EPSN);
            v4u o; o.x = pk2(d[0] * rstd * gsc[0], d[1] * rstd * gsc[1]); o.y = pk2(d[2] * rstd * gsc[2], d[3] * rstd * gsc[3]);
            o.z = pk2(d[4] * rstd * gsc[4], d[5] * rstd * gsc[5]); o.w = pk2(d[6] * rstd * gsc[6], d[7] * rstd * gsc[7]);
            *(v4u*)(Z + (size_t)row * ZW + ZQB + F.lane * 8) = o;
        }
        {
            int mrow; float sc;
            if (w < CTXL) { mrow = b * RPB + ((CTXL - w) & (CTXL - 1)); sc = 0.5f * 0.005524271728019903f; }
            else { const int s = w - CTXL; mrow = b * RPB + CTXL + ((SEQL - s) & (SEQL - 1)); sc = 1.0f / 2048.0f; }
            const int g = F.lane >> 4, j0 = (F.lane & 15) * 8;
            const bf16* rk = T2 + (size_t)row * 512 + g * 128; const v4u mv = *(const v4u*)(T2 + (size_t)mrow * 512 + g * 128 + j0);
            float r[8];
#pragma unroll
            for (int e = 0; e < 8; ++e) r[e] = bf2f(rk[(128 - (j0 + e)) & 127]);
            v4u o; o.x = pk2((r[0] + bflo(mv.x)) * sc, (r[1] + bfhi(mv.x)) * sc); o.y = pk2((r[2] + bflo(mv.y)) * sc, (r[3] + bfhi(mv.y)) * sc);
            o.z = pk2((r[4] + bflo(mv.z)) * sc, (r[5] + bfhi(mv.z)) * sc); o.w = pk2((r[6] + bflo(mv.w)) * sc, (r[7] + bfhi(mv.w)) * sc);
            *(v4u*)(Z + (size_t)row * ZW + ZKB + F.lane * 8) = o;
        }
    }
}
template <bool PROBE> __device__ __forceinline__ void mixer_phase(Frame& F, int l) {
    constexpr int NHL = 128, NHC = 4, NAL = NBATCH * 24 * 32, NAC = NBATCH * 24;
    const int TOTAL = PROBE ? NHL + NBATCH * 16 * 32 : ((l == NLAYER - 1) ? NHL + NAL : NHL + NAL + NHC + NAC);
    unsigned* qctr = F.ctl + CW_Q + 64 * l + (PROBE ? 32 : 0);
    bf16* Z = WSP(bf16, WS_Z);
    for (;;) {
        if (F.tid == 0) F.MISC[0] = __hip_atomic_fetch_add(qctr, 1u, __ATOMIC_RELAXED, __HIP_MEMORY_SCOPE_AGENT);
        __syncthreads();
        const int it = (int)F.MISC[0];
        __syncthreads();
        if (it >= TOTAL) break;
        if (it < NHL) {
            const int b = it >> 6, r = it & 63, par = r >> 5, r2 = r & 31;
            pg8::Gemm g{WSP(bf16, WS_CAS), WSP(bf16, WS_PQ) + (size_t)(b * 2 + par) * 512 * HN, HN, 512, HN, HN, HN};
            pg8::OneUnit S{r2 >> 1, r2 & 1};
            pg8::EpiStore E{WSP(bf16, WS_T2), 512, 1 << 30, b * RPB + CTXL + par, 2};
            pg8::gemm_phase<pg8::EpiStore, pg8::OneUnit, true, true, HN, HN, HN>(F.lds, g, S, E);
        } else if (it >= NHL + NAL && it < NHL + NAL + NHC) {
            const int r = it - NHL - NAL, b = r >> 1;
            pg8::Gemm g{WSP(bf16, WS_CAS256), WSP(bf16, WS_T1T) + (size_t)b * RPB, 256, 512, 256, 256, MROWS};
            pg8::OneUnit S{0, r & 1};
            pg8::EpiStore E{WSP(bf16, WS_T2), 512, 1 << 30, b * RPB, 1};
            pg8::gemm_phase<pg8::EpiStore, pg8::OneUnit, true, true, 256, 256, MROWS>(F.lds, g, S, E);
        } else {
            int r = it - NHL, b, hu, qrow, nt;
            if (PROBE) { const int qb = r & 31; r >>= 5; hu = 8 + (r & 15); b = r >> 4; qrow = b * RPB + CTXL + qb * 256; nt = RPB / 64; }
            else if (r < NAL) { const int qb = r & 31; r >>= 5; hu = r % 24; b = r / 24; qrow = b * RPB + CTXL + qb * 256; nt = RPB / 64; }
            else { r -= NAL + NHC; hu = r % 24; b = r / 24; qrow = b * RPB; nt = CTXL / 64; }
            const bf16 *Qp, *Kp, *Vp; bf16* Op; int po;
            if (hu < 8) { Qp = Z + ZQA + hu * 64; Kp = Z + ZKA + (hu >> 2) * 64; Vp = Z + ZVA + (hu >> 2) * 64; Op = Z + ZQA + hu * 64; po = ZW; }
            else { const int j = hu - 8, h = j >> 2, mm = (j >> 1) & 1, vh = j & 1; Qp = Z + ZQB + (h * 2 + mm) * 64; Kp = Z + ZKB + (h * 2 + mm) * 64; Vp = Z + ZVB + h * 128 + vh * 64;
                   Op = WSP(bf16, WS_HN) + mm * 512 + h * 128 + vh * 64; po = 1024; }
            const size_t kv0 = (size_t)b * RPB;
            attn_body::attn_unit<8>((const attn_body::bf16*)(Qp + (size_t)qrow * ZW), ZW, (const attn_body::bf16*)(Kp + kv0 * ZW), ZW, (const attn_body::bf16*)(Vp + kv0 * ZW), ZW,
                                    (attn_body::bf16*)(Op + (size_t)qrow * po), po, nt, (char*)F.lds);
        }
    }
}

#ifndef MK_PER_PHASE
#define MK_PER_PHASE 0
#endif
constexpr int NPHASE = 1 + 13 * NLAYER;
struct Args { const float* in[15]; float* out; unsigned char* ws; int ph_lo, ph_hi; };
__device__ __forceinline__ void load_frame(Frame& F) {
    const __attribute__((address_space(4))) Args* a = (const __attribute__((address_space(4))) Args*)__builtin_amdgcn_kernarg_segment_ptr();
    asm volatile("" : "+s"(a));
    extern __shared__ __attribute__((aligned(16))) unsigned char lds_raw[];
    F.lds = (LAS unsigned char*)lds_raw; F.MISC = (volatile LAS unsigned*)(F.lds + MISC_OFF);
    int t = my_tid(); asm volatile("" : "+v"(t));
    F.tid = t; F.lane = t & 63; F.wave = __builtin_amdgcn_readfirstlane(t >> 6); F.G = gridDim.x; F.bid = blockIdx.x;
    F.x = a->in[0]; F.c = a->in[1]; F.ctx = a->in[2]; F.cctx = a->in[3]; F.w_ada = a->in[4]; F.b_ada = a->in[5]; F.norm_g = a->in[6]; F.ffn_wi = a->in[7];
    F.ffn_wo = a->in[8]; F.w_in = a->in[9]; F.qk_g = a->in[10]; F.diff_lam = a->in[11]; F.subln_g = a->in[12]; F.w_branch = a->in[13]; F.w_out = a->in[14];
    F.out = a->out; F.ws = a->ws; F.ctl = (unsigned*)(a->ws + WS_CTL);
}
#ifndef MK_MASK
#define MK_MASK 0xffffffffu
#endif
#define EN(j) (((MK_MASK) >> (j)) & 1u)
#ifndef MK_DUP
#define MK_DUP 0
#endif
#define DUP(b) for (int rep_ = 0; rep_ < (((MK_DUP) >> (b)) & 1) + 1; ++rep_)
__device__ __forceinline__ void seam_barrier() {
    const __attribute__((address_space(4))) Args* a = (const __attribute__((address_space(4))) Args*)__builtin_amdgcn_kernarg_segment_ptr();
    asm volatile("" : "+s"(a));
    extern __shared__ __attribute__((aligned(16))) unsigned char lds_raw[];
    XcdBarrier b; b.bar = (unsigned*)(a->ws + WS_CTL) + CW_BAR; b.x = xb_xcc_id(); b.st = (volatile LAS unsigned*)((LAS unsigned char*)lds_raw + MISC_OFF) + 8;
    xcd_barrier(b);
}
#define LF() Frame F; load_frame(F); float* hlat = F.out; float* hctx = WSP(float, WS_HC); const float* modl = WSP(float, WS_MOD) + (size_t)l * 3 * MODW; const float* ng = F.norm_g + (size_t)l * 3 * 1024; \
    const float* slat = (l == 0) ? F.x : hlat; const float* sctx = (l == 0) ? F.ctx : hctx; (void)hlat; (void)hctx; (void)modl; (void)ng; (void)slat; (void)sctx
__global__ void __launch_bounds__(NWAVES * 64, 2) mk_fwd(Args args) {
    cg::grid_group grid = cg::this_grid();
    const int lo = args.ph_lo, hi = args.ph_hi;
    {
        extern __shared__ __attribute__((aligned(16))) unsigned char lds_raw[];
        volatile LAS unsigned* misc = (volatile LAS unsigned*)((LAS unsigned char*)lds_raw + MISC_OFF);
        const int t0 = threadIdx.x;
        if (t0 < 32) misc[t0] = 0u;
        if ((t0 & 63) == 0) ((volatile LAS int*)((LAS unsigned char*)lds_raw + WTAB_OFF))[hw_slot()] = t0 >> 6;
        __syncthreads();
        if (hi - lo > 1) (void)xcd_barrier_post((unsigned*)(args.ws + WS_CTL) + CW_BAR, misc + 8);
    }
#define IN(k) (lo <= (k) && (k) < hi)
    if (lo < 0) grid.sync();
#define SEAM(k) do { if (IN(k) && IN((k) + 1)) { seam_barrier(); } } while (0)
    if (EN(0) && IN(0)) { const int l = 0; LF(); DUP(4) { make_mod(F); convert_weights(F, 0); make_cas(F); make_rope(F); } }
    SEAM(0);
    for (int l = 0; l < NLAYER; ++l) {
        const int p0 = 1 + 13 * l;
        if (EN(1) && IN(p0 + 0)) { LF(); if (l > 0) DUP(4) convert_weights(F, l); norm_mod(F, slat, sctx, ng, modl, 0, hctx, (l == 0) ? nullptr : WSP(float, WS_PART), DFF / 256); }
        SEAM(p0 + 0);
        if (EN(2) && IN(p0 + 1)) { LF(); pg8::Gemm g{WSP(bf16, WS_HN), WSP(bf16, WS_WUP0), MROWS, NUP, 1024, 1024, 1024}; pg8::StaticOrder S; S.init(MROWS, NUP, F.G, F.bid);
            pg8::EpiSwiGLU E{WSP(bf16, WS_Z), DFF}; DUP(1) pg8::gemm_phase<pg8::EpiSwiGLU, pg8::StaticOrder, true, true, 1024, 1024, 1024>(F.lds, g, S, E); }
        SEAM(p0 + 1);
        if (EN(3) && IN(p0 + 2)) { LF();
            { pg8::Gemm g{WSP(bf16, WS_Z), WSP(bf16, WS_WDN0), MROWS, 1024, DFF, DFF, DFF}; pg8::LatOrder S; S.init(1024, F.G, F.bid);
              pg8::EpiResid E{slat, sctx, hlat, hctx, modl + 2 * 1024, 0.5f}; for (int rep_ = 0; rep_ < ((((MK_DUP) >> 7) & 1) && l == 0 ? 4 : 1); ++rep_) pg8::gemm_phase<pg8::EpiResid, pg8::LatOrder, true, true, DFF, DFF, DFF>(F.lds, g, S, E); }
            { pg8::Gemm g{WSP(bf16, WS_Z), WSP(bf16, WS_WDN0), MROWS, 1024, 256, DFF, DFF}; pg8::CtxSplit S{F.G, F.G - 1 - F.bid, DFF / 256};
              pg8::EpiResidA E{WSP(float, WS_PART), modl + 2 * MODW + 2 * 1024, 0.5f}; pg8::gemm_phase<pg8::EpiResidA, pg8::CtxSplit, true, true, 256, DFF, DFF>(F.lds, g, S, E); } }
        SEAM(p0 + 2);
        if (EN(4) && IN(p0 + 3)) { LF(); norm_mod(F, hlat, hctx, ng + 1024, modl, 3, hctx, WSP(float, WS_PART), DFF / 256); }
        SEAM(p0 + 3);
        if (EN(5) && IN(p0 + 4)) { LF();
            { pg8::Gemm g{WSP(bf16, WS_HN), WSP(bf16, WS_WIN), MROWS, ZW, 1024, 1024, 1024}; pg8::StaticOrder S; S.init(MROWS, ZW, F.G, F.bid);
              pg8::EpiStore E{WSP(bf16, WS_Z), ZW, ZGATE, 0, 1}; DUP(5) pg8::gemm_phase<pg8::EpiStore, pg8::StaticOrder, true, true, 1024, 1024, 1024>(F.lds, g, S, E); }
            { pg8::Gemm g{WSP(bf16, WS_WC), WSP(bf16, WS_HN), 512, MROWS, 1024, 1024, 1024}; pg8::StaticOrder S; S.init(512, MROWS, F.G, F.G - 1 - F.bid);
              pg8::EpiStore E{WSP(bf16, WS_T1T), MROWS, 1 << 30, 0, 1}; DUP(5) pg8::gemm_phase<pg8::EpiStore, pg8::StaticOrder, true, true, 1024, 1024, 1024>(F.lds, g, S, E); }
        }
        SEAM(p0 + 4);
        if (EN(6) && IN(p0 + 5)) { LF(); qk_rope(F, l); make_pq(F); }
        SEAM(p0 + 5);
        if (EN(7) && IN(p0 + 6)) { LF(); mixer_phase<false>(F, l); if ((MK_DUP) & 8) mixer_phase<true>(F, l); }
        SEAM(p0 + 6);
        if (EN(8) && IN(p0 + 7)) { LF(); post_mix(F, l); }
        SEAM(p0 + 7);
        if (EN(9) && IN(p0 + 8)) { LF(); pg8::Gemm g{WSP(bf16, WS_Z), WSP(bf16, WS_WBR), MROWS, 3072, 512, ZW, 512}; pg8::MergeOrder S{F.G, F.bid, l == NLAYER - 1};
            pg8::EpiMerge E{WSP(bf16, WS_Z), WSP(bf16, WS_HN)}; DUP(6) pg8::gemm_phase<pg8::EpiMerge, pg8::MergeOrder, true, true, 512, ZW, 512>(F.lds, g, S, E); }
        SEAM(p0 + 8);
        if (EN(10) && IN(p0 + 9)) { LF();
            { pg8::Gemm g{WSP(bf16, WS_HN), WSP(bf16, WS_WOUT), MROWS, 1024, 1024, 1024, 1024}; pg8::LatOrder S; S.init(1024, F.G, F.bid);
              pg8::EpiResid E{hlat, hctx, hlat, hctx, modl + 5 * 1024, 1.0f}; pg8::gemm_phase<pg8::EpiResid, pg8::LatOrder, true, true, 1024, 1024, 1024>(F.lds, g, S, E); }
            if (l < NLAYER - 1) { pg8::Gemm g{WSP(bf16, WS_HN), WSP(bf16, WS_WOUT), MROWS, 1024, 256, 1024, 1024}; pg8::CtxSplit S{F.G, F.G - 1 - F.bid, 4};
              pg8::EpiResidA E{WSP(float, WS_PART), modl + 2 * MODW + 5 * 1024, 1.0f}; pg8::gemm_phase<pg8::EpiResidA, pg8::CtxSplit, true, true, 256, 1024, 1024>(F.lds, g, S, E); } }
        SEAM(p0 + 9);
        if (EN(11) && IN(p0 + 10)) { LF(); norm_mod(F, hlat, hctx, ng + 2048, modl, 6, (l == 0) ? hctx : nullptr, (l == 0) ? WSP(float, WS_PART) : nullptr, 4); }
        SEAM(p0 + 10);
        if (EN(12) && IN(p0 + 11)) { LF(); pg8::Gemm g{WSP(bf16, WS_HN), WSP(bf16, WS_WUP1), MROWS, NUP, 1024, 1024, 1024}; pg8::StaticOrder S; S.init(MROWS, NUP, F.G, F.bid);
            pg8::EpiSwiGLU E{WSP(bf16, WS_Z), DFF}; DUP(1) pg8::gemm_phase<pg8::EpiSwiGLU, pg8::StaticOrder, true, true, 1024, 1024, 1024>(F.lds, g, S, E); }
        SEAM(p0 + 11);
        if (EN(13) && IN(p0 + 12)) { LF();
            { pg8::Gemm g{WSP(bf16, WS_Z), WSP(bf16, WS_WDN1), MROWS, 1024, DFF, DFF, DFF}; pg8::LatOrder S; S.init(1024, F.G, F.bid);
              pg8::EpiResid E{hlat, hctx, hlat, hctx, modl + 8 * 1024, 0.5f}; pg8::gemm_phase<pg8::EpiResid, pg8::LatOrder, true, true, DFF, DFF, DFF>(F.lds, g, S, E); }
            if (l < NLAYER - 1) { pg8::Gemm g{WSP(bf16, WS_Z), WSP(bf16, WS_WDN1), MROWS, 1024, 256, DFF, DFF}; pg8::CtxSplit S{F.G, F.G - 1 - F.bid, DFF / 256};
              pg8::EpiResidA E{WSP(float, WS_PART), modl + 2 * MODW + 8 * 1024, 0.5f}; pg8::gemm_phase<pg8::EpiResidA, pg8::CtxSplit, true, true, 256, DFF, DFF>(F.lds, g, S, E); } }
        SEAM(p0 + 12);
    }
#undef IN
#undef SEAM
}

extern "C" void kernel_launch(void* const* d_in, const int* in_sizes, int n_in, void* d_out, int out_size, void* d_ws, size_t ws_size, hipStream_t stream) {
    static int grid = 0;
    if (grid == 0) {
        if (n_in != 15 || ws_size < WS_END) { fprintf(stderr, "kernel_launch: need 15 inputs and >= %zu bytes of workspace; got n_in %d, ws %zu\n", (size_t)WS_END, n_in, ws_size); grid = -1; return; }
        int dev = 0, cus = 0, per_cu = 0;
        if (hipGetDevice(&dev) != hipSuccess || hipDeviceGetAttribute(&cus, hipDeviceAttributeMultiprocessorCount, dev) != hipSuccess) { grid = -1; return; }
        if (hipFuncSetAttribute((const void*)mk_fwd, hipFuncAttributeMaxDynamicSharedMemorySize, LDS_BYTES) != hipSuccess) { fprintf(stderr, "kernel_launch: hipFuncSetAttribute failed\n"); grid = -1; return; }
        if (hipOccupancyMaxActiveBlocksPerMultiprocessor(&per_cu, (const void*)mk_fwd, NWAVES * 64, LDS_BYTES) != hipSuccess || per_cu < 1) { fprintf(stderr, "kernel_launch: occupancy query says %d\n", per_cu); per_cu = 1; }
        (void)hipGetLastError();
        grid = cus * per_cu;
    }
    if (grid < 0) return;
    (void)hipMemsetAsync((char*)d_ws + WS_CTL, 0, CTL_ZERO_BYTES, stream);
    Args a{};
    for (int i = 0; i < 15; ++i) a.in[i] = (const float*)d_in[i];
    a.out = (float*)d_out; a.ws = (unsigned char*)d_ws;
#if MK_PER_PHASE
    for (int p = 0; p < NPHASE; ++p) { a.ph_lo = p; a.ph_hi = p + 1; hipLaunchKernelGGL(mk_fwd, dim3(grid), dim3(NWAVES * 64), LDS_BYTES, stream, a); }
#else
    a.ph_lo = 0; a.ph_hi = NPHASE;
    void* kargs[] = {&a};
    hipError_t e = hipLaunchCooperativeKernel((const void*)mk_fwd, dim3(grid), dim3(NWAVES * 64), kargs, LDS_BYTES, stream);
    if (e != hipSuccess) fprintf(stderr, "kernel_launch: cooperative launch failed: %s (grid %d)\n", hipGetErrorString(e), grid);
#endif
}
```

```cpp
#include <hip/hip_runtime.h>
#include <hip/hip_cooperative_groups.h>
#include <hip/hip_bf16.h>
#include <cstdio>
#include <cstdint>
#include <cmath>
namespace cg = cooperative_groups;

#define LAS __attribute__((address_space(3)))
constexpr int LDS_BYTES = 147456, MISC_OFF = 131072 + 320, WTAB_OFF = MISC_OFF + 128;
__device__ __forceinline__ int lane_id() { int l; asm volatile("v_mbcnt_lo_u32_b32 %0, -1, 0\n\tv_mbcnt_hi_u32_b32 %0, -1, %0" : "=&v"(l)); return l; }
__device__ __forceinline__ unsigned hw_slot() { return (unsigned)__builtin_amdgcn_s_getreg((5 << 11) | 4) & 63u; }
__device__ __forceinline__ int my_tid() {
    extern __shared__ __attribute__((aligned(16))) unsigned char lds_raw[];
    const int w = ((volatile LAS int*)((LAS unsigned char*)lds_raw + WTAB_OFF))[hw_slot()];
    return __builtin_amdgcn_readfirstlane(w) * 64 + lane_id();
}

namespace pg8 {
#define PG8_LAS __attribute__((address_space(3)))
typedef unsigned short bf16_t;
typedef short bf16x8 __attribute__((ext_vector_type(8)));
typedef float f32x4 __attribute__((ext_vector_type(4)));
typedef unsigned u32x4 __attribute__((ext_vector_type(4)));
constexpr int BM = 256, BK = 64, HALF = 128, HTB = HALF * BK * 2  , STAGE_BYTES = 8 * HTB, NXCD = 8, WGM = 8;

__host__ __device__ __forceinline__ int lds_byte(int r, int c) { const int st = (r >> 4) * 2 + (c >> 5), rr = r & 15, cc = c & 31, ob = rr * 64 + cc * 2; return st * 1024 + (ob ^ (((ob >> 9) & 1) << 5)); }
__host__ __device__ __forceinline__ void stage_rc(int b, int& R, int& C) { const int st = b / 1024, sb = b % 1024, swz = sb ^ (((sb >> 9) & 1) << 5); R = (st >> 1) * 16 + swz / 64; C = (st & 1) * 32 + (swz % 64) / 2; }
__host__ __device__ __forceinline__ int perm32(int rho) { const int n = rho >> 4, i = rho & 15; return 8 * (i >> 2) + 4 * n + (i & 3); }

struct Unit { int pm, pn, kp; };
struct Gemm { const bf16_t* A; const bf16_t* Bt; int M, N, K, lda, ldb; };

struct StaticOrder {
    int nM, nN, nwg, G, c;
    __host__ __device__ void init(int M, int N, int G_, int c_) { nM = M / BM; nN = N / BM; nwg = nM * nN; G = G_; c = c_; }
    __host__ __device__ bool next(int i, Unit& u) const {
        const long L = (long)i * G + c; if (L >= nwg) return false;
        int wgid = (int)L; { const int q = nwg / NXCD, r = nwg % NXCD, xcd = wgid % NXCD, off = wgid / NXCD; wgid = (xcd < r ? xcd * (q + 1) : r * (q + 1) + (xcd - r) * q) + off; }
        const int nig = WGM * nN, gid = wgid / nig, fm = gid * WGM, gsz = (nM - fm) < WGM ? (nM - fm) : WGM;
        u.pm = fm + ((wgid % nig) % gsz); u.pn = (wgid % nig) / gsz; return true;
    }
    __device__ __forceinline__ void a_ready(const Unit&) const {}
    __device__ __forceinline__ void done(const Unit&) const {}
    __device__ __forceinline__ size_t aoff(const Unit&) const { return 0; }
    __device__ __forceinline__ size_t boff(const Unit&) const { return 0; }
};


__device__ __forceinline__ unsigned cvt_pk_bf16(float lo, float hi) { unsigned r; asm volatile("v_cvt_pk_bf16_f32 %0, %1, %2" : "=v"(r) : "v"(lo), "v"(hi)); return r; }
typedef float f32x2 __attribute__((ext_vector_type(2)));

template <class Epi, class Sched, bool ALIGN_EPI, bool SP2, int TK, int TLDA, int TLDB>
__device__ __forceinline__ void gemm_phase(PG8_LAS unsigned char* lds, const Gemm g, const Sched& S, const Epi& E) {
    int tid_ = my_tid(); asm volatile("" : "+v"(tid_)); const int tid = tid_, wid = __builtin_amdgcn_readfirstlane(tid >> 6), lane = tid & 63, wr = wid >> 2, wc = wid & 3, fr = lane & 15, fq = lane >> 4;
    constexpr int K = TK, nt = K / BK;
    unsigned voffA[2], voffB[2];
#pragma unroll
    for (int i = 0; i < 2; ++i) { int R, C; stage_rc(tid * 16 + i * 8192, R, C); const int Rb = Epi::PERM ? ((R & ~31) + perm32(R & 31)) : R;
        voffA[i] = (unsigned)(R * TLDA + C) * 2u; voffB[i] = (unsigned)(Rb * TLDB + C) * 2u; }
    const size_t kstep = (size_t)(BK * 2);
    const size_t hstepA = (size_t)HALF * TLDA * 2, hstepB = (size_t)HALF * TLDB * 2;
    const size_t tstepA = 2 * hstepA, tstepB = 2 * hstepB;
    const unsigned ldsw = (unsigned)wid * 1024u;
    const int aoff = lds_byte(wr * 64 + fr, fq * 8), boff = lds_byte(wc * 32 + fr, fq * 8);
#define PG8_SA(b, h) (((b) * 2 + (h)) * HTB)
#define PG8_SB(b, h) ((4 + (b) * 2 + (h)) * HTB)
#define PG8_STAGE(bufoff, gbase, voff) do { _Pragma("unroll") for (int _i = 0; _i < 2; ++_i) \
        __builtin_amdgcn_global_load_lds((const unsigned*)((const char*)(gbase) + (voff)[_i]), (PG8_LAS unsigned*)(lds + (bufoff) + ldsw + _i * 8192), 16, 0, 0); } while (0)
#define PG8_LDA(dst, b, h) do { _Pragma("unroll") for (int m = 0; m < 4; ++m) _Pragma("unroll") for (int k = 0; k < 2; ++k) dst[m][k] = *(const PG8_LAS bf16x8*)(lds + PG8_SA(b, h) + aoff + m * 2048 + k * 1024); } while (0)
#define PG8_LDB(dst, b, h) do { _Pragma("unroll") for (int n = 0; n < 2; ++n) _Pragma("unroll") for (int k = 0; k < 2; ++k) dst[n][k] = *(const PG8_LAS bf16x8*)(lds + PG8_SB(b, h) + boff + n * 2048 + k * 1024); } while (0)
#define PG8_MMA(ai, bj, At, Bt) do { __builtin_amdgcn_s_setprio(1); _Pragma("unroll") for (int m = 0; m < 4; ++m) _Pragma("unroll") for (int n = 0; n < 2; ++n) _Pragma("unroll") for (int k = 0; k < 2; ++k) \
        acc[ai][bj][m][n] = __builtin_amdgcn_mfma_f32_16x16x32_bf16(Bt[n][k], At[m][k], acc[ai][bj][m][n], 0, 0, 0); __builtin_amdgcn_s_setprio(0); } while (0)
#define PG8_WAIT_V(n) asm volatile("s_waitcnt vmcnt(" #n ")" ::: "memory")
#define PG8_WAIT_L(n) asm volatile("s_waitcnt lgkmcnt(" #n ")" ::: "memory")
#define PG8_BAR __builtin_amdgcn_s_barrier()
#define PG8_SCHED __builtin_amdgcn_sched_barrier(0)
    Unit cur, nxt; int ui = 0;
    if (!S.next(0, cur)) return;
    f32x4 acc[2][2][4][2];
#pragma unroll
    for (int a = 0; a < 2; ++a)
#pragma unroll
        for (int b = 0; b < 2; ++b)
#pragma unroll
            for (int m = 0; m < 4; ++m)
#pragma unroll
                for (int n = 0; n < 2; ++n) acc[a][b][m][n] = (f32x4){0.f, 0.f, 0.f, 0.f};
    bf16x8 At[4][2], B0[2][2], B1[2][2];
    const char* cA = (const char*)g.A + (size_t)cur.pm * tstepA + S.aoff(cur); const char* cB = (const char*)g.Bt + (size_t)cur.pn * tstepB + S.boff(cur);
    S.a_ready(cur);
    if constexpr (SP2) {
        PG8_STAGE(PG8_SB(0, 0), cB, voffB); PG8_STAGE(PG8_SB(0, 1), cB + hstepB, voffB); PG8_STAGE(PG8_SA(0, 0), cA, voffA); PG8_STAGE(PG8_SA(0, 1), cA + hstepA, voffA);
        if (wr == 1) PG8_BAR;
        PG8_WAIT_V(2); PG8_BAR;
        PG8_STAGE(PG8_SB(1, 0), cB + kstep, voffB); PG8_STAGE(PG8_SA(1, 0), cA + kstep, voffA); PG8_STAGE(PG8_SB(1, 1), cB + hstepB + kstep, voffB);
        PG8_WAIT_V(6); PG8_BAR;
    } else {
        PG8_STAGE(PG8_SB(0, 0), cB, voffB); PG8_STAGE(PG8_SA(0, 0), cA, voffA); PG8_STAGE(PG8_SB(0, 1), cB + hstepB, voffB); PG8_STAGE(PG8_SA(0, 1), cA + hstepA, voffA);
        if (wr == 1) PG8_BAR;
        PG8_WAIT_V(4); PG8_BAR;
        PG8_STAGE(PG8_SB(1, 0), cB + kstep, voffB); PG8_STAGE(PG8_SA(1, 0), cA + kstep, voffA); PG8_STAGE(PG8_SB(1, 1), cB + hstepB + kstep, voffB);
        PG8_WAIT_V(6); PG8_BAR;
    }
    for (;;) {
        const bool has_next = S.next(ui + 1, nxt);
        const char* nA = has_next ? (const char*)g.A + (size_t)nxt.pm * tstepA + S.aoff(nxt) : cA; const char* nB = has_next ? (const char*)g.Bt + (size_t)nxt.pn * tstepB + S.boff(nxt) : cB;
        for (int t = 0; t < nt; t += 2) {
            const bool last = (t == nt - 2);
            const char* a1 = cA + (size_t)(t + 1) * kstep;
            const char* a2 = last ? nA : cA + (size_t)(t + 2) * kstep; const char* b2 = last ? nB : cB + (size_t)(t + 2) * kstep;
            const char* a3 = a2 + kstep; const char* b3 = b2 + kstep;
            if (last && has_next) S.a_ready(nxt);
            if constexpr (SP2) {
            PG8_LDB(B0, 0, 0); PG8_LDB(B1, 0, 1); PG8_SCHED; PG8_LDA(At, 0, 0); PG8_STAGE(PG8_SA(1, 1), a1 + hstepA, voffA);
            PG8_WAIT_V(8); PG8_WAIT_L(0); PG8_BAR; PG8_MMA(0, 0, At, B0); PG8_MMA(0, 1, At, B1); PG8_BAR; PG8_SCHED;
            PG8_LDA(At, 0, 1); PG8_STAGE(PG8_SB(0, 0), b2, voffB); PG8_STAGE(PG8_SB(0, 1), b2 + hstepB, voffB); PG8_STAGE(PG8_SA(0, 0), a2, voffA);
            PG8_WAIT_V(8); PG8_WAIT_L(0); PG8_BAR; PG8_MMA(1, 0, At, B0); PG8_MMA(1, 1, At, B1); PG8_BAR; PG8_SCHED;
            PG8_LDB(B0, 1, 0); PG8_LDB(B1, 1, 1); PG8_SCHED; PG8_LDA(At, 1, 0); PG8_STAGE(PG8_SA(0, 1), a2 + hstepA, voffA);
            PG8_WAIT_V(8); PG8_WAIT_L(0); PG8_BAR; PG8_MMA(0, 0, At, B0); PG8_MMA(0, 1, At, B1); PG8_BAR; PG8_SCHED;
            PG8_LDA(At, 1, 1); PG8_STAGE(PG8_SB(1, 0), b3, voffB); PG8_STAGE(PG8_SB(1, 1), b3 + hstepB, voffB); PG8_STAGE(PG8_SA(1, 0), a3, voffA);
            PG8_WAIT_V(8); PG8_WAIT_L(0); PG8_BAR; PG8_MMA(1, 0, At, B0); PG8_MMA(1, 1, At, B1); PG8_BAR; PG8_SCHED;
            } else {
            PG8_LDB(B0, 0, 0); PG8_SCHED; PG8_LDA(At, 0, 0); PG8_STAGE(PG8_SA(1, 1), a1 + hstepA, voffA);
            PG8_WAIT_L(8); PG8_BAR; PG8_WAIT_L(0); PG8_MMA(0, 0, At, B0); PG8_BAR; PG8_SCHED;
            PG8_LDB(B1, 0, 1); PG8_STAGE(PG8_SB(0, 0), b2, voffB);
            PG8_BAR; PG8_WAIT_L(0); PG8_MMA(0, 1, At, B1); PG8_BAR;
            PG8_LDA(At, 0, 1); PG8_STAGE(PG8_SA(0, 0), a2, voffA);
            PG8_BAR; PG8_WAIT_L(0); PG8_MMA(1, 0, At, B0); PG8_BAR; PG8_SCHED;
            PG8_STAGE(PG8_SB(0, 1), b2 + hstepB, voffB);
            PG8_WAIT_V(6); PG8_BAR; PG8_MMA(1, 1, At, B1); PG8_BAR;
            PG8_LDB(B0, 1, 0); PG8_SCHED; PG8_LDA(At, 1, 0); PG8_STAGE(PG8_SA(0, 1), a2 + hstepA, voffA);
            PG8_WAIT_L(8); PG8_BAR; PG8_WAIT_L(0); PG8_MMA(0, 0, At, B0); PG8_BAR; PG8_SCHED;
            PG8_LDB(B1, 1, 1); PG8_STAGE(PG8_SB(1, 0), b3, voffB);
            PG8_BAR; PG8_WAIT_L(0); PG8_MMA(0, 1, At, B1); PG8_BAR;
            PG8_LDA(At, 1, 1); PG8_STAGE(PG8_SA(1, 0), a3, voffA);
            PG8_BAR; PG8_WAIT_L(0); PG8_MMA(1, 0, At, B0); PG8_BAR; PG8_SCHED;
            PG8_STAGE(PG8_SB(1, 1), b3 + hstepB, voffB);
            PG8_WAIT_V(6); PG8_BAR; PG8_MMA(1, 1, At, B1); PG8_BAR;
            }
        }
        if constexpr (ALIGN_EPI) { if (wr == 0) PG8_BAR; }
        if constexpr (!Epi::AFTER_DRAIN) { E(acc, cur, wr, wc, fr, fq); S.done(cur); }
        if (!has_next) break;
#pragma unroll
        for (int a = 0; a < 2; ++a)
#pragma unroll
            for (int b = 0; b < 2; ++b)
#pragma unroll
                for (int m = 0; m < 4; ++m)
#pragma unroll
                    for (int n = 0; n < 2; ++n) acc[a][b][m][n] = (f32x4){0.f, 0.f, 0.f, 0.f};
        cur = nxt; cA = nA; cB = nB; ++ui;
        if constexpr (ALIGN_EPI) { if (wr == 1) PG8_BAR; }
    }
    PG8_WAIT_V(0);
    if constexpr (!ALIGN_EPI) { if (wr == 0) PG8_BAR; }
    PG8_BAR;
    if constexpr (Epi::AFTER_DRAIN) { E.fused(acc, cur, wr, wc, fr, fq, lds, wid, lane); S.done(cur); }
#undef PG8_SA
#undef PG8_SB
#undef PG8_STAGE
#undef PG8_LDA
#undef PG8_LDB
#undef PG8_MMA
#undef PG8_WAIT_V
#undef PG8_WAIT_L
#undef PG8_BAR
#undef PG8_SCHED
}
}


namespace attn_body {
using bf16=__hip_bfloat16;
using bf16x8=__attribute__((ext_vector_type(8)))short;
using s16x4=__attribute__((ext_vector_type(4)))short;
using f32x16=__attribute__((ext_vector_type(16)))float;
using u32x4=__attribute__((ext_vector_type(4)))unsigned;
constexpr int D=64;
constexpr int NW=8,QBLK=32,QB=QBLK*NW,KVBLK=64;
constexpr int ATTN_UNIT_ROWS=QB;
__device__ __forceinline__ int crow(int r,int hi){return (r&3)+8*(r>>2)+4*hi;}
#define SBAR() __builtin_amdgcn_sched_barrier(0)
constexpr int NSLOT=3, SLOTB=8192;
constexpr int LDS_K=0, LDS_V=NSLOT*SLOTB, LDS_WS=2*NSLOT*SLOTB, LDS_OST=LDS_WS+NW*64*4, LDS_BYTES=LDS_OST+NW*4096;
constexpr float C2=0.125f*1.4426950408889634f;
__device__ __forceinline__ void glds16(const void*gsrc,unsigned lds_dst){unsigned keep;
  asm volatile("s_mov_b32 %0, m0\n\ts_mov_b32 m0, %2\n\ts_nop 0\n\tglobal_load_lds_dwordx4 %1, off\n\ts_mov_b32 m0, %0":"=&s"(keep):"v"(gsrc),"s"(lds_dst):"memory");}
__device__ __forceinline__ float max3f(float a,float b,float c){float r;asm("v_max3_f32 %0, %1, %2, %3":"=v"(r):"v"(a),"v"(b),"v"(c));return r;}
__device__ __forceinline__ float max2f(float a,float b){float r;asm("v_max_f32_e32 %0, %1, %2":"=v"(r):"v"(a),"v"(b));return r;}
__device__ __forceinline__ float fadd_s(float a,float b){float r;asm("v_add_f32_e32 %0, %1, %2":"=v"(r):"v"(a),"v"(b));return r;}
__device__ __forceinline__ float fsub_s(float a,float b){float r;asm("v_sub_f32_e32 %0, %1, %2":"=v"(r):"v"(a),"v"(b));return r;}
typedef float f32x2_t __attribute__((ext_vector_type(2))); typedef __bf16 bf16x2_t __attribute__((ext_vector_type(2)));
__device__ __forceinline__ unsigned cvtpk_s(float lo,float hi){f32x2_t v={lo,hi};bf16x2_t b=__builtin_convertvector(v,bf16x2_t);return __builtin_bit_cast(unsigned,b);}
#define WAIT_BAR(N) asm volatile("s_waitcnt vmcnt(" #N ") lgkmcnt(0)\n\ts_barrier":::"memory")

__device__ __forceinline__ void qkt(f32x16&p0,f32x16&p1,const char*Kslot,const bf16x8*qr,const f32x16&negm,int r32,int hi){
  const char*kb=Kslot+hi*1024+r32*16;
  #pragma unroll
  for(int d0=0;d0<4;++d0){
    const bf16x8 b0=*reinterpret_cast<const bf16x8*>(kb+d0*2048);
    const bf16x8 b1=*reinterpret_cast<const bf16x8*>(kb+d0*2048+512);
    if(d0==0){p0=__builtin_amdgcn_mfma_f32_32x32x16_bf16(b0,qr[0],negm,0,0,0);p1=__builtin_amdgcn_mfma_f32_32x32x16_bf16(b1,qr[0],negm,0,0,0);}
    else{p0=__builtin_amdgcn_mfma_f32_32x32x16_bf16(b0,qr[d0],p0,0,0,0);p1=__builtin_amdgcn_mfma_f32_32x32x16_bf16(b1,qr[d0],p1,0,0,0);}}
}
typedef __attribute__((address_space(3))) const char* lds_cptr;
typedef short v4i16_t __attribute__((ext_vector_type(4)));
__device__ __forceinline__ void kload8(bf16x8*kf,lds_cptr kp){
  kf[0]=*(const __attribute__((address_space(3))) bf16x8*)(kp);      kf[1]=*(const __attribute__((address_space(3))) bf16x8*)(kp+512);
  kf[2]=*(const __attribute__((address_space(3))) bf16x8*)(kp+2048); kf[3]=*(const __attribute__((address_space(3))) bf16x8*)(kp+2560);
  kf[4]=*(const __attribute__((address_space(3))) bf16x8*)(kp+4096); kf[5]=*(const __attribute__((address_space(3))) bf16x8*)(kp+4608);
  kf[6]=*(const __attribute__((address_space(3))) bf16x8*)(kp+6144); kf[7]=*(const __attribute__((address_space(3))) bf16x8*)(kp+6656);
}
__device__ __forceinline__ void kload2(bf16x8*kf,lds_cptr kp,int j){ kf[2*j]=*(const __attribute__((address_space(3))) bf16x8*)(kp+j*2048); kf[2*j+1]=*(const __attribute__((address_space(3))) bf16x8*)(kp+j*2048+512); }
__device__ __forceinline__ s16x4 vtr(lds_cptr p){ return __builtin_bit_cast(s16x4,__builtin_amdgcn_ds_read_tr16_b64_v4i16((__attribute__((address_space(3))) v4i16_t*)p)); }
__device__ __forceinline__ float rowmax(const f32x16&p0,const f32x16&p1){
  float a=max3f(p0[0],p0[1],p1[0]),b=max3f(p0[2],p0[3],p1[1]);a=max3f(a,p1[2],p1[3]);
  #pragma unroll
  for(int r=4;r<16;r+=4){a=max3f(a,p0[r],p0[r+1]);b=max3f(b,p0[r+2],p0[r+3]);a=max3f(a,p1[r],p1[r+1]);b=max3f(b,p1[r+2],p1[r+3]);}
  const float m=max2f(a,b);
  auto rr=__builtin_amdgcn_permlane32_swap(__float_as_uint(m),__float_as_uint(m),false,false);
  return max2f(__uint_as_float(rr[0]),__uint_as_float(rr[1]));
}
__device__ __forceinline__ void pv(f32x16*o,int vb,bf16x8 pa0,bf16x8 pa1,bf16x8 pa2,bf16x8 pa3){
  #pragma unroll
  for(int d0=0;d0<2;++d0){s16x4 lo[4],hi[4];
    #pragma unroll
    for(int ks=0;ks<4;++ks){
      asm volatile("ds_read_b64_tr_b16 %0,%1 offset:%c2":"=&v"(lo[ks]):"v"(vb),"i"(d0*4096+ks*1024):"memory");
      asm volatile("ds_read_b64_tr_b16 %0,%1 offset:%c2":"=&v"(hi[ks]):"v"(vb),"i"(d0*4096+ks*1024+512):"memory");}
    asm volatile("s_waitcnt lgkmcnt(0)":::"memory");SBAR();
    #define PK(k) (bf16x8){lo[k][0],lo[k][1],lo[k][2],lo[k][3],hi[k][0],hi[k][1],hi[k][2],hi[k][3]}
    o[d0]=__builtin_amdgcn_mfma_f32_32x32x16_bf16(pa0,PK(0),o[d0],0,0,0);
    o[d0]=__builtin_amdgcn_mfma_f32_32x32x16_bf16(pa1,PK(1),o[d0],0,0,0);
    o[d0]=__builtin_amdgcn_mfma_f32_32x32x16_bf16(pa2,PK(2),o[d0],0,0,0);
    o[d0]=__builtin_amdgcn_mfma_f32_32x32x16_bf16(pa3,PK(3),o[d0],0,0,0);
    #undef PK
  }
}

#ifndef ATTN_STORE16
#define ATTN_STORE16(p,v) (*(u32x4*)(p)=(v))
#endif
template<int THRL> __device__ __forceinline__ void attn_unit(const bf16*Q0,int ldq,const bf16*__restrict__ Kh,int ldk,const bf16*__restrict__ Vh,int ldv,bf16*O0,int ldo,int NT,char*shm){
  int tid_=my_tid(); asm volatile("":"+v"(tid_)); const int tid=tid_,lane=tid&63,r32=lane&31,hi=lane>>5; const int wid=__builtin_amdgcn_readfirstlane(tid>>6);
  const bf16*Qw=Q0+(long)(wid*QBLK)*ldq;
  const unsigned lds0=(unsigned)(uintptr_t)shm;
  float*wsf=(float*)(shm+LDS_WS)+wid*64;
  const bf16*ksrc=Kh+(long)lane*ldk+wid*8;
  const bf16*vsrc=Vh+(long)(16*(wid&3)+(lane>>2))*ldv+(wid>>2)*32+(lane&3)*8;
  const unsigned kdst=lds0+LDS_K+wid*1024, vdst=lds0+LDS_V+wid*1024;
  #define DMA_K(t,slot) glds16(ksrc+(long)(t)*KVBLK*ldk,(unsigned)__builtin_amdgcn_readfirstlane(kdst+(slot)))
  #define DMA_V(t,slot) glds16(vsrc+(long)(t)*KVBLK*ldv,(unsigned)__builtin_amdgcn_readfirstlane(vdst+(slot)))
  const int vb0=(int)(lds0+LDS_V)+((lane>>4)&1)*32+(lane&3)*8+(4*hi+((lane&15)>>2))*64;
  const char*Kbase=shm+LDS_K; bf16x8 kf[8];
  const lds_cptr shm3=(lds_cptr)shm; const lds_cptr kp0=shm3+LDS_K+hi*1024+r32*16; const lds_cptr vp0=shm3+LDS_V+((lane>>4)&1)*32+(lane&3)*8+(4*hi+((lane&15)>>2))*64;
  DMA_K(0,0);DMA_V(0,0);DMA_K(1,SLOTB);
  bf16x8 qr[4];
  #pragma unroll
  for(int d0=0;d0<4;++d0)qr[d0]=*reinterpret_cast<const bf16x8*>(&Qw[(long)r32*ldq+d0*16+hi*8]);
  float mhat=0.f,l_reg=0.f;f32x16 o[2];o[0]=f32x16{};o[1]=f32x16{};f32x16 negm=f32x16{};asm volatile("":"+v"(negm));
  #define CMASK(P0,P1,t) do{}while(0)
  bool resc=false;
  #define START(P0,P1) do{ const float rm=rowmax(P0,P1); resc=false; \
    { const float dl=rm; mhat=fadd_s(mhat,dl); \
      _Pragma("unroll") for(int r=0;r<16;++r){P0[r]=fsub_s(P0[r],dl);P1[r]=fsub_s(P1[r],dl);} \
      _Pragma("unroll") for(int r=0;r<16;++r)negm[r]=-mhat; asm volatile("":"+v"(negm)); } \
    _Pragma("unroll") for(int r=0;r<16;++r)P0[r]=__builtin_amdgcn_exp2f(P0[r]); }while(0)
  #define RESC() do{ if(resc){ asm volatile("s_waitcnt lgkmcnt(0)":::"memory"); \
      _Pragma("unroll") for(int d_=0;d_<2;++d_) _Pragma("unroll") for(int r=0;r<16;++r)o[d_][r]*=wsf[crow(r,hi)]; } }while(0)
  f32x16 pA0,pA1,pB0,pB1;
  int sl_prev=0,sl_cur=0,sl_next=SLOTB;
  #define ROT() do{sl_prev=sl_cur;sl_cur=sl_next;sl_next=(sl_next==(NSLOT-1)*SLOTB)?0:sl_next+SLOTB;}while(0)
  DMA_K(2,2*SLOTB);
  WAIT_BAR(3);
  qkt(pA0,pA1,Kbase,qr,negm,r32,hi);asm volatile("s_nop 15\n\ts_nop 7":"+v"(pA0),"+v"(pA1));CMASK(pA0,pA1,0);
  START(pA0,pA1);
  _Pragma("unroll") for(int r=0;r<16;++r)pA1[r]=__builtin_amdgcn_exp2f(pA1[r]);
  WAIT_BAR(0);
  DMA_K(3,0);DMA_V(1,SLOTB);
  ROT();
  kload8(kf,kp0+sl_cur);
  WAIT_BAR(2);
  s16x4 vlo[8],vhi[8]; u32x4 pw0,pw1,pw2,pw3;
  #define PKW(P,B) cvtpk_s(P[B],P[B+1])
  #define PAF(k) __builtin_bit_cast(bf16x8,pw##k)
  #define VFR(i) (bf16x8){vlo[i][0],vlo[i][1],vlo[i][2],vlo[i][3],vhi[i][0],vhi[i][1],vhi[i][2],vhi[i][3]}
  #define PIN(x) asm volatile("":"+v"(x))
  #define MX3(a,b,c) __builtin_fmaxf(__builtin_fmaxf((a),(b)),(c))
  #define GAPA(MF,A0,A1,A2,A3,W0,W1,PW) do{ MF; sacc+=A0; sacc+=A1; sacc+=A2; sacc+=A3; PIN(sacc); W0; W1; PIN(PW); SBAR(); }while(0)
  #define EX(v) __builtin_amdgcn_exp2f(v)
  #define GAPB(MF,X,B) do{ MF; X[B]=EX(X[B]); X[B+1]=EX(X[B+1]); X[B+2]=EX(X[B+2]); X[B+3]=EX(X[B+3]); PIN(X); SBAR(); }while(0)
  #define VRD(i) do{ vlo[i]=vtr(vp_+(((i)>>2)*4096+((i)&3)*1024)); vhi[i]=vtr(vp_+(((i)>>2)*4096+((i)&3)*1024+512)); }while(0)
  #define KRD(G,j) do{ if(G){ kload2(kf,kp0+sl_next,j); SBAR(); } }while(0)
  #define STEP(C0,C1,P0,P1,t,GK,GV,GL) do{ SBAR(); \
    const lds_cptr vp_=vp0+sl_prev; \
    VRD(0); SBAR(); float sacc=(P0[0]+P0[1]); \
    GAPA(C0=__builtin_amdgcn_mfma_f32_32x32x16_bf16(kf[0],qr[0],negm,0,0,0), P0[2],P0[3],P0[4],P0[5],     pw0[0]=PKW(P0,0), pw0[1]=PKW(P0,2), pw0); \
    VRD(4); SBAR(); GAPA(C1=__builtin_amdgcn_mfma_f32_32x32x16_bf16(kf[1],qr[0],negm,0,0,0), P0[6],P0[7],P0[8],P0[9],     pw0[2]=PKW(P0,4), pw0[3]=PKW(P0,6), pw0); \
    VRD(1); SBAR(); GAPA(C0=__builtin_amdgcn_mfma_f32_32x32x16_bf16(kf[2],qr[1],C0,0,0,0),   P0[10],P0[11],P0[12],P0[13], pw1[0]=PKW(P0,8), pw1[1]=PKW(P0,10), pw1); \
    VRD(5); SBAR(); GAPA(C1=__builtin_amdgcn_mfma_f32_32x32x16_bf16(kf[3],qr[1],C1,0,0,0),   P0[14],P0[15],P1[0],P1[1],   pw1[2]=PKW(P0,12),pw1[3]=PKW(P0,14), pw1); \
    VRD(2); SBAR(); GAPA(C0=__builtin_amdgcn_mfma_f32_32x32x16_bf16(kf[4],qr[2],C0,0,0,0),   P1[2],P1[3],P1[4],P1[5],     pw2[0]=PKW(P1,0), pw2[1]=PKW(P1,2), pw2); \
    VRD(6); SBAR(); GAPA(C1=__builtin_amdgcn_mfma_f32_32x32x16_bf16(kf[5],qr[2],C1,0,0,0),   P1[6],P1[7],P1[8],P1[9],     pw2[2]=PKW(P1,4), pw2[3]=PKW(P1,6), pw2); \
    VRD(3); SBAR(); GAPA(C0=__builtin_amdgcn_mfma_f32_32x32x16_bf16(kf[6],qr[3],C0,0,0,0),   P1[10],P1[11],P1[12],P1[13], pw3[0]=PKW(P1,8), pw3[1]=PKW(P1,10), pw3); \
    VRD(7); SBAR(); GAPA(C1=__builtin_amdgcn_mfma_f32_32x32x16_bf16(kf[7],qr[3],C1,0,0,0),   P1[14],P1[15],0.f,0.f,       pw3[2]=PKW(P1,12),pw3[3]=PKW(P1,14), pw3); \
    l_reg+=sacc; \
    if(GK){DMA_K((t)+3,sl_cur);} if(GV){DMA_V((t)+1,sl_next);} \
    CMASK(C0,C1,t); \
    { float a=MX3(C0[0],C0[1],C1[0]),b=MX3(C0[2],C0[3],C1[1]); a=MX3(a,C1[2],C1[3]); \
      _Pragma("unroll") for(int r=4;r<16;r+=4){a=MX3(a,C0[r],C0[r+1]);b=MX3(b,C0[r+2],C0[r+3]);a=MX3(a,C1[r],C1[r+1]);b=MX3(b,C1[r+2],C1[r+3]);} \
      float rm=__builtin_fmaxf(a,b); { auto rr=__builtin_amdgcn_permlane32_swap(__float_as_uint(rm),__float_as_uint(rm),false,false); rm=__builtin_fmaxf(__uint_as_float(rr[0]),__uint_as_float(rr[1])); } \
      resc=false; \
      if(__builtin_expect(__any(rm>(float)THRL),0)){ const float dl=__builtin_fmaxf(rm,0.f); mhat+=dl; \
        _Pragma("unroll") for(int r=0;r<16;++r){C0[r]-=dl;C1[r]-=dl;} \
        _Pragma("unroll") for(int r=0;r<16;++r)negm[r]=-mhat; asm volatile("":"+v"(negm)); \
        const float f=__builtin_amdgcn_exp2f(-dl); l_reg*=f; if(hi==0)wsf[r32]=f; resc=true; } } \
    SBAR(); \
    GAPB(o[0]=__builtin_amdgcn_mfma_f32_32x32x16_bf16(PAF(0),VFR(0),o[0],0,0,0), C0,0); \
    GAPB(o[1]=__builtin_amdgcn_mfma_f32_32x32x16_bf16(PAF(0),VFR(4),o[1],0,0,0), C0,4); \
    KRD(GL,0); GAPB(o[0]=__builtin_amdgcn_mfma_f32_32x32x16_bf16(PAF(1),VFR(1),o[0],0,0,0), C0,8); \
    KRD(GL,1); GAPB(o[1]=__builtin_amdgcn_mfma_f32_32x32x16_bf16(PAF(1),VFR(5),o[1],0,0,0), C0,12); \
    KRD(GL,2); GAPB(o[0]=__builtin_amdgcn_mfma_f32_32x32x16_bf16(PAF(2),VFR(2),o[0],0,0,0), C1,0); \
    KRD(GL,3); GAPB(o[1]=__builtin_amdgcn_mfma_f32_32x32x16_bf16(PAF(2),VFR(6),o[1],0,0,0), C1,4); \
    GAPB(o[0]=__builtin_amdgcn_mfma_f32_32x32x16_bf16(PAF(3),VFR(3),o[0],0,0,0), C1,8); \
    GAPB(o[1]=__builtin_amdgcn_mfma_f32_32x32x16_bf16(PAF(3),VFR(7),o[1],0,0,0), C1,12); \
    }while(0)
  int t=1;
  #undef CMASK
  #define CMASK(P0,P1,t) do{}while(0)
  for(;t+5<NT;t+=2){
    STEP(pB0,pB1,pA0,pA1,t,true,true,true);     WAIT_BAR(2); RESC(); ROT();
    STEP(pA0,pA1,pB0,pB1,t+1,true,true,true);   WAIT_BAR(2); RESC(); ROT();
  }
  #undef CMASK
  #define CMASK(P0,P1,t) do{}while(0)
  #define ENDW(tt) do{ if((tt)+3<NT){WAIT_BAR(2);} else if((tt)+2<NT){WAIT_BAR(1);} else {WAIT_BAR(0);} }while(0)
  for(;t+1<NT;t+=2){
    STEP(pB0,pB1,pA0,pA1,t,(t+3<NT),(t+1<NT),(t+1<NT));       ENDW(t);   RESC(); ROT();
    STEP(pA0,pA1,pB0,pB1,t+1,(t+4<NT),(t+2<NT),(t+2<NT));     ENDW(t+1); RESC(); ROT();
  }
  STEP(pB0,pB1,pA0,pA1,NT-1,false,false,false); RESC();
  { float sacc=pB0[0]+pB0[1]; _Pragma("unroll") for(int r=2;r<16;++r)sacc+=pB0[r]; _Pragma("unroll") for(int r=0;r<16;++r)sacc+=pB1[r]; l_reg+=sacc;
    pw0=(u32x4){PKW(pB0,0),PKW(pB0,2),PKW(pB0,4),PKW(pB0,6)};pw1=(u32x4){PKW(pB0,8),PKW(pB0,10),PKW(pB0,12),PKW(pB0,14)};pw2=(u32x4){PKW(pB1,0),PKW(pB1,2),PKW(pB1,4),PKW(pB1,6)};pw3=(u32x4){PKW(pB1,8),PKW(pB1,10),PKW(pB1,12),PKW(pB1,14)};
    SBAR(); pv(o,vb0+sl_cur,PAF(0),PAF(1),PAF(2),PAF(3)); }
  #undef PKW
  #undef PAF
  #undef VFR
  #undef PIN
  #undef MX3
  #undef GAPA
  #undef GAPB
  #undef EX
  #undef VRD
  #undef KRD
  #undef STEP
  #undef ENDW
  {auto rr=__builtin_amdgcn_permlane32_swap(__float_as_uint(l_reg),__float_as_uint(l_reg),false,false);l_reg=__uint_as_float(rr[0])+__uint_as_float(rr[1]);}
  if(hi==0)wsf[32+r32]=l_reg;asm volatile("s_waitcnt lgkmcnt(0)":::"memory");
  float rli[16];
  #pragma unroll
  for(int r=0;r<16;++r)rli[r]=__builtin_amdgcn_rcpf(wsf[32+crow(r,hi)]);
  bf16*Ow=O0+(long)(wid*QBLK)*ldo;
  { bf16*stg=(bf16*)(shm+LDS_OST)+wid*2048;
    #pragma unroll
    for(int r=0;r<16;++r){const int orow=crow(r,hi);
      #pragma unroll
      for(int d0=0;d0<2;++d0)stg[orow*64+d0*32+r32]=__float2bfloat16(o[d0][r]*rli[r]);}
    asm volatile("s_waitcnt lgkmcnt(0)":::"memory");
    #pragma unroll
    for(int i=0;i<4;++i){const int row=i*8+(lane>>3),ch=lane&7; const u32x4 v=*(const u32x4*)(stg+row*64+ch*8); ATTN_STORE16(Ow+(long)row*ldo+ch*8,v);} }
  asm volatile("s_waitcnt lgkmcnt(0)\n\ts_barrier":::"memory");
  #undef DMA_K
  #undef DMA_V
  #undef CMASK
  #undef START
  #undef RESC
  #undef ROT
}
constexpr int ATTN_LDS_BYTES=LDS_BYTES;
#undef SBAR
#undef WAIT_BAR
}


constexpr int NWAVES = 8;
constexpr int DMODEL = 1024, NBATCH = 2, SEQL = 8192, CTXL = 256, RPB = SEQL + CTXL, MROWS = NBATCH * RPB, NLAYER = 2;
constexpr int DFF = 2816, NUP = 2 * DFF, INW = 5888, ZW = 5376, NMODV = 9, MODW = NMODV * DMODEL;
constexpr int ZQA = 0, ZKA = 512, ZVA = 640, ZQB = 768, ZKB = 1280, ZVB = 1792, ZGATE = 2304;
constexpr int TPB = RPB / 256;
constexpr float EPSN = 1e-6f;
constexpr int HN = 4096;

constexpr size_t MiB = 1u << 20, KiB = 1024;
constexpr size_t WS_CTL = 0, CTL_ZERO_BYTES = 64 * KiB;
constexpr size_t WS_MOD = 1 * MiB;
constexpr size_t WS_CAS256 = 1 * MiB + 512 * KiB;
constexpr size_t WS_HC = 2 * MiB;
constexpr size_t WS_WUP0 = 4 * MiB, WS_WDN0 = 15 * MiB, WS_WUP1 = 20 * MiB + 512 * KiB, WS_WDN1 = 31 * MiB + 512 * KiB;
constexpr size_t WS_WIN = 37 * MiB, WS_WC = 47 * MiB + 512 * KiB, WS_WBR = 48 * MiB + 512 * KiB, WS_WOUT = 51 * MiB + 512 * KiB;
constexpr size_t WS_HN = 54 * MiB;
constexpr size_t WS_Z = 87 * MiB;
constexpr size_t WS_T1T = 261 * MiB;
constexpr size_t WS_PART = WS_T1T;
constexpr size_t WS_T2B = WS_T1T;
constexpr size_t WS_T2 = 278 * MiB;
constexpr size_t WS_PQ = 295 * MiB;
constexpr size_t WS_CAS = 311 * MiB;
constexpr size_t WS_ROPE = 343 * MiB;
constexpr size_t WS_END = 345 * MiB;
static_assert(WS_Z + (size_t)MROWS * ZW * 2 <= WS_T1T && WS_HN + (size_t)MROWS * DMODEL * 2 <= WS_Z && WS_WOUT + 2 * MiB <= WS_HN, "ws map");
constexpr int CW_BAR = 4096;
constexpr int CW_Q = 1024;


#define GAS __attribute__((address_space(1)))
typedef unsigned short bf16;
typedef unsigned v4u __attribute__((ext_vector_type(4)));
typedef float f32x4 __attribute__((ext_vector_type(4)));
#define LDS_WAIT() asm volatile("s_waitcnt lgkmcnt(0)" ::: "memory")

__device__ __forceinline__ float bf2f(unsigned v) { return __uint_as_float(v << 16); }
__device__ __forceinline__ float bflo(unsigned w) { return __uint_as_float(w << 16); }
__device__ __forceinline__ float bfhi(unsigned w) { return __uint_as_float(w & 0xffff0000u); }
__device__ __forceinline__ unsigned pk2(float lo, float hi) { return pg8::cvt_pk_bf16(lo, hi); }
__device__ __forceinline__ float fexp(float x) { return __builtin_amdgcn_exp2f(x * 1.4426950408889634f); }
__device__ __forceinline__ float sigm(float x) { return __builtin_amdgcn_rcpf(1.0f + fexp(-x)); }
__device__ __forceinline__ float siluf(float x) { return x * sigm(x); }
__device__ __forceinline__ float shfl_xor(float v, int o) { return __builtin_bit_cast(float, __builtin_amdgcn_ds_bpermute((lane_id() ^ o) << 2, __builtin_bit_cast(int, v))); }
__device__ __forceinline__ float wave_sum(float v) {
#pragma unroll
    for (int o = 1; o < 64; o <<= 1) v += shfl_xor(v, o);
    return v;
}

namespace pg8 {
struct EpiStore {
    static constexpr bool PERM = true, AFTER_DRAIN = false;
    bf16_t* O; int ldc; int sig_from; int rbase, rmul;
    __device__ __forceinline__ void operator()(const f32x4 (&acc)[2][2][4][2], const Unit& u, int wr, int wc, int fr_, int fq_) const {
        (void)fr_; (void)fq_; const int ln_ = lane_id(); const int fr = ln_ & 15, fq = ln_ >> 4;
        const int row0 = u.pm * BM + wr * 64 + fr, col0 = u.pn * BM + wc * 32 + 8 * fq;
        const bool sg = (u.pn * BM) >= sig_from;
#pragma unroll
        for (int ai = 0; ai < 2; ++ai)
#pragma unroll
            for (int m = 0; m < 4; ++m) { const int row = row0 + ai * HALF + m * 16; bf16_t* rowp = O + (size_t)(rbase + row * rmul) * ldc + col0;
#pragma unroll
                for (int bj = 0; bj < 2; ++bj) { f32x4 v0 = acc[ai][bj][m][0], v1 = acc[ai][bj][m][1];
                    if (sg) { v0[0] = sigm(v0[0]); v0[1] = sigm(v0[1]); v0[2] = sigm(v0[2]); v0[3] = sigm(v0[3]); v1[0] = sigm(v1[0]); v1[1] = sigm(v1[1]); v1[2] = sigm(v1[2]); v1[3] = sigm(v1[3]); }
                    u32x4 w; w.x = cvt_pk_bf16(v0[0], v0[1]); w.y = cvt_pk_bf16(v0[2], v0[3]); w.z = cvt_pk_bf16(v1[0], v1[1]); w.w = cvt_pk_bf16(v1[2], v1[3]);
                    *(u32x4*)(rowp + bj * HALF) = w; } }
    }
};
struct EpiSwiGLU {
    static constexpr bool PERM = true, AFTER_DRAIN = false;
    bf16_t* H; int ldc;
    __device__ __forceinline__ void operator()(const f32x4 (&acc)[2][2][4][2], const Unit& u, int wr, int wc, int fr_, int fq_) const {
        (void)fr_; (void)fq_; const int ln_ = lane_id(); const int fr = ln_ & 15, fq = ln_ >> 4;
        const int row0 = u.pm * BM + wr * 64 + fr, col0 = u.pn * HALF + wc * 32 + 8 * fq;
#pragma unroll
        for (int ai = 0; ai < 2; ++ai)
#pragma unroll
            for (int m = 0; m < 4; ++m) { const int row = row0 + ai * HALF + m * 16; bf16_t* rowp = H + (size_t)row * ldc + col0;
                const f32x4 g0 = acc[ai][0][m][0], g1 = acc[ai][0][m][1], u0 = acc[ai][1][m][0], u1 = acc[ai][1][m][1];
                u32x4 w; w.x = cvt_pk_bf16(siluf(g0[0]) * u0[0], siluf(g0[1]) * u0[1]); w.y = cvt_pk_bf16(siluf(g0[2]) * u0[2], siluf(g0[3]) * u0[3]);
                w.z = cvt_pk_bf16(siluf(g1[0]) * u1[0], siluf(g1[1]) * u1[1]); w.w = cvt_pk_bf16(siluf(g1[2]) * u1[2], siluf(g1[3]) * u1[3]);
                *(u32x4*)rowp = w; }
    }
};
template <bool ATOMIC> struct EpiResidT {
    static constexpr bool PERM = false, AFTER_DRAIN = false;
    const float* base_lat; const float* base_ctx; float* out_lat; float* out_ctx; const float* gate; float scale;
    __device__ __forceinline__ void operator()(const f32x4 (&acc)[2][2][4][2], const Unit& u, int wr, int wc, int fr_, int fq_) const {
        (void)fr_; (void)fq_; const int ln_ = lane_id(); const int fr = ln_ & 15, fq = ln_ >> 4;
        const int b = u.pm / 33, w = u.pm % 33; const int set = (w == 0) ? 2 : b;
        const size_t toff = (w == 0) ? (size_t)b * 256 * 1024 : ((size_t)b * 8192 + (size_t)(w - 1) * 256) * 1024;
        const float* base = ((w == 0) ? base_ctx : base_lat) + toff; float* out = ((w == 0) ? out_ctx : out_lat) + toff;
        const int frr = fr;
        const int col0 = u.pn * BM + wc * 32 + 4 * fq; const float* gp = gate + set * 9216 + col0;
#pragma unroll
        for (int bj = 0; bj < 2; ++bj)
#pragma unroll
            for (int n = 0; n < 2; ++n) { const f32x4 gv = *(const f32x4*)(gp + bj * HALF + n * 16) * scale;
#pragma unroll
                for (int ai = 0; ai < 2; ++ai) {
#pragma unroll
                    for (int m = 0; m < 4; ++m) { const unsigned off = (unsigned)(ai * HALF + wr * 64 + m * 16 + frr) * 1024u + (unsigned)(col0 + bj * HALF + n * 16);
                        if constexpr (ATOMIC) { float one = 1.0f; asm volatile("" : "+v"(one) :: "memory"); const f32x4 v = (gv * one) * acc[ai][bj][m][n]; __attribute__((address_space(1))) float* ap = (__attribute__((address_space(1))) float*)(out + off); (void)__builtin_amdgcn_global_atomic_fadd_f32(ap, v[0]); (void)__builtin_amdgcn_global_atomic_fadd_f32(ap + 1, v[1]); (void)__builtin_amdgcn_global_atomic_fadd_f32(ap + 2, v[2]); (void)__builtin_amdgcn_global_atomic_fadd_f32(ap + 3, v[3]); asm volatile("" ::: "memory"); }
                        else { const f32x4 bs = *(const f32x4*)(base + off); *(f32x4*)(out + off) = bs + gv * acc[ai][bj][m][n]; } }
                    asm volatile("" ::: "memory"); } }
    }
};
typedef EpiResidT<false> EpiResid;
struct EpiResidA {
    static constexpr bool PERM = false, AFTER_DRAIN = false;
    float* part; const float* gate; float scale;
    __device__ __forceinline__ void operator()(const f32x4 (&acc)[2][2][4][2], const Unit& u, int wr, int wc, int fr_, int fq_) const {
        (void)fr_; (void)fq_; const int ln_ = lane_id(); const int fr = ln_ & 15, fq = ln_ >> 4;
        const int col0 = u.pn * BM + wc * 32 + 4 * fq;
        float* out = part + ((size_t)u.kp * 512 + (u.pm ? 256 : 0)) * 1024 + (unsigned)((wr * 64 + fr) * 1024 + col0);
#pragma unroll
        for (int bj = 0; bj < 2; ++bj)
#pragma unroll
            for (int n = 0; n < 2; ++n) { const f32x4 gv = *(const f32x4*)(gate + col0 + bj * HALF + n * 16) * scale;
#pragma unroll
                for (int ai = 0; ai < 2; ++ai) {
#pragma unroll
                    for (int m = 0; m < 4; ++m) *(f32x4*)(out + (ai * HALF + m * 16) * 1024 + bj * HALF + n * 16) = gv * acc[ai][bj][m][n];
                    asm volatile("" ::: "memory"); } }
    }
};
struct EpiMerge {
    static constexpr bool PERM = true, AFTER_DRAIN = false;
    const bf16_t* Z; bf16_t* Mo;
    __device__ __forceinline__ void operator()(const f32x4 (&acc)[2][2][4][2], const Unit& u, int wr, int wc, int fr_, int fq_) const {
        (void)fr_; (void)fq_; const int ln_ = lane_id(); const int fr = ln_ & 15, fq = ln_ >> 4;
        const int br = u.pn >> 2, ct = u.pn & 3;
        const int row0 = u.pm * BM + wr * 64 + fr, col0 = ct * BM + wc * 32 + 8 * fq;
#pragma unroll
        for (int ai = 0; ai < 2; ++ai)
#pragma unroll
            for (int m = 0; m < 4; ++m) { const int row = row0 + ai * HALF + m * 16; const bf16_t* gp = Z + (size_t)row * 5376 + 2304 + br * 1024 + col0; bf16_t* mp = Mo + (size_t)row * 1024 + col0;
#pragma unroll
                for (int bj = 0; bj < 2; ++bj) { const u32x4 gw = *(const u32x4*)(gp + bj * HALF); const f32x4 a0 = acc[ai][bj][m][0], a1 = acc[ai][bj][m][1];
                    float r0 = __uint_as_float(gw.x << 16) * a0[0], r1 = __uint_as_float(gw.x & 0xffff0000u) * a0[1], r2 = __uint_as_float(gw.y << 16) * a0[2], r3 = __uint_as_float(gw.y & 0xffff0000u) * a0[3];
                    float r4 = __uint_as_float(gw.z << 16) * a1[0], r5 = __uint_as_float(gw.z & 0xffff0000u) * a1[1], r6 = __uint_as_float(gw.w << 16) * a1[2], r7 = __uint_as_float(gw.w & 0xffff0000u) * a1[3];
                    if (br > 0) { const u32x4 ow = *(const u32x4*)(mp + bj * HALF);
                        r0 += __uint_as_float(ow.x << 16); r1 += __uint_as_float(ow.x & 0xffff0000u); r2 += __uint_as_float(ow.y << 16); r3 += __uint_as_float(ow.y & 0xffff0000u);
                        r4 += __uint_as_float(ow.z << 16); r5 += __uint_as_float(ow.z & 0xffff0000u); r6 += __uint_as_float(ow.w << 16); r7 += __uint_as_float(ow.w & 0xffff0000u); }
                    u32x4 w; w.x = cvt_pk_bf16(r0, r1); w.y = cvt_pk_bf16(r2, r3); w.z = cvt_pk_bf16(r4, r5); w.w = cvt_pk_bf16(r6, r7);
                    *(u32x4*)(mp + bj * HALF) = w; } }
    }
};
struct MergeOrder {
    int G, c, lat;
    __device__ bool next(int i, Unit& u) const { const int grp = (i / 3) * G + c; if (grp >= (lat ? 256 : 264)) return false; int pm = grp >> 2; if (lat) pm = pm + 1 + (pm >= 32); u.pm = pm; u.pn = (grp & 3) + 4 * (i % 3); return true; }
    __device__ __forceinline__ void a_ready(const Unit&) const {}
    __device__ __forceinline__ void done(const Unit&) const {}
    __device__ __forceinline__ size_t aoff(const Unit& u) const { const int br = u.pn >> 2; return (size_t)(br == 0 ? 0 : (br == 1 ? 768 : 1280)) * 2; }
    __device__ __forceinline__ size_t boff(const Unit&) const { return 0; }
};
struct LatOrder {
    StaticOrder so;
    __device__ void init(int N, int G_, int c_) { so.init(64 * BM, N, G_, c_); }
    __device__ bool next(int i, Unit& u) const { if (!so.next(i, u)) return false; u.pm = u.pm + 1 + (u.pm >= 32); return true; }
    __device__ __forceinline__ void a_ready(const Unit&) const {}
    __device__ __forceinline__ void done(const Unit&) const {}
    __device__ __forceinline__ size_t aoff(const Unit&) const { return 0; }
    __device__ __forceinline__ size_t boff(const Unit&) const { return 0; }
};
struct CtxSplit {
    int G, c, KP;
    __device__ bool next(int i, Unit& u) const { const int s = i * G + c; if (s >= 8 * KP) return false; const int t = s / KP; u.pn = t & 3; u.kp = s % KP; u.pm = (t >> 2) * 33; return true; }
    __device__ __forceinline__ void a_ready(const Unit&) const {}
    __device__ __forceinline__ void done(const Unit&) const {}
    __device__ __forceinline__ size_t aoff(const Unit& u) const { return (size_t)u.kp * 512; }
    __device__ __forceinline__ size_t boff(const Unit& u) const { return (size_t)u.kp * 512; }
};
struct OneUnit {
    int pm, pn;
    __device__ bool next(int i, Unit& u) const { if (i) return false; u.pm = pm; u.pn = pn; return true; }
    __device__ __forceinline__ void a_ready(const Unit&) const {}
    __device__ __forceinline__ void done(const Unit&) const {}
    __device__ __forceinline__ size_t aoff(const Unit&) const { return 0; }
    __device__ __forceinline__ size_t boff(const Unit&) const { return 0; }
};
}

#define XB_TMO      128
#define XB_XCNT(j)  (256  + 64 * (j))
#define XB_XSUB(j)  (1280 + 64 * (j))
#define XB_XGEN(j)  (2304 + 64 * (j))
#define XB_TOP      3328
#define XB_TOPGEN   3392
#define XCD_BAR_WORDS 3456
#define XB_SPIN_CAP (1u << 18)

__device__ __forceinline__ unsigned xb_ld(unsigned* p)              { return __hip_atomic_load(p, __ATOMIC_RELAXED, __HIP_MEMORY_SCOPE_AGENT); }
__device__ __forceinline__ unsigned xb_add(unsigned* p, unsigned v) { return __hip_atomic_fetch_add(p, v, __ATOMIC_RELAXED, __HIP_MEMORY_SCOPE_AGENT); }
__device__ __forceinline__ unsigned xb_xcc_id() { return (unsigned)__builtin_amdgcn_s_getreg((3 << 11) | 20) & 0xFu; }
#define XB_SPIN(cond, bar) do { unsigned _sp = 0; while (cond) { __builtin_amdgcn_s_sleep(1); \
    if ((++_sp & 255u) == 0u) { if (xb_ld(&(bar)[XB_TMO])) break; if (_sp > XB_SPIN_CAP) { atomicAdd(&(bar)[XB_TMO], 1u); break; } } } } while (0)

struct XcdBarrier {
    unsigned* bar; unsigned x;
    volatile LAS unsigned* st;
};

__device__ __forceinline__ XcdBarrier xcd_barrier_post(unsigned* bar, volatile LAS unsigned* st) {
    XcdBarrier b; b.bar = bar; b.x = xb_xcc_id(); b.st = st;
    if (my_tid() == 0) (void)xb_add(&bar[XB_XCNT(b.x)], 1u);
    return b;
}
__device__ __forceinline__ void xcd_barrier_complete(unsigned* bar, unsigned x, unsigned& nloc, unsigned& nx) {
    const unsigned G = gridDim.x * gridDim.y * gridDim.z;
    unsigned sum, cnt, mine, sp = 0u;
    for (;;) {
        sum = 0u; cnt = 0u; mine = 0u;
#pragma unroll
        for (unsigned j = 0; j < 16; ++j) { const unsigned c = xb_ld(&bar[XB_XCNT(j)]); sum += c; cnt += (c > 0u) ? 1u : 0u; mine = (j == x) ? c : mine; }
        if (sum == G) break;
        __builtin_amdgcn_s_sleep(1);
        if ((++sp & 255u) == 0u) { if (xb_ld(&bar[XB_TMO])) break; if (sp > XB_SPIN_CAP) { atomicAdd(&bar[XB_TMO], 1u); break; } }
    }
    nloc = mine > 0u ? mine : 1u; nx = cnt > 0u ? cnt : 1u;
}

__device__ __forceinline__ void xcd_barrier(const XcdBarrier& b) {
    asm volatile("s_waitcnt vmcnt(0)" ::: "memory");
    __syncthreads();
    if (my_tid() == 0) {
        unsigned* bar = b.bar;
        __builtin_amdgcn_s_waitcnt(0);
        unsigned nloc = b.st[0], nx = b.st[1];
        if (nloc == 0u) { xcd_barrier_complete(bar, b.x, nloc, nx); b.st[0] = nloc; b.st[1] = nx; }
        const unsigned old = xb_add(&bar[XB_XSUB(b.x)], 1u);
        const unsigned gen = old / nloc;
        if (old + 1u == (gen + 1u) * nloc) {
            __builtin_amdgcn_fence(__ATOMIC_RELEASE, "agent");
            asm volatile("s_waitcnt vmcnt(0)" ::: "memory");
            const unsigned og = xb_add(&bar[XB_TOP], 1u);
            const unsigned tg = og / nx;
            if (og + 1u == (tg + 1u) * nx) xb_add(&bar[XB_TOPGEN], 1u);
            else XB_SPIN(xb_ld(&bar[XB_TOPGEN]) == tg, bar);
            __builtin_amdgcn_fence(__ATOMIC_ACQUIRE, "agent");
            xb_add(&bar[XB_XGEN(b.x)], 1u);
            asm volatile("s_waitcnt vmcnt(0)" ::: "memory");
        } else {
            XB_SPIN(xb_ld(&bar[XB_XGEN(b.x)]) == gen, bar);
            __builtin_amdgcn_fence(__ATOMIC_ACQUIRE, "agent");
            asm volatile("s_waitcnt vmcnt(0)" ::: "memory");
        }
    }
    __syncthreads();
}

struct Frame {
    LAS unsigned char* lds; volatile LAS unsigned* MISC; unsigned* ctl;
    int tid, lane, wave, G, bid;
    const float *x, *c, *ctx, *cctx, *w_ada, *b_ada, *norm_g, *ffn_wi, *ffn_wo, *w_in, *qk_g, *diff_lam, *subln_g, *w_branch, *w_out;
    float* out; unsigned char* ws;
};
#define WSP(T, off) ((T*)(F.ws + (off)))

__device__ __forceinline__ void transpose_item(const float* W, int N, bf16* WT, int ldt, int k0, int n0, int dst_row0, LAS float* scr, int lane) {
#pragma unroll 8
    for (int i = 0; i < 32; ++i) { const int kk = 2 * i + (lane >> 5); scr[kk * 33 + (lane & 31)] = W[(size_t)(k0 + kk) * N + n0 + (lane & 31)]; }
    LDS_WAIT(); asm volatile("" ::: "memory");
    const int c = lane & 7;
#pragma unroll
    for (int j = 0; j < 4; ++j) { const int n = (lane >> 3) + 8 * j; const LAS float* s = scr + (8 * c) * 33 + n;
        v4u o; o.x = pk2(s[0 * 33], s[1 * 33]); o.y = pk2(s[2 * 33], s[3 * 33]); o.z = pk2(s[4 * 33], s[5 * 33]); o.w = pk2(s[6 * 33], s[7 * 33]);
        *(v4u*)(WT + (size_t)(dst_row0 + n) * ldt + k0 + 8 * c) = o; }
    LDS_WAIT(); asm volatile("" ::: "memory");
}
__device__ __forceinline__ void convert_weights(Frame& F, int l) {
    LAS float* scr = (LAS float*)(F.lds + F.wave * 16384);
    const int gw = F.bid * NWAVES + F.wave, NGW = F.G * NWAVES;
    constexpr int I_UP = 16 * 176, I_DN = 44 * 32, I_IN = 16 * 184, I_BR = 8 * 32, I_OUT = 16 * 32;
    constexpr int NITEMS = 2 * I_UP + 2 * I_DN + I_IN + 3 * I_BR + I_OUT;
    const float* wi = F.ffn_wi + (size_t)l * 2 * 1024 * NUP; const float* wo = F.ffn_wo + (size_t)l * 2 * DFF * 1024;
    const float* win = F.w_in + (size_t)l * 1024 * INW; const float* wbr = F.w_branch + (size_t)l * 3 * 512 * 1024; const float* wout = F.w_out + (size_t)l * 1024 * 1024;
    for (int it = gw; it < NITEMS; it += NGW) {
        int r = it;
        if (r < 2 * I_UP) { const int h = r / I_UP; r -= h * I_UP; const int kb = r / 176, nb = r % 176; int n0 = nb * 32; const int isu = n0 >= DFF; const int nn = n0 - isu * DFF;
            transpose_item(wi + (size_t)h * 1024 * NUP, NUP, WSP(bf16, h ? WS_WUP1 : WS_WUP0), 1024, kb * 64, n0, (nn / 128) * 256 + isu * 128 + (nn % 128), scr, F.lane); continue; }
        r -= 2 * I_UP;
        if (r < 2 * I_DN) { const int h = r / I_DN; r -= h * I_DN; const int kb = r / 32, nb = r % 32;
            transpose_item(wo + (size_t)h * DFF * 1024, 1024, WSP(bf16, h ? WS_WDN1 : WS_WDN0), DFF, kb * 64, nb * 32, nb * 32, scr, F.lane); continue; }
        r -= 2 * I_DN;
        if (r < I_IN) { const int kb = r / 184, nb = r % 184; const int n0 = nb * 32;
            if (n0 >= 2304 && n0 < 2816) continue;
            transpose_item(win, INW, WSP(bf16, WS_WIN), 1024, kb * 64, n0, n0 < 2304 ? n0 : n0 - 512, scr, F.lane); continue; }
        r -= I_IN;
        if (r < 3 * I_BR) { const int i = r / I_BR; r -= i * I_BR; const int kb = r / 32, nb = r % 32;
            transpose_item(wbr + (size_t)i * 512 * 1024, 1024, WSP(bf16, WS_WBR), 512, kb * 64, nb * 32, i * 1024 + nb * 32, scr, F.lane); continue; }
        r -= 3 * I_BR;
        { const int kb = r / 32, nb = r % 32; transpose_item(wout, 1024, WSP(bf16, WS_WOUT), 1024, kb * 64, nb * 32, nb * 32, scr, F.lane); }
    }
    {
        const int t = F.bid * 512 + F.tid;
        if (t < 65536) {
            const int jl = t & 63, rest = t >> 6, kc = rest & 127, rj = rest >> 7; const int row = rj * 64 + jl, g = row >> 7, j = row & 127;
            float a[8];
#pragma unroll
            for (int e = 0; e < 8; ++e) a[e] = 0.f;
            const float* wp = win + (size_t)(kc * 8) * INW + 2304 + g * 128;
            for (int c4 = 0; c4 < 32; ++c4) {
                float cs[4];
#pragma unroll
                for (int q = 0; q < 4; ++q) { const int idx = ((c4 * 4 + q) * j) & 127; float sn, co; sincospif((float)idx * (1.0f / 64.0f), &sn, &co); cs[q] = sn + co; }
#pragma unroll
                for (int e = 0; e < 8; ++e) { const f32x4 w = *(const f32x4*)(wp + (size_t)e * INW + c4 * 4); a[e] += w[0] * cs[0] + w[1] * cs[1] + w[2] * cs[2] + w[3] * cs[3]; }
            }
            v4u o; o.x = pk2(a[0], a[1]); o.y = pk2(a[2], a[3]); o.z = pk2(a[4], a[5]); o.w = pk2(a[6], a[7]);
            *(v4u*)(WSP(bf16, WS_WC) + (size_t)row * 1024 + kc * 8) = o;
        }
    }
}
__device__ __forceinline__ void make_cas(Frame& F) {
    const int t0 = F.bid * 512 + F.tid, NT_ = F.G * 512;
    for (int it = t0; it < HN * HN / 8; it += NT_) { const int k = it >> 9, n0 = (it & 511) * 8; float v[8];
#pragma unroll
        for (int e = 0; e < 8; ++e) { const int idx = (k * (n0 + e)) & (HN - 1); float sn, co; sincospif((float)idx * (2.0f / HN), &sn, &co); v[e] = sn + co; }
        v4u o; o.x = pk2(v[0], v[1]); o.y = pk2(v[2], v[3]); o.z = pk2(v[4], v[5]); o.w = pk2(v[6], v[7]);
        *(v4u*)(WSP(bf16, WS_CAS) + (size_t)k * HN + n0) = o; }
    for (int it = t0; it < 256 * 256 / 8; it += NT_) { const int k = it >> 5, n0 = (it & 31) * 8; float v[8];
#pragma unroll
        for (int e = 0; e < 8; ++e) { const int idx = (k * (n0 + e)) & 255; float sn, co; sincospif((float)idx * (1.0f / 128.0f), &sn, &co); v[e] = sn + co; }
        v4u o; o.x = pk2(v[0], v[1]); o.y = pk2(v[2], v[3]); o.z = pk2(v[4], v[5]); o.w = pk2(v[6], v[7]);
        *(v4u*)(WSP(bf16, WS_CAS256) + (size_t)k * 256 + n0) = o; }
}
__device__ __forceinline__ void make_mod(Frame& F) {
    LAS float* red = (LAS float*)F.lds;
    for (int item = F.bid; item < 288; item += F.G) {
        const int l = item / 144, cb = item % 144;
        const int c4 = F.lane & 15, ks = F.lane >> 4, slice = F.wave * 4 + ks;
        const float* W = F.w_ada + (size_t)l * 1024 * MODW + cb * 64 + c4 * 4;
        f32x4 a0 = {0.f, 0.f, 0.f, 0.f}, a1 = a0, a2 = a0;
        for (int r = 0; r < 32; ++r) { const int k = slice * 32 + r; const f32x4 w = *(const f32x4*)(W + (size_t)k * MODW);
            const float s0 = siluf(F.c[k]), s1 = siluf(F.c[1024 + k]), s2 = siluf(F.cctx[k]); a0 += w * s0; a1 += w * s1; a2 += w * s2; }
#pragma unroll
        for (int q = 0; q < 4; ++q) { red[(slice * 3 + 0) * 64 + c4 * 4 + q] = a0[q]; red[(slice * 3 + 1) * 64 + c4 * 4 + q] = a1[q]; red[(slice * 3 + 2) * 64 + c4 * 4 + q] = a2[q]; }
        __syncthreads();
        if (F.tid < 192) { const int set = F.tid >> 6, col = F.tid & 63; float s = 0.f;
            for (int sl = 0; sl < 32; ++sl) s += red[(sl * 3 + set) * 64 + col];
            WSP(float, WS_MOD)[((size_t)l * 3 + set) * MODW + cb * 64 + col] = s + F.b_ada[(size_t)l * MODW + cb * 64 + col]; }
        __syncthreads();
    }
}
__device__ __forceinline__ const float* hrow_ptr(const float* lat, const float* ctxp, int row, int& set) {
    const int b = row / RPB, w = row % RPB;
    if (w < CTXL) { set = 2; return ctxp + ((size_t)b * CTXL + w) * 1024; }
    set = b; return lat + ((size_t)b * SEQL + (w - CTXL)) * 1024;
}
__device__ __forceinline__ void norm_mod(Frame& F, const float* lat, const float* ctxp, const float* g, const float* modl  , int ishift, float* copy_ctx, const float* parts, int nparts) {
    const int gw = F.bid * NWAVES + F.wave, NGW = F.G * NWAVES;
    for (int row = gw; row < MROWS; row += NGW) {
        int set; const float* hr = hrow_ptr(lat, ctxp, row, set);
        const float* sh = modl + (size_t)set * MODW + ishift * 1024; const float* sc = sh + 1024;
        f32x4 v[4]; float ss = 0.f;
#pragma unroll
        for (int j = 0; j < 4; ++j) v[j] = *((const f32x4*)hr + F.lane + 64 * j);
        if (set == 2 && parts != nullptr) { const float* pr = parts + (hr - ctxp);
            for (int p = 0; p < nparts; ++p) {
#pragma unroll
                for (int j = 0; j < 4; ++j) v[j] += *((const f32x4*)(pr + (size_t)p * 512 * 1024) + F.lane + 64 * j); } }
#pragma unroll
        for (int j = 0; j < 4; ++j) ss += (v[j][0] * v[j][0] + v[j][1] * v[j][1]) + (v[j][2] * v[j][2] + v[j][3] * v[j][3]);
        const float rstd = 1.0f / sqrtf(wave_sum(ss) * (1.0f / 1024.0f) + EPSN);
        if (copy_ctx != nullptr && set == 2) { f32x4* cp = (f32x4*)(copy_ctx + (hr - ctxp)) + F.lane;
#pragma unroll
            for (int j = 0; j < 4; ++j) cp[64 * j] = v[j]; }
        unsigned long long* o8 = (unsigned long long*)(WSP(bf16, WS_HN) + (size_t)row * 1024) + F.lane;
#pragma unroll
        for (int j = 0; j < 4; ++j) { const f32x4 gg = *((const f32x4*)g + F.lane + 64 * j), s1 = *((const f32x4*)sc + F.lane + 64 * j), s0 = *((const f32x4*)sh + F.lane + 64 * j);
            const f32x4 y = v[j] * rstd * gg * (s1 + 1.0f) + s0;
            o8[64 * j] = (unsigned long long)pk2(y[0], y[1]) | ((unsigned long long)pk2(y[2], y[3]) << 32); }
    }
}
__device__ __forceinline__ void make_rope(Frame& F) {
    const int t0 = F.bid * 512 + F.tid, NT_ = F.G * 512;
    float* ct = WSP(float, WS_ROPE); float* st = ct + SEQL * 32;
    for (int it = t0; it < SEQL * 32; it += NT_) { const int s = it >> 5, i = it & 31;
        const float inv = exp2f(-(float)(i & 15) * (13.287712379549449f / 16.0f));
        const float pos = (float)((i < 16) ? (s >> 6) : (s & 63)); float sn, cs; sincosf(pos * inv, &sn, &cs); ct[it] = cs; st[it] = sn; }
}
__device__ __forceinline__ void qk_rope(Frame& F, int l) {
    const int gw = F.bid * NWAVES + F.wave, NGW = F.G * NWAVES;
    const float* qg = F.qk_g + (size_t)l * 256;
    const float* ct = WSP(float, WS_ROPE); const float* st = ct + SEQL * 32;
    for (int row = gw; row < MROWS; row += NGW) {
        const int w = row % RPB; bf16* zr = WSP(bf16, WS_Z) + (size_t)row * ZW;
#pragma unroll
        for (int pass = 0; pass < 2; ++pass) {
            const int q = pass * 64 + F.lane; const bool act = q < 104; const int hv = act ? (q >> 2) : 0, c = q & 3;
            int col, gsel; bool isq;
            if (hv < 8) { col = ZQA + hv * 64; gsel = 0; isq = true; } else if (hv < 10) { col = ZKA + (hv - 8) * 64; gsel = 1; isq = false; }
            else if (hv < 18) { col = ZQB + (hv - 10) * 64; gsel = 2; isq = true; } else { col = ZKB + (hv - 18) * 64; gsel = 3; isq = false; }
            const v4u lo = *(const v4u*)(zr + col + 8 * c), hi = *(const v4u*)(zr + col + 32 + 8 * c);
            float x1[8], x2[8];
            x1[0] = bflo(lo.x); x1[1] = bfhi(lo.x); x1[2] = bflo(lo.y); x1[3] = bfhi(lo.y); x1[4] = bflo(lo.z); x1[5] = bfhi(lo.z); x1[6] = bflo(lo.w); x1[7] = bfhi(lo.w);
            x2[0] = bflo(hi.x); x2[1] = bfhi(hi.x); x2[2] = bflo(hi.y); x2[3] = bfhi(hi.y); x2[4] = bflo(hi.z); x2[5] = bfhi(hi.z); x2[6] = bflo(hi.w); x2[7] = bfhi(hi.w);
            float ss = 0.f;
#pragma unroll
            for (int e = 0; e < 8; ++e) ss += x1[e] * x1[e] + x2[e] * x2[e];
            ss += shfl_xor(ss, 1); ss += shfl_xor(ss, 2);
            const float rstd = 1.0f / sqrtf(ss * (1.0f / 64.0f) + EPSN);
            const float sc = isq ? attn_body::C2 : 1.0f;
            const f32x4 ga = *(const f32x4*)(qg + gsel * 64 + 8 * c), gb = *(const f32x4*)(qg + gsel * 64 + 8 * c + 4), gc = *(const f32x4*)(qg + gsel * 64 + 32 + 8 * c), gd = *(const f32x4*)(qg + gsel * 64 + 36 + 8 * c);
            f32x4 ca = {1.f, 1.f, 1.f, 1.f}, cb = ca, sa = {0.f, 0.f, 0.f, 0.f}, sb = sa;
            if (w >= CTXL) { const int s = w - CTXL; ca = *(const f32x4*)(ct + s * 32 + 8 * c); cb = *(const f32x4*)(ct + s * 32 + 8 * c + 4); sa = *(const f32x4*)(st + s * 32 + 8 * c); sb = *(const f32x4*)(st + s * 32 + 8 * c + 4); }
            float o1[8], o2[8];
#pragma unroll
            for (int e = 0; e < 8; ++e) { const float g1 = e < 4 ? ga[e & 3] : gb[e & 3], g2 = e < 4 ? gc[e & 3] : gd[e & 3], cs = e < 4 ? ca[e & 3] : cb[e & 3], sn = e < 4 ? sa[e & 3] : sb[e & 3];
                const float y1 = x1[e] * rstd * g1, y2 = x2[e] * rstd * g2; o1[e] = (y1 * cs - y2 * sn) * sc; o2[e] = (y1 * sn + y2 * cs) * sc; }
            if (act) { v4u a, b2; a.x = pk2(o1[0], o1[1]); a.y = pk2(o1[2], o1[3]); a.z = pk2(o1[4], o1[5]); a.w = pk2(o1[6], o1[7]);
                b2.x = pk2(o2[0], o2[1]); b2.y = pk2(o2[2], o2[3]); b2.z = pk2(o2[4], o2[5]); b2.w = pk2(o2[6], o2[7]);
                *(v4u*)(zr + col + 8 * c) = a; *(v4u*)(zr + col + 32 + 8 * c) = b2; }
        }
    }
}
__device__ __forceinline__ void make_pq(Frame& F) {
    const int t0 = F.bid * 512 + F.tid, NT_ = F.G * 512;
    const bf16* T1 = WSP(bf16, WS_T1T); bf16* PQ = WSP(bf16, WS_PQ);
    for (int it = t0; it < 2 * 512 * HN; it += NT_) {
        const int n = it & (HN - 1), col = (it >> 12) & 511, b = it >> 21;
        const bf16* xr = T1 + (size_t)col * MROWS + b * RPB + CTXL;
        const int nm = (HN - n) & (HN - 1);
        const float x0 = bf2f(xr[n]), x1 = bf2f(xr[n + HN]), y0 = bf2f(xr[nm]), y1 = bf2f(xr[nm + HN]);
        float sn, co, snm, com; sincospif((float)n * (1.0f / HN), &sn, &co); sincospif((float)nm * (1.0f / HN), &snm, &com);
        const float p = x0 + x1, q = (x0 - x1) * co + (y0 - y1) * snm;
        PQ[((size_t)(b * 2 + 0) * 512 + col) * HN + n] = (bf16)(pk2(p, 0.f) & 0xffffu);
        PQ[((size_t)(b * 2 + 1) * 512 + col) * HN + n] = (bf16)(pk2(q, 0.f) & 0xffffu);
    }
}
__device__ __forceinline__ void post_mix(Frame& F, int l) {
    const int gw = F.bid * NWAVES + F.wave, NGW = F.G * NWAVES;
    const float lam_init = 0.8f - 0.6f * expf(-0.3f * (float)l);
    const float* dl = F.diff_lam + (size_t)l * 256;
    const float s1 = wave_sum(dl[F.lane] * dl[64 + F.lane]), s2 = wave_sum(dl[128 + F.lane] * dl[192 + F.lane]);
    const float lam = expf(s1) - expf(s2) + lam_init;
    const float* sg = F.subln_g + (size_t)l * 128 + (F.lane & 15) * 8;
    float gsc[8];
#pragma unroll
    for (int e = 0; e < 8; ++e) gsc[e] = sg[e] * (1.0f - lam_init);
    const bf16* OB = WSP(bf16, WS_HN); const bf16* T2 = WSP(bf16, WS_T2); bf16* Z = WSP(bf16, WS_Z);
    for (int row = gw; row < MROWS; row += NGW) {
        const int b = row / RPB, w = row % RPB;
        {
            const v4u a = *(const v4u*)(OB + (size_t)row * 1024 + F.lane * 8), c2 = *(const v4u*)(OB + (size_t)row * 1024 + 512 + F.lane * 8);
            float d[8];
            d[0] = bflo(a.x) - lam * bflo(c2.x); d[1] = bfhi(a.x) - lam * bfhi(c2.x); d[2] = bflo(a.y) - lam * bflo(c2.y); d[3] = bfhi(a.y) - lam * bfhi(c2.y);
            d[4] = bflo(a.z) - lam * bflo(c2.z); d[5] = bfhi(a.z) - lam * bfhi(c2.z); d[6] = bflo(a.w) - lam * bflo(c2.w); d[7] = bfhi(a.w) - lam * bfhi(c2.w);
            float ss = 0.f;
#pragma unroll
            for (int e = 0; e < 8; ++e) ss += d[e] * d[e];
#pragma unroll
            for (int o = 1; o < 16; o <<= 1) ss += shfl_xor(ss, o);
            const float rstd = 1.0f / sqrtf(ss * (1.0f / 128.0f) + EPSN);
            v4u o; o.x = pk2(d[0] * rstd * gsc[0], d[1] * rstd * gsc[1]); o.y = pk2(d[2] * rstd * gsc[2], d[3] * rstd * gsc[3]);
            o.z = pk2(d[4] * rstd * gsc[4], d[5] * rstd * gsc[5]); o.w = pk2(d[6] * rstd * gsc[6], d[7] * rstd * gsc[7]);
            *(v4u*)(Z + (size_t)row * ZW + ZQB + F.lane * 8) = o;
        }
        {
            int mrow; float sc;
            if (w < CTXL) { mrow = b * RPB + ((CTXL - w) & (CTXL - 1)); sc = 0.5f * 0.005524271728019903f; }
            else { const int s = w - CTXL; mrow = b * RPB + CTXL + ((SEQL - s) & (SEQL - 1)); sc = 1.0f / 2048.0f; }
            const int g = F.lane >> 4, j0 = (F.lane & 15) * 8;
            const bf16* rk = T2 + (size_t)row * 512 + g * 128; v4u mv = *(const v4u*)(T2 + (size_t)mrow * 512 + g * 128 + j0);
            float r[8], mm_[8];
#pragma unroll
            for (int e = 0; e < 8; ++e) r[e] = bf2f(rk[(128 - (j0 + e)) & 127]);
            mm_[0] = bflo(mv.x); mm_[1] = bfhi(mv.x); mm_[2] = bflo(mv.y); mm_[3] = bfhi(mv.y); mm_[4] = bflo(mv.z); mm_[5] = bfhi(mv.z); mm_[6] = bflo(mv.w); mm_[7] = bfhi(mv.w);
            if (w >= CTXL) { const bf16* T2B = WSP(bf16, WS_T2B); const bf16* rk2 = T2B + (size_t)row * 512 + g * 128; mv = *(const v4u*)(T2B + (size_t)mrow * 512 + g * 128 + j0);
#pragma unroll
                for (int e = 0; e < 8; ++e) r[e] += bf2f(rk2[(128 - (j0 + e)) & 127]);
                mm_[0] += bflo(mv.x); mm_[1] += bfhi(mv.x); mm_[2] += bflo(mv.y); mm_[3] += bfhi(mv.y); mm_[4] += bflo(mv.z); mm_[5] += bfhi(mv.z); mm_[6] += bflo(mv.w); mm_[7] += bfhi(mv.w); }
            v4u o; o.x = pk2((r[0] + mm_[0]) * sc, (r[1] + mm_[1]) * sc); o.y = pk2((r[2] + mm_[2]) * sc, (r[3] + mm_[3]) * sc);
            o.z = pk2((r[4] + mm_[4]) * sc, (r[5] + mm_[5]) * sc); o.w = pk2((r[6] + mm_[6]) * sc, (r[7] + mm_[7]) * sc);
            *(v4u*)(Z + (size_t)row * ZW + ZKB + F.lane * 8) = o;
        }
    }
}
__device__ __forceinline__ void hartley_ctx(Frame& F) {
    for (int r = F.bid; r < 4; r += F.G) { const int b = r >> 1;
        pg8::Gemm g{WSP(bf16, WS_CAS256), WSP(bf16, WS_T1T) + (size_t)b * RPB, 256, 512, 256, 256, MROWS};
        pg8::OneUnit S{0, r & 1};
        pg8::EpiStore E{WSP(bf16, WS_T2), 512, 1 << 30, b * RPB, 1};
        pg8::gemm_phase<pg8::EpiStore, pg8::OneUnit, true, true, 256, 256, MROWS>(F.lds, g, S, E); }
}
__device__ __forceinline__ void mixer_phase(Frame& F, int l) {
    constexpr int NAL = NBATCH * 24 * 32, NHL = 256, NAC = NBATCH * 24;
    const int TOTAL = (l == NLAYER - 1) ? NAL + NHL : NAL + NHL + NAC;
    unsigned* qctr = F.ctl + CW_Q + 64 * l;
    bf16* Z = WSP(bf16, WS_Z);
    for (;;) {
        if (F.tid == 0) F.MISC[0] = __hip_atomic_fetch_add(qctr, 1u, __ATOMIC_RELAXED, __HIP_MEMORY_SCOPE_AGENT);
        __syncthreads();
        const int it = (int)F.MISC[0];
        __syncthreads();
        if (it >= TOTAL) break;
        if (it >= NAL && it < NAL + NHL) {
            int r = it - NAL; const int kh = r & 1; r >>= 1; const int b = r >> 6, r6 = r & 63, par = r6 >> 5, r2 = r6 & 31;
            pg8::Gemm g{WSP(bf16, WS_CAS) + kh * (HN / 2), WSP(bf16, WS_PQ) + (size_t)(b * 2 + par) * 512 * HN + kh * (HN / 2), HN, 512, HN / 2, HN, HN};
            pg8::OneUnit S{r2 >> 1, r2 & 1};
            pg8::EpiStore E{WSP(bf16, kh ? WS_T2B : WS_T2), 512, 1 << 30, b * RPB + CTXL + par, 2};
            pg8::gemm_phase<pg8::EpiStore, pg8::OneUnit, true, true, HN / 2, HN, HN>(F.lds, g, S, E);
        } else {
            int r = it, b, hu, qrow, nt;
            if (r < NAL) { const int qb = r & 31; r >>= 5; hu = r % 24; b = r / 24; qrow = b * RPB + CTXL + qb * 256; nt = RPB / 64; }
            else { r -= NAL + NHL; hu = r % 24; b = r / 24; qrow = b * RPB; nt = CTXL / 64; }
            const bf16 *Qp, *Kp, *Vp; bf16* Op; int po;
            if (hu < 8) { Qp = Z + ZQA + hu * 64; Kp = Z + ZKA + (hu >> 2) * 64; Vp = Z + ZVA + (hu >> 2) * 64; Op = Z + ZQA + hu * 64; po = ZW; }
            else { const int j = hu - 8, h = j >> 2, mm = (j >> 1) & 1, vh = j & 1; Qp = Z + ZQB + (h * 2 + mm) * 64; Kp = Z + ZKB + (h * 2 + mm) * 64; Vp = Z + ZVB + h * 128 + vh * 64;
                   Op = WSP(bf16, WS_HN) + mm * 512 + h * 128 + vh * 64; po = 1024; }
            const size_t kv0 = (size_t)b * RPB;
            attn_body::attn_unit<8>((const attn_body::bf16*)(Qp + (size_t)qrow * ZW), ZW, (const attn_body::bf16*)(Kp + kv0 * ZW), ZW, (const attn_body::bf16*)(Vp + kv0 * ZW), ZW,
                                    (attn_body::bf16*)(Op + (size_t)qrow * po), po, nt, (char*)F.lds);
        }
    }
}

#ifndef MK_PER_PHASE
#define MK_PER_PHASE 0
#endif
constexpr int NPHASE = 1 + 13 * NLAYER;
struct Args { const float* in[15]; float* out; unsigned char* ws; int ph_lo, ph_hi; };
__device__ __forceinline__ void load_frame(Frame& F) {
    const __attribute__((address_space(4))) Args* a = (const __attribute__((address_space(4))) Args*)__builtin_amdgcn_kernarg_segment_ptr();
    asm volatile("" : "+s"(a));
    extern __shared__ __attribute__((aligned(16))) unsigned char lds_raw[];
    F.lds = (LAS unsigned char*)lds_raw; F.MISC = (volatile LAS unsigned*)(F.lds + MISC_OFF);
    int t = my_tid(); asm volatile("" : "+v"(t));
    F.tid = t; F.lane = t & 63; F.wave = __builtin_amdgcn_readfirstlane(t >> 6); F.G = gridDim.x; F.bid = blockIdx.x;
    F.x = a->in[0]; F.c = a->in[1]; F.ctx = a->in[2]; F.cctx = a->in[3]; F.w_ada = a->in[4]; F.b_ada = a->in[5]; F.norm_g = a->in[6]; F.ffn_wi = a->in[7];
    F.ffn_wo = a->in[8]; F.w_in = a->in[9]; F.qk_g = a->in[10]; F.diff_lam = a->in[11]; F.subln_g = a->in[12]; F.w_branch = a->in[13]; F.w_out = a->in[14];
    F.out = a->out; F.ws = a->ws; F.ctl = (unsigned*)(a->ws + WS_CTL);
}
#ifndef MK_MASK
#define MK_MASK 0xffffffffu
#endif
#define EN(j) (((MK_MASK) >> (j)) & 1u)
#ifndef MK_DUP
#define MK_DUP 0
#endif
#define DUP(b) for (int rep_ = 0; rep_ < (((MK_DUP) >> (b)) & 1) + 1; ++rep_)
__device__ __forceinline__ void seam_barrier() {
    const __attribute__((address_space(4))) Args* a = (const __attribute__((address_space(4))) Args*)__builtin_amdgcn_kernarg_segment_ptr();
    asm volatile("" : "+s"(a));
    extern __shared__ __attribute__((aligned(16))) unsigned char lds_raw[];
    XcdBarrier b; b.bar = (unsigned*)(a->ws + WS_CTL) + CW_BAR; b.x = xb_xcc_id(); b.st = (volatile LAS unsigned*)((LAS unsigned char*)lds_raw + MISC_OFF) + 8;
    xcd_barrier(b);
}
#define LF() Frame F; load_frame(F); float* hlat = F.out; float* hctx = WSP(float, WS_HC); const float* modl = WSP(float, WS_MOD) + (size_t)l * 3 * MODW; const float* ng = F.norm_g + (size_t)l * 3 * 1024; \
    const float* slat = (l == 0) ? F.x : hlat; const float* sctx = (l == 0) ? F.ctx : hctx; (void)hlat; (void)hctx; (void)modl; (void)ng; (void)slat; (void)sctx
__global__ void __launch_bounds__(NWAVES * 64, 2) mk_fwd(Args args) {
    cg::grid_group grid = cg::this_grid();
    const int lo = args.ph_lo, hi = args.ph_hi;
    {
        extern __shared__ __attribute__((aligned(16))) unsigned char lds_raw[];
        volatile LAS unsigned* misc = (volatile LAS unsigned*)((LAS unsigned char*)lds_raw + MISC_OFF);
        const int t0 = threadIdx.x;
        if (t0 < 32) misc[t0] = 0u;
        if ((t0 & 63) == 0) ((volatile LAS int*)((LAS unsigned char*)lds_raw + WTAB_OFF))[hw_slot()] = t0 >> 6;
        __syncthreads();
        if (hi - lo > 1) (void)xcd_barrier_post((unsigned*)(args.ws + WS_CTL) + CW_BAR, misc + 8);
    }
#define IN(k) (lo <= (k) && (k) < hi)
    if (lo < 0) grid.sync();
#define SEAM(k) do { if (IN(k) && IN((k) + 1)) { seam_barrier(); } } while (0)
    if (EN(0) && IN(0)) { const int l = 0; LF(); DUP(4) { make_mod(F); convert_weights(F, 0); make_cas(F); make_rope(F); } }
    SEAM(0);
    for (int l = 0; l < NLAYER; ++l) {
        const int p0 = 1 + 13 * l;
        if (EN(1) && IN(p0 + 0)) { LF(); if (l > 0) DUP(4) convert_weights(F, l); norm_mod(F, slat, sctx, ng, modl, 0, hctx, (l == 0) ? nullptr : WSP(float, WS_PART), DFF / 256); }
        SEAM(p0 + 0);
        if (EN(2) && IN(p0 + 1)) { LF(); pg8::Gemm g{WSP(bf16, WS_HN), WSP(bf16, WS_WUP0), MROWS, NUP, 1024, 1024, 1024}; pg8::StaticOrder S; S.init(MROWS, NUP, F.G, F.bid);
            pg8::EpiSwiGLU E{WSP(bf16, WS_Z), DFF}; DUP(1) pg8::gemm_phase<pg8::EpiSwiGLU, pg8::StaticOrder, true, true, 1024, 1024, 1024>(F.lds, g, S, E); }
        SEAM(p0 + 1);
        if (EN(3) && IN(p0 + 2)) { LF();
            { pg8::Gemm g{WSP(bf16, WS_Z), WSP(bf16, WS_WDN0), MROWS, 1024, DFF, DFF, DFF}; pg8::LatOrder S; S.init(1024, F.G, F.bid);
              pg8::EpiResid E{slat, sctx, hlat, hctx, modl + 2 * 1024, 0.5f}; for (int rep_ = 0; rep_ < ((((MK_DUP) >> 7) & 1) && l == 0 ? 4 : 1); ++rep_) pg8::gemm_phase<pg8::EpiResid, pg8::LatOrder, true, true, DFF, DFF, DFF>(F.lds, g, S, E); }
            { pg8::Gemm g{WSP(bf16, WS_Z), WSP(bf16, WS_WDN0), MROWS, 1024, 256, DFF, DFF}; pg8::CtxSplit S{F.G, F.G - 1 - F.bid, DFF / 256};
              pg8::EpiResidA E{WSP(float, WS_PART), modl + 2 * MODW + 2 * 1024, 0.5f}; pg8::gemm_phase<pg8::EpiResidA, pg8::CtxSplit, true, true, 256, DFF, DFF>(F.lds, g, S, E); } }
        SEAM(p0 + 2);
        if (EN(4) && IN(p0 + 3)) { LF(); norm_mod(F, hlat, hctx, ng + 1024, modl, 3, hctx, WSP(float, WS_PART), DFF / 256); }
        SEAM(p0 + 3);
        if (EN(5) && IN(p0 + 4)) { LF();
            { pg8::Gemm g{WSP(bf16, WS_HN), WSP(bf16, WS_WIN), MROWS, ZW, 1024, 1024, 1024}; pg8::StaticOrder S; S.init(MROWS, ZW, F.G, F.bid);
              pg8::EpiStore E{WSP(bf16, WS_Z), ZW, ZGATE, 0, 1}; DUP(5) pg8::gemm_phase<pg8::EpiStore, pg8::StaticOrder, true, true, 1024, 1024, 1024>(F.lds, g, S, E); }
            { pg8::Gemm g{WSP(bf16, WS_WC), WSP(bf16, WS_HN), 512, MROWS, 1024, 1024, 1024}; pg8::StaticOrder S; S.init(512, MROWS, F.G, F.G - 1 - F.bid);
              pg8::EpiStore E{WSP(bf16, WS_T1T), MROWS, 1 << 30, 0, 1}; DUP(5) pg8::gemm_phase<pg8::EpiStore, pg8::StaticOrder, true, true, 1024, 1024, 1024>(F.lds, g, S, E); }
        }
        SEAM(p0 + 4);
        if (EN(6) && IN(p0 + 5)) { LF(); qk_rope(F, l); make_pq(F); if (l < NLAYER - 1) hartley_ctx(F); }
        SEAM(p0 + 5);
        if (EN(7) && IN(p0 + 6)) { LF(); mixer_phase(F, l); }
        SEAM(p0 + 6);
        if (EN(8) && IN(p0 + 7)) { LF(); post_mix(F, l); }
        SEAM(p0 + 7);
        if (EN(9) && IN(p0 + 8)) { LF(); pg8::Gemm g{WSP(bf16, WS_Z), WSP(bf16, WS_WBR), MROWS, 3072, 512, ZW, 512}; pg8::MergeOrder S{F.G, F.bid, l == NLAYER - 1};
            pg8::EpiMerge E{WSP(bf16, WS_Z), WSP(bf16, WS_HN)}; DUP(6) pg8::gemm_phase<pg8::EpiMerge, pg8::MergeOrder, true, true, 512, ZW, 512>(F.lds, g, S, E); }
        SEAM(p0 + 8);
        if (EN(10) && IN(p0 + 9)) { LF();
            { pg8::Gemm g{WSP(bf16, WS_HN), WSP(bf16, WS_WOUT), MROWS, 1024, 1024, 1024, 1024}; pg8::LatOrder S; S.init(1024, F.G, F.bid);
              pg8::EpiResid E{hlat, hctx, hlat, hctx, modl + 5 * 1024, 1.0f}; pg8::gemm_phase<pg8::EpiResid, pg8::LatOrder, true, true, 1024, 1024, 1024>(F.lds, g, S, E); }
            if (l < NLAYER - 1) { pg8::Gemm g{WSP(bf16, WS_HN), WSP(bf16, WS_WOUT), MROWS, 1024, 256, 1024, 1024}; pg8::CtxSplit S{F.G, F.G - 1 - F.bid, 4};
              pg8::EpiResidA E{WSP(float, WS_PART), modl + 2 * MODW + 5 * 1024, 1.0f}; pg8::gemm_phase<pg8::EpiResidA, pg8::CtxSplit, true, true, 256, 1024, 1024>(F.lds, g, S, E); } }
        SEAM(p0 + 9);
        if (EN(11) && IN(p0 + 10)) { LF(); norm_mod(F, hlat, hctx, ng + 2048, modl, 6, (l == 0) ? hctx : nullptr, (l == 0) ? WSP(float, WS_PART) : nullptr, 4); }
        SEAM(p0 + 10);
        if (EN(12) && IN(p0 + 11)) { LF(); pg8::Gemm g{WSP(bf16, WS_HN), WSP(bf16, WS_WUP1), MROWS, NUP, 1024, 1024, 1024}; pg8::StaticOrder S; S.init(MROWS, NUP, F.G, F.bid);
            pg8::EpiSwiGLU E{WSP(bf16, WS_Z), DFF}; DUP(1) pg8::gemm_phase<pg8::EpiSwiGLU, pg8::StaticOrder, true, true, 1024, 1024, 1024>(F.lds, g, S, E); }
        SEAM(p0 + 11);
        if (EN(13) && IN(p0 + 12)) { LF();
            { pg8::Gemm g{WSP(bf16, WS_Z), WSP(bf16, WS_WDN1), MROWS, 1024, DFF, DFF, DFF}; pg8::LatOrder S; S.init(1024, F.G, F.bid);
              pg8::EpiResid E{hlat, hctx, hlat, hctx, modl + 8 * 1024, 0.5f}; pg8::gemm_phase<pg8::EpiResid, pg8::LatOrder, true, true, DFF, DFF, DFF>(F.lds, g, S, E); }
            if (l < NLAYER - 1) { pg8::Gemm g{WSP(bf16, WS_Z), WSP(bf16, WS_WDN1), MROWS, 1024, 256, DFF, DFF}; pg8::CtxSplit S{F.G, F.G - 1 - F.bid, DFF / 256};
              pg8::EpiResidA E{WSP(float, WS_PART), modl + 2 * MODW + 8 * 1024, 0.5f}; pg8::gemm_phase<pg8::EpiResidA, pg8::CtxSplit, true, true, 256, DFF, DFF>(F.lds, g, S, E); } }
        SEAM(p0 + 12);
    }
#undef IN
#undef SEAM
}

extern "C" void kernel_launch(void* const* d_in, const int* in_sizes, int n_in, void* d_out, int out_size, void* d_ws, size_t ws_size, hipStream_t stream) {
    static int grid = 0;
    if (grid == 0) {
        if (n_in != 15 || ws_size < WS_END) { fprintf(stderr, "kernel_launch: need 15 inputs and >= %zu bytes of workspace; got n_in %d, ws %zu\n", (size_t)WS_END, n_in, ws_size); grid = -1; return; }
        int dev = 0, cus = 0, per_cu = 0;
        if (hipGetDevice(&dev) != hipSuccess || hipDeviceGetAttribute(&cus, hipDeviceAttributeMultiprocessorCount, dev) != hipSuccess) { grid = -1; return; }
        if (hipFuncSetAttribute((const void*)mk_fwd, hipFuncAttributeMaxDynamicSharedMemorySize, LDS_BYTES) != hipSuccess) { fprintf(stderr, "kernel_launch: hipFuncSetAttribute failed\n"); grid = -1; return; }
        if (hipOccupancyMaxActiveBlocksPerMultiprocessor(&per_cu, (const void*)mk_fwd, NWAVES * 64, LDS_BYTES) != hipSuccess || per_cu < 1) { fprintf(stderr, "kernel_launch: occupancy query says %d\n", per_cu); per_cu = 1; }
        (void)hipGetLastError();
        grid = cus * per_cu;
    }
    if (grid < 0) return;
    (void)hipMemsetAsync((char*)d_ws + WS_CTL, 0, CTL_ZERO_BYTES, stream);
    Args a{};
    for (int i = 0; i < 15; ++i) a.in[i] = (const float*)d_in[i];
    a.out = (float*)d_out; a.ws = (unsigned char*)d_ws;
#if MK_PER_PHASE
    for (int p = 0; p < NPHASE; ++p) { a.ph_lo = p; a.ph_hi = p + 1; hipLaunchKernelGGL(mk_fwd, dim3(grid), dim3(NWAVES * 64), LDS_BYTES, stream, a); }
#else
    a.ph_lo = 0; a.ph_hi = NPHASE;
    void* kargs[] = {&a};
    hipError_t e = hipLaunchCooperativeKernel((const void*)mk_fwd, dim3(grid), dim3(NWAVES * 64), kargs, LDS_BYTES, stream);
    if (e != hipSuccess) fprintf(stderr, "kernel_launch: cooperative launch failed: %s (grid %d)\n", hipGetErrorString(e), grid);
#endif
}
```

```cpp
#include <hip/hip_runtime.h>
#include <hip/hip_cooperative_groups.h>
#include <hip/hip_bf16.h>
#include <cstdio>
#include <cstdint>
#include <cmath>
namespace cg = cooperative_groups;

#define LAS __attribute__((address_space(3)))
constexpr int LDS_BYTES = 147456, MISC_OFF = 131072 + 320, WTAB_OFF = MISC_OFF + 128;
__device__ __forceinline__ int lane_id() { int l; asm volatile("v_mbcnt_lo_u32_b32 %0, -1, 0\n\tv_mbcnt_hi_u32_b32 %0, -1, %0" : "=&v"(l)); return l; }
__device__ __forceinline__ unsigned hw_slot() { return (unsigned)__builtin_amdgcn_s_getreg((5 << 11) | 4) & 63u; }
__device__ __forceinline__ int my_tid() {
    extern __shared__ __attribute__((aligned(16))) unsigned char lds_raw[];
    const int w = ((volatile LAS int*)((LAS unsigned char*)lds_raw + WTAB_OFF))[hw_slot()];
    return __builtin_amdgcn_readfirstlane(w) * 64 + lane_id();
}

namespace pg8 {
#define PG8_LAS __attribute__((address_space(3)))
typedef unsigned short bf16_t;
typedef short bf16x8 __attribute__((ext_vector_type(8)));
typedef float f32x4 __attribute__((ext_vector_type(4)));
typedef unsigned u32x4 __attribute__((ext_vector_type(4)));
constexpr int BM = 256, BK = 64, HALF = 128, HTB = HALF * BK * 2  , STAGE_BYTES = 8 * HTB, NXCD = 8, WGM = 8;

__host__ __device__ __forceinline__ int lds_byte(int r, int c) { const int st = (r >> 4) * 2 + (c >> 5), rr = r & 15, cc = c & 31, ob = rr * 64 + cc * 2; return st * 1024 + (ob ^ (((ob >> 9) & 1) << 5)); }
__host__ __device__ __forceinline__ void stage_rc(int b, int& R, int& C) { const int st = b / 1024, sb = b % 1024, swz = sb ^ (((sb >> 9) & 1) << 5); R = (st >> 1) * 16 + swz / 64; C = (st & 1) * 32 + (swz % 64) / 2; }
__host__ __device__ __forceinline__ int perm32(int rho) { const int n = rho >> 4, i = rho & 15; return 8 * (i >> 2) + 4 * n + (i & 3); }

struct Unit { int pm, pn, kp; };
struct Gemm { const bf16_t* A; const bf16_t* Bt; int M, N, K, lda, ldb; };

struct StaticOrder {
    int nM, nN, nwg, G, c;
    __host__ __device__ void init(int M, int N, int G_, int c_) { nM = M / BM; nN = N / BM; nwg = nM * nN; G = G_; c = c_; }
    __host__ __device__ bool next(int i, Unit& u) const {
        const long L = (long)i * G + c; if (L >= nwg) return false;
        int wgid = (int)L; { const int q = nwg / NXCD, r = nwg % NXCD, xcd = wgid % NXCD, off = wgid / NXCD; wgid = (xcd < r ? xcd * (q + 1) : r * (q + 1) + (xcd - r) * q) + off; }
        const int nig = WGM * nN, gid = wgid / nig, fm = gid * WGM, gsz = (nM - fm) < WGM ? (nM - fm) : WGM;
        u.pm = fm + ((wgid % nig) % gsz); u.pn = (wgid % nig) / gsz; return true;
    }
    __device__ __forceinline__ void a_ready(const Unit&) const {}
    __device__ __forceinline__ void done(const Unit&) const {}
    __device__ __forceinline__ size_t aoff(const Unit&) const { return 0; }
    __device__ __forceinline__ size_t boff(const Unit&) const { return 0; }
};


__device__ __forceinline__ unsigned cvt_pk_bf16(float lo, float hi) { unsigned r; asm volatile("v_cvt_pk_bf16_f32 %0, %1, %2" : "=v"(r) : "v"(lo), "v"(hi)); return r; }
typedef float f32x2 __attribute__((ext_vector_type(2)));

template <class Epi, class Sched, bool ALIGN_EPI, bool SP2, int TK, int TLDA, int TLDB>
__device__ __forceinline__ void gemm_phase(PG8_LAS unsigned char* lds, const Gemm g, const Sched& S, const Epi& E) {
    int tid_ = my_tid(); asm volatile("" : "+v"(tid_)); const int tid = tid_, wid = __builtin_amdgcn_readfirstlane(tid >> 6), lane = tid & 63, wr = wid >> 2, wc = wid & 3, fr = lane & 15, fq = lane >> 4;
    constexpr int K = TK, nt = K / BK;
    unsigned voffA[2], voffB[2];
#pragma unroll
    for (int i = 0; i < 2; ++i) { int R, C; stage_rc(tid * 16 + i * 8192, R, C); const int Rb = Epi::PERM ? ((R & ~31) + perm32(R & 31)) : R;
        voffA[i] = (unsigned)(R * TLDA + C) * 2u; voffB[i] = (unsigned)(Rb * TLDB + C) * 2u; }
    const size_t kstep = (size_t)(BK * 2);
    const size_t hstepA = (size_t)HALF * TLDA * 2, hstepB = (size_t)HALF * TLDB * 2;
    const size_t tstepA = 2 * hstepA, tstepB = 2 * hstepB;
    const unsigned ldsw = (unsigned)wid * 1024u;
    const int aoff = lds_byte(wr * 64 + fr, fq * 8), boff = lds_byte(wc * 32 + fr, fq * 8);
#define PG8_SA(b, h) (((b) * 2 + (h)) * HTB)
#define PG8_SB(b, h) ((4 + (b) * 2 + (h)) * HTB)
#define PG8_STAGE(bufoff, gbase, voff) do { _Pragma("unroll") for (int _i = 0; _i < 2; ++_i) \
        __builtin_amdgcn_global_load_lds((const unsigned*)((const char*)(gbase) + (voff)[_i]), (PG8_LAS unsigned*)(lds + (bufoff) + ldsw + _i * 8192), 16, 0, 0); } while (0)
#define PG8_LDA(dst, b, h) do { _Pragma("unroll") for (int m = 0; m < 4; ++m) _Pragma("unroll") for (int k = 0; k < 2; ++k) dst[m][k] = *(const PG8_LAS bf16x8*)(lds + PG8_SA(b, h) + aoff + m * 2048 + k * 1024); } while (0)
#define PG8_LDB(dst, b, h) do { _Pragma("unroll") for (int n = 0; n < 2; ++n) _Pragma("unroll") for (int k = 0; k < 2; ++k) dst[n][k] = *(const PG8_LAS bf16x8*)(lds + PG8_SB(b, h) + boff + n * 2048 + k * 1024); } while (0)
#define PG8_MMA(ai, bj, At, Bt) do { __builtin_amdgcn_s_setprio(1); _Pragma("unroll") for (int m = 0; m < 4; ++m) _Pragma("unroll") for (int n = 0; n < 2; ++n) _Pragma("unroll") for (int k = 0; k < 2; ++k) \
        acc[ai][bj][m][n] = __builtin_amdgcn_mfma_f32_16x16x32_bf16(Bt[n][k], At[m][k], acc[ai][bj][m][n], 0, 0, 0); __builtin_amdgcn_s_setprio(0); } while (0)
#define PG8_WAIT_V(n) asm volatile("s_waitcnt vmcnt(" #n ")" ::: "memory")
#define PG8_WAIT_L(n) asm volatile("s_waitcnt lgkmcnt(" #n ")" ::: "memory")
#define PG8_BAR __builtin_amdgcn_s_barrier()
#define PG8_SCHED __builtin_amdgcn_sched_barrier(0)
    Unit cur, nxt; int ui = 0;
    if (!S.next(0, cur)) return;
    f32x4 acc[2][2][4][2];
#pragma unroll
    for (int a = 0; a < 2; ++a)
#pragma unroll
        for (int b = 0; b < 2; ++b)
#pragma unroll
            for (int m = 0; m < 4; ++m)
#pragma unroll
                for (int n = 0; n < 2; ++n) acc[a][b][m][n] = (f32x4){0.f, 0.f, 0.f, 0.f};
    bf16x8 At[4][2], B0[2][2], B1[2][2];
    const char* cA = (const char*)g.A + (size_t)cur.pm * tstepA + S.aoff(cur); const char* cB = (const char*)g.Bt + (size_t)cur.pn * tstepB + S.boff(cur);
    S.a_ready(cur);
    if constexpr (SP2) {
        PG8_STAGE(PG8_SB(0, 0), cB, voffB); PG8_STAGE(PG8_SB(0, 1), cB + hstepB, voffB); PG8_STAGE(PG8_SA(0, 0), cA, voffA); PG8_STAGE(PG8_SA(0, 1), cA + hstepA, voffA);
        if (wr == 1) PG8_BAR;
        PG8_WAIT_V(2); PG8_BAR;
        PG8_STAGE(PG8_SB(1, 0), cB + kstep, voffB); PG8_STAGE(PG8_SA(1, 0), cA + kstep, voffA); PG8_STAGE(PG8_SB(1, 1), cB + hstepB + kstep, voffB);
        PG8_WAIT_V(6); PG8_BAR;
    } else {
        PG8_STAGE(PG8_SB(0, 0), cB, voffB); PG8_STAGE(PG8_SA(0, 0), cA, voffA); PG8_STAGE(PG8_SB(0, 1), cB + hstepB, voffB); PG8_STAGE(PG8_SA(0, 1), cA + hstepA, voffA);
        if (wr == 1) PG8_BAR;
        PG8_WAIT_V(4); PG8_BAR;
        PG8_STAGE(PG8_SB(1, 0), cB + kstep, voffB); PG8_STAGE(PG8_SA(1, 0), cA + kstep, voffA); PG8_STAGE(PG8_SB(1, 1), cB + hstepB + kstep, voffB);
        PG8_WAIT_V(6); PG8_BAR;
    }
    for (;;) {
        const bool has_next = S.next(ui + 1, nxt);
        const char* nA = has_next ? (const char*)g.A + (size_t)nxt.pm * tstepA + S.aoff(nxt) : cA; const char* nB = has_next ? (const char*)g.Bt + (size_t)nxt.pn * tstepB + S.boff(nxt) : cB;
        for (int t = 0; t < nt; t += 2) {
            const bool last = (t == nt - 2);
            const char* a1 = cA + (size_t)(t + 1) * kstep;
            const char* a2 = last ? nA : cA + (size_t)(t + 2) * kstep; const char* b2 = last ? nB : cB + (size_t)(t + 2) * kstep;
            const char* a3 = a2 + kstep; const char* b3 = b2 + kstep;
            if (last && has_next) S.a_ready(nxt);
            if constexpr (SP2) {
            PG8_LDB(B0, 0, 0); PG8_LDB(B1, 0, 1); PG8_SCHED; PG8_LDA(At, 0, 0); PG8_STAGE(PG8_SA(1, 1), a1 + hstepA, voffA);
            PG8_WAIT_V(8); PG8_WAIT_L(0); PG8_BAR; PG8_MMA(0, 0, At, B0); PG8_MMA(0, 1, At, B1); PG8_BAR; PG8_SCHED;
            PG8_LDA(At, 0, 1); PG8_STAGE(PG8_SB(0, 0), b2, voffB); PG8_STAGE(PG8_SB(0, 1), b2 + hstepB, voffB); PG8_STAGE(PG8_SA(0, 0), a2, voffA);
            PG8_WAIT_V(8); PG8_WAIT_L(0); PG8_BAR; PG8_MMA(1, 0, At, B0); PG8_MMA(1, 1, At, B1); PG8_BAR; PG8_SCHED;
            PG8_LDB(B0, 1, 0); PG8_LDB(B1, 1, 1); PG8_SCHED; PG8_LDA(At, 1, 0); PG8_STAGE(PG8_SA(0, 1), a2 + hstepA, voffA);
            PG8_WAIT_V(8); PG8_WAIT_L(0); PG8_BAR; PG8_MMA(0, 0, At, B0); PG8_MMA(0, 1, At, B1); PG8_BAR; PG8_SCHED;
            PG8_LDA(At, 1, 1); PG8_STAGE(PG8_SB(1, 0), b3, voffB); PG8_STAGE(PG8_SB(1, 1), b3 + hstepB, voffB); PG8_STAGE(PG8_SA(1, 0), a3, voffA);
            PG8_WAIT_V(8); PG8_WAIT_L(0); PG8_BAR; PG8_MMA(1, 0, At, B0); PG8_MMA(1, 1, At, B1); PG8_BAR; PG8_SCHED;
            } else {
            PG8_LDB(B0, 0, 0); PG8_SCHED; PG8_LDA(At, 0, 0); PG8_STAGE(PG8_SA(1, 1), a1 + hstepA, voffA);
            PG8_WAIT_L(8); PG8_BAR; PG8_WAIT_L(0); PG8_MMA(0, 0, At, B0); PG8_BAR; PG8_SCHED;
            PG8_LDB(B1, 0, 1); PG8_STAGE(PG8_SB(0, 0), b2, voffB);
            PG8_BAR; PG8_WAIT_L(0); PG8_MMA(0, 1, At, B1); PG8_BAR;
            PG8_LDA(At, 0, 1); PG8_STAGE(PG8_SA(0, 0), a2, voffA);
            PG8_BAR; PG8_WAIT_L(0); PG8_MMA(1, 0, At, B0); PG8_BAR; PG8_SCHED;
            PG8_STAGE(PG8_SB(0, 1), b2 + hstepB, voffB);
            PG8_WAIT_V(6); PG8_BAR; PG8_MMA(1, 1, At, B1); PG8_BAR;
            PG8_LDB(B0, 1, 0); PG8_SCHED; PG8_LDA(At, 1, 0); PG8_STAGE(PG8_SA(0, 1), a2 + hstepA, voffA);
            PG8_WAIT_L(8); PG8_BAR; PG8_WAIT_L(0); PG8_MMA(0, 0, At, B0); PG8_BAR; PG8_SCHED;
            PG8_LDB(B1, 1, 1); PG8_STAGE(PG8_SB(1, 0), b3, voffB);
            PG8_BAR; PG8_WAIT_L(0); PG8_MMA(0, 1, At, B1); PG8_BAR;
            PG8_LDA(At, 1, 1); PG8_STAGE(PG8_SA(1, 0), a3, voffA);
            PG8_BAR; PG8_WAIT_L(0); PG8_MMA(1, 0, At, B0); PG8_BAR; PG8_SCHED;
            PG8_STAGE(PG8_SB(1, 1), b3 + hstepB, voffB);
            PG8_WAIT_V(6); PG8_BAR; PG8_MMA(1, 1, At, B1); PG8_BAR;
            }
        }
        if constexpr (ALIGN_EPI) { if (wr == 0) PG8_BAR; }
        if constexpr (!Epi::AFTER_DRAIN) { E(acc, cur, wr, wc, fr, fq); S.done(cur); }
        if (!has_next) break;
#pragma unroll
        for (int a = 0; a < 2; ++a)
#pragma unroll
            for (int b = 0; b < 2; ++b)
#pragma unroll
                for (int m = 0; m < 4; ++m)
#pragma unroll
                    for (int n = 0; n < 2; ++n) acc[a][b][m][n] = (f32x4){0.f, 0.f, 0.f, 0.f};
        cur = nxt; cA = nA; cB = nB; ++ui;
        if constexpr (ALIGN_EPI) { if (wr == 1) PG8_BAR; }
    }
    PG8_WAIT_V(0);
    if constexpr (!ALIGN_EPI) { if (wr == 0) PG8_BAR; }
    PG8_BAR;
    if constexpr (Epi::AFTER_DRAIN) { E.fused(acc, cur, wr, wc, fr, fq, lds, wid, lane); S.done(cur); }
#undef PG8_SA
#undef PG8_SB
#undef PG8_STAGE
#undef PG8_LDA
#undef PG8_LDB
#undef PG8_MMA
#undef PG8_WAIT_V
#undef PG8_WAIT_L
#undef PG8_BAR
#undef PG8_SCHED
}
}


namespace attn_body {
using bf16=__hip_bfloat16;
using bf16x8=__attribute__((ext_vector_type(8)))short;
using s16x4=__attribute__((ext_vector_type(4)))short;
using f32x16=__attribute__((ext_vector_type(16)))float;
using u32x4=__attribute__((ext_vector_type(4)))unsigned;
constexpr int D=64;
constexpr int NW=8,QBLK=32,QB=QBLK*NW,KVBLK=64;
constexpr int ATTN_UNIT_ROWS=QB;
__device__ __forceinline__ int crow(int r,int hi){return (r&3)+8*(r>>2)+4*hi;}
#define SBAR() __builtin_amdgcn_sched_barrier(0)
constexpr int NSLOT=3, SLOTB=8192;
constexpr int LDS_K=0, LDS_V=NSLOT*SLOTB, LDS_WS=2*NSLOT*SLOTB, LDS_OST=LDS_WS+NW*64*4, LDS_BYTES=LDS_OST+NW*4096;
constexpr float C2=0.125f*1.4426950408889634f;
__device__ __forceinline__ void glds16(const void*gsrc,unsigned lds_dst){unsigned keep;
  asm volatile("s_mov_b32 %0, m0\n\ts_mov_b32 m0, %2\n\ts_nop 0\n\tglobal_load_lds_dwordx4 %1, off\n\ts_mov_b32 m0, %0":"=&s"(keep):"v"(gsrc),"s"(lds_dst):"memory");}
__device__ __forceinline__ float max3f(float a,float b,float c){float r;asm("v_max3_f32 %0, %1, %2, %3":"=v"(r):"v"(a),"v"(b),"v"(c));return r;}
__device__ __forceinline__ float max2f(float a,float b){float r;asm("v_max_f32_e32 %0, %1, %2":"=v"(r):"v"(a),"v"(b));return r;}
__device__ __forceinline__ float fadd_s(float a,float b){float r;asm("v_add_f32_e32 %0, %1, %2":"=v"(r):"v"(a),"v"(b));return r;}
__device__ __forceinline__ float fsub_s(float a,float b){float r;asm("v_sub_f32_e32 %0, %1, %2":"=v"(r):"v"(a),"v"(b));return r;}
typedef float f32x2_t __attribute__((ext_vector_type(2))); typedef __bf16 bf16x2_t __attribute__((ext_vector_type(2)));
__device__ __forceinline__ unsigned cvtpk_s(float lo,float hi){f32x2_t v={lo,hi};bf16x2_t b=__builtin_convertvector(v,bf16x2_t);return __builtin_bit_cast(unsigned,b);}
#define WAIT_BAR(N) asm volatile("s_waitcnt vmcnt(" #N ") lgkmcnt(0)\n\ts_barrier":::"memory")

__device__ __forceinline__ void qkt(f32x16&p0,f32x16&p1,const char*Kslot,const bf16x8*qr,const f32x16&negm,int r32,int hi){
  const char*kb=Kslot+hi*1024+r32*16;
  #pragma unroll
  for(int d0=0;d0<4;++d0){
    const bf16x8 b0=*reinterpret_cast<const bf16x8*>(kb+d0*2048);
    const bf16x8 b1=*reinterpret_cast<const bf16x8*>(kb+d0*2048+512);
    if(d0==0){p0=__builtin_amdgcn_mfma_f32_32x32x16_bf16(b0,qr[0],negm,0,0,0);p1=__builtin_amdgcn_mfma_f32_32x32x16_bf16(b1,qr[0],negm,0,0,0);}
    else{p0=__builtin_amdgcn_mfma_f32_32x32x16_bf16(b0,qr[d0],p0,0,0,0);p1=__builtin_amdgcn_mfma_f32_32x32x16_bf16(b1,qr[d0],p1,0,0,0);}}
}
typedef __attribute__((address_space(3))) const char* lds_cptr;
typedef short v4i16_t __attribute__((ext_vector_type(4)));
__device__ __forceinline__ void kload8(bf16x8*kf,lds_cptr kp){
  kf[0]=*(const __attribute__((address_space(3))) bf16x8*)(kp);      kf[1]=*(const __attribute__((address_space(3))) bf16x8*)(kp+512);
  kf[2]=*(const __attribute__((address_space(3))) bf16x8*)(kp+2048); kf[3]=*(const __attribute__((address_space(3))) bf16x8*)(kp+2560);
  kf[4]=*(const __attribute__((address_space(3))) bf16x8*)(kp+4096); kf[5]=*(const __attribute__((address_space(3))) bf16x8*)(kp+4608);
  kf[6]=*(const __attribute__((address_space(3))) bf16x8*)(kp+6144); kf[7]=*(const __attribute__((address_space(3))) bf16x8*)(kp+6656);
}
__device__ __forceinline__ void kload2(bf16x8*kf,lds_cptr kp,int j){ kf[2*j]=*(const __attribute__((address_space(3))) bf16x8*)(kp+j*2048); kf[2*j+1]=*(const __attribute__((address_space(3))) bf16x8*)(kp+j*2048+512); }
__device__ __forceinline__ s16x4 vtr(lds_cptr p){ return __builtin_bit_cast(s16x4,__builtin_amdgcn_ds_read_tr16_b64_v4i16((__attribute__((address_space(3))) v4i16_t*)p)); }
__device__ __forceinline__ float rowmax(const f32x16&p0,const f32x16&p1){
  float a=max3f(p0[0],p0[1],p1[0]),b=max3f(p0[2],p0[3],p1[1]);a=max3f(a,p1[2],p1[3]);
  #pragma unroll
  for(int r=4;r<16;r+=4){a=max3f(a,p0[r],p0[r+1]);b=max3f(b,p0[r+2],p0[r+3]);a=max3f(a,p1[r],p1[r+1]);b=max3f(b,p1[r+2],p1[r+3]);}
  const float m=max2f(a,b);
  auto rr=__builtin_amdgcn_permlane32_swap(__float_as_uint(m),__float_as_uint(m),false,false);
  return max2f(__uint_as_float(rr[0]),__uint_as_float(rr[1]));
}
__device__ __forceinline__ void pv(f32x16*o,int vb,bf16x8 pa0,bf16x8 pa1,bf16x8 pa2,bf16x8 pa3){
  #pragma unroll
  for(int d0=0;d0<2;++d0){s16x4 lo[4],hi[4];
    #pragma unroll
    for(int ks=0;ks<4;++ks){
      asm volatile("ds_read_b64_tr_b16 %0,%1 offset:%c2":"=&v"(lo[ks]):"v"(vb),"i"(d0*4096+ks*1024):"memory");
      asm volatile("ds_read_b64_tr_b16 %0,%1 offset:%c2":"=&v"(hi[ks]):"v"(vb),"i"(d0*4096+ks*1024+512):"memory");}
    asm volatile("s_waitcnt lgkmcnt(0)":::"memory");SBAR();
    #define PK(k) (bf16x8){lo[k][0],lo[k][1],lo[k][2],lo[k][3],hi[k][0],hi[k][1],hi[k][2],hi[k][3]}
    o[d0]=__builtin_amdgcn_mfma_f32_32x32x16_bf16(pa0,PK(0),o[d0],0,0,0);
    o[d0]=__builtin_amdgcn_mfma_f32_32x32x16_bf16(pa1,PK(1),o[d0],0,0,0);
    o[d0]=__builtin_amdgcn_mfma_f32_32x32x16_bf16(pa2,PK(2),o[d0],0,0,0);
    o[d0]=__builtin_amdgcn_mfma_f32_32x32x16_bf16(pa3,PK(3),o[d0],0,0,0);
    #undef PK
  }
}

#ifndef ATTN_STORE16
#define ATTN_STORE16(p,v) (*(u32x4*)(p)=(v))
#endif
template<int THRL> __device__ __forceinline__ void attn_unit(const bf16*Q0,int ldq,const bf16*__restrict__ Kh,int ldk,const bf16*__restrict__ Vh,int ldv,bf16*O0,int ldo,int NT,char*shm){
  int tid_=my_tid(); asm volatile("":"+v"(tid_)); const int tid=tid_,lane=tid&63,r32=lane&31,hi=lane>>5; const int wid=__builtin_amdgcn_readfirstlane(tid>>6);
  const bf16*Qw=Q0+(long)(wid*QBLK)*ldq;
  const unsigned lds0=(unsigned)(uintptr_t)shm;
  float*wsf=(float*)(shm+LDS_WS)+wid*64;
  const bf16*ksrc=Kh+(long)lane*ldk+wid*8;
  const bf16*vsrc=Vh+(long)(16*(wid&3)+(lane>>2))*ldv+(wid>>2)*32+(lane&3)*8;
  const unsigned kdst=lds0+LDS_K+wid*1024, vdst=lds0+LDS_V+wid*1024;
  #define DMA_K(t,slot) glds16(ksrc+(long)(t)*KVBLK*ldk,(unsigned)__builtin_amdgcn_readfirstlane(kdst+(slot)))
  #define DMA_V(t,slot) glds16(vsrc+(long)(t)*KVBLK*ldv,(unsigned)__builtin_amdgcn_readfirstlane(vdst+(slot)))
  const int vb0=(int)(lds0+LDS_V)+((lane>>4)&1)*32+(lane&3)*8+(4*hi+((lane&15)>>2))*64;
  const char*Kbase=shm+LDS_K; bf16x8 kf[8];
  const lds_cptr shm3=(lds_cptr)shm; const lds_cptr kp0=shm3+LDS_K+hi*1024+r32*16; const lds_cptr vp0=shm3+LDS_V+((lane>>4)&1)*32+(lane&3)*8+(4*hi+((lane&15)>>2))*64;
  DMA_K(0,0);DMA_V(0,0);DMA_K(1,SLOTB);
  bf16x8 qr[4];
  #pragma unroll
  for(int d0=0;d0<4;++d0)qr[d0]=*reinterpret_cast<const bf16x8*>(&Qw[(long)r32*ldq+d0*16+hi*8]);
  float mhat=0.f,l_reg=0.f;f32x16 o[2];o[0]=f32x16{};o[1]=f32x16{};f32x16 negm=f32x16{};asm volatile("":"+v"(negm));
  #define CMASK(P0,P1,t) do{}while(0)
  bool resc=false;
  #define START(P0,P1) do{ const float rm=rowmax(P0,P1); resc=false; \
    { const float dl=rm; mhat=fadd_s(mhat,dl); \
      _Pragma("unroll") for(int r=0;r<16;++r){P0[r]=fsub_s(P0[r],dl);P1[r]=fsub_s(P1[r],dl);} \
      _Pragma("unroll") for(int r=0;r<16;++r)negm[r]=-mhat; asm volatile("":"+v"(negm)); } \
    _Pragma("unroll") for(int r=0;r<16;++r)P0[r]=__builtin_amdgcn_exp2f(P0[r]); }while(0)
  #define RESC() do{ if(resc){ asm volatile("s_waitcnt lgkmcnt(0)":::"memory"); \
      _Pragma("unroll") for(int d_=0;d_<2;++d_) _Pragma("unroll") for(int r=0;r<16;++r)o[d_][r]*=wsf[crow(r,hi)]; } }while(0)
  f32x16 pA0,pA1,pB0,pB1;
  int sl_prev=0,sl_cur=0,sl_next=SLOTB;
  #define ROT() do{sl_prev=sl_cur;sl_cur=sl_next;sl_next=(sl_next==(NSLOT-1)*SLOTB)?0:sl_next+SLOTB;}while(0)
  DMA_K(2,2*SLOTB);
  WAIT_BAR(3);
  qkt(pA0,pA1,Kbase,qr,negm,r32,hi);asm volatile("s_nop 15\n\ts_nop 7":"+v"(pA0),"+v"(pA1));CMASK(pA0,pA1,0);
  START(pA0,pA1);
  _Pragma("unroll") for(int r=0;r<16;++r)pA1[r]=__builtin_amdgcn_exp2f(pA1[r]);
  WAIT_BAR(0);
  DMA_K(3,0);DMA_V(1,SLOTB);
  ROT();
  kload8(kf,kp0+sl_cur);
  WAIT_BAR(2);
  s16x4 vlo[8],vhi[8]; u32x4 pw0,pw1,pw2,pw3;
  #define PKW(P,B) cvtpk_s(P[B],P[B+1])
  #define PAF(k) __builtin_bit_cast(bf16x8,pw##k)
  #define VFR(i) (bf16x8){vlo[i][0],vlo[i][1],vlo[i][2],vlo[i][3],vhi[i][0],vhi[i][1],vhi[i][2],vhi[i][3]}
  #define PIN(x) asm volatile("":"+v"(x))
  #define MX3(a,b,c) __builtin_fmaxf(__builtin_fmaxf((a),(b)),(c))
  #define GAPA(MF,A0,A1,A2,A3,W0,W1,PW) do{ MF; sacc+=A0; sacc+=A1; sacc+=A2; sacc+=A3; PIN(sacc); W0; W1; PIN(PW); SBAR(); }while(0)
  #define EX(v) __builtin_amdgcn_exp2f(v)
  #define GAPB(MF,X,B) do{ MF; X[B]=EX(X[B]); X[B+1]=EX(X[B+1]); X[B+2]=EX(X[B+2]); X[B+3]=EX(X[B+3]); PIN(X); SBAR(); }while(0)
  #define VRD(i) do{ vlo[i]=vtr(vp_+(((i)>>2)*4096+((i)&3)*1024)); vhi[i]=vtr(vp_+(((i)>>2)*4096+((i)&3)*1024+512)); }while(0)
  #define KRD(G,j) do{ if(G){ kload2(kf,kp0+sl_next,j); SBAR(); } }while(0)
  #define STEP(C0,C1,P0,P1,t,GK,GV,GL) do{ SBAR(); \
    const lds_cptr vp_=vp0+sl_prev; \
    VRD(0); SBAR(); float sacc=(P0[0]+P0[1]); \
    GAPA(C0=__builtin_amdgcn_mfma_f32_32x32x16_bf16(kf[0],qr[0],negm,0,0,0), P0[2],P0[3],P0[4],P0[5],     pw0[0]=PKW(P0,0), pw0[1]=PKW(P0,2), pw0); \
    VRD(4); SBAR(); GAPA(C1=__builtin_amdgcn_mfma_f32_32x32x16_bf16(kf[1],qr[0],negm,0,0,0), P0[6],P0[7],P0[8],P0[9],     pw0[2]=PKW(P0,4), pw0[3]=PKW(P0,6), pw0); \
    VRD(1); SBAR(); GAPA(C0=__builtin_amdgcn_mfma_f32_32x32x16_bf16(kf[2],qr[1],C0,0,0,0),   P0[10],P0[11],P0[12],P0[13], pw1[0]=PKW(P0,8), pw1[1]=PKW(P0,10), pw1); \
    VRD(5); SBAR(); GAPA(C1=__builtin_amdgcn_mfma_f32_32x32x16_bf16(kf[3],qr[1],C1,0,0,0),   P0[14],P0[15],P1[0],P1[1],   pw1[2]=PKW(P0,12),pw1[3]=PKW(P0,14), pw1); \
    VRD(2); SBAR(); GAPA(C0=__builtin_amdgcn_mfma_f32_32x32x16_bf16(kf[4],qr[2],C0,0,0,0),   P1[2],P1[3],P1[4],P1[5],     pw2[0]=PKW(P1,0), pw2[1]=PKW(P1,2), pw2); \
    VRD(6); SBAR(); GAPA(C1=__builtin_amdgcn_mfma_f32_32x32x16_bf16(kf[5],qr[2],C1,0,0,0),   P1[6],P1[7],P1[8],P1[9],     pw2[2]=PKW(P1,4), pw2[3]=PKW(P1,6), pw2); \
    VRD(3); SBAR(); GAPA(C0=__builtin_amdgcn_mfma_f32_32x32x16_bf16(kf[6],qr[3],C0,0,0,0),   P1[10],P1[11],P1[12],P1[13], pw3[0]=PKW(P1,8), pw3[1]=PKW(P1,10), pw3); \
    VRD(7); SBAR(); GAPA(C1=__builtin_amdgcn_mfma_f32_32x32x16_bf16(kf[7],qr[3],C1,0,0,0),   P1[14],P1[15],0.f,0.f,       pw3[2]=PKW(P1,12),pw3[3]=PKW(P1,14), pw3); \
    l_reg+=sacc; \
    if(GK){DMA_K((t)+3,sl_cur);} if(GV){DMA_V((t)+1,sl_next);} \
    CMASK(C0,C1,t); \
    { float a=MX3(C0[0],C0[1],C1[0]),b=MX3(C0[2],C0[3],C1[1]); a=MX3(a,C1[2],C1[3]); \
      _Pragma("unroll") for(int r=4;r<16;r+=4){a=MX3(a,C0[r],C0[r+1]);b=MX3(b,C0[r+2],C0[r+3]);a=MX3(a,C1[r],C1[r+1]);b=MX3(b,C1[r+2],C1[r+3]);} \
      float rm=__builtin_fmaxf(a,b); { auto rr=__builtin_amdgcn_permlane32_swap(__float_as_uint(rm),__float_as_uint(rm),false,false); rm=__builtin_fmaxf(__uint_as_float(rr[0]),__uint_as_float(rr[1])); } \
      resc=false; \
      if(__builtin_expect(__any(rm>(float)THRL),0)){ const float dl=__builtin_fmaxf(rm,0.f); mhat+=dl; \
        _Pragma("unroll") for(int r=0;r<16;++r){C0[r]-=dl;C1[r]-=dl;} \
        _Pragma("unroll") for(int r=0;r<16;++r)negm[r]=-mhat; asm volatile("":"+v"(negm)); \
        const float f=__builtin_amdgcn_exp2f(-dl); l_reg*=f; if(hi==0)wsf[r32]=f; resc=true; } } \
    SBAR(); \
    GAPB(o[0]=__builtin_amdgcn_mfma_f32_32x32x16_bf16(PAF(0),VFR(0),o[0],0,0,0), C0,0); \
    GAPB(o[1]=__builtin_amdgcn_mfma_f32_32x32x16_bf16(PAF(0),VFR(4),o[1],0,0,0), C0,4); \
    KRD(GL,0); GAPB(o[0]=__builtin_amdgcn_mfma_f32_32x32x16_bf16(PAF(1),VFR(1),o[0],0,0,0), C0,8); \
    KRD(GL,1); GAPB(o[1]=__builtin_amdgcn_mfma_f32_32x32x16_bf16(PAF(1),VFR(5),o[1],0,0,0), C0,12); \
    KRD(GL,2); GAPB(o[0]=__builtin_amdgcn_mfma_f32_32x32x16_bf16(PAF(2),VFR(2),o[0],0,0,0), C1,0); \
    KRD(GL,3); GAPB(o[1]=__builtin_amdgcn_mfma_f32_32x32x16_bf16(PAF(2),VFR(6),o[1],0,0,0), C1,4); \
    GAPB(o[0]=__builtin_amdgcn_mfma_f32_32x32x16_bf16(PAF(3),VFR(3),o[0],0,0,0), C1,8); \
    GAPB(o[1]=__builtin_amdgcn_mfma_f32_32x32x16_bf16(PAF(3),VFR(7),o[1],0,0,0), C1,12); \
    }while(0)
  int t=1;
  #undef CMASK
  #define CMASK(P0,P1,t) do{}while(0)
  for(;t+5<NT;t+=2){
    STEP(pB0,pB1,pA0,pA1,t,true,true,true);     WAIT_BAR(2); RESC(); ROT();
    STEP(pA0,pA1,pB0,pB1,t+1,true,true,true);   WAIT_BAR(2); RESC(); ROT();
  }
  #undef CMASK
  #define CMASK(P0,P1,t) do{}while(0)
  #define ENDW(tt) do{ if((tt)+3<NT){WAIT_BAR(2);} else if((tt)+2<NT){WAIT_BAR(1);} else {WAIT_BAR(0);} }while(0)
  for(;t+1<NT;t+=2){
    STEP(pB0,pB1,pA0,pA1,t,(t+3<NT),(t+1<NT),(t+1<NT));       ENDW(t);   RESC(); ROT();
    STEP(pA0,pA1,pB0,pB1,t+1,(t+4<NT),(t+2<NT),(t+2<NT));     ENDW(t+1); RESC(); ROT();
  }
  STEP(pB0,pB1,pA0,pA1,NT-1,false,false,false); RESC();
  { float sacc=pB0[0]+pB0[1]; _Pragma("unroll") for(int r=2;r<16;++r)sacc+=pB0[r]; _Pragma("unroll") for(int r=0;r<16;++r)sacc+=pB1[r]; l_reg+=sacc;
    pw0=(u32x4){PKW(pB0,0),PKW(pB0,2),PKW(pB0,4),PKW(pB0,6)};pw1=(u32x4){PKW(pB0,8),PKW(pB0,10),PKW(pB0,12),PKW(pB0,14)};pw2=(u32x4){PKW(pB1,0),PKW(pB1,2),PKW(pB1,4),PKW(pB1,6)};pw3=(u32x4){PKW(pB1,8),PKW(pB1,10),PKW(pB1,12),PKW(pB1,14)};
    SBAR(); pv(o,vb0+sl_cur,PAF(0),PAF(1),PAF(2),PAF(3)); }
  #undef PKW
  #undef PAF
  #undef VFR
  #undef PIN
  #undef MX3
  #undef GAPA
  #undef GAPB
  #undef EX
  #undef VRD
  #undef KRD
  #undef STEP
  #undef ENDW
  {auto rr=__builtin_amdgcn_permlane32_swap(__float_as_uint(l_reg),__float_as_uint(l_reg),false,false);l_reg=__uint_as_float(rr[0])+__uint_as_float(rr[1]);}
  if(hi==0)wsf[32+r32]=l_reg;asm volatile("s_waitcnt lgkmcnt(0)":::"memory");
  float rli[16];
  #pragma unroll
  for(int r=0;r<16;++r)rli[r]=__builtin_amdgcn_rcpf(wsf[32+crow(r,hi)]);
  bf16*Ow=O0+(long)(wid*QBLK)*ldo;
  { bf16*stg=(bf16*)(shm+LDS_OST)+wid*2048;
    #pragma unroll
    for(int r=0;r<16;++r){const int orow=crow(r,hi);
      #pragma unroll
      for(int d0=0;d0<2;++d0)stg[orow*64+d0*32+r32]=__float2bfloat16(o[d0][r]*rli[r]);}
    asm volatile("s_waitcnt lgkmcnt(0)":::"memory");
    #pragma unroll
    for(int i=0;i<4;++i){const int row=i*8+(lane>>3),ch=lane&7; const u32x4 v=*(const u32x4*)(stg+row*64+ch*8); ATTN_STORE16(Ow+(long)row*ldo+ch*8,v);} }
  asm volatile("s_waitcnt lgkmcnt(0)\n\ts_barrier":::"memory");
  #undef DMA_K
  #undef DMA_V
  #undef CMASK
  #undef START
  #undef RESC
  #undef ROT
}
constexpr int LDS_WS128=LDS_V+NSLOT*16384, LDS_OST128=LDS_WS128+NW*64*4, LDS_BYTES128=LDS_OST128+NW*4096;
template<int THRL> __device__ __forceinline__ void attn_unit128(const bf16*Q0,int ldq,const bf16*__restrict__ Kh,int ldk,const bf16*__restrict__ Vh,int ldv,bf16*O0,int ldo,int NT,char*shm){
  int tid_=my_tid(); asm volatile("":"+v"(tid_)); const int tid=tid_,lane=tid&63,r32=lane&31,hi=lane>>5; const int wid=__builtin_amdgcn_readfirstlane(tid>>6);
  const bf16*Qw=Q0+(long)(wid*QBLK)*ldq;
  const unsigned lds0=(unsigned)(uintptr_t)shm;
  float*wsf=(float*)(shm+LDS_WS128)+wid*64;
  const bf16*ksrc=Kh+(long)lane*ldk+wid*8;
  const bf16*vsrc=Vh+(long)(16*(wid&3)+(lane>>2))*ldv+(wid>>2)*32+(lane&3)*8;
  const unsigned kdst=lds0+LDS_K+wid*1024, vdst=lds0+LDS_V+wid*1024;
  #define DMA_K(t,slot) glds16(ksrc+(long)(t)*KVBLK*ldk,(unsigned)__builtin_amdgcn_readfirstlane(kdst+(slot)))
  #define DMA_V(t,slot) do{ glds16(vsrc+(long)(t)*KVBLK*ldv,(unsigned)__builtin_amdgcn_readfirstlane(vdst+2*(slot))); glds16(vsrc+(long)(t)*KVBLK*ldv+64,(unsigned)__builtin_amdgcn_readfirstlane(vdst+2*(slot)+8192)); }while(0)
  const int vb0=(int)(lds0+LDS_V)+((lane>>4)&1)*32+(lane&3)*8+(4*hi+((lane&15)>>2))*64;
  const char*Kbase=shm+LDS_K; bf16x8 kf[8];
  const lds_cptr shm3=(lds_cptr)shm; const lds_cptr kp0=shm3+LDS_K+hi*1024+r32*16; const lds_cptr vp0=shm3+LDS_V+((lane>>4)&1)*32+(lane&3)*8+(4*hi+((lane&15)>>2))*64;
  DMA_K(0,0);DMA_V(0,0);DMA_K(1,SLOTB);
  bf16x8 qr[4];
  #pragma unroll
  for(int d0=0;d0<4;++d0)qr[d0]=*reinterpret_cast<const bf16x8*>(&Qw[(long)r32*ldq+d0*16+hi*8]);
  float mhat=0.f,l_reg=0.f;f32x16 o[4];o[0]=f32x16{};o[1]=f32x16{};o[2]=f32x16{};o[3]=f32x16{};f32x16 negm=f32x16{};asm volatile("":"+v"(negm));
  #define CMASK(P0,P1,t) do{}while(0)
  bool resc=false;
  #define START(P0,P1) do{ const float rm=rowmax(P0,P1); resc=false; \
    { const float dl=rm; mhat=fadd_s(mhat,dl); \
      _Pragma("unroll") for(int r=0;r<16;++r){P0[r]=fsub_s(P0[r],dl);P1[r]=fsub_s(P1[r],dl);} \
      _Pragma("unroll") for(int r=0;r<16;++r)negm[r]=-mhat; asm volatile("":"+v"(negm)); } \
    _Pragma("unroll") for(int r=0;r<16;++r)P0[r]=__builtin_amdgcn_exp2f(P0[r]); }while(0)
  #define RESC() do{ if(resc){ asm volatile("s_waitcnt lgkmcnt(0)":::"memory"); \
      _Pragma("unroll") for(int d_=0;d_<4;++d_) _Pragma("unroll") for(int r=0;r<16;++r)o[d_][r]*=wsf[crow(r,hi)]; } }while(0)
  f32x16 pA0,pA1,pB0,pB1;
  int sl_prev=0,sl_cur=0,sl_next=SLOTB;
  #define ROT() do{sl_prev=sl_cur;sl_cur=sl_next;sl_next=(sl_next==(NSLOT-1)*SLOTB)?0:sl_next+SLOTB;}while(0)
  DMA_K(2,2*SLOTB);
  WAIT_BAR(3);
  qkt(pA0,pA1,Kbase,qr,negm,r32,hi);asm volatile("s_nop 15\n\ts_nop 7":"+v"(pA0),"+v"(pA1));CMASK(pA0,pA1,0);
  START(pA0,pA1);
  _Pragma("unroll") for(int r=0;r<16;++r)pA1[r]=__builtin_amdgcn_exp2f(pA1[r]);
  WAIT_BAR(0);
  DMA_K(3,0);DMA_V(1,SLOTB);
  ROT();
  kload8(kf,kp0+sl_cur);
  WAIT_BAR(3);
  s16x4 vlo[8],vhi[8]; u32x4 pw0,pw1,pw2,pw3;
  #define PKW(P,B) cvtpk_s(P[B],P[B+1])
  #define PAF(k) __builtin_bit_cast(bf16x8,pw##k)
  #define VFR(i) (bf16x8){vlo[i][0],vlo[i][1],vlo[i][2],vlo[i][3],vhi[i][0],vhi[i][1],vhi[i][2],vhi[i][3]}
  #define PIN(x) asm volatile("":"+v"(x))
  #define MX3(a,b,c) __builtin_fmaxf(__builtin_fmaxf((a),(b)),(c))
  #define GAPA(MF,A0,A1,A2,A3,W0,W1,PW) do{ MF; sacc+=A0; sacc+=A1; sacc+=A2; sacc+=A3; PIN(sacc); W0; W1; PIN(PW); SBAR(); }while(0)
  #define EX(v) __builtin_amdgcn_exp2f(v)
  #define GAPB(MF,X,B) do{ MF; X[B]=EX(X[B]); X[B+1]=EX(X[B+1]); X[B+2]=EX(X[B+2]); X[B+3]=EX(X[B+3]); PIN(X); SBAR(); }while(0)
  #define VRD(i) do{ vlo[i]=vtr(vp_+(((i)>>2)*4096+((i)&3)*1024)); vhi[i]=vtr(vp_+(((i)>>2)*4096+((i)&3)*1024+512)); }while(0)
  #define VRDQ(i) do{ vlo[i]=vtr(vq_+(((i)>>2)*4096+((i)&3)*1024)); vhi[i]=vtr(vq_+(((i)>>2)*4096+((i)&3)*1024+512)); }while(0)
  #define KRD(G,j) do{ if(G){ kload2(kf,kp0+sl_next,j); SBAR(); } }while(0)
  #define STEP(C0,C1,P0,P1,t,GK,GV,GL) do{ SBAR(); \
    const lds_cptr vp_=vp0+2*sl_prev; \
    VRD(0); SBAR(); float sacc=(P0[0]+P0[1]); \
    GAPA(C0=__builtin_amdgcn_mfma_f32_32x32x16_bf16(kf[0],qr[0],negm,0,0,0), P0[2],P0[3],P0[4],P0[5],     pw0[0]=PKW(P0,0), pw0[1]=PKW(P0,2), pw0); \
    VRD(4); SBAR(); GAPA(C1=__builtin_amdgcn_mfma_f32_32x32x16_bf16(kf[1],qr[0],negm,0,0,0), P0[6],P0[7],P0[8],P0[9],     pw0[2]=PKW(P0,4), pw0[3]=PKW(P0,6), pw0); \
    VRD(1); SBAR(); GAPA(C0=__builtin_amdgcn_mfma_f32_32x32x16_bf16(kf[2],qr[1],C0,0,0,0),   P0[10],P0[11],P0[12],P0[13], pw1[0]=PKW(P0,8), pw1[1]=PKW(P0,10), pw1); \
    VRD(5); SBAR(); GAPA(C1=__builtin_amdgcn_mfma_f32_32x32x16_bf16(kf[3],qr[1],C1,0,0,0),   P0[14],P0[15],P1[0],P1[1],   pw1[2]=PKW(P0,12),pw1[3]=PKW(P0,14), pw1); \
    VRD(2); SBAR(); GAPA(C0=__builtin_amdgcn_mfma_f32_32x32x16_bf16(kf[4],qr[2],C0,0,0,0),   P1[2],P1[3],P1[4],P1[5],     pw2[0]=PKW(P1,0), pw2[1]=PKW(P1,2), pw2); \
    VRD(6); SBAR(); GAPA(C1=__builtin_amdgcn_mfma_f32_32x32x16_bf16(kf[5],qr[2],C1,0,0,0),   P1[6],P1[7],P1[8],P1[9],     pw2[2]=PKW(P1,4), pw2[3]=PKW(P1,6), pw2); \
    VRD(3); SBAR(); GAPA(C0=__builtin_amdgcn_mfma_f32_32x32x16_bf16(kf[6],qr[3],C0,0,0,0),   P1[10],P1[11],P1[12],P1[13], pw3[0]=PKW(P1,8), pw3[1]=PKW(P1,10), pw3); \
    VRD(7); SBAR(); GAPA(C1=__builtin_amdgcn_mfma_f32_32x32x16_bf16(kf[7],qr[3],C1,0,0,0),   P1[14],P1[15],0.f,0.f,       pw3[2]=PKW(P1,12),pw3[3]=PKW(P1,14), pw3); \
    l_reg+=sacc; \
    if(GK){DMA_K((t)+3,sl_cur);} if(GV){DMA_V((t)+1,sl_next);} \
    CMASK(C0,C1,t); \
    { float a=MX3(C0[0],C0[1],C1[0]),b=MX3(C0[2],C0[3],C1[1]); a=MX3(a,C1[2],C1[3]); \
      _Pragma("unroll") for(int r=4;r<16;r+=4){a=MX3(a,C0[r],C0[r+1]);b=MX3(b,C0[r+2],C0[r+3]);a=MX3(a,C1[r],C1[r+1]);b=MX3(b,C1[r+2],C1[r+3]);} \
      float rm=__builtin_fmaxf(a,b); { auto rr=__builtin_amdgcn_permlane32_swap(__float_as_uint(rm),__float_as_uint(rm),false,false); rm=__builtin_fmaxf(__uint_as_float(rr[0]),__uint_as_float(rr[1])); } \
      resc=false; \
      if(__builtin_expect(__any(rm>(float)THRL),0)){ const float dl=__builtin_fmaxf(rm,0.f); mhat+=dl; \
        _Pragma("unroll") for(int r=0;r<16;++r){C0[r]-=dl;C1[r]-=dl;} \
        _Pragma("unroll") for(int r=0;r<16;++r)negm[r]=-mhat; asm volatile("":"+v"(negm)); \
        const float f=__builtin_amdgcn_exp2f(-dl); l_reg*=f; if(hi==0)wsf[r32]=f; resc=true; } } \
    SBAR(); \
    GAPB(o[0]=__builtin_amdgcn_mfma_f32_32x32x16_bf16(PAF(0),VFR(0),o[0],0,0,0), C0,0); \
    GAPB(o[1]=__builtin_amdgcn_mfma_f32_32x32x16_bf16(PAF(0),VFR(4),o[1],0,0,0), C0,4); \
    KRD(GL,0); GAPB(o[0]=__builtin_amdgcn_mfma_f32_32x32x16_bf16(PAF(1),VFR(1),o[0],0,0,0), C0,8); \
    KRD(GL,1); GAPB(o[1]=__builtin_amdgcn_mfma_f32_32x32x16_bf16(PAF(1),VFR(5),o[1],0,0,0), C0,12); \
    KRD(GL,2); GAPB(o[0]=__builtin_amdgcn_mfma_f32_32x32x16_bf16(PAF(2),VFR(2),o[0],0,0,0), C1,0); \
    KRD(GL,3); GAPB(o[1]=__builtin_amdgcn_mfma_f32_32x32x16_bf16(PAF(2),VFR(6),o[1],0,0,0), C1,4); \
    GAPB(o[0]=__builtin_amdgcn_mfma_f32_32x32x16_bf16(PAF(3),VFR(3),o[0],0,0,0), C1,8); \
    GAPB(o[1]=__builtin_amdgcn_mfma_f32_32x32x16_bf16(PAF(3),VFR(7),o[1],0,0,0), C1,12); \
    { const lds_cptr vq_=vp_+8192; VRDQ(0);VRDQ(4);VRDQ(1);VRDQ(5);VRDQ(2);VRDQ(6);VRDQ(3);VRDQ(7); asm volatile("s_waitcnt lgkmcnt(0)":::"memory"); SBAR(); \
      o[2]=__builtin_amdgcn_mfma_f32_32x32x16_bf16(PAF(0),VFR(0),o[2],0,0,0); o[3]=__builtin_amdgcn_mfma_f32_32x32x16_bf16(PAF(0),VFR(4),o[3],0,0,0); \
      o[2]=__builtin_amdgcn_mfma_f32_32x32x16_bf16(PAF(1),VFR(1),o[2],0,0,0); o[3]=__builtin_amdgcn_mfma_f32_32x32x16_bf16(PAF(1),VFR(5),o[3],0,0,0); \
      o[2]=__builtin_amdgcn_mfma_f32_32x32x16_bf16(PAF(2),VFR(2),o[2],0,0,0); o[3]=__builtin_amdgcn_mfma_f32_32x32x16_bf16(PAF(2),VFR(6),o[3],0,0,0); \
      o[2]=__builtin_amdgcn_mfma_f32_32x32x16_bf16(PAF(3),VFR(3),o[2],0,0,0); o[3]=__builtin_amdgcn_mfma_f32_32x32x16_bf16(PAF(3),VFR(7),o[3],0,0,0); \
      SBAR(); } \
    }while(0)
  int t=1;
  #undef CMASK
  #define CMASK(P0,P1,t) do{}while(0)
  for(;t+5<NT;t+=2){
    STEP(pB0,pB1,pA0,pA1,t,true,true,true);     WAIT_BAR(3); RESC(); ROT();
    STEP(pA0,pA1,pB0,pB1,t+1,true,true,true);   WAIT_BAR(3); RESC(); ROT();
  }
  #undef CMASK
  #define CMASK(P0,P1,t) do{}while(0)
  #define ENDW(tt) do{ if((tt)+3<NT){WAIT_BAR(3);} else if((tt)+2<NT){WAIT_BAR(2);} else {WAIT_BAR(0);} }while(0)
  for(;t+1<NT;t+=2){
    STEP(pB0,pB1,pA0,pA1,t,(t+3<NT),(t+1<NT),(t+1<NT));       ENDW(t);   RESC(); ROT();
    STEP(pA0,pA1,pB0,pB1,t+1,(t+4<NT),(t+2<NT),(t+2<NT));     ENDW(t+1); RESC(); ROT();
  }
  STEP(pB0,pB1,pA0,pA1,NT-1,false,false,false); RESC();
  { float sacc=pB0[0]+pB0[1]; _Pragma("unroll") for(int r=2;r<16;++r)sacc+=pB0[r]; _Pragma("unroll") for(int r=0;r<16;++r)sacc+=pB1[r]; l_reg+=sacc;
    pw0=(u32x4){PKW(pB0,0),PKW(pB0,2),PKW(pB0,4),PKW(pB0,6)};pw1=(u32x4){PKW(pB0,8),PKW(pB0,10),PKW(pB0,12),PKW(pB0,14)};pw2=(u32x4){PKW(pB1,0),PKW(pB1,2),PKW(pB1,4),PKW(pB1,6)};pw3=(u32x4){PKW(pB1,8),PKW(pB1,10),PKW(pB1,12),PKW(pB1,14)};
    SBAR(); pv(o,vb0+2*sl_cur,PAF(0),PAF(1),PAF(2),PAF(3)); pv(o+2,vb0+2*sl_cur+8192,PAF(0),PAF(1),PAF(2),PAF(3)); }
  #undef PKW
  #undef PAF
  #undef VFR
  #undef PIN
  #undef MX3
  #undef GAPA
  #undef GAPB
  #undef EX
  #undef VRD
  #undef KRD
  #undef VRDQ
  #undef STEP
  #undef ENDW
  {auto rr=__builtin_amdgcn_permlane32_swap(__float_as_uint(l_reg),__float_as_uint(l_reg),false,false);l_reg=__uint_as_float(rr[0])+__uint_as_float(rr[1]);}
  if(hi==0)wsf[32+r32]=l_reg;asm volatile("s_waitcnt lgkmcnt(0)":::"memory");
  float rli[16];
  #pragma unroll
  for(int r=0;r<16;++r)rli[r]=__builtin_amdgcn_rcpf(wsf[32+crow(r,hi)]);
  bf16*Ow=O0+(long)(wid*QBLK)*ldo;
  { bf16*stg=(bf16*)(shm+LDS_OST128)+wid*2048;
    #pragma unroll
    for(int h2=0;h2<2;++h2){
      #pragma unroll
      for(int r=0;r<16;++r){const int orow=crow(r,hi);
        #pragma unroll
        for(int d0=0;d0<2;++d0)stg[orow*64+d0*32+r32]=__float2bfloat16(o[2*h2+d0][r]*rli[r]);}
      asm volatile("s_waitcnt lgkmcnt(0)":::"memory");
      #pragma unroll
      for(int i=0;i<4;++i){const int row=i*8+(lane>>3),ch=lane&7; const u32x4 v=*(const u32x4*)(stg+row*64+ch*8); ATTN_STORE16(Ow+(long)row*ldo+h2*64+ch*8,v);}
      asm volatile("s_waitcnt lgkmcnt(0)":::"memory"); } }
  asm volatile("s_waitcnt lgkmcnt(0)\n\ts_barrier":::"memory");
  #undef DMA_K
  #undef DMA_V
  #undef CMASK
  #undef START
  #undef RESC
  #undef ROT
}
constexpr int ATTN_LDS_BYTES=LDS_BYTES;
#undef SBAR
#undef WAIT_BAR
}


constexpr int NWAVES = 8;
constexpr int DMODEL = 1024, NBATCH = 2, SEQL = 8192, CTXL = 256, RPB = SEQL + CTXL, MROWS = NBATCH * RPB, NLAYER = 2;
constexpr int DFF = 2816, NUP = 2 * DFF, INW = 5888, ZW = 5376, NMODV = 9, MODW = NMODV * DMODEL;
constexpr int ZQA = 0, ZKA = 512, ZVA = 640, ZQB = 768, ZKB = 1280, ZVB = 1792, ZGATE = 2304;
constexpr int TPB = RPB / 256;
constexpr float EPSN = 1e-6f;
constexpr int HN = 4096;

constexpr size_t MiB = 1u << 20, KiB = 1024;
constexpr size_t WS_CTL = 0, CTL_ZERO_BYTES = 64 * KiB;
constexpr size_t WS_MOD = 1 * MiB;
constexpr size_t WS_CAS256 = 1 * MiB + 512 * KiB;
constexpr size_t WS_HC = 2 * MiB;
constexpr size_t WS_WUP0 = 4 * MiB, WS_WDN0 = 15 * MiB, WS_WUP1 = 20 * MiB + 512 * KiB, WS_WDN1 = 31 * MiB + 512 * KiB;
constexpr size_t WS_WIN = 37 * MiB, WS_WC = 47 * MiB + 512 * KiB, WS_WBR = 48 * MiB + 512 * KiB, WS_WOUT = 51 * MiB + 512 * KiB;
constexpr size_t WS_HN = 54 * MiB;
constexpr size_t WS_Z = 87 * MiB;
constexpr size_t WS_T1T = 261 * MiB;
constexpr size_t WS_PART = WS_T1T;
constexpr size_t WS_T2B = WS_T1T;
constexpr size_t WS_T2 = 278 * MiB;
constexpr size_t WS_PQ = 295 * MiB;
constexpr size_t WS_CAS = 311 * MiB;
constexpr size_t WS_ROPE = 343 * MiB;
constexpr size_t WS_END = 345 * MiB;
static_assert(WS_Z + (size_t)MROWS * ZW * 2 <= WS_T1T && WS_HN + (size_t)MROWS * DMODEL * 2 <= WS_Z && WS_WOUT + 2 * MiB <= WS_HN, "ws map");
constexpr int CW_BAR = 4096;
constexpr int CW_Q = 1024;


#define GAS __attribute__((address_space(1)))
typedef unsigned short bf16;
typedef unsigned v4u __attribute__((ext_vector_type(4)));
typedef float f32x4 __attribute__((ext_vector_type(4)));
#define LDS_WAIT() asm volatile("s_waitcnt lgkmcnt(0)" ::: "memory")

__device__ __forceinline__ float bf2f(unsigned v) { return __uint_as_float(v << 16); }
__device__ __forceinline__ float bflo(unsigned w) { return __uint_as_float(w << 16); }
__device__ __forceinline__ float bfhi(unsigned w) { return __uint_as_float(w & 0xffff0000u); }
__device__ __forceinline__ unsigned pk2(float lo, float hi) { return pg8::cvt_pk_bf16(lo, hi); }
__device__ __forceinline__ float fexp(float x) { return __builtin_amdgcn_exp2f(x * 1.4426950408889634f); }
__device__ __forceinline__ float sigm(float x) { return __builtin_amdgcn_rcpf(1.0f + fexp(-x)); }
__device__ __forceinline__ float siluf(float x) { return x * sigm(x); }
__device__ __forceinline__ float shfl_xor(float v, int o) { return __builtin_bit_cast(float, __builtin_amdgcn_ds_bpermute((lane_id() ^ o) << 2, __builtin_bit_cast(int, v))); }
__device__ __forceinline__ float wave_sum(float v) {
#pragma unroll
    for (int o = 1; o < 64; o <<= 1) v += shfl_xor(v, o);
    return v;
}

namespace pg8 {
struct EpiStore {
    static constexpr bool PERM = true, AFTER_DRAIN = false;
    bf16_t* O; int ldc; int sig_from; int rbase, rmul;
    __device__ __forceinline__ void operator()(const f32x4 (&acc)[2][2][4][2], const Unit& u, int wr, int wc, int fr_, int fq_) const {
        (void)fr_; (void)fq_; const int ln_ = lane_id(); const int fr = ln_ & 15, fq = ln_ >> 4;
        const int row0 = u.pm * BM + wr * 64 + fr, col0 = u.pn * BM + wc * 32 + 8 * fq;
        const bool sg = (u.pn * BM) >= sig_from;
#pragma unroll
        for (int ai = 0; ai < 2; ++ai)
#pragma unroll
            for (int m = 0; m < 4; ++m) { const int row = row0 + ai * HALF + m * 16; bf16_t* rowp = O + (size_t)(rbase + row * rmul) * ldc + col0;
#pragma unroll
                for (int bj = 0; bj < 2; ++bj) { f32x4 v0 = acc[ai][bj][m][0], v1 = acc[ai][bj][m][1];
                    if (sg) { v0[0] = sigm(v0[0]); v0[1] = sigm(v0[1]); v0[2] = sigm(v0[2]); v0[3] = sigm(v0[3]); v1[0] = sigm(v1[0]); v1[1] = sigm(v1[1]); v1[2] = sigm(v1[2]); v1[3] = sigm(v1[3]); }
                    u32x4 w; w.x = cvt_pk_bf16(v0[0], v0[1]); w.y = cvt_pk_bf16(v0[2], v0[3]); w.z = cvt_pk_bf16(v1[0], v1[1]); w.w = cvt_pk_bf16(v1[2], v1[3]);
                    *(u32x4*)(rowp + bj * HALF) = w; } }
    }
};
struct EpiSwiGLU {
    static constexpr bool PERM = true, AFTER_DRAIN = false;
    bf16_t* H; int ldc;
    __device__ __forceinline__ void operator()(const f32x4 (&acc)[2][2][4][2], const Unit& u, int wr, int wc, int fr_, int fq_) const {
        (void)fr_; (void)fq_; const int ln_ = lane_id(); const int fr = ln_ & 15, fq = ln_ >> 4;
        const int row0 = u.pm * BM + wr * 64 + fr, col0 = u.pn * HALF + wc * 32 + 8 * fq;
#pragma unroll
        for (int ai = 0; ai < 2; ++ai)
#pragma unroll
            for (int m = 0; m < 4; ++m) { const int row = row0 + ai * HALF + m * 16; bf16_t* rowp = H + (size_t)row * ldc + col0;
                const f32x4 g0 = acc[ai][0][m][0], g1 = acc[ai][0][m][1], u0 = acc[ai][1][m][0], u1 = acc[ai][1][m][1];
                u32x4 w; w.x = cvt_pk_bf16(siluf(g0[0]) * u0[0], siluf(g0[1]) * u0[1]); w.y = cvt_pk_bf16(siluf(g0[2]) * u0[2], siluf(g0[3]) * u0[3]);
                w.z = cvt_pk_bf16(siluf(g1[0]) * u1[0], siluf(g1[1]) * u1[1]); w.w = cvt_pk_bf16(siluf(g1[2]) * u1[2], siluf(g1[3]) * u1[3]);
                *(u32x4*)rowp = w; }
    }
};
template <bool ATOMIC> struct EpiResidT {
    static constexpr bool PERM = false, AFTER_DRAIN = false;
    const float* base_lat; const float* base_ctx; float* out_lat; float* out_ctx; const float* gate; float scale;
    __device__ __forceinline__ void operator()(const f32x4 (&acc)[2][2][4][2], const Unit& u, int wr, int wc, int fr_, int fq_) const {
        (void)fr_; (void)fq_; const int ln_ = lane_id(); const int fr = ln_ & 15, fq = ln_ >> 4;
        const int b = u.pm / 33, w = u.pm % 33; const int set = (w == 0) ? 2 : b;
        const size_t toff = (w == 0) ? (size_t)b * 256 * 1024 : ((size_t)b * 8192 + (size_t)(w - 1) * 256) * 1024;
        const float* base = ((w == 0) ? base_ctx : base_lat) + toff; float* out = ((w == 0) ? out_ctx : out_lat) + toff;
        const int frr = fr;
        const int col0 = u.pn * BM + wc * 32 + 4 * fq; const float* gp = gate + set * 9216 + col0;
#pragma unroll
        for (int bj = 0; bj < 2; ++bj)
#pragma unroll
            for (int n = 0; n < 2; ++n) { const f32x4 gv = *(const f32x4*)(gp + bj * HALF + n * 16) * scale;
#pragma unroll
                for (int ai = 0; ai < 2; ++ai) {
#pragma unroll
                    for (int m = 0; m < 4; ++m) { const unsigned off = (unsigned)(ai * HALF + wr * 64 + m * 16 + frr) * 1024u + (unsigned)(col0 + bj * HALF + n * 16);
                        if constexpr (ATOMIC) { float one = 1.0f; asm volatile("" : "+v"(one) :: "memory"); const f32x4 v = (gv * one) * acc[ai][bj][m][n]; __attribute__((address_space(1))) float* ap = (__attribute__((address_space(1))) float*)(out + off); (void)__builtin_amdgcn_global_atomic_fadd_f32(ap, v[0]); (void)__builtin_amdgcn_global_atomic_fadd_f32(ap + 1, v[1]); (void)__builtin_amdgcn_global_atomic_fadd_f32(ap + 2, v[2]); (void)__builtin_amdgcn_global_atomic_fadd_f32(ap + 3, v[3]); asm volatile("" ::: "memory"); }
                        else { const f32x4 bs = *(const f32x4*)(base + off); *(f32x4*)(out + off) = bs + gv * acc[ai][bj][m][n]; } }
                    asm volatile("" ::: "memory"); } }
    }
};
typedef EpiResidT<false> EpiResid;
struct EpiResidA {
    static constexpr bool PERM = false, AFTER_DRAIN = false;
    float* part; const float* gate; float scale;
    __device__ __forceinline__ void operator()(const f32x4 (&acc)[2][2][4][2], const Unit& u, int wr, int wc, int fr_, int fq_) const {
        (void)fr_; (void)fq_; const int ln_ = lane_id(); const int fr = ln_ & 15, fq = ln_ >> 4;
        const int col0 = u.pn * BM + wc * 32 + 4 * fq;
        float* out = part + ((size_t)u.kp * 512 + (u.pm ? 256 : 0)) * 1024 + (unsigned)((wr * 64 + fr) * 1024 + col0);
#pragma unroll
        for (int bj = 0; bj < 2; ++bj)
#pragma unroll
            for (int n = 0; n < 2; ++n) { const f32x4 gv = *(const f32x4*)(gate + col0 + bj * HALF + n * 16) * scale;
#pragma unroll
                for (int ai = 0; ai < 2; ++ai) {
#pragma unroll
                    for (int m = 0; m < 4; ++m) *(f32x4*)(out + (ai * HALF + m * 16) * 1024 + bj * HALF + n * 16) = gv * acc[ai][bj][m][n];
                    asm volatile("" ::: "memory"); } }
    }
};
struct EpiMerge {
    static constexpr bool PERM = true, AFTER_DRAIN = false;
    const bf16_t* Z; bf16_t* Mo;
    __device__ __forceinline__ void operator()(const f32x4 (&acc)[2][2][4][2], const Unit& u, int wr, int wc, int fr_, int fq_) const {
        (void)fr_; (void)fq_; const int ln_ = lane_id(); const int fr = ln_ & 15, fq = ln_ >> 4;
        const int br = u.pn >> 2, ct = u.pn & 3;
        const int row0 = u.pm * BM + wr * 64 + fr, col0 = ct * BM + wc * 32 + 8 * fq;
#pragma unroll
        for (int ai = 0; ai < 2; ++ai)
#pragma unroll
            for (int m = 0; m < 4; ++m) { const int row = row0 + ai * HALF + m * 16; const bf16_t* gp = Z + (size_t)row * 5376 + 2304 + br * 1024 + col0; bf16_t* mp = Mo + (size_t)row * 1024 + col0;
#pragma unroll
                for (int bj = 0; bj < 2; ++bj) { const u32x4 gw = *(const u32x4*)(gp + bj * HALF); const f32x4 a0 = acc[ai][bj][m][0], a1 = acc[ai][bj][m][1];
                    float r0 = __uint_as_float(gw.x << 16) * a0[0], r1 = __uint_as_float(gw.x & 0xffff0000u) * a0[1], r2 = __uint_as_float(gw.y << 16) * a0[2], r3 = __uint_as_float(gw.y & 0xffff0000u) * a0[3];
                    float r4 = __uint_as_float(gw.z << 16) * a1[0], r5 = __uint_as_float(gw.z & 0xffff0000u) * a1[1], r6 = __uint_as_float(gw.w << 16) * a1[2], r7 = __uint_as_float(gw.w & 0xffff0000u) * a1[3];
                    if (br > 0) { const u32x4 ow = *(const u32x4*)(mp + bj * HALF);
                        r0 += __uint_as_float(ow.x << 16); r1 += __uint_as_float(ow.x & 0xffff0000u); r2 += __uint_as_float(ow.y << 16); r3 += __uint_as_float(ow.y & 0xffff0000u);
                        r4 += __uint_as_float(ow.z << 16); r5 += __uint_as_float(ow.z & 0xffff0000u); r6 += __uint_as_float(ow.w << 16); r7 += __uint_as_float(ow.w & 0xffff0000u); }
                    u32x4 w; w.x = cvt_pk_bf16(r0, r1); w.y = cvt_pk_bf16(r2, r3); w.z = cvt_pk_bf16(r4, r5); w.w = cvt_pk_bf16(r6, r7);
                    *(u32x4*)(mp + bj * HALF) = w; } }
    }
};
struct MergeOrder {
    int G, c, lat;
    __device__ bool next(int i, Unit& u) const { const int grp = (i / 3) * G + c; if (grp >= (lat ? 256 : 264)) return false; int pm = grp >> 2; if (lat) pm = pm + 1 + (pm >= 32); u.pm = pm; u.pn = (grp & 3) + 4 * (i % 3); return true; }
    __device__ __forceinline__ void a_ready(const Unit&) const {}
    __device__ __forceinline__ void done(const Unit&) const {}
    __device__ __forceinline__ size_t aoff(const Unit& u) const { const int br = u.pn >> 2; return (size_t)(br == 0 ? 0 : (br == 1 ? 768 : 1280)) * 2; }
    __device__ __forceinline__ size_t boff(const Unit&) const { return 0; }
};
struct LatOrder {
    StaticOrder so;
    __device__ void init(int N, int G_, int c_) { so.init(64 * BM, N, G_, c_); }
    __device__ bool next(int i, Unit& u) const { if (!so.next(i, u)) return false; u.pm = u.pm + 1 + (u.pm >= 32); return true; }
    __device__ __forceinline__ void a_ready(const Unit&) const {}
    __device__ __forceinline__ void done(const Unit&) const {}
    __device__ __forceinline__ size_t aoff(const Unit&) const { return 0; }
    __device__ __forceinline__ size_t boff(const Unit&) const { return 0; }
};
struct CtxSplit {
    int G, c, KP;
    __device__ bool next(int i, Unit& u) const { const int s = i * G + c; if (s >= 8 * KP) return false; const int t = s / KP; u.pn = t & 3; u.kp = s % KP; u.pm = (t >> 2) * 33; return true; }
    __device__ __forceinline__ void a_ready(const Unit&) const {}
    __device__ __forceinline__ void done(const Unit&) const {}
    __device__ __forceinline__ size_t aoff(const Unit& u) const { return (size_t)u.kp * 512; }
    __device__ __forceinline__ size_t boff(const Unit& u) const { return (size_t)u.kp * 512; }
};
struct OneUnit {
    int pm, pn;
    __device__ bool next(int i, Unit& u) const { if (i) return false; u.pm = pm; u.pn = pn; return true; }
    __device__ __forceinline__ void a_ready(const Unit&) const {}
    __device__ __forceinline__ void done(const Unit&) const {}
    __device__ __forceinline__ size_t aoff(const Unit&) const { return 0; }
    __device__ __forceinline__ size_t boff(const Unit&) const { return 0; }
};
}

#define XB_TMO      128
#define XB_XCNT(j)  (256  + 64 * (j))
#define XB_XSUB(j)  (1280 + 64 * (j))
#define XB_XGEN(j)  (2304 + 64 * (j))
#define XB_TOP      3328
#define XB_TOPGEN   3392
#define XCD_BAR_WORDS 3456
#define XB_SPIN_CAP (1u << 18)

__device__ __forceinline__ unsigned xb_ld(unsigned* p)              { return __hip_atomic_load(p, __ATOMIC_RELAXED, __HIP_MEMORY_SCOPE_AGENT); }
__device__ __forceinline__ unsigned xb_add(unsigned* p, unsigned v) { return __hip_atomic_fetch_add(p, v, __ATOMIC_RELAXED, __HIP_MEMORY_SCOPE_AGENT); }
__device__ __forceinline__ unsigned xb_xcc_id() { return (unsigned)__builtin_amdgcn_s_getreg((3 << 11) | 20) & 0xFu; }
#define XB_SPIN(cond, bar) do { unsigned _sp = 0; while (cond) { __builtin_amdgcn_s_sleep(1); \
    if ((++_sp & 255u) == 0u) { if (xb_ld(&(bar)[XB_TMO])) break; if (_sp > XB_SPIN_CAP) { atomicAdd(&(bar)[XB_TMO], 1u); break; } } } } while (0)

struct XcdBarrier {
    unsigned* bar; unsigned x;
    volatile LAS unsigned* st;
};

__device__ __forceinline__ XcdBarrier xcd_barrier_post(unsigned* bar, volatile LAS unsigned* st) {
    XcdBarrier b; b.bar = bar; b.x = xb_xcc_id(); b.st = st;
    if (my_tid() == 0) (void)xb_add(&bar[XB_XCNT(b.x)], 1u);
    return b;
}
__device__ __forceinline__ void xcd_barrier_complete(unsigned* bar, unsigned x, unsigned& nloc, unsigned& nx) {
    const unsigned G = gridDim.x * gridDim.y * gridDim.z;
    unsigned sum, cnt, mine, sp = 0u;
    for (;;) {
        sum = 0u; cnt = 0u; mine = 0u;
#pragma unroll
        for (unsigned j = 0; j < 16; ++j) { const unsigned c = xb_ld(&bar[XB_XCNT(j)]); sum += c; cnt += (c > 0u) ? 1u : 0u; mine = (j == x) ? c : mine; }
        if (sum == G) break;
        __builtin_amdgcn_s_sleep(1);
        if ((++sp & 255u) == 0u) { if (xb_ld(&bar[XB_TMO])) break; if (sp > XB_SPIN_CAP) { atomicAdd(&bar[XB_TMO], 1u); break; } }
    }
    nloc = mine > 0u ? mine : 1u; nx = cnt > 0u ? cnt : 1u;
}

__device__ __forceinline__ void xcd_barrier(const XcdBarrier& b) {
    asm volatile("s_waitcnt vmcnt(0)" ::: "memory");
    __syncthreads();
    if (my_tid() == 0) {
        unsigned* bar = b.bar;
        __builtin_amdgcn_s_waitcnt(0);
        unsigned nloc = b.st[0], nx = b.st[1];
        if (nloc == 0u) { xcd_barrier_complete(bar, b.x, nloc, nx); b.st[0] = nloc; b.st[1] = nx; }
        const unsigned old = xb_add(&bar[XB_XSUB(b.x)], 1u);
        const unsigned gen = old / nloc;
        if (old + 1u == (gen + 1u) * nloc) {
            __builtin_amdgcn_fence(__ATOMIC_RELEASE, "agent");
            asm volatile("s_waitcnt vmcnt(0)" ::: "memory");
            const unsigned og = xb_add(&bar[XB_TOP], 1u);
            const unsigned tg = og / nx;
            if (og + 1u == (tg + 1u) * nx) xb_add(&bar[XB_TOPGEN], 1u);
            else XB_SPIN(xb_ld(&bar[XB_TOPGEN]) == tg, bar);
            __builtin_amdgcn_fence(__ATOMIC_ACQUIRE, "agent");
            xb_add(&bar[XB_XGEN(b.x)], 1u);
            asm volatile("s_waitcnt vmcnt(0)" ::: "memory");
        } else {
            XB_SPIN(xb_ld(&bar[XB_XGEN(b.x)]) == gen, bar);
            __builtin_amdgcn_fence(__ATOMIC_ACQUIRE, "agent");
            asm volatile("s_waitcnt vmcnt(0)" ::: "memory");
        }
    }
    __syncthreads();
}

struct Frame {
    LAS unsigned char* lds; volatile LAS unsigned* MISC; unsigned* ctl;
    int tid, lane, wave, G, bid;
    const float *x, *c, *ctx, *cctx, *w_ada, *b_ada, *norm_g, *ffn_wi, *ffn_wo, *w_in, *qk_g, *diff_lam, *subln_g, *w_branch, *w_out;
    float* out; unsigned char* ws;
};
#define WSP(T, off) ((T*)(F.ws + (off)))

__device__ __forceinline__ void transpose_item(const float* W, int N, bf16* WT, int ldt, int k0, int n0, int dst_row0, LAS float* scr, int lane) {
#pragma unroll 8
    for (int i = 0; i < 32; ++i) { const int kk = 2 * i + (lane >> 5); scr[kk * 33 + (lane & 31)] = W[(size_t)(k0 + kk) * N + n0 + (lane & 31)]; }
    LDS_WAIT(); asm volatile("" ::: "memory");
    const int c = lane & 7;
#pragma unroll
    for (int j = 0; j < 4; ++j) { const int n = (lane >> 3) + 8 * j; const LAS float* s = scr + (8 * c) * 33 + n;
        v4u o; o.x = pk2(s[0 * 33], s[1 * 33]); o.y = pk2(s[2 * 33], s[3 * 33]); o.z = pk2(s[4 * 33], s[5 * 33]); o.w = pk2(s[6 * 33], s[7 * 33]);
        *(v4u*)(WT + (size_t)(dst_row0 + n) * ldt + k0 + 8 * c) = o; }
    LDS_WAIT(); asm volatile("" ::: "memory");
}
__device__ __forceinline__ void convert_weights(Frame& F, int l) {
    LAS float* scr = (LAS float*)(F.lds + F.wave * 16384);
    const int gw = F.bid * NWAVES + F.wave, NGW = F.G * NWAVES;
    constexpr int I_UP = 16 * 176, I_DN = 44 * 32, I_IN = 16 * 184, I_BR = 8 * 32, I_OUT = 16 * 32;
    constexpr int NITEMS = 2 * I_UP + 2 * I_DN + I_IN + 3 * I_BR + I_OUT;
    const float* wi = F.ffn_wi + (size_t)l * 2 * 1024 * NUP; const float* wo = F.ffn_wo + (size_t)l * 2 * DFF * 1024;
    const float* win = F.w_in + (size_t)l * 1024 * INW; const float* wbr = F.w_branch + (size_t)l * 3 * 512 * 1024; const float* wout = F.w_out + (size_t)l * 1024 * 1024;
    for (int it = gw; it < NITEMS; it += NGW) {
        int r = it;
        if (r < 2 * I_UP) { const int h = r / I_UP; r -= h * I_UP; const int kb = r / 176, nb = r % 176; int n0 = nb * 32; const int isu = n0 >= DFF; const int nn = n0 - isu * DFF;
            transpose_item(wi + (size_t)h * 1024 * NUP, NUP, WSP(bf16, h ? WS_WUP1 : WS_WUP0), 1024, kb * 64, n0, (nn / 128) * 256 + isu * 128 + (nn % 128), scr, F.lane); continue; }
        r -= 2 * I_UP;
        if (r < 2 * I_DN) { const int h = r / I_DN; r -= h * I_DN; const int kb = r / 32, nb = r % 32;
            transpose_item(wo + (size_t)h * DFF * 1024, 1024, WSP(bf16, h ? WS_WDN1 : WS_WDN0), DFF, kb * 64, nb * 32, nb * 32, scr, F.lane); continue; }
        r -= 2 * I_DN;
        if (r < I_IN) { const int kb = r / 184, nb = r % 184; const int n0 = nb * 32;
            if (n0 >= 2304 && n0 < 2816) continue;
            transpose_item(win, INW, WSP(bf16, WS_WIN), 1024, kb * 64, n0, n0 < 2304 ? n0 : n0 - 512, scr, F.lane); continue; }
        r -= I_IN;
        if (r < 3 * I_BR) { const int i = r / I_BR; r -= i * I_BR; const int kb = r / 32, nb = r % 32;
            transpose_item(wbr + (size_t)i * 512 * 1024, 1024, WSP(bf16, WS_WBR), 512, kb * 64, nb * 32, i * 1024 + nb * 32, scr, F.lane); continue; }
        r -= 3 * I_BR;
        { const int kb = r / 32, nb = r % 32; transpose_item(wout, 1024, WSP(bf16, WS_WOUT), 1024, kb * 64, nb * 32, nb * 32, scr, F.lane); }
    }
    {
        const int t = F.bid * 512 + F.tid;
        if (t < 65536) {
            const int jl = t & 63, rest = t >> 6, kc = rest & 127, rj = rest >> 7; const int row = rj * 64 + jl, g = row >> 7, j = row & 127;
            float a[8];
#pragma unroll
            for (int e = 0; e < 8; ++e) a[e] = 0.f;
            const float* wp = win + (size_t)(kc * 8) * INW + 2304 + g * 128;
            for (int c4 = 0; c4 < 32; ++c4) {
                float cs[4];
#pragma unroll
                for (int q = 0; q < 4; ++q) { const int idx = ((c4 * 4 + q) * j) & 127; float sn, co; sincospif((float)idx * (1.0f / 64.0f), &sn, &co); cs[q] = sn + co; }
#pragma unroll
                for (int e = 0; e < 8; ++e) { const f32x4 w = *(const f32x4*)(wp + (size_t)e * INW + c4 * 4); a[e] += w[0] * cs[0] + w[1] * cs[1] + w[2] * cs[2] + w[3] * cs[3]; }
            }
            v4u o; o.x = pk2(a[0], a[1]); o.y = pk2(a[2], a[3]); o.z = pk2(a[4], a[5]); o.w = pk2(a[6], a[7]);
            *(v4u*)(WSP(bf16, WS_WC) + (size_t)row * 1024 + kc * 8) = o;
        }
    }
}
__device__ __forceinline__ void make_cas(Frame& F) {
    const int t0 = F.bid * 512 + F.tid, NT_ = F.G * 512;
    for (int it = t0; it < HN * HN / 8; it += NT_) { const int k = it >> 9, n0 = (it & 511) * 8; float v[8];
#pragma unroll
        for (int e = 0; e < 8; ++e) { const int idx = (k * (n0 + e)) & (HN - 1); float sn, co; sincospif((float)idx * (2.0f / HN), &sn, &co); v[e] = sn + co; }
        v4u o; o.x = pk2(v[0], v[1]); o.y = pk2(v[2], v[3]); o.z = pk2(v[4], v[5]); o.w = pk2(v[6], v[7]);
        *(v4u*)(WSP(bf16, WS_CAS) + (size_t)k * HN + n0) = o; }
    for (int it = t0; it < 256 * 256 / 8; it += NT_) { const int k = it >> 5, n0 = (it & 31) * 8; float v[8];
#pragma unroll
        for (int e = 0; e < 8; ++e) { const int idx = (k * (n0 + e)) & 255; float sn, co; sincospif((float)idx * (1.0f / 128.0f), &sn, &co); v[e] = sn + co; }
        v4u o; o.x = pk2(v[0], v[1]); o.y = pk2(v[2], v[3]); o.z = pk2(v[4], v[5]); o.w = pk2(v[6], v[7]);
        *(v4u*)(WSP(bf16, WS_CAS256) + (size_t)k * 256 + n0) = o; }
}
__device__ __forceinline__ void make_mod(Frame& F) {
    LAS float* red = (LAS float*)F.lds;
    for (int item = F.bid; item < 288; item += F.G) {
        const int l = item / 144, cb = item % 144;
        const int c4 = F.lane & 15, ks = F.lane >> 4, slice = F.wave * 4 + ks;
        const float* W = F.w_ada + (size_t)l * 1024 * MODW + cb * 64 + c4 * 4;
        f32x4 a0 = {0.f, 0.f, 0.f, 0.f}, a1 = a0, a2 = a0;
        for (int r = 0; r < 32; ++r) { const int k = slice * 32 + r; const f32x4 w = *(const f32x4*)(W + (size_t)k * MODW);
            const float s0 = siluf(F.c[k]), s1 = siluf(F.c[1024 + k]), s2 = siluf(F.cctx[k]); a0 += w * s0; a1 += w * s1; a2 += w * s2; }
#pragma unroll
        for (int q = 0; q < 4; ++q) { red[(slice * 3 + 0) * 64 + c4 * 4 + q] = a0[q]; red[(slice * 3 + 1) * 64 + c4 * 4 + q] = a1[q]; red[(slice * 3 + 2) * 64 + c4 * 4 + q] = a2[q]; }
        __syncthreads();
        if (F.tid < 192) { const int set = F.tid >> 6, col = F.tid & 63; float s = 0.f;
            for (int sl = 0; sl < 32; ++sl) s += red[(sl * 3 + set) * 64 + col];
            WSP(float, WS_MOD)[((size_t)l * 3 + set) * MODW + cb * 64 + col] = s + F.b_ada[(size_t)l * MODW + cb * 64 + col]; }
        __syncthreads();
    }
}
__device__ __forceinline__ const float* hrow_ptr(const float* lat, const float* ctxp, int row, int& set) {
    const int b = row / RPB, w = row % RPB;
    if (w < CTXL) { set = 2; return ctxp + ((size_t)b * CTXL + w) * 1024; }
    set = b; return lat + ((size_t)b * SEQL + (w - CTXL)) * 1024;
}
__device__ __forceinline__ void norm_mod(Frame& F, const float* lat, const float* ctxp, const float* g, const float* modl  , int ishift, float* copy_ctx, const float* parts, int nparts) {
    const int gw = F.bid * NWAVES + F.wave, NGW = F.G * NWAVES;
    constexpr int NR = 3;
    for (int row0 = gw; row0 < MROWS; row0 += NR * NGW) {
        f32x4 v[NR][4]; int set[NR]; const float* hr[NR]; bool ok[NR]; float ss[NR];
#pragma unroll
        for (int r = 0; r < NR; ++r) { const int row = row0 + r * NGW; ok[r] = row < MROWS; hr[r] = hrow_ptr(lat, ctxp, ok[r] ? row : gw, set[r]);
#pragma unroll
            for (int j = 0; j < 4; ++j) v[r][j] = *((const f32x4*)hr[r] + F.lane + 64 * j); }
#pragma unroll
        for (int r = 0; r < NR; ++r) {
            if (set[r] == 2 && parts != nullptr) { const float* pr = parts + (hr[r] - ctxp);
                for (int p = 0; p < nparts; ++p) {
#pragma unroll
                    for (int j = 0; j < 4; ++j) v[r][j] += *((const f32x4*)(pr + (size_t)p * 512 * 1024) + F.lane + 64 * j); } }
            float s = 0.f;
#pragma unroll
            for (int j = 0; j < 4; ++j) s += (v[r][j][0] * v[r][j][0] + v[r][j][1] * v[r][j][1]) + (v[r][j][2] * v[r][j][2] + v[r][j][3] * v[r][j][3]);
            ss[r] = s; }
#pragma unroll
        for (int o = 1; o < 64; o <<= 1) {
#pragma unroll
            for (int r = 0; r < NR; ++r) ss[r] += shfl_xor(ss[r], o); }
#pragma unroll
        for (int r = 0; r < NR; ++r) if (ok[r]) {
            const int row = row0 + r * NGW;
            const float rstd = 1.0f / sqrtf(ss[r] * (1.0f / 1024.0f) + EPSN);
            const float* sh = modl + (size_t)set[r] * MODW + ishift * 1024; const float* sc = sh + 1024;
            if (copy_ctx != nullptr && set[r] == 2) { f32x4* cp = (f32x4*)(copy_ctx + (hr[r] - ctxp)) + F.lane;
#pragma unroll
                for (int j = 0; j < 4; ++j) cp[64 * j] = v[r][j]; }
            unsigned long long* o8 = (unsigned long long*)(WSP(bf16, WS_HN) + (size_t)row * 1024) + F.lane;
#pragma unroll
            for (int j = 0; j < 4; ++j) { const f32x4 gg = *((const f32x4*)g + F.lane + 64 * j), s1 = *((const f32x4*)sc + F.lane + 64 * j), s0 = *((const f32x4*)sh + F.lane + 64 * j);
                const f32x4 y = v[r][j] * rstd * gg * (s1 + 1.0f) + s0;
                o8[64 * j] = (unsigned long long)pk2(y[0], y[1]) | ((unsigned long long)pk2(y[2], y[3]) << 32); }
        }
    }
}
__device__ __forceinline__ void make_rope(Frame& F) {
    const int t0 = F.bid * 512 + F.tid, NT_ = F.G * 512;
    float* ct = WSP(float, WS_ROPE); float* st = ct + SEQL * 32;
    for (int it = t0; it < SEQL * 32; it += NT_) { const int s = it >> 5, i = it & 31;
        const float inv = exp2f(-(float)(i & 15) * (13.287712379549449f / 16.0f));
        const float pos = (float)((i < 16) ? (s >> 6) : (s & 63)); float sn, cs; sincosf(pos * inv, &sn, &cs); ct[it] = cs; st[it] = sn; }
}
__device__ __forceinline__ void qk_rope(Frame& F, int l) {
    const int gw = F.bid * NWAVES + F.wave, NGW = F.G * NWAVES;
    const float* qg = F.qk_g + (size_t)l * 256;
    const float* ct = WSP(float, WS_ROPE); const float* st = ct + SEQL * 32;
    const int c = F.lane & 3;
    int col[2], gsel[2]; bool isq[2], act[2];
#pragma unroll
    for (int pass = 0; pass < 2; ++pass) { const int q = pass * 64 + F.lane; act[pass] = q < 104; const int hv = act[pass] ? (q >> 2) : 0;
        if (hv < 8) { col[pass] = ZQA + hv * 64; gsel[pass] = 0; isq[pass] = true; } else if (hv < 10) { col[pass] = ZKA + (hv - 8) * 64; gsel[pass] = 1; isq[pass] = false; }
        else if (hv < 18) { col[pass] = ZQB + (hv - 10) * 64; gsel[pass] = 2; isq[pass] = true; } else { col[pass] = ZKB + (hv - 18) * 64; gsel[pass] = 3; isq[pass] = false; } }
    for (int row0 = gw; row0 < MROWS; row0 += 2 * NGW) {
        v4u lo[2][2], hi[2][2];
#pragma unroll
        for (int rr = 0; rr < 2; ++rr) { const int row = row0 + rr * NGW; const bf16* zr = WSP(bf16, WS_Z) + (size_t)(row < MROWS ? row : gw) * ZW;
#pragma unroll
            for (int pass = 0; pass < 2; ++pass) { lo[rr][pass] = *(const v4u*)(zr + col[pass] + 8 * c); hi[rr][pass] = *(const v4u*)(zr + col[pass] + 32 + 8 * c); } }
#pragma unroll
        for (int rr = 0; rr < 2; ++rr) { const int row = row0 + rr * NGW; const bool ok = row < MROWS; const int w = (ok ? row : gw) % RPB; bf16* zr = WSP(bf16, WS_Z) + (size_t)(ok ? row : gw) * ZW;
#pragma unroll
            for (int pass = 0; pass < 2; ++pass) {
                const v4u lo_ = lo[rr][pass], hi_ = hi[rr][pass];
                float x1[8], x2[8];
                x1[0] = bflo(lo_.x); x1[1] = bfhi(lo_.x); x1[2] = bflo(lo_.y); x1[3] = bfhi(lo_.y); x1[4] = bflo(lo_.z); x1[5] = bfhi(lo_.z); x1[6] = bflo(lo_.w); x1[7] = bfhi(lo_.w);
                x2[0] = bflo(hi_.x); x2[1] = bfhi(hi_.x); x2[2] = bflo(hi_.y); x2[3] = bfhi(hi_.y); x2[4] = bflo(hi_.z); x2[5] = bfhi(hi_.z); x2[6] = bflo(hi_.w); x2[7] = bfhi(hi_.w);
                float ss = 0.f;
#pragma unroll
                for (int e = 0; e < 8; ++e) ss += x1[e] * x1[e] + x2[e] * x2[e];
                ss += shfl_xor(ss, 1); ss += shfl_xor(ss, 2);
                const float rstd = 1.0f / sqrtf(ss * (1.0f / 64.0f) + EPSN);
                const float sc = isq[pass] ? attn_body::C2 : 1.0f;
                const float* gq = qg + gsel[pass] * 64 + 8 * c;
                const f32x4 ga = *(const f32x4*)(gq), gb = *(const f32x4*)(gq + 4), gc = *(const f32x4*)(gq + 32), gd = *(const f32x4*)(gq + 36);
                f32x4 ca = {1.f, 1.f, 1.f, 1.f}, cb = ca, sa = {0.f, 0.f, 0.f, 0.f}, sb = sa;
                if (w >= CTXL) { const int s = w - CTXL; ca = *(const f32x4*)(ct + s * 32 + 8 * c); cb = *(const f32x4*)(ct + s * 32 + 8 * c + 4); sa = *(const f32x4*)(st + s * 32 + 8 * c); sb = *(const f32x4*)(st + s * 32 + 8 * c + 4); }
                float o1[8], o2[8];
#pragma unroll
                for (int e = 0; e < 8; ++e) { const float g1 = e < 4 ? ga[e & 3] : gb[e & 3], g2 = e < 4 ? gc[e & 3] : gd[e & 3], cs = e < 4 ? ca[e & 3] : cb[e & 3], sn = e < 4 ? sa[e & 3] : sb[e & 3];
                    const float y1 = x1[e] * rstd * g1, y2 = x2[e] * rstd * g2; o1[e] = (y1 * cs - y2 * sn) * sc; o2[e] = (y1 * sn + y2 * cs) * sc; }
                if (act[pass] && ok) { v4u a, b2; a.x = pk2(o1[0], o1[1]); a.y = pk2(o1[2], o1[3]); a.z = pk2(o1[4], o1[5]); a.w = pk2(o1[6], o1[7]);
                    b2.x = pk2(o2[0], o2[1]); b2.y = pk2(o2[2], o2[3]); b2.z = pk2(o2[4], o2[5]); b2.w = pk2(o2[6], o2[7]);
                    *(v4u*)(zr + col[pass] + 8 * c) = a; *(v4u*)(zr + col[pass] + 32 + 8 * c) = b2; }
            }
        }
    }
}
__device__ __forceinline__ void make_pq(Frame& F) {
    const int t0 = F.bid * 512 + F.tid, NT_ = F.G * 512;
    const bf16* T1 = WSP(bf16, WS_T1T); bf16* PQ = WSP(bf16, WS_PQ);
    for (int it0 = t0; it0 < 2 * 512 * HN; it0 += 4 * NT_) {
        float x0[4], x1[4], y0[4], y1[4];
#pragma unroll
        for (int u = 0; u < 4; ++u) { const int it = it0 + u * NT_; const int itc = it < 2 * 512 * HN ? it : t0;
            const int n = itc & (HN - 1), col = (itc >> 12) & 511, b = itc >> 21; const bf16* xr = T1 + (size_t)col * MROWS + b * RPB + CTXL; const int nm = (HN - n) & (HN - 1);
            x0[u] = bf2f(xr[n]); x1[u] = bf2f(xr[n + HN]); y0[u] = bf2f(xr[nm]); y1[u] = bf2f(xr[nm + HN]); }
#pragma unroll
        for (int u = 0; u < 4; ++u) { const int it = it0 + u * NT_; if (it < 2 * 512 * HN) {
            const int n = it & (HN - 1), col = (it >> 12) & 511, b = it >> 21; const int nm = (HN - n) & (HN - 1);
            float sn, co, snm, com; sincospif((float)n * (1.0f / HN), &sn, &co); sincospif((float)nm * (1.0f / HN), &snm, &com);
            const float p = x0[u] + x1[u], q = (x0[u] - x1[u]) * co + (y0[u] - y1[u]) * snm;
            PQ[((size_t)(b * 2 + 0) * 512 + col) * HN + n] = (bf16)(pk2(p, 0.f) & 0xffffu);
            PQ[((size_t)(b * 2 + 1) * 512 + col) * HN + n] = (bf16)(pk2(q, 0.f) & 0xffffu); } }
    }
}
__device__ __forceinline__ void post_mix(Frame& F, int l) {
    const int gw = F.bid * NWAVES + F.wave, NGW = F.G * NWAVES;
    const float lam_init = 0.8f - 0.6f * expf(-0.3f * (float)l);
    const float* dl = F.diff_lam + (size_t)l * 256;
    const float s1 = wave_sum(dl[F.lane] * dl[64 + F.lane]), s2 = wave_sum(dl[128 + F.lane] * dl[192 + F.lane]);
    const float lam = expf(s1) - expf(s2) + lam_init;
    const float* sg = F.subln_g + (size_t)l * 128 + (F.lane & 15) * 8;
    float gsc[8];
#pragma unroll
    for (int e = 0; e < 8; ++e) gsc[e] = sg[e] * (1.0f - lam_init);
    const bf16* OB = WSP(bf16, WS_HN); const bf16* T2 = WSP(bf16, WS_T2); bf16* Z = WSP(bf16, WS_Z);
    for (int row = gw; row < MROWS; row += NGW) {
        const int b = row / RPB, w = row % RPB;
        {
            const v4u a = *(const v4u*)(OB + (size_t)row * 1024 + F.lane * 8), c2 = *(const v4u*)(OB + (size_t)row * 1024 + 512 + F.lane * 8);
            float d[8];
            d[0] = bflo(a.x) - lam * bflo(c2.x); d[1] = bfhi(a.x) - lam * bfhi(c2.x); d[2] = bflo(a.y) - lam * bflo(c2.y); d[3] = bfhi(a.y) - lam * bfhi(c2.y);
            d[4] = bflo(a.z) - lam * bflo(c2.z); d[5] = bfhi(a.z) - lam * bfhi(c2.z); d[6] = bflo(a.w) - lam * bflo(c2.w); d[7] = bfhi(a.w) - lam * bfhi(c2.w);
            float ss = 0.f;
#pragma unroll
            for (int e = 0; e < 8; ++e) ss += d[e] * d[e];
#pragma unroll
            for (int o = 1; o < 16; o <<= 1) ss += shfl_xor(ss, o);
            const float rstd = 1.0f / sqrtf(ss * (1.0f / 128.0f) + EPSN);
            v4u o; o.x = pk2(d[0] * rstd * gsc[0], d[1] * rstd * gsc[1]); o.y = pk2(d[2] * rstd * gsc[2], d[3] * rstd * gsc[3]);
            o.z = pk2(d[4] * rstd * gsc[4], d[5] * rstd * gsc[5]); o.w = pk2(d[6] * rstd * gsc[6], d[7] * rstd * gsc[7]);
            *(v4u*)(Z + (size_t)row * ZW + ZQB + F.lane * 8) = o;
        }
        {
            int mrow; float sc;
            if (w < CTXL) { mrow = b * RPB + ((CTXL - w) & (CTXL - 1)); sc = 0.5f * 0.005524271728019903f; }
            else { const int s = w - CTXL; mrow = b * RPB + CTXL + ((SEQL - s) & (SEQL - 1)); sc = 1.0f / 2048.0f; }
            const int g = F.lane >> 4, j0 = (F.lane & 15) * 8;
            const bf16* rk = T2 + (size_t)row * 512 + g * 128; v4u mv = *(const v4u*)(T2 + (size_t)mrow * 512 + g * 128 + j0);
            float r[8], mm_[8];
#pragma unroll
            for (int e = 0; e < 8; ++e) r[e] = bf2f(rk[(128 - (j0 + e)) & 127]);
            mm_[0] = bflo(mv.x); mm_[1] = bfhi(mv.x); mm_[2] = bflo(mv.y); mm_[3] = bfhi(mv.y); mm_[4] = bflo(mv.z); mm_[5] = bfhi(mv.z); mm_[6] = bflo(mv.w); mm_[7] = bfhi(mv.w);
            if (w >= CTXL) { const bf16* T2B = WSP(bf16, WS_T2B); const bf16* rk2 = T2B + (size_t)row * 512 + g * 128; mv = *(const v4u*)(T2B + (size_t)mrow * 512 + g * 128 + j0);
#pragma unroll
                for (int e = 0; e < 8; ++e) r[e] += bf2f(rk2[(128 - (j0 + e)) & 127]);
                mm_[0] += bflo(mv.x); mm_[1] += bfhi(mv.x); mm_[2] += bflo(mv.y); mm_[3] += bfhi(mv.y); mm_[4] += bflo(mv.z); mm_[5] += bfhi(mv.z); mm_[6] += bflo(mv.w); mm_[7] += bfhi(mv.w); }
            v4u o; o.x = pk2((r[0] + mm_[0]) * sc, (r[1] + mm_[1]) * sc); o.y = pk2((r[2] + mm_[2]) * sc, (r[3] + mm_[3]) * sc);
            o.z = pk2((r[4] + mm_[4]) * sc, (r[5] + mm_[5]) * sc); o.w = pk2((r[6] + mm_[6]) * sc, (r[7] + mm_[7]) * sc);
            *(v4u*)(Z + (size_t)row * ZW + ZKB + F.lane * 8) = o;
        }
    }
}
__device__ __forceinline__ void hartley_ctx(Frame& F) {
    for (int r = F.bid; r < 4; r += F.G) { const int b = r >> 1;
        pg8::Gemm g{WSP(bf16, WS_CAS256), WSP(bf16, WS_T1T) + (size_t)b * RPB, 256, 512, 256, 256, MROWS};
        pg8::OneUnit S{0, r & 1};
        pg8::EpiStore E{WSP(bf16, WS_T2), 512, 1 << 30, b * RPB, 1};
        pg8::gemm_phase<pg8::EpiStore, pg8::OneUnit, true, true, 256, 256, MROWS>(F.lds, g, S, E); }
}
__device__ __forceinline__ void mixer_phase(Frame& F, int l) {
    constexpr int NAL = NBATCH * 16 * 32, NHL = 256, NAC = NBATCH * 16;
    const int TOTAL = (l == NLAYER - 1) ? NAL + NHL : NAL + NHL + NAC;
    unsigned* qctr = F.ctl + CW_Q + 64 * l;
    bf16* Z = WSP(bf16, WS_Z);
    for (;;) {
        if (F.tid == 0) F.MISC[0] = __hip_atomic_fetch_add(qctr, 1u, __ATOMIC_RELAXED, __HIP_MEMORY_SCOPE_AGENT);
        __syncthreads();
        const int it = (int)F.MISC[0];
        __syncthreads();
        if (it >= TOTAL) break;
        if (it >= NAL && it < NAL + NHL) {
            int r = it - NAL; const int kh = r & 1; r >>= 1; const int b = r >> 6, r6 = r & 63, par = r6 >> 5, r2 = r6 & 31;
            pg8::Gemm g{WSP(bf16, WS_CAS) + kh * (HN / 2), WSP(bf16, WS_PQ) + (size_t)(b * 2 + par) * 512 * HN + kh * (HN / 2), HN, 512, HN / 2, HN, HN};
            pg8::OneUnit S{r2 >> 1, r2 & 1};
            pg8::EpiStore E{WSP(bf16, kh ? WS_T2B : WS_T2), 512, 1 << 30, b * RPB + CTXL + par, 2};
            pg8::gemm_phase<pg8::EpiStore, pg8::OneUnit, true, true, HN / 2, HN, HN>(F.lds, g, S, E);
        } else {
            int b, j, qrow, nt; bool big;
            if (it < NAL) { const int r = it & 511; big = it < 512; const int qb = r & 31; j = (r >> 5) & 7; b = r >> 8; qrow = b * RPB + CTXL + qb * 256; nt = RPB / 64; }
            else { const int r = it - NAL - NHL; big = r < 16; j = r & 7; b = (r >> 3) & 1; qrow = b * RPB; nt = CTXL / 64; }
            const size_t kv0 = (size_t)b * RPB;
            if (big) { const int h = j >> 1, mm = j & 1;
                const bf16* Qp = Z + ZQB + (h * 2 + mm) * 64; const bf16* Kp = Z + ZKB + (h * 2 + mm) * 64; const bf16* Vp = Z + ZVB + h * 128; bf16* Op = WSP(bf16, WS_HN) + mm * 512 + h * 128;
                attn_body::attn_unit128<8>((const attn_body::bf16*)(Qp + (size_t)qrow * ZW), ZW, (const attn_body::bf16*)(Kp + kv0 * ZW), ZW, (const attn_body::bf16*)(Vp + kv0 * ZW), ZW,
                                           (attn_body::bf16*)(Op + (size_t)qrow * 1024), 1024, nt, (char*)F.lds);
            } else {
                const bf16* Qp = Z + ZQA + j * 64; const bf16* Kp = Z + ZKA + (j >> 2) * 64; const bf16* Vp = Z + ZVA + (j >> 2) * 64; bf16* Op = Z + ZQA + j * 64;
                attn_body::attn_unit<8>((const attn_body::bf16*)(Qp + (size_t)qrow * ZW), ZW, (const attn_body::bf16*)(Kp + kv0 * ZW), ZW, (const attn_body::bf16*)(Vp + kv0 * ZW), ZW,
                                        (attn_body::bf16*)(Op + (size_t)qrow * ZW), ZW, nt, (char*)F.lds);
            }
        }
    }
}

#ifndef MK_PER_PHASE
#define MK_PER_PHASE 0
#endif
constexpr int NPHASE = 1 + 13 * NLAYER;
struct Args { const float* in[15]; float* out; unsigned char* ws; int ph_lo, ph_hi; };
__device__ __forceinline__ void load_frame(Frame& F) {
    const __attribute__((address_space(4))) Args* a = (const __attribute__((address_space(4))) Args*)__builtin_amdgcn_kernarg_segment_ptr();
    asm volatile("" : "+s"(a));
    extern __shared__ __attribute__((aligned(16))) unsigned char lds_raw[];
    F.lds = (LAS unsigned char*)lds_raw; F.MISC = (volatile LAS unsigned*)(F.lds + MISC_OFF);
    int t = my_tid(); asm volatile("" : "+v"(t));
    F.tid = t; F.lane = t & 63; F.wave = __builtin_amdgcn_readfirstlane(t >> 6); F.G = gridDim.x; F.bid = blockIdx.x;
    F.x = a->in[0]; F.c = a->in[1]; F.ctx = a->in[2]; F.cctx = a->in[3]; F.w_ada = a->in[4]; F.b_ada = a->in[5]; F.norm_g = a->in[6]; F.ffn_wi = a->in[7];
    F.ffn_wo = a->in[8]; F.w_in = a->in[9]; F.qk_g = a->in[10]; F.diff_lam = a->in[11]; F.subln_g = a->in[12]; F.w_branch = a->in[13]; F.w_out = a->in[14];
    F.out = a->out; F.ws = a->ws; F.ctl = (unsigned*)(a->ws + WS_CTL);
}
#ifndef MK_MASK
#define MK_MASK 0xffffffffu
#endif
#define EN(j) (((MK_MASK) >> (j)) & 1u)
#ifndef MK_DUP
#define MK_DUP 0
#endif
#define DUP(b) for (int rep_ = 0; rep_ < (((MK_DUP) >> (b)) & 1) + 1; ++rep_)
__device__ __forceinline__ void seam_barrier() {
    const __attribute__((address_space(4))) Args* a = (const __attribute__((address_space(4))) Args*)__builtin_amdgcn_kernarg_segment_ptr();
    asm volatile("" : "+s"(a));
    extern __shared__ __attribute__((aligned(16))) unsigned char lds_raw[];
    XcdBarrier b; b.bar = (unsigned*)(a->ws + WS_CTL) + CW_BAR; b.x = xb_xcc_id(); b.st = (volatile LAS unsigned*)((LAS unsigned char*)lds_raw + MISC_OFF) + 8;
    xcd_barrier(b);
}
#define LF() Frame F; load_frame(F); float* hlat = F.out; float* hctx = WSP(float, WS_HC); const float* modl = WSP(float, WS_MOD) + (size_t)l * 3 * MODW; const float* ng = F.norm_g + (size_t)l * 3 * 1024; \
    const float* slat = (l == 0) ? F.x : hlat; const float* sctx = (l == 0) ? F.ctx : hctx; (void)hlat; (void)hctx; (void)modl; (void)ng; (void)slat; (void)sctx
__global__ void __launch_bounds__(NWAVES * 64, 2) mk_fwd(Args args) {
    cg::grid_group grid = cg::this_grid();
    const int lo = args.ph_lo, hi = args.ph_hi;
    {
        extern __shared__ __attribute__((aligned(16))) unsigned char lds_raw[];
        volatile LAS unsigned* misc = (volatile LAS unsigned*)((LAS unsigned char*)lds_raw + MISC_OFF);
        const int t0 = threadIdx.x;
        if (t0 < 32) misc[t0] = 0u;
        if ((t0 & 63) == 0) ((volatile LAS int*)((LAS unsigned char*)lds_raw + WTAB_OFF))[hw_slot()] = t0 >> 6;
        __syncthreads();
        if (hi - lo > 1) (void)xcd_barrier_post((unsigned*)(args.ws + WS_CTL) + CW_BAR, misc + 8);
    }
#define IN(k) (lo <= (k) && (k) < hi)
    if (lo < 0) grid.sync();
#define SEAM(k) do { if (IN(k) && IN((k) + 1)) { seam_barrier(); } } while (0)
    if (EN(0) && IN(0)) { const int l = 0; LF(); DUP(4) { make_mod(F); convert_weights(F, 0); make_cas(F); make_rope(F); } }
    SEAM(0);
    for (int l = 0; l < NLAYER; ++l) {
        const int p0 = 1 + 13 * l;
        if (EN(1) && IN(p0 + 0)) { LF(); if (l > 0) DUP(4) convert_weights(F, l); norm_mod(F, slat, sctx, ng, modl, 0, hctx, (l == 0) ? nullptr : WSP(float, WS_PART), DFF / 256); }
        SEAM(p0 + 0);
        if (EN(2) && IN(p0 + 1)) { LF(); pg8::Gemm g{WSP(bf16, WS_HN), WSP(bf16, WS_WUP0), MROWS, NUP, 1024, 1024, 1024}; pg8::StaticOrder S; S.init(MROWS, NUP, F.G, F.bid);
            pg8::EpiSwiGLU E{WSP(bf16, WS_Z), DFF}; DUP(1) pg8::gemm_phase<pg8::EpiSwiGLU, pg8::StaticOrder, true, true, 1024, 1024, 1024>(F.lds, g, S, E); }
        SEAM(p0 + 1);
        if (EN(3) && IN(p0 + 2)) { LF();
            { pg8::Gemm g{WSP(bf16, WS_Z), WSP(bf16, WS_WDN0), MROWS, 1024, DFF, DFF, DFF}; pg8::LatOrder S; S.init(1024, F.G, F.bid);
              pg8::EpiResid E{slat, sctx, hlat, hctx, modl + 2 * 1024, 0.5f}; for (int rep_ = 0; rep_ < ((((MK_DUP) >> 7) & 1) && l == 0 ? 4 : 1); ++rep_) pg8::gemm_phase<pg8::EpiResid, pg8::LatOrder, true, true, DFF, DFF, DFF>(F.lds, g, S, E); }
            { pg8::Gemm g{WSP(bf16, WS_Z), WSP(bf16, WS_WDN0), MROWS, 1024, 256, DFF, DFF}; pg8::CtxSplit S{F.G, F.G - 1 - F.bid, DFF / 256};
              pg8::EpiResidA E{WSP(float, WS_PART), modl + 2 * MODW + 2 * 1024, 0.5f}; pg8::gemm_phase<pg8::EpiResidA, pg8::CtxSplit, true, true, 256, DFF, DFF>(F.lds, g, S, E); } }
        SEAM(p0 + 2);
        if (EN(4) && IN(p0 + 3)) { LF(); norm_mod(F, hlat, hctx, ng + 1024, modl, 3, hctx, WSP(float, WS_PART), DFF / 256); }
        SEAM(p0 + 3);
        if (EN(5) && IN(p0 + 4)) { LF();
            { pg8::Gemm g{WSP(bf16, WS_HN), WSP(bf16, WS_WIN), MROWS, ZW, 1024, 1024, 1024}; pg8::StaticOrder S; S.init(MROWS, ZW, F.G, F.bid);
              pg8::EpiStore E{WSP(bf16, WS_Z), ZW, ZGATE, 0, 1}; DUP(5) pg8::gemm_phase<pg8::EpiStore, pg8::StaticOrder, true, true, 1024, 1024, 1024>(F.lds, g, S, E); }
            { pg8::Gemm g{WSP(bf16, WS_WC), WSP(bf16, WS_HN), 512, MROWS, 1024, 1024, 1024}; pg8::StaticOrder S; S.init(512, MROWS, F.G, F.G - 1 - F.bid);
              pg8::EpiStore E{WSP(bf16, WS_T1T), MROWS, 1 << 30, 0, 1}; DUP(5) pg8::gemm_phase<pg8::EpiStore, pg8::StaticOrder, true, true, 1024, 1024, 1024>(F.lds, g, S, E); }
        }
        SEAM(p0 + 4);
        if (EN(6) && IN(p0 + 5)) { LF(); qk_rope(F, l); make_pq(F); if (l < NLAYER - 1) hartley_ctx(F); }
        SEAM(p0 + 5);
        if (EN(7) && IN(p0 + 6)) { LF(); mixer_phase(F, l); }
        SEAM(p0 + 6);
        if (EN(8) && IN(p0 + 7)) { LF(); post_mix(F, l); }
        SEAM(p0 + 7);
        if (EN(9) && IN(p0 + 8)) { LF(); pg8::Gemm g{WSP(bf16, WS_Z), WSP(bf16, WS_WBR), MROWS, 3072, 512, ZW, 512}; pg8::MergeOrder S{F.G, F.bid, l == NLAYER - 1};
            pg8::EpiMerge E{WSP(bf16, WS_Z), WSP(bf16, WS_HN)}; DUP(6) pg8::gemm_phase<pg8::EpiMerge, pg8::MergeOrder, true, true, 512, ZW, 512>(F.lds, g, S, E); }
        SEAM(p0 + 8);
        if (EN(10) && IN(p0 + 9)) { LF();
            { pg8::Gemm g{WSP(bf16, WS_HN), WSP(bf16, WS_WOUT), MROWS, 1024, 1024, 1024, 1024}; pg8::LatOrder S; S.init(1024, F.G, F.bid);
              pg8::EpiResid E{hlat, hctx, hlat, hctx, modl + 5 * 1024, 1.0f}; pg8::gemm_phase<pg8::EpiResid, pg8::LatOrder, true, true, 1024, 1024, 1024>(F.lds, g, S, E); }
            if (l < NLAYER - 1) { pg8::Gemm g{WSP(bf16, WS_HN), WSP(bf16, WS_WOUT), MROWS, 1024, 256, 1024, 1024}; pg8::CtxSplit S{F.G, F.G - 1 - F.bid, 4};
              pg8::EpiResidA E{WSP(float, WS_PART), modl + 2 * MODW + 5 * 1024, 1.0f}; pg8::gemm_phase<pg8::EpiResidA, pg8::CtxSplit, true, true, 256, 1024, 1024>(F.lds, g, S, E); } }
        SEAM(p0 + 9);
        if (EN(11) && IN(p0 + 10)) { LF(); norm_mod(F, hlat, hctx, ng + 2048, modl, 6, (l == 0) ? hctx : nullptr, (l == 0) ? WSP(float, WS_PART) : nullptr, 4); }
        SEAM(p0 + 10);
        if (EN(12) && IN(p0 + 11)) { LF(); pg8::Gemm g{WSP(bf16, WS_HN), WSP(bf16, WS_WUP1), MROWS, NUP, 1024, 1024, 1024}; pg8::StaticOrder S; S.init(MROWS, NUP, F.G, F.bid);
            pg8::EpiSwiGLU E{WSP(bf16, WS_Z), DFF}; DUP(1) pg8::gemm_phase<pg8::EpiSwiGLU, pg8::StaticOrder, true, true, 1024, 1024, 1024>(F.lds, g, S, E); }
        SEAM(p0 + 11);
        if (EN(13) && IN(p0 + 12)) { LF();
            { pg8::Gemm g{WSP(bf16, WS_Z), WSP(bf16, WS_WDN1), MROWS, 1024, DFF, DFF, DFF}; pg8::LatOrder S; S.init(1024, F.G, F.bid);
              pg8::EpiResid E{hlat, hctx, hlat, hctx, modl + 8 * 1024, 0.5f}; pg8::gemm_phase<pg8::EpiResid, pg8::LatOrder, true, true, DFF, DFF, DFF>(F.lds, g, S, E); }
            if (l < NLAYER - 1) { pg8::Gemm g{WSP(bf16, WS_Z), WSP(bf16, WS_WDN1), MROWS, 1024, 256, DFF, DFF}; pg8::CtxSplit S{F.G, F.G - 1 - F.bid, DFF / 256};
              pg8::EpiResidA E{WSP(float, WS_PART), modl + 2 * MODW + 8 * 1024, 0.5f}; pg8::gemm_phase<pg8::EpiResidA, pg8::CtxSplit, true, true, 256, DFF, DFF>(F.lds, g, S, E); } }
        SEAM(p0 + 12);
    }
#undef IN
#undef SEAM
}

extern "C" void kernel_launch(void* const* d_in, const int* in_sizes, int n_in, void* d_out, int out_size, void* d_ws, size_t ws_size, hipStream_t stream) {
    static int grid = 0;
    if (grid == 0) {
        if (n_in != 15 || ws_size < WS_END) { fprintf(stderr, "kernel_launch: need 15 inputs and >= %zu bytes of workspace; got n_in %d, ws %zu\n", (size_t)WS_END, n_in, ws_size); grid = -1; return; }
        int dev = 0, cus = 0, per_cu = 0;
        if (hipGetDevice(&dev) != hipSuccess || hipDeviceGetAttribute(&cus, hipDeviceAttributeMultiprocessorCount, dev) != hipSuccess) { grid = -1; return; }
        if (hipFuncSetAttribute((const void*)mk_fwd, hipFuncAttributeMaxDynamicSharedMemorySize, LDS_BYTES) != hipSuccess) { fprintf(stderr, "kernel_launch: hipFuncSetAttribute failed\n"); grid = -1; return; }
        if (hipOccupancyMaxActiveBlocksPerMultiprocessor(&per_cu, (const void*)mk_fwd, NWAVES * 64, LDS_BYTES) != hipSuccess || per_cu < 1) { fprintf(stderr, "kernel_launch: occupancy query says %d\n", per_cu); per_cu = 1; }
        (void)hipGetLastError();
        grid = cus * per_cu;
    }
    if (grid < 0) return;
    (void)hipMemsetAsync((char*)d_ws + WS_CTL, 0, CTL_ZERO_BYTES, stream);
    Args a{};
    for (int i = 0; i < 15; ++i) a.in[i] = (const float*)d_in[i];
    a.out = (float*)d_out; a.ws = (unsigned char*)d_ws;
#if MK_PER_PHASE
    for (int p = 0; p < NPHASE; ++p) { a.ph_lo = p; a.ph_hi = p + 1; hipLaunchKernelGGL(mk_fwd, dim3(grid), dim3(NWAVES * 64), LDS_BYTES, stream, a); }
#else
    a.ph_lo = 0; a.ph_hi = NPHASE;
    void* kargs[] = {&a};
    hipError_t e = hipLaunchCooperativeKernel((const void*)mk_fwd, dim3(grid), dim3(NWAVES * 64), kargs, LDS_BYTES, stream);
    if (e != hipSuccess) fprintf(stderr, "kernel_launch: cooperative launch failed: %s (grid %d)\n", hipGetErrorString(e), grid);
#endif
}
```

```cpp
#include <hip/hip_runtime.h>
#include <hip/hip_cooperative_groups.h>
#include <hip/hip_bf16.h>
#include <cstdio>
#include <cstdint>
#include <cmath>
namespace cg = cooperative_groups;

#define LAS __attribute__((address_space(3)))
constexpr int LDS_BYTES = 147456, MISC_OFF = 131072 + 320, WTAB_OFF = MISC_OFF + 128;
__device__ __forceinline__ int lane_id() { int l; asm volatile("v_mbcnt_lo_u32_b32 %0, -1, 0\n\tv_mbcnt_hi_u32_b32 %0, -1, %0" : "=&v"(l)); return l; }
__device__ __forceinline__ unsigned hw_slot() { return (unsigned)__builtin_amdgcn_s_getreg((5 << 11) | 4) & 63u; }
__device__ __forceinline__ int my_tid() {
    extern __shared__ __attribute__((aligned(16))) unsigned char lds_raw[];
    const int w = ((volatile LAS int*)((LAS unsigned char*)lds_raw + WTAB_OFF))[hw_slot()];
    return __builtin_amdgcn_readfirstlane(w) * 64 + lane_id();
}

namespace pg8 {
#define PG8_LAS __attribute__((address_space(3)))
typedef unsigned short bf16_t;
typedef short bf16x8 __attribute__((ext_vector_type(8)));
typedef float f32x4 __attribute__((ext_vector_type(4)));
typedef unsigned u32x4 __attribute__((ext_vector_type(4)));
constexpr int BM = 256, BK = 64, HALF = 128, HTB = HALF * BK * 2  , STAGE_BYTES = 8 * HTB, NXCD = 8, WGM = 8;

__host__ __device__ __forceinline__ int lds_byte(int r, int c) { const int st = (r >> 4) * 2 + (c >> 5), rr = r & 15, cc = c & 31, ob = rr * 64 + cc * 2; return st * 1024 + (ob ^ (((ob >> 9) & 1) << 5)); }
__host__ __device__ __forceinline__ void stage_rc(int b, int& R, int& C) { const int st = b / 1024, sb = b % 1024, swz = sb ^ (((sb >> 9) & 1) << 5); R = (st >> 1) * 16 + swz / 64; C = (st & 1) * 32 + (swz % 64) / 2; }
__host__ __device__ __forceinline__ int perm32(int rho) { const int n = rho >> 4, i = rho & 15; return 8 * (i >> 2) + 4 * n + (i & 3); }

struct Unit { int pm, pn, kp; };
struct Gemm { const bf16_t* A; const bf16_t* Bt; int M, N, K, lda, ldb; };

struct StaticOrder {
    int nM, nN, nwg, G, c;
    __host__ __device__ void init(int M, int N, int G_, int c_) { nM = M / BM; nN = N / BM; nwg = nM * nN; G = G_; c = c_; }
    __host__ __device__ bool next(int i, Unit& u) const {
        const long L = (long)i * G + c; if (L >= nwg) return false;
        int wgid = (int)L; { const int q = nwg / NXCD, r = nwg % NXCD, xcd = wgid % NXCD, off = wgid / NXCD; wgid = (xcd < r ? xcd * (q + 1) : r * (q + 1) + (xcd - r) * q) + off; }
        const int nig = WGM * nN, gid = wgid / nig, fm = gid * WGM, gsz = (nM - fm) < WGM ? (nM - fm) : WGM;
        u.pm = fm + ((wgid % nig) % gsz); u.pn = (wgid % nig) / gsz; return true;
    }
    __device__ __forceinline__ void a_ready(const Unit&) const {}
    __device__ __forceinline__ void done(const Unit&) const {}
    __device__ __forceinline__ size_t aoff(const Unit&) const { return 0; }
    __device__ __forceinline__ size_t boff(const Unit&) const { return 0; }
};


__device__ __forceinline__ unsigned cvt_pk_bf16(float lo, float hi) { unsigned r; asm volatile("v_cvt_pk_bf16_f32 %0, %1, %2" : "=v"(r) : "v"(lo), "v"(hi)); return r; }
typedef float f32x2 __attribute__((ext_vector_type(2)));

template <class Epi, class Sched, bool ALIGN_EPI, bool SP2, int TK, int TLDA, int TLDB, int KSA = 0, int TSA = 0, int KSB = 0, int TSB = 0>
__device__ __forceinline__ void gemm_phase(PG8_LAS unsigned char* lds, const Gemm g, const Sched& S, const Epi& E) {
    int tid_ = my_tid(); asm volatile("" : "+v"(tid_)); const int tid = tid_, wid = __builtin_amdgcn_readfirstlane(tid >> 6), lane = tid & 63, wr = wid >> 2, wc = wid & 3, fr = lane & 15, fq = lane >> 4;
    constexpr int K = TK, nt = K / BK;
    unsigned voffA[2], voffB[2];
#pragma unroll
    for (int i = 0; i < 2; ++i) { int R, C; stage_rc(tid * 16 + i * 8192, R, C); const int Rb = Epi::PERM ? ((R & ~31) + perm32(R & 31)) : R;
        voffA[i] = (unsigned)(R * TLDA + C) * 2u; voffB[i] = (unsigned)(Rb * TLDB + C) * 2u; }
    constexpr size_t kstepA = KSA ? (size_t)KSA : (size_t)(BK * 2), kstepB = KSB ? (size_t)KSB : (size_t)(BK * 2);
    const size_t hstepA = (size_t)HALF * TLDA * 2, hstepB = (size_t)HALF * TLDB * 2;
    const size_t tstepA = TSA ? (size_t)TSA : 2 * hstepA, tstepB = TSB ? (size_t)TSB : 2 * hstepB;
    const unsigned ldsw = (unsigned)wid * 1024u;
    const int aoff = lds_byte(wr * 64 + fr, fq * 8), boff = lds_byte(wc * 32 + fr, fq * 8);
#define PG8_SA(b, h) (((b) * 2 + (h)) * HTB)
#define PG8_SB(b, h) ((4 + (b) * 2 + (h)) * HTB)
#define PG8_STAGE(bufoff, gbase, voff) do { _Pragma("unroll") for (int _i = 0; _i < 2; ++_i) \
        __builtin_amdgcn_global_load_lds((const unsigned*)((const char*)(gbase) + (voff)[_i]), (PG8_LAS unsigned*)(lds + (bufoff) + ldsw + _i * 8192), 16, 0, 0); } while (0)
#define PG8_LDA(dst, b, h) do { _Pragma("unroll") for (int m = 0; m < 4; ++m) _Pragma("unroll") for (int k = 0; k < 2; ++k) dst[m][k] = *(const PG8_LAS bf16x8*)(lds + PG8_SA(b, h) + aoff + m * 2048 + k * 1024); } while (0)
#define PG8_LDB(dst, b, h) do { _Pragma("unroll") for (int n = 0; n < 2; ++n) _Pragma("unroll") for (int k = 0; k < 2; ++k) dst[n][k] = *(const PG8_LAS bf16x8*)(lds + PG8_SB(b, h) + boff + n * 2048 + k * 1024); } while (0)
#define PG8_MMA(ai, bj, At, Bt) do { __builtin_amdgcn_s_setprio(1); _Pragma("unroll") for (int m = 0; m < 4; ++m) _Pragma("unroll") for (int n = 0; n < 2; ++n) _Pragma("unroll") for (int k = 0; k < 2; ++k) \
        acc[ai][bj][m][n] = __builtin_amdgcn_mfma_f32_16x16x32_bf16(Bt[n][k], At[m][k], acc[ai][bj][m][n], 0, 0, 0); __builtin_amdgcn_s_setprio(0); } while (0)
#define PG8_WAIT_V(n) asm volatile("s_waitcnt vmcnt(" #n ")" ::: "memory")
#define PG8_WAIT_L(n) asm volatile("s_waitcnt lgkmcnt(" #n ")" ::: "memory")
#define PG8_BAR __builtin_amdgcn_s_barrier()
#define PG8_SCHED __builtin_amdgcn_sched_barrier(0)
    Unit cur, nxt; int ui = 0;
    if (!S.next(0, cur)) return;
    f32x4 acc[2][2][4][2];
#pragma unroll
    for (int a = 0; a < 2; ++a)
#pragma unroll
        for (int b = 0; b < 2; ++b)
#pragma unroll
            for (int m = 0; m < 4; ++m)
#pragma unroll
                for (int n = 0; n < 2; ++n) acc[a][b][m][n] = (f32x4){0.f, 0.f, 0.f, 0.f};
    bf16x8 At[4][2], B0[2][2], B1[2][2];
    const char* cA = (const char*)g.A + (size_t)cur.pm * tstepA + S.aoff(cur); const char* cB = (const char*)g.Bt + (size_t)cur.pn * tstepB + S.boff(cur);
    S.a_ready(cur);
    if constexpr (SP2) {
        PG8_STAGE(PG8_SB(0, 0), cB, voffB); PG8_STAGE(PG8_SB(0, 1), cB + hstepB, voffB); PG8_STAGE(PG8_SA(0, 0), cA, voffA); PG8_STAGE(PG8_SA(0, 1), cA + hstepA, voffA);
        if (wr == 1) PG8_BAR;
        PG8_WAIT_V(2); PG8_BAR;
        PG8_STAGE(PG8_SB(1, 0), cB + kstepB, voffB); PG8_STAGE(PG8_SA(1, 0), cA + kstepA, voffA); PG8_STAGE(PG8_SB(1, 1), cB + hstepB + kstepB, voffB);
        PG8_WAIT_V(6); PG8_BAR;
    } else {
        PG8_STAGE(PG8_SB(0, 0), cB, voffB); PG8_STAGE(PG8_SA(0, 0), cA, voffA); PG8_STAGE(PG8_SB(0, 1), cB + hstepB, voffB); PG8_STAGE(PG8_SA(0, 1), cA + hstepA, voffA);
        if (wr == 1) PG8_BAR;
        PG8_WAIT_V(4); PG8_BAR;
        PG8_STAGE(PG8_SB(1, 0), cB + kstepB, voffB); PG8_STAGE(PG8_SA(1, 0), cA + kstepA, voffA); PG8_STAGE(PG8_SB(1, 1), cB + hstepB + kstepB, voffB);
        PG8_WAIT_V(6); PG8_BAR;
    }
    for (;;) {
        const bool has_next = S.next(ui + 1, nxt);
        const char* nA = has_next ? (const char*)g.A + (size_t)nxt.pm * tstepA + S.aoff(nxt) : cA; const char* nB = has_next ? (const char*)g.Bt + (size_t)nxt.pn * tstepB + S.boff(nxt) : cB;
        for (int t = 0; t < nt; t += 2) {
            const bool last = (t == nt - 2);
            const char* a1 = cA + (size_t)(t + 1) * kstepA;
            const char* a2 = last ? nA : cA + (size_t)(t + 2) * kstepA; const char* b2 = last ? nB : cB + (size_t)(t + 2) * kstepB;
            const char* a3 = a2 + kstepA; const char* b3 = b2 + kstepB;
            if (last && has_next) S.a_ready(nxt);
            if constexpr (SP2) {
            PG8_LDB(B0, 0, 0); PG8_LDB(B1, 0, 1); PG8_SCHED; PG8_LDA(At, 0, 0); PG8_STAGE(PG8_SA(1, 1), a1 + hstepA, voffA);
            PG8_WAIT_V(8); PG8_WAIT_L(0); PG8_BAR; PG8_MMA(0, 0, At, B0); PG8_MMA(0, 1, At, B1); PG8_BAR; PG8_SCHED;
            PG8_LDA(At, 0, 1); PG8_STAGE(PG8_SB(0, 0), b2, voffB); PG8_STAGE(PG8_SB(0, 1), b2 + hstepB, voffB); PG8_STAGE(PG8_SA(0, 0), a2, voffA);
            PG8_WAIT_V(8); PG8_WAIT_L(0); PG8_BAR; PG8_MMA(1, 0, At, B0); PG8_MMA(1, 1, At, B1); PG8_BAR; PG8_SCHED;
            PG8_LDB(B0, 1, 0); PG8_LDB(B1, 1, 1); PG8_SCHED; PG8_LDA(At, 1, 0); PG8_STAGE(PG8_SA(0, 1), a2 + hstepA, voffA);
            PG8_WAIT_V(8); PG8_WAIT_L(0); PG8_BAR; PG8_MMA(0, 0, At, B0); PG8_MMA(0, 1, At, B1); PG8_BAR; PG8_SCHED;
            PG8_LDA(At, 1, 1); PG8_STAGE(PG8_SB(1, 0), b3, voffB); PG8_STAGE(PG8_SB(1, 1), b3 + hstepB, voffB); PG8_STAGE(PG8_SA(1, 0), a3, voffA);
            PG8_WAIT_V(8); PG8_WAIT_L(0); PG8_BAR; PG8_MMA(1, 0, At, B0); PG8_MMA(1, 1, At, B1); PG8_BAR; PG8_SCHED;
            } else {
            PG8_LDB(B0, 0, 0); PG8_SCHED; PG8_LDA(At, 0, 0); PG8_STAGE(PG8_SA(1, 1), a1 + hstepA, voffA);
            PG8_WAIT_L(8); PG8_BAR; PG8_WAIT_L(0); PG8_MMA(0, 0, At, B0); PG8_BAR; PG8_SCHED;
            PG8_LDB(B1, 0, 1); PG8_STAGE(PG8_SB(0, 0), b2, voffB);
            PG8_BAR; PG8_WAIT_L(0); PG8_MMA(0, 1, At, B1); PG8_BAR;
            PG8_LDA(At, 0, 1); PG8_STAGE(PG8_SA(0, 0), a2, voffA);
            PG8_BAR; PG8_WAIT_L(0); PG8_MMA(1, 0, At, B0); PG8_BAR; PG8_SCHED;
            PG8_STAGE(PG8_SB(0, 1), b2 + hstepB, voffB);
            PG8_WAIT_V(6); PG8_BAR; PG8_MMA(1, 1, At, B1); PG8_BAR;
            PG8_LDB(B0, 1, 0); PG8_SCHED; PG8_LDA(At, 1, 0); PG8_STAGE(PG8_SA(0, 1), a2 + hstepA, voffA);
            PG8_WAIT_L(8); PG8_BAR; PG8_WAIT_L(0); PG8_MMA(0, 0, At, B0); PG8_BAR; PG8_SCHED;
            PG8_LDB(B1, 1, 1); PG8_STAGE(PG8_SB(1, 0), b3, voffB);
            PG8_BAR; PG8_WAIT_L(0); PG8_MMA(0, 1, At, B1); PG8_BAR;
            PG8_LDA(At, 1, 1); PG8_STAGE(PG8_SA(1, 0), a3, voffA);
            PG8_BAR; PG8_WAIT_L(0); PG8_MMA(1, 0, At, B0); PG8_BAR; PG8_SCHED;
            PG8_STAGE(PG8_SB(1, 1), b3 + hstepB, voffB);
            PG8_WAIT_V(6); PG8_BAR; PG8_MMA(1, 1, At, B1); PG8_BAR;
            }
        }
        if constexpr (ALIGN_EPI) { if (wr == 0) PG8_BAR; }
        if constexpr (!Epi::AFTER_DRAIN) { E(acc, cur, wr, wc, fr, fq); S.done(cur); }
        if (!has_next) break;
#pragma unroll
        for (int a = 0; a < 2; ++a)
#pragma unroll
            for (int b = 0; b < 2; ++b)
#pragma unroll
                for (int m = 0; m < 4; ++m)
#pragma unroll
                    for (int n = 0; n < 2; ++n) acc[a][b][m][n] = (f32x4){0.f, 0.f, 0.f, 0.f};
        cur = nxt; cA = nA; cB = nB; ++ui;
        if constexpr (ALIGN_EPI) { if (wr == 1) PG8_BAR; }
    }
    PG8_WAIT_V(0);
    if constexpr (!ALIGN_EPI) { if (wr == 0) PG8_BAR; }
    PG8_BAR;
    if constexpr (Epi::AFTER_DRAIN) { E.fused(acc, cur, wr, wc, fr, fq, lds, wid, lane); S.done(cur); }
#undef PG8_SA
#undef PG8_SB
#undef PG8_STAGE
#undef PG8_LDA
#undef PG8_LDB
#undef PG8_MMA
#undef PG8_WAIT_V
#undef PG8_WAIT_L
#undef PG8_BAR
#undef PG8_SCHED
}
}


namespace attn_body {
using bf16=__hip_bfloat16;
using bf16x8=__attribute__((ext_vector_type(8)))short;
using s16x4=__attribute__((ext_vector_type(4)))short;
using f32x16=__attribute__((ext_vector_type(16)))float;
using u32x4=__attribute__((ext_vector_type(4)))unsigned;
constexpr int D=64;
constexpr int NW=8,QBLK=32,QB=QBLK*NW,KVBLK=64;
constexpr int ATTN_UNIT_ROWS=QB;
__device__ __forceinline__ int crow(int r,int hi){return (r&3)+8*(r>>2)+4*hi;}
#define SBAR() __builtin_amdgcn_sched_barrier(0)
constexpr int NSLOT=3, SLOTB=8192;
constexpr int LDS_K=0, LDS_V=NSLOT*SLOTB, LDS_WS=2*NSLOT*SLOTB, LDS_OST=LDS_WS+NW*64*4, LDS_BYTES=LDS_OST+NW*4096;
constexpr float C2=0.125f*1.4426950408889634f;
__device__ __forceinline__ void glds16(const void*gsrc,unsigned lds_dst){unsigned keep;
  asm volatile("s_mov_b32 %0, m0\n\ts_mov_b32 m0, %2\n\ts_nop 0\n\tglobal_load_lds_dwordx4 %1, off\n\ts_mov_b32 m0, %0":"=&s"(keep):"v"(gsrc),"s"(lds_dst):"memory");}
__device__ __forceinline__ float max3f(float a,float b,float c){float r;asm("v_max3_f32 %0, %1, %2, %3":"=v"(r):"v"(a),"v"(b),"v"(c));return r;}
__device__ __forceinline__ float max2f(float a,float b){float r;asm("v_max_f32_e32 %0, %1, %2":"=v"(r):"v"(a),"v"(b));return r;}
__device__ __forceinline__ float fadd_s(float a,float b){float r;asm("v_add_f32_e32 %0, %1, %2":"=v"(r):"v"(a),"v"(b));return r;}
__device__ __forceinline__ float fsub_s(float a,float b){float r;asm("v_sub_f32_e32 %0, %1, %2":"=v"(r):"v"(a),"v"(b));return r;}
typedef float f32x2_t __attribute__((ext_vector_type(2))); typedef __bf16 bf16x2_t __attribute__((ext_vector_type(2)));
__device__ __forceinline__ unsigned cvtpk_s(float lo,float hi){f32x2_t v={lo,hi};bf16x2_t b=__builtin_convertvector(v,bf16x2_t);return __builtin_bit_cast(unsigned,b);}
#define WAIT_BAR(N) asm volatile("s_waitcnt vmcnt(" #N ") lgkmcnt(0)\n\ts_barrier":::"memory")

__device__ __forceinline__ void qkt(f32x16&p0,f32x16&p1,const char*Kslot,const bf16x8*qr,const f32x16&negm,int r32,int hi){
  const char*kb=Kslot+hi*1024+r32*16;
  #pragma unroll
  for(int d0=0;d0<4;++d0){
    const bf16x8 b0=*reinterpret_cast<const bf16x8*>(kb+d0*2048);
    const bf16x8 b1=*reinterpret_cast<const bf16x8*>(kb+d0*2048+512);
    if(d0==0){p0=__builtin_amdgcn_mfma_f32_32x32x16_bf16(b0,qr[0],negm,0,0,0);p1=__builtin_amdgcn_mfma_f32_32x32x16_bf16(b1,qr[0],negm,0,0,0);}
    else{p0=__builtin_amdgcn_mfma_f32_32x32x16_bf16(b0,qr[d0],p0,0,0,0);p1=__builtin_amdgcn_mfma_f32_32x32x16_bf16(b1,qr[d0],p1,0,0,0);}}
}
typedef __attribute__((address_space(3))) const char* lds_cptr;
typedef short v4i16_t __attribute__((ext_vector_type(4)));
__device__ __forceinline__ void kload8(bf16x8*kf,lds_cptr kp){
  kf[0]=*(const __attribute__((address_space(3))) bf16x8*)(kp);      kf[1]=*(const __attribute__((address_space(3))) bf16x8*)(kp+512);
  kf[2]=*(const __attribute__((address_space(3))) bf16x8*)(kp+2048); kf[3]=*(const __attribute__((address_space(3))) bf16x8*)(kp+2560);
  kf[4]=*(const __attribute__((address_space(3))) bf16x8*)(kp+4096); kf[5]=*(const __attribute__((address_space(3))) bf16x8*)(kp+4608);
  kf[6]=*(const __attribute__((address_space(3))) bf16x8*)(kp+6144); kf[7]=*(const __attribute__((address_space(3))) bf16x8*)(kp+6656);
}
__device__ __forceinline__ void kload2(bf16x8*kf,lds_cptr kp,int j){ kf[2*j]=*(const __attribute__((address_space(3))) bf16x8*)(kp+j*2048); kf[2*j+1]=*(const __attribute__((address_space(3))) bf16x8*)(kp+j*2048+512); }
__device__ __forceinline__ s16x4 vtr(lds_cptr p){ return __builtin_bit_cast(s16x4,__builtin_amdgcn_ds_read_tr16_b64_v4i16((__attribute__((address_space(3))) v4i16_t*)p)); }
__device__ __forceinline__ float rowmax(const f32x16&p0,const f32x16&p1){
  float a=max3f(p0[0],p0[1],p1[0]),b=max3f(p0[2],p0[3],p1[1]);a=max3f(a,p1[2],p1[3]);
  #pragma unroll
  for(int r=4;r<16;r+=4){a=max3f(a,p0[r],p0[r+1]);b=max3f(b,p0[r+2],p0[r+3]);a=max3f(a,p1[r],p1[r+1]);b=max3f(b,p1[r+2],p1[r+3]);}
  const float m=max2f(a,b);
  auto rr=__builtin_amdgcn_permlane32_swap(__float_as_uint(m),__float_as_uint(m),false,false);
  return max2f(__uint_as_float(rr[0]),__uint_as_float(rr[1]));
}
__device__ __forceinline__ void pv(f32x16*o,int vb,bf16x8 pa0,bf16x8 pa1,bf16x8 pa2,bf16x8 pa3){
  #pragma unroll
  for(int d0=0;d0<2;++d0){s16x4 lo[4],hi[4];
    #pragma unroll
    for(int ks=0;ks<4;++ks){
      asm volatile("ds_read_b64_tr_b16 %0,%1 offset:%c2":"=&v"(lo[ks]):"v"(vb),"i"(d0*4096+ks*1024):"memory");
      asm volatile("ds_read_b64_tr_b16 %0,%1 offset:%c2":"=&v"(hi[ks]):"v"(vb),"i"(d0*4096+ks*1024+512):"memory");}
    asm volatile("s_waitcnt lgkmcnt(0)":::"memory");SBAR();
    #define PK(k) (bf16x8){lo[k][0],lo[k][1],lo[k][2],lo[k][3],hi[k][0],hi[k][1],hi[k][2],hi[k][3]}
    o[d0]=__builtin_amdgcn_mfma_f32_32x32x16_bf16(pa0,PK(0),o[d0],0,0,0);
    o[d0]=__builtin_amdgcn_mfma_f32_32x32x16_bf16(pa1,PK(1),o[d0],0,0,0);
    o[d0]=__builtin_amdgcn_mfma_f32_32x32x16_bf16(pa2,PK(2),o[d0],0,0,0);
    o[d0]=__builtin_amdgcn_mfma_f32_32x32x16_bf16(pa3,PK(3),o[d0],0,0,0);
    #undef PK
  }
}

#ifndef ATTN_STORE16
#define ATTN_STORE16(p,v) (*(u32x4*)(p)=(v))
#endif
template<int THRL> __device__ __forceinline__ void attn_unit(const bf16*Q0,int ldq,const bf16*__restrict__ Kh,int ldk,const bf16*__restrict__ Vh,int ldv,bf16*O0,int ldo,int NT,char*shm){
  int tid_=my_tid(); asm volatile("":"+v"(tid_)); const int tid=tid_,lane=tid&63,r32=lane&31,hi=lane>>5; const int wid=__builtin_amdgcn_readfirstlane(tid>>6);
  const bf16*Qw=Q0+(long)(wid*QBLK)*ldq;
  const unsigned lds0=(unsigned)(uintptr_t)shm;
  float*wsf=(float*)(shm+LDS_WS)+wid*64;
  const bf16*ksrc=Kh+(long)lane*ldk+wid*8;
  const bf16*vsrc=Vh+(long)(16*(wid&3)+(lane>>2))*ldv+(wid>>2)*32+(lane&3)*8;
  const unsigned kdst=lds0+LDS_K+wid*1024, vdst=lds0+LDS_V+wid*1024;
  #define DMA_K(t,slot) glds16(ksrc+(long)(t)*KVBLK*ldk,(unsigned)__builtin_amdgcn_readfirstlane(kdst+(slot)))
  #define DMA_V(t,slot) glds16(vsrc+(long)(t)*KVBLK*ldv,(unsigned)__builtin_amdgcn_readfirstlane(vdst+(slot)))
  const int vb0=(int)(lds0+LDS_V)+((lane>>4)&1)*32+(lane&3)*8+(4*hi+((lane&15)>>2))*64;
  const char*Kbase=shm+LDS_K; bf16x8 kf[8];
  const lds_cptr shm3=(lds_cptr)shm; const lds_cptr kp0=shm3+LDS_K+hi*1024+r32*16; const lds_cptr vp0=shm3+LDS_V+((lane>>4)&1)*32+(lane&3)*8+(4*hi+((lane&15)>>2))*64;
  DMA_K(0,0);DMA_V(0,0);DMA_K(1,SLOTB);
  bf16x8 qr[4];
  #pragma unroll
  for(int d0=0;d0<4;++d0)qr[d0]=*reinterpret_cast<const bf16x8*>(&Qw[(long)r32*ldq+d0*16+hi*8]);
  float mhat=0.f,l_reg=0.f;f32x16 o[2];o[0]=f32x16{};o[1]=f32x16{};f32x16 negm=f32x16{};asm volatile("":"+v"(negm));
  #define CMASK(P0,P1,t) do{}while(0)
  bool resc=false;
  #define START(P0,P1) do{ const float rm=rowmax(P0,P1); resc=false; \
    { const float dl=rm; mhat=fadd_s(mhat,dl); \
      _Pragma("unroll") for(int r=0;r<16;++r){P0[r]=fsub_s(P0[r],dl);P1[r]=fsub_s(P1[r],dl);} \
      _Pragma("unroll") for(int r=0;r<16;++r)negm[r]=-mhat; asm volatile("":"+v"(negm)); } \
    _Pragma("unroll") for(int r=0;r<16;++r)P0[r]=__builtin_amdgcn_exp2f(P0[r]); }while(0)
  #define RESC() do{ if(resc){ asm volatile("s_waitcnt lgkmcnt(0)":::"memory"); \
      _Pragma("unroll") for(int d_=0;d_<2;++d_) _Pragma("unroll") for(int r=0;r<16;++r)o[d_][r]*=wsf[crow(r,hi)]; } }while(0)
  f32x16 pA0,pA1,pB0,pB1;
  int sl_prev=0,sl_cur=0,sl_next=SLOTB;
  #define ROT() do{sl_prev=sl_cur;sl_cur=sl_next;sl_next=(sl_next==(NSLOT-1)*SLOTB)?0:sl_next+SLOTB;}while(0)
  DMA_K(2,2*SLOTB);
  WAIT_BAR(3);
  qkt(pA0,pA1,Kbase,qr,negm,r32,hi);asm volatile("s_nop 15\n\ts_nop 7":"+v"(pA0),"+v"(pA1));CMASK(pA0,pA1,0);
  START(pA0,pA1);
  _Pragma("unroll") for(int r=0;r<16;++r)pA1[r]=__builtin_amdgcn_exp2f(pA1[r]);
  WAIT_BAR(0);
  DMA_K(3,0);DMA_V(1,SLOTB);
  ROT();
  kload8(kf,kp0+sl_cur);
  WAIT_BAR(2);
  s16x4 vlo[8],vhi[8]; u32x4 pw0,pw1,pw2,pw3;
  #define PKW(P,B) cvtpk_s(P[B],P[B+1])
  #define PAF(k) __builtin_bit_cast(bf16x8,pw##k)
  #define VFR(i) (bf16x8){vlo[i][0],vlo[i][1],vlo[i][2],vlo[i][3],vhi[i][0],vhi[i][1],vhi[i][2],vhi[i][3]}
  #define PIN(x) asm volatile("":"+v"(x))
  #define MX3(a,b,c) __builtin_fmaxf(__builtin_fmaxf((a),(b)),(c))
  #define GAPA(MF,A0,A1,A2,A3,W0,W1,PW) do{ MF; sacc+=A0; sacc+=A1; sacc+=A2; sacc+=A3; PIN(sacc); W0; W1; PIN(PW); SBAR(); }while(0)
  #define EX(v) __builtin_amdgcn_exp2f(v)
  #define GAPB(MF,X,B) do{ MF; X[B]=EX(X[B]); X[B+1]=EX(X[B+1]); X[B+2]=EX(X[B+2]); X[B+3]=EX(X[B+3]); PIN(X); SBAR(); }while(0)
  #define VRD(i) do{ vlo[i]=vtr(vp_+(((i)>>2)*4096+((i)&3)*1024)); vhi[i]=vtr(vp_+(((i)>>2)*4096+((i)&3)*1024+512)); }while(0)
  #define KRD(G,j) do{ if(G){ kload2(kf,kp0+sl_next,j); SBAR(); } }while(0)
  #define STEP(C0,C1,P0,P1,t,GK,GV,GL) do{ SBAR(); \
    const lds_cptr vp_=vp0+sl_prev; \
    VRD(0); SBAR(); float sacc=(P0[0]+P0[1]); \
    GAPA(C0=__builtin_amdgcn_mfma_f32_32x32x16_bf16(kf[0],qr[0],negm,0,0,0), P0[2],P0[3],P0[4],P0[5],     pw0[0]=PKW(P0,0), pw0[1]=PKW(P0,2), pw0); \
    VRD(4); SBAR(); GAPA(C1=__builtin_amdgcn_mfma_f32_32x32x16_bf16(kf[1],qr[0],negm,0,0,0), P0[6],P0[7],P0[8],P0[9],     pw0[2]=PKW(P0,4), pw0[3]=PKW(P0,6), pw0); \
    VRD(1); SBAR(); GAPA(C0=__builtin_amdgcn_mfma_f32_32x32x16_bf16(kf[2],qr[1],C0,0,0,0),   P0[10],P0[11],P0[12],P0[13], pw1[0]=PKW(P0,8), pw1[1]=PKW(P0,10), pw1); \
    VRD(5); SBAR(); GAPA(C1=__builtin_amdgcn_mfma_f32_32x32x16_bf16(kf[3],qr[1],C1,0,0,0),   P0[14],P0[15],P1[0],P1[1],   pw1[2]=PKW(P0,12),pw1[3]=PKW(P0,14), pw1); \
    VRD(2); SBAR(); GAPA(C0=__builtin_amdgcn_mfma_f32_32x32x16_bf16(kf[4],qr[2],C0,0,0,0),   P1[2],P1[3],P1[4],P1[5],     pw2[0]=PKW(P1,0), pw2[1]=PKW(P1,2), pw2); \
    VRD(6); SBAR(); GAPA(C1=__builtin_amdgcn_mfma_f32_32x32x16_bf16(kf[5],qr[2],C1,0,0,0),   P1[6],P1[7],P1[8],P1[9],     pw2[2]=PKW(P1,4), pw2[3]=PKW(P1,6), pw2); \
    VRD(3); SBAR(); GAPA(C0=__builtin_amdgcn_mfma_f32_32x32x16_bf16(kf[6],qr[3],C0,0,0,0),   P1[10],P1[11],P1[12],P1[13], pw3[0]=PKW(P1,8), pw3[1]=PKW(P1,10), pw3); \
    VRD(7); SBAR(); GAPA(C1=__builtin_amdgcn_mfma_f32_32x32x16_bf16(kf[7],qr[3],C1,0,0,0),   P1[14],P1[15],0.f,0.f,       pw3[2]=PKW(P1,12),pw3[3]=PKW(P1,14), pw3); \
    l_reg+=sacc; \
    if(GK){DMA_K((t)+3,sl_cur);} if(GV){DMA_V((t)+1,sl_next);} \
    CMASK(C0,C1,t); \
    { float a=MX3(C0[0],C0[1],C1[0]),b=MX3(C0[2],C0[3],C1[1]); a=MX3(a,C1[2],C1[3]); \
      _Pragma("unroll") for(int r=4;r<16;r+=4){a=MX3(a,C0[r],C0[r+1]);b=MX3(b,C0[r+2],C0[r+3]);a=MX3(a,C1[r],C1[r+1]);b=MX3(b,C1[r+2],C1[r+3]);} \
      float rm=__builtin_fmaxf(a,b); { auto rr=__builtin_amdgcn_permlane32_swap(__float_as_uint(rm),__float_as_uint(rm),false,false); rm=__builtin_fmaxf(__uint_as_float(rr[0]),__uint_as_float(rr[1])); } \
      resc=false; \
      if(__builtin_expect(__any(rm>(float)THRL),0)){ const float dl=__builtin_fmaxf(rm,0.f); mhat+=dl; \
        _Pragma("unroll") for(int r=0;r<16;++r){C0[r]-=dl;C1[r]-=dl;} \
        _Pragma("unroll") for(int r=0;r<16;++r)negm[r]=-mhat; asm volatile("":"+v"(negm)); \
        const float f=__builtin_amdgcn_exp2f(-dl); l_reg*=f; if(hi==0)wsf[r32]=f; resc=true; } } \
    SBAR(); \
    GAPB(o[0]=__builtin_amdgcn_mfma_f32_32x32x16_bf16(PAF(0),VFR(0),o[0],0,0,0), C0,0); \
    GAPB(o[1]=__builtin_amdgcn_mfma_f32_32x32x16_bf16(PAF(0),VFR(4),o[1],0,0,0), C0,4); \
    KRD(GL,0); GAPB(o[0]=__builtin_amdgcn_mfma_f32_32x32x16_bf16(PAF(1),VFR(1),o[0],0,0,0), C0,8); \
    KRD(GL,1); GAPB(o[1]=__builtin_amdgcn_mfma_f32_32x32x16_bf16(PAF(1),VFR(5),o[1],0,0,0), C0,12); \
    KRD(GL,2); GAPB(o[0]=__builtin_amdgcn_mfma_f32_32x32x16_bf16(PAF(2),VFR(2),o[0],0,0,0), C1,0); \
    KRD(GL,3); GAPB(o[1]=__builtin_amdgcn_mfma_f32_32x32x16_bf16(PAF(2),VFR(6),o[1],0,0,0), C1,4); \
    GAPB(o[0]=__builtin_amdgcn_mfma_f32_32x32x16_bf16(PAF(3),VFR(3),o[0],0,0,0), C1,8); \
    GAPB(o[1]=__builtin_amdgcn_mfma_f32_32x32x16_bf16(PAF(3),VFR(7),o[1],0,0,0), C1,12); \
    }while(0)
  int t=1;
  #undef CMASK
  #define CMASK(P0,P1,t) do{}while(0)
  for(;t+5<NT;t+=2){
    STEP(pB0,pB1,pA0,pA1,t,true,true,true);     WAIT_BAR(2); RESC(); ROT();
    STEP(pA0,pA1,pB0,pB1,t+1,true,true,true);   WAIT_BAR(2); RESC(); ROT();
  }
  #undef CMASK
  #define CMASK(P0,P1,t) do{}while(0)
  #define ENDW(tt) do{ if((tt)+3<NT){WAIT_BAR(2);} else if((tt)+2<NT){WAIT_BAR(1);} else {WAIT_BAR(0);} }while(0)
  for(;t+1<NT;t+=2){
    STEP(pB0,pB1,pA0,pA1,t,(t+3<NT),(t+1<NT),(t+1<NT));       ENDW(t);   RESC(); ROT();
    STEP(pA0,pA1,pB0,pB1,t+1,(t+4<NT),(t+2<NT),(t+2<NT));     ENDW(t+1); RESC(); ROT();
  }
  STEP(pB0,pB1,pA0,pA1,NT-1,false,false,false); RESC();
  { float sacc=pB0[0]+pB0[1]; _Pragma("unroll") for(int r=2;r<16;++r)sacc+=pB0[r]; _Pragma("unroll") for(int r=0;r<16;++r)sacc+=pB1[r]; l_reg+=sacc;
    pw0=(u32x4){PKW(pB0,0),PKW(pB0,2),PKW(pB0,4),PKW(pB0,6)};pw1=(u32x4){PKW(pB0,8),PKW(pB0,10),PKW(pB0,12),PKW(pB0,14)};pw2=(u32x4){PKW(pB1,0),PKW(pB1,2),PKW(pB1,4),PKW(pB1,6)};pw3=(u32x4){PKW(pB1,8),PKW(pB1,10),PKW(pB1,12),PKW(pB1,14)};
    SBAR(); pv(o,vb0+sl_cur,PAF(0),PAF(1),PAF(2),PAF(3)); }
  #undef PKW
  #undef PAF
  #undef VFR
  #undef PIN
  #undef MX3
  #undef GAPA
  #undef GAPB
  #undef EX
  #undef VRD
  #undef KRD
  #undef STEP
  #undef ENDW
  {auto rr=__builtin_amdgcn_permlane32_swap(__float_as_uint(l_reg),__float_as_uint(l_reg),false,false);l_reg=__uint_as_float(rr[0])+__uint_as_float(rr[1]);}
  if(hi==0)wsf[32+r32]=l_reg;asm volatile("s_waitcnt lgkmcnt(0)":::"memory");
  float rli[16];
  #pragma unroll
  for(int r=0;r<16;++r)rli[r]=__builtin_amdgcn_rcpf(wsf[32+crow(r,hi)]);
  bf16*Ow=O0+(long)(wid*QBLK)*ldo;
  { bf16*stg=(bf16*)(shm+LDS_OST)+wid*2048;
    #pragma unroll
    for(int r=0;r<16;++r){const int orow=crow(r,hi);
      #pragma unroll
      for(int d0=0;d0<2;++d0)stg[orow*64+d0*32+r32]=__float2bfloat16(o[d0][r]*rli[r]);}
    asm volatile("s_waitcnt lgkmcnt(0)":::"memory");
    #pragma unroll
    for(int i=0;i<4;++i){const int row=i*8+(lane>>3),ch=lane&7; const u32x4 v=*(const u32x4*)(stg+row*64+ch*8); ATTN_STORE16(Ow+(long)row*ldo+ch*8,v);} }
  asm volatile("s_waitcnt lgkmcnt(0)\n\ts_barrier":::"memory");
  #undef DMA_K
  #undef DMA_V
  #undef CMASK
  #undef START
  #undef RESC
  #undef ROT
}
constexpr int LDS_WS128=LDS_V+NSLOT*16384, LDS_OST128=LDS_WS128+NW*64*4, LDS_BYTES128=LDS_OST128+NW*4096;
template<int THRL> __device__ __forceinline__ void attn_unit128(const bf16*Q0,int ldq,const bf16*__restrict__ Kh,int ldk,const bf16*__restrict__ Vh,int ldv,bf16*O0,int ldo,int NT,char*shm){
  int tid_=my_tid(); asm volatile("":"+v"(tid_)); const int tid=tid_,lane=tid&63,r32=lane&31,hi=lane>>5; const int wid=__builtin_amdgcn_readfirstlane(tid>>6);
  const bf16*Qw=Q0+(long)(wid*QBLK)*ldq;
  const unsigned lds0=(unsigned)(uintptr_t)shm;
  float*wsf=(float*)(shm+LDS_WS128)+wid*64;
  const bf16*ksrc=Kh+(long)lane*ldk+wid*8;
  const bf16*vsrc=Vh+(long)(16*(wid&3)+(lane>>2))*ldv+(wid>>2)*32+(lane&3)*8;
  const unsigned kdst=lds0+LDS_K+wid*1024, vdst=lds0+LDS_V+wid*1024;
  #define DMA_K(t,slot) glds16(ksrc+(long)(t)*KVBLK*ldk,(unsigned)__builtin_amdgcn_readfirstlane(kdst+(slot)))
  #define DMA_V(t,slot) do{ glds16(vsrc+(long)(t)*KVBLK*ldv,(unsigned)__builtin_amdgcn_readfirstlane(vdst+2*(slot))); glds16(vsrc+(long)(t)*KVBLK*ldv+64,(unsigned)__builtin_amdgcn_readfirstlane(vdst+2*(slot)+8192)); }while(0)
  const int vb0=(int)(lds0+LDS_V)+((lane>>4)&1)*32+(lane&3)*8+(4*hi+((lane&15)>>2))*64;
  const char*Kbase=shm+LDS_K; bf16x8 kf[8];
  const lds_cptr shm3=(lds_cptr)shm; const lds_cptr kp0=shm3+LDS_K+hi*1024+r32*16; const lds_cptr vp0=shm3+LDS_V+((lane>>4)&1)*32+(lane&3)*8+(4*hi+((lane&15)>>2))*64;
  DMA_K(0,0);DMA_V(0,0);DMA_K(1,SLOTB);
  bf16x8 qr[4];
  #pragma unroll
  for(int d0=0;d0<4;++d0)qr[d0]=*reinterpret_cast<const bf16x8*>(&Qw[(long)r32*ldq+d0*16+hi*8]);
  float mhat=0.f,l_reg=0.f;f32x16 o[4];o[0]=f32x16{};o[1]=f32x16{};o[2]=f32x16{};o[3]=f32x16{};f32x16 negm=f32x16{};asm volatile("":"+v"(negm));
  #define CMASK(P0,P1,t) do{}while(0)
  bool resc=false;
  #define START(P0,P1) do{ const float rm=rowmax(P0,P1); resc=false; \
    { const float dl=rm; mhat=fadd_s(mhat,dl); \
      _Pragma("unroll") for(int r=0;r<16;++r){P0[r]=fsub_s(P0[r],dl);P1[r]=fsub_s(P1[r],dl);} \
      _Pragma("unroll") for(int r=0;r<16;++r)negm[r]=-mhat; asm volatile("":"+v"(negm)); } \
    _Pragma("unroll") for(int r=0;r<16;++r)P0[r]=__builtin_amdgcn_exp2f(P0[r]); }while(0)
  #define RESC() do{ if(resc){ asm volatile("s_waitcnt lgkmcnt(0)":::"memory"); \
      _Pragma("unroll") for(int d_=0;d_<4;++d_) _Pragma("unroll") for(int r=0;r<16;++r)o[d_][r]*=wsf[crow(r,hi)]; } }while(0)
  f32x16 pA0,pA1,pB0,pB1;
  int sl_prev=0,sl_cur=0,sl_next=SLOTB;
  #define ROT() do{sl_prev=sl_cur;sl_cur=sl_next;sl_next=(sl_next==(NSLOT-1)*SLOTB)?0:sl_next+SLOTB;}while(0)
  DMA_K(2,2*SLOTB);
  WAIT_BAR(3);
  qkt(pA0,pA1,Kbase,qr,negm,r32,hi);asm volatile("s_nop 15\n\ts_nop 7":"+v"(pA0),"+v"(pA1));CMASK(pA0,pA1,0);
  START(pA0,pA1);
  _Pragma("unroll") for(int r=0;r<16;++r)pA1[r]=__builtin_amdgcn_exp2f(pA1[r]);
  WAIT_BAR(0);
  DMA_K(3,0);DMA_V(1,SLOTB);
  ROT();
  kload8(kf,kp0+sl_cur);
  WAIT_BAR(3);
  s16x4 vlo[8],vhi[8]; u32x4 pw0,pw1,pw2,pw3;
  #define PKW(P,B) cvtpk_s(P[B],P[B+1])
  #define PAF(k) __builtin_bit_cast(bf16x8,pw##k)
  #define VFR(i) (bf16x8){vlo[i][0],vlo[i][1],vlo[i][2],vlo[i][3],vhi[i][0],vhi[i][1],vhi[i][2],vhi[i][3]}
  #define PIN(x) asm volatile("":"+v"(x))
  #define MX3(a,b,c) __builtin_fmaxf(__builtin_fmaxf((a),(b)),(c))
  #define GAPA(MF,A0,A1,A2,A3,W0,W1,PW) do{ MF; sacc+=A0; sacc+=A1; sacc+=A2; sacc+=A3; PIN(sacc); W0; W1; PIN(PW); SBAR(); }while(0)
  #define EX(v) __builtin_amdgcn_exp2f(v)
  #define GAPB2(MF,X,B) do{ MF; X[B]=EX(X[B]); X[B+1]=EX(X[B+1]); PIN(X); SBAR(); }while(0)
  #define GAPB(MF,X,B) do{ MF; X[B]=EX(X[B]); X[B+1]=EX(X[B+1]); X[B+2]=EX(X[B+2]); X[B+3]=EX(X[B+3]); PIN(X); SBAR(); }while(0)
  #define VRD(i) do{ vlo[i]=vtr(vp_+(((i)>>2)*4096+((i)&3)*1024)); vhi[i]=vtr(vp_+(((i)>>2)*4096+((i)&3)*1024+512)); }while(0)
  #define VRDQ(i) do{ vlo[i]=vtr(vq_+(((i)>>2)*4096+((i)&3)*1024)); vhi[i]=vtr(vq_+(((i)>>2)*4096+((i)&3)*1024+512)); }while(0)
  #define KRD(G,j) do{ if(G){ kload2(kf,kp0+sl_next,j); SBAR(); } }while(0)
  #define STEP(C0,C1,P0,P1,t,GK,GV,GL) do{ SBAR(); \
    const lds_cptr vp_=vp0+2*sl_prev; const lds_cptr vq_=vp_+8192; \
    VRD(0); SBAR(); float sacc=(P0[0]+P0[1]); \
    GAPA(C0=__builtin_amdgcn_mfma_f32_32x32x16_bf16(kf[0],qr[0],negm,0,0,0), P0[2],P0[3],P0[4],P0[5],     pw0[0]=PKW(P0,0), pw0[1]=PKW(P0,2), pw0); \
    VRD(4); SBAR(); GAPA(C1=__builtin_amdgcn_mfma_f32_32x32x16_bf16(kf[1],qr[0],negm,0,0,0), P0[6],P0[7],P0[8],P0[9],     pw0[2]=PKW(P0,4), pw0[3]=PKW(P0,6), pw0); \
    VRD(1); SBAR(); GAPA(C0=__builtin_amdgcn_mfma_f32_32x32x16_bf16(kf[2],qr[1],C0,0,0,0),   P0[10],P0[11],P0[12],P0[13], pw1[0]=PKW(P0,8), pw1[1]=PKW(P0,10), pw1); \
    VRD(5); SBAR(); GAPA(C1=__builtin_amdgcn_mfma_f32_32x32x16_bf16(kf[3],qr[1],C1,0,0,0),   P0[14],P0[15],P1[0],P1[1],   pw1[2]=PKW(P0,12),pw1[3]=PKW(P0,14), pw1); \
    VRD(2); SBAR(); GAPA(C0=__builtin_amdgcn_mfma_f32_32x32x16_bf16(kf[4],qr[2],C0,0,0,0),   P1[2],P1[3],P1[4],P1[5],     pw2[0]=PKW(P1,0), pw2[1]=PKW(P1,2), pw2); \
    VRD(6); SBAR(); GAPA(C1=__builtin_amdgcn_mfma_f32_32x32x16_bf16(kf[5],qr[2],C1,0,0,0),   P1[6],P1[7],P1[8],P1[9],     pw2[2]=PKW(P1,4), pw2[3]=PKW(P1,6), pw2); \
    VRD(3); SBAR(); GAPA(C0=__builtin_amdgcn_mfma_f32_32x32x16_bf16(kf[6],qr[3],C0,0,0,0),   P1[10],P1[11],P1[12],P1[13], pw3[0]=PKW(P1,8), pw3[1]=PKW(P1,10), pw3); \
    VRD(7); SBAR(); GAPA(C1=__builtin_amdgcn_mfma_f32_32x32x16_bf16(kf[7],qr[3],C1,0,0,0),   P1[14],P1[15],0.f,0.f,       pw3[2]=PKW(P1,12),pw3[3]=PKW(P1,14), pw3); \
    l_reg+=sacc; \
    if(GK){DMA_K((t)+3,sl_cur);} if(GV){DMA_V((t)+1,sl_next);} \
    CMASK(C0,C1,t); \
    { float a=MX3(C0[0],C0[1],C1[0]),b=MX3(C0[2],C0[3],C1[1]); a=MX3(a,C1[2],C1[3]); \
      _Pragma("unroll") for(int r=4;r<16;r+=4){a=MX3(a,C0[r],C0[r+1]);b=MX3(b,C0[r+2],C0[r+3]);a=MX3(a,C1[r],C1[r+1]);b=MX3(b,C1[r+2],C1[r+3]);} \
      float rm=__builtin_fmaxf(a,b); { auto rr=__builtin_amdgcn_permlane32_swap(__float_as_uint(rm),__float_as_uint(rm),false,false); rm=__builtin_fmaxf(__uint_as_float(rr[0]),__uint_as_float(rr[1])); } \
      resc=false; \
      if(__builtin_expect(__any(rm>(float)THRL),0)){ const float dl=__builtin_fmaxf(rm,0.f); mhat+=dl; \
        _Pragma("unroll") for(int r=0;r<16;++r){C0[r]-=dl;C1[r]-=dl;} \
        _Pragma("unroll") for(int r=0;r<16;++r)negm[r]=-mhat; asm volatile("":"+v"(negm)); \
        const float f=__builtin_amdgcn_exp2f(-dl); l_reg*=f; if(hi==0)wsf[r32]=f; resc=true; } } \
    SBAR(); \
    GAPB2(o[0]=__builtin_amdgcn_mfma_f32_32x32x16_bf16(PAF(0),VFR(0),o[0],0,0,0), C0,0); \
    VRDQ(0); SBAR(); \
    GAPB2(o[1]=__builtin_amdgcn_mfma_f32_32x32x16_bf16(PAF(0),VFR(4),o[1],0,0,0), C0,2); \
    VRDQ(4); SBAR(); \
    KRD(GL,0); GAPB2(o[0]=__builtin_amdgcn_mfma_f32_32x32x16_bf16(PAF(1),VFR(1),o[0],0,0,0), C0,4); \
    VRDQ(1); SBAR(); \
    KRD(GL,1); GAPB2(o[1]=__builtin_amdgcn_mfma_f32_32x32x16_bf16(PAF(1),VFR(5),o[1],0,0,0), C0,6); \
    VRDQ(5); SBAR(); \
    KRD(GL,2); GAPB2(o[0]=__builtin_amdgcn_mfma_f32_32x32x16_bf16(PAF(2),VFR(2),o[0],0,0,0), C0,8); \
    VRDQ(2); SBAR(); \
    KRD(GL,3); GAPB2(o[1]=__builtin_amdgcn_mfma_f32_32x32x16_bf16(PAF(2),VFR(6),o[1],0,0,0), C0,10); \
    VRDQ(6); SBAR(); \
    GAPB2(o[0]=__builtin_amdgcn_mfma_f32_32x32x16_bf16(PAF(3),VFR(3),o[0],0,0,0), C0,12); \
    VRDQ(3); SBAR(); \
    GAPB2(o[1]=__builtin_amdgcn_mfma_f32_32x32x16_bf16(PAF(3),VFR(7),o[1],0,0,0), C0,14); \
    VRDQ(7); SBAR(); \
    GAPB2(o[2]=__builtin_amdgcn_mfma_f32_32x32x16_bf16(PAF(0),VFR(0),o[2],0,0,0), C1,0); \
    GAPB2(o[3]=__builtin_amdgcn_mfma_f32_32x32x16_bf16(PAF(0),VFR(4),o[3],0,0,0), C1,2); \
    GAPB2(o[2]=__builtin_amdgcn_mfma_f32_32x32x16_bf16(PAF(1),VFR(1),o[2],0,0,0), C1,4); \
    GAPB2(o[3]=__builtin_amdgcn_mfma_f32_32x32x16_bf16(PAF(1),VFR(5),o[3],0,0,0), C1,6); \
    GAPB2(o[2]=__builtin_amdgcn_mfma_f32_32x32x16_bf16(PAF(2),VFR(2),o[2],0,0,0), C1,8); \
    GAPB2(o[3]=__builtin_amdgcn_mfma_f32_32x32x16_bf16(PAF(2),VFR(6),o[3],0,0,0), C1,10); \
    GAPB2(o[2]=__builtin_amdgcn_mfma_f32_32x32x16_bf16(PAF(3),VFR(3),o[2],0,0,0), C1,12); \
    GAPB2(o[3]=__builtin_amdgcn_mfma_f32_32x32x16_bf16(PAF(3),VFR(7),o[3],0,0,0), C1,14); \
    }while(0)
  int t=1;
  #undef CMASK
  #define CMASK(P0,P1,t) do{}while(0)
  for(;t+5<NT;t+=2){
    STEP(pB0,pB1,pA0,pA1,t,true,true,true);     WAIT_BAR(3); RESC(); ROT();
    STEP(pA0,pA1,pB0,pB1,t+1,true,true,true);   WAIT_BAR(3); RESC(); ROT();
  }
  #undef CMASK
  #define CMASK(P0,P1,t) do{}while(0)
  #define ENDW(tt) do{ if((tt)+3<NT){WAIT_BAR(3);} else if((tt)+2<NT){WAIT_BAR(2);} else {WAIT_BAR(0);} }while(0)
  for(;t+1<NT;t+=2){
    STEP(pB0,pB1,pA0,pA1,t,(t+3<NT),(t+1<NT),(t+1<NT));       ENDW(t);   RESC(); ROT();
    STEP(pA0,pA1,pB0,pB1,t+1,(t+4<NT),(t+2<NT),(t+2<NT));     ENDW(t+1); RESC(); ROT();
  }
  STEP(pB0,pB1,pA0,pA1,NT-1,false,false,false); RESC();
  { float sacc=pB0[0]+pB0[1]; _Pragma("unroll") for(int r=2;r<16;++r)sacc+=pB0[r]; _Pragma("unroll") for(int r=0;r<16;++r)sacc+=pB1[r]; l_reg+=sacc;
    pw0=(u32x4){PKW(pB0,0),PKW(pB0,2),PKW(pB0,4),PKW(pB0,6)};pw1=(u32x4){PKW(pB0,8),PKW(pB0,10),PKW(pB0,12),PKW(pB0,14)};pw2=(u32x4){PKW(pB1,0),PKW(pB1,2),PKW(pB1,4),PKW(pB1,6)};pw3=(u32x4){PKW(pB1,8),PKW(pB1,10),PKW(pB1,12),PKW(pB1,14)};
    SBAR(); pv(o,vb0+2*sl_cur,PAF(0),PAF(1),PAF(2),PAF(3)); pv(o+2,vb0+2*sl_cur+8192,PAF(0),PAF(1),PAF(2),PAF(3)); }
  #undef PKW
  #undef PAF
  #undef VFR
  #undef PIN
  #undef MX3
  #undef GAPA
  #undef GAPB
  #undef GAPB2
  #undef EX
  #undef VRD
  #undef KRD
  #undef VRDQ
  #undef STEP
  #undef ENDW
  {auto rr=__builtin_amdgcn_permlane32_swap(__float_as_uint(l_reg),__float_as_uint(l_reg),false,false);l_reg=__uint_as_float(rr[0])+__uint_as_float(rr[1]);}
  if(hi==0)wsf[32+r32]=l_reg;asm volatile("s_waitcnt lgkmcnt(0)":::"memory");
  float rli[16];
  #pragma unroll
  for(int r=0;r<16;++r)rli[r]=__builtin_amdgcn_rcpf(wsf[32+crow(r,hi)]);
  bf16*Ow=O0+(long)(wid*QBLK)*ldo;
  { bf16*stg=(bf16*)(shm+LDS_OST128)+wid*2048;
    #pragma unroll
    for(int h2=0;h2<2;++h2){
      #pragma unroll
      for(int r=0;r<16;++r){const int orow=crow(r,hi);
        #pragma unroll
        for(int d0=0;d0<2;++d0)stg[orow*64+d0*32+r32]=__float2bfloat16(o[2*h2+d0][r]*rli[r]);}
      asm volatile("s_waitcnt lgkmcnt(0)":::"memory");
      #pragma unroll
      for(int i=0;i<4;++i){const int row=i*8+(lane>>3),ch=lane&7; const u32x4 v=*(const u32x4*)(stg+row*64+ch*8); ATTN_STORE16(Ow+(long)row*ldo+h2*64+ch*8,v);}
      asm volatile("s_waitcnt lgkmcnt(0)":::"memory"); } }
  asm volatile("s_waitcnt lgkmcnt(0)\n\ts_barrier":::"memory");
  #undef DMA_K
  #undef DMA_V
  #undef CMASK
  #undef START
  #undef RESC
  #undef ROT
}
constexpr int ATTN_LDS_BYTES=LDS_BYTES;
#undef SBAR
#undef WAIT_BAR
}


constexpr int NWAVES = 8;
constexpr int DMODEL = 1024, NBATCH = 2, SEQL = 8192, CTXL = 256, RPB = SEQL + CTXL, MROWS = NBATCH * RPB, NLAYER = 2;
constexpr int DFF = 2816, NUP = 2 * DFF, INW = 5888, ZW = 5376, NMODV = 9, MODW = NMODV * DMODEL;
constexpr int ZQA = 0, ZKA = 512, ZVA = 640, ZQB = 768, ZKB = 1280, ZVB = 1792, ZGATE = 2304;
constexpr int TPB = RPB / 256;
constexpr float EPSN = 1e-6f;
constexpr int HN = 4096;

constexpr size_t MiB = 1u << 20, KiB = 1024;
constexpr size_t WS_CTL = 0, CTL_ZERO_BYTES = 64 * KiB;
constexpr size_t WS_MOD = 1 * MiB;
constexpr size_t WS_CAS256 = 1 * MiB + 512 * KiB;
constexpr size_t WS_HC = 2 * MiB;
constexpr size_t WS_WUP0 = 4 * MiB, WS_WDN0 = 15 * MiB, WS_WUP1 = 20 * MiB + 512 * KiB, WS_WDN1 = 31 * MiB + 512 * KiB;
constexpr size_t WS_WIN = 37 * MiB, WS_WC = 47 * MiB + 512 * KiB, WS_WBR = 48 * MiB + 512 * KiB, WS_WOUT = 51 * MiB + 512 * KiB;
constexpr size_t WS_HN = 54 * MiB;
constexpr size_t WS_Z = 87 * MiB;
constexpr size_t WS_T1T = 261 * MiB;
constexpr size_t WS_PART = WS_T1T;
constexpr size_t WS_T2B = WS_T1T;
constexpr size_t WS_T2 = 278 * MiB;
constexpr size_t WS_PQ = 295 * MiB;
constexpr size_t WS_CAS = 311 * MiB;
constexpr size_t WS_ROPE = 343 * MiB;
constexpr size_t WS_END = 345 * MiB;
static_assert(WS_Z + (size_t)MROWS * ZW * 2 <= WS_T1T && WS_HN + (size_t)MROWS * DMODEL * 2 <= WS_Z && WS_WOUT + 2 * MiB <= WS_HN, "ws map");
constexpr int CW_BAR = 4096;
constexpr int CW_Q = 1024;


#define GAS __attribute__((address_space(1)))
typedef unsigned short bf16;
typedef unsigned v4u __attribute__((ext_vector_type(4)));
typedef float f32x4 __attribute__((ext_vector_type(4)));
#define LDS_WAIT() asm volatile("s_waitcnt lgkmcnt(0)" ::: "memory")

__device__ __forceinline__ float bf2f(unsigned v) { return __uint_as_float(v << 16); }
__device__ __forceinline__ float bflo(unsigned w) { return __uint_as_float(w << 16); }
__device__ __forceinline__ float bfhi(unsigned w) { return __uint_as_float(w & 0xffff0000u); }
__device__ __forceinline__ unsigned pk2(float lo, float hi) { return pg8::cvt_pk_bf16(lo, hi); }
__device__ __forceinline__ float fexp(float x) { return __builtin_amdgcn_exp2f(x * 1.4426950408889634f); }
__device__ __forceinline__ float sigm(float x) { return __builtin_amdgcn_rcpf(1.0f + fexp(-x)); }
__device__ __forceinline__ float siluf(float x) { return x * sigm(x); }
__device__ __forceinline__ float shfl_xor(float v, int o) { return __builtin_bit_cast(float, __builtin_amdgcn_ds_bpermute((lane_id() ^ o) << 2, __builtin_bit_cast(int, v))); }
__device__ __forceinline__ float wave_sum(float v) {
#pragma unroll
    for (int o = 1; o < 64; o <<= 1) v += shfl_xor(v, o);
    return v;
}

namespace pg8 {
struct EpiStore {
    static constexpr bool PERM = true, AFTER_DRAIN = false;
    bf16_t* O; int ldc; int sig_from; int rbase, rmul;
    __device__ __forceinline__ void operator()(const f32x4 (&acc)[2][2][4][2], const Unit& u, int wr, int wc, int fr_, int fq_) const {
        (void)fr_; (void)fq_; const int ln_ = lane_id(); const int fr = ln_ & 15, fq = ln_ >> 4;
        const int row0 = u.pm * BM + wr * 64 + fr, col0 = u.pn * BM + wc * 32 + 8 * fq;
        const bool sg = (u.pn * BM) >= sig_from;
#pragma unroll
        for (int ai = 0; ai < 2; ++ai)
#pragma unroll
            for (int m = 0; m < 4; ++m) { const int row = row0 + ai * HALF + m * 16; bf16_t* rowp = O + (size_t)(rbase + row * rmul) * ldc + col0;
#pragma unroll
                for (int bj = 0; bj < 2; ++bj) { f32x4 v0 = acc[ai][bj][m][0], v1 = acc[ai][bj][m][1];
                    if (sg) { v0[0] = sigm(v0[0]); v0[1] = sigm(v0[1]); v0[2] = sigm(v0[2]); v0[3] = sigm(v0[3]); v1[0] = sigm(v1[0]); v1[1] = sigm(v1[1]); v1[2] = sigm(v1[2]); v1[3] = sigm(v1[3]); }
                    u32x4 w; w.x = cvt_pk_bf16(v0[0], v0[1]); w.y = cvt_pk_bf16(v0[2], v0[3]); w.z = cvt_pk_bf16(v1[0], v1[1]); w.w = cvt_pk_bf16(v1[2], v1[3]);
                    *(u32x4*)(rowp + bj * HALF) = w; } }
    }
};
struct EpiSwiGLU {
    static constexpr bool PERM = true, AFTER_DRAIN = false; static constexpr int DFF_ = 2816;
    bf16_t* H; int ldc;
    __device__ __forceinline__ void operator()(const f32x4 (&acc)[2][2][4][2], const Unit& u, int wr, int wc, int fr_, int fq_) const {
        (void)fr_; (void)fq_; const int ln_ = lane_id(); const int fr = ln_ & 15, fq = ln_ >> 4;
        const int row0 = u.pm * BM + wr * 64 + fr, col0 = u.pn * HALF + wc * 32 + 8 * fq;
#pragma unroll
        for (int ai = 0; ai < 2; ++ai)
#pragma unroll
            for (int m = 0; m < 4; ++m) { const int rin = wr * 64 + fr + ai * HALF + m * 16; bf16_t* rowp = H + ((size_t)(u.pm * (DFF_ / 64) + (col0 >> 6)) * 256 + rin) * 64 + (col0 & 63);
                const f32x4 g0 = acc[ai][0][m][0], g1 = acc[ai][0][m][1], u0 = acc[ai][1][m][0], u1 = acc[ai][1][m][1];
                u32x4 w; w.x = cvt_pk_bf16(siluf(g0[0]) * u0[0], siluf(g0[1]) * u0[1]); w.y = cvt_pk_bf16(siluf(g0[2]) * u0[2], siluf(g0[3]) * u0[3]);
                w.z = cvt_pk_bf16(siluf(g1[0]) * u1[0], siluf(g1[1]) * u1[1]); w.w = cvt_pk_bf16(siluf(g1[2]) * u1[2], siluf(g1[3]) * u1[3]);
                *(u32x4*)rowp = w; }
    }
};
template <bool ATOMIC> struct EpiResidT {
    static constexpr bool PERM = false, AFTER_DRAIN = false;
    const float* base_lat; const float* base_ctx; float* out_lat; float* out_ctx; const float* gate; float scale;
    __device__ __forceinline__ void operator()(const f32x4 (&acc)[2][2][4][2], const Unit& u, int wr, int wc, int fr_, int fq_) const {
        (void)fr_; (void)fq_; const int ln_ = lane_id(); const int fr = ln_ & 15, fq = ln_ >> 4;
        const int b = u.pm / 33, w = u.pm % 33; const int set = (w == 0) ? 2 : b;
        const size_t toff = (w == 0) ? (size_t)b * 256 * 1024 : ((size_t)b * 8192 + (size_t)(w - 1) * 256) * 1024;
        const float* base = ((w == 0) ? base_ctx : base_lat) + toff; float* out = ((w == 0) ? out_ctx : out_lat) + toff;
        const int frr = fr;
        const int col0 = u.pn * BM + wc * 32 + 4 * fq; const float* gp = gate + set * 9216 + col0;
#pragma unroll
        for (int bj = 0; bj < 2; ++bj)
#pragma unroll
            for (int n = 0; n < 2; ++n) { const f32x4 gv = *(const f32x4*)(gp + bj * HALF + n * 16) * scale;
                f32x4 bs[2][4];
#pragma unroll
                for (int ai = 0; ai < 2; ++ai)
#pragma unroll
                    for (int m = 0; m < 4; ++m) bs[ai][m] = *(const f32x4*)(base + (unsigned)(ai * HALF + wr * 64 + m * 16 + frr) * 1024u + (unsigned)(col0 + bj * HALF + n * 16));
#pragma unroll
                for (int ai = 0; ai < 2; ++ai)
#pragma unroll
                    for (int m = 0; m < 4; ++m) *(f32x4*)(out + (unsigned)(ai * HALF + wr * 64 + m * 16 + frr) * 1024u + (unsigned)(col0 + bj * HALF + n * 16)) = bs[ai][m] + gv * acc[ai][bj][m][n];
                asm volatile("" ::: "memory"); }
    }
};
typedef EpiResidT<false> EpiResid;
struct EpiResidA {
    static constexpr bool PERM = false, AFTER_DRAIN = false;
    float* part; const float* gate; float scale;
    __device__ __forceinline__ void operator()(const f32x4 (&acc)[2][2][4][2], const Unit& u, int wr, int wc, int fr_, int fq_) const {
        (void)fr_; (void)fq_; const int ln_ = lane_id(); const int fr = ln_ & 15, fq = ln_ >> 4;
        const int col0 = u.pn * BM + wc * 32 + 4 * fq;
        float* out = part + ((size_t)u.kp * 512 + (u.pm ? 256 : 0)) * 1024 + (unsigned)((wr * 64 + fr) * 1024 + col0);
#pragma unroll
        for (int bj = 0; bj < 2; ++bj)
#pragma unroll
            for (int n = 0; n < 2; ++n) { const f32x4 gv = *(const f32x4*)(gate + col0 + bj * HALF + n * 16) * scale;
#pragma unroll
                for (int ai = 0; ai < 2; ++ai) {
#pragma unroll
                    for (int m = 0; m < 4; ++m) *(f32x4*)(out + (ai * HALF + m * 16) * 1024 + bj * HALF + n * 16) = gv * acc[ai][bj][m][n];
                    asm volatile("" ::: "memory"); } }
    }
};
struct EpiMerge {
    static constexpr bool PERM = true, AFTER_DRAIN = false;
    const bf16_t* Z; bf16_t* Mo;
    __device__ __forceinline__ void operator()(const f32x4 (&acc)[2][2][4][2], const Unit& u, int wr, int wc, int fr_, int fq_) const {
        (void)fr_; (void)fq_; const int ln_ = lane_id(); const int fr = ln_ & 15, fq = ln_ >> 4;
        const int br = u.pn >> 2, ct = u.pn & 3;
        const int row0 = u.pm * BM + wr * 64 + fr, col0 = ct * BM + wc * 32 + 8 * fq;
#pragma unroll
        for (int ai = 0; ai < 2; ++ai)
#pragma unroll
            for (int m = 0; m < 4; ++m) { const int row = row0 + ai * HALF + m * 16; const bf16_t* gp = Z + (size_t)row * 5376 + 2304 + br * 1024 + col0; bf16_t* mp = Mo + (size_t)row * 1024 + col0;
#pragma unroll
                for (int bj = 0; bj < 2; ++bj) { const u32x4 gw = *(const u32x4*)(gp + bj * HALF); const f32x4 a0 = acc[ai][bj][m][0], a1 = acc[ai][bj][m][1];
                    float r0 = __uint_as_float(gw.x << 16) * a0[0], r1 = __uint_as_float(gw.x & 0xffff0000u) * a0[1], r2 = __uint_as_float(gw.y << 16) * a0[2], r3 = __uint_as_float(gw.y & 0xffff0000u) * a0[3];
                    float r4 = __uint_as_float(gw.z << 16) * a1[0], r5 = __uint_as_float(gw.z & 0xffff0000u) * a1[1], r6 = __uint_as_float(gw.w << 16) * a1[2], r7 = __uint_as_float(gw.w & 0xffff0000u) * a1[3];
                    if (br > 0) { const u32x4 ow = *(const u32x4*)(mp + bj * HALF);
                        r0 += __uint_as_float(ow.x << 16); r1 += __uint_as_float(ow.x & 0xffff0000u); r2 += __uint_as_float(ow.y << 16); r3 += __uint_as_float(ow.y & 0xffff0000u);
                        r4 += __uint_as_float(ow.z << 16); r5 += __uint_as_float(ow.z & 0xffff0000u); r6 += __uint_as_float(ow.w << 16); r7 += __uint_as_float(ow.w & 0xffff0000u); }
                    u32x4 w; w.x = cvt_pk_bf16(r0, r1); w.y = cvt_pk_bf16(r2, r3); w.z = cvt_pk_bf16(r4, r5); w.w = cvt_pk_bf16(r6, r7);
                    *(u32x4*)(mp + bj * HALF) = w; } }
    }
};
struct MergeOrder {
    int G, c, lat;
    __device__ bool next(int i, Unit& u) const { const int grp = (i / 3) * G + c; if (grp >= (lat ? 256 : 264)) return false; int pm = grp >> 2; if (lat) pm = pm + 1 + (pm >= 32); u.pm = pm; u.pn = (grp & 3) + 4 * (i % 3); return true; }
    __device__ __forceinline__ void a_ready(const Unit&) const {}
    __device__ __forceinline__ void done(const Unit&) const {}
    __device__ __forceinline__ size_t aoff(const Unit& u) const { const int br = u.pn >> 2; return (size_t)(br == 0 ? 0 : (br == 1 ? 768 : 1280)) * 2; }
    __device__ __forceinline__ size_t boff(const Unit&) const { return 0; }
};
struct LatOrder {
    StaticOrder so;
    __device__ void init(int N, int G_, int c_) { so.init(64 * BM, N, G_, c_); }
    __device__ bool next(int i, Unit& u) const { if (!so.next(i, u)) return false; u.pm = u.pm + 1 + (u.pm >= 32); return true; }
    __device__ __forceinline__ void a_ready(const Unit&) const {}
    __device__ __forceinline__ void done(const Unit&) const {}
    __device__ __forceinline__ size_t aoff(const Unit&) const { return 0; }
    __device__ __forceinline__ size_t boff(const Unit&) const { return 0; }
};
struct CtxSplit {
    int G, c, KP, koff;
    __device__ bool next(int i, Unit& u) const { const int s = i * G + c; if (s >= 8 * KP) return false; const int t = s / KP; u.pn = t & 3; u.kp = s % KP; u.pm = (t >> 2) * 33; return true; }
    __device__ __forceinline__ void a_ready(const Unit&) const {}
    __device__ __forceinline__ void done(const Unit&) const {}
    __device__ __forceinline__ size_t aoff(const Unit& u) const { return (size_t)u.kp * koff; }
    __device__ __forceinline__ size_t boff(const Unit& u) const { return (size_t)u.kp * koff; }
};
struct OneUnit {
    int pm, pn;
    __device__ bool next(int i, Unit& u) const { if (i) return false; u.pm = pm; u.pn = pn; return true; }
    __device__ __forceinline__ void a_ready(const Unit&) const {}
    __device__ __forceinline__ void done(const Unit&) const {}
    __device__ __forceinline__ size_t aoff(const Unit&) const { return 0; }
    __device__ __forceinline__ size_t boff(const Unit&) const { return 0; }
};
}

#define XB_TMO      128
#define XB_XCNT(j)  (256  + 64 * (j))
#define XB_XSUB(j)  (1280 + 64 * (j))
#define XB_XGEN(j)  (2304 + 64 * (j))
#define XB_TOP      3328
#define XB_TOPGEN   3392
#define XCD_BAR_WORDS 3456
#define XB_SPIN_CAP (1u << 18)

__device__ __forceinline__ unsigned xb_ld(unsigned* p)              { return __hip_atomic_load(p, __ATOMIC_RELAXED, __HIP_MEMORY_SCOPE_AGENT); }
__device__ __forceinline__ unsigned xb_add(unsigned* p, unsigned v) { return __hip_atomic_fetch_add(p, v, __ATOMIC_RELAXED, __HIP_MEMORY_SCOPE_AGENT); }
__device__ __forceinline__ unsigned xb_xcc_id() { return (unsigned)__builtin_amdgcn_s_getreg((3 << 11) | 20) & 0xFu; }
#define XB_SPIN(cond, bar) do { unsigned _sp = 0; while (cond) { __builtin_amdgcn_s_sleep(1); \
    if ((++_sp & 255u) == 0u) { if (xb_ld(&(bar)[XB_TMO])) break; if (_sp > XB_SPIN_CAP) { atomicAdd(&(bar)[XB_TMO], 1u); break; } } } } while (0)

struct XcdBarrier {
    unsigned* bar; unsigned x;
    volatile LAS unsigned* st;
};

__device__ __forceinline__ XcdBarrier xcd_barrier_post(unsigned* bar, volatile LAS unsigned* st) {
    XcdBarrier b; b.bar = bar; b.x = xb_xcc_id(); b.st = st;
    if (my_tid() == 0) (void)xb_add(&bar[XB_XCNT(b.x)], 1u);
    return b;
}
__device__ __forceinline__ void xcd_barrier_complete(unsigned* bar, unsigned x, unsigned& nloc, unsigned& nx) {
    const unsigned G = gridDim.x * gridDim.y * gridDim.z;
    unsigned sum, cnt, mine, sp = 0u;
    for (;;) {
        sum = 0u; cnt = 0u; mine = 0u;
#pragma unroll
        for (unsigned j = 0; j < 16; ++j) { const unsigned c = xb_ld(&bar[XB_XCNT(j)]); sum += c; cnt += (c > 0u) ? 1u : 0u; mine = (j == x) ? c : mine; }
        if (sum == G) break;
        __builtin_amdgcn_s_sleep(1);
        if ((++sp & 255u) == 0u) { if (xb_ld(&bar[XB_TMO])) break; if (sp > XB_SPIN_CAP) { atomicAdd(&bar[XB_TMO], 1u); break; } }
    }
    nloc = mine > 0u ? mine : 1u; nx = cnt > 0u ? cnt : 1u;
}

__device__ __forceinline__ void xcd_barrier(const XcdBarrier& b) {
    asm volatile("s_waitcnt vmcnt(0)" ::: "memory");
    __syncthreads();
    if (my_tid() == 0) {
        unsigned* bar = b.bar;
        __builtin_amdgcn_s_waitcnt(0);
        unsigned nloc = b.st[0], nx = b.st[1];
        if (nloc == 0u) { xcd_barrier_complete(bar, b.x, nloc, nx); b.st[0] = nloc; b.st[1] = nx; }
        const unsigned old = xb_add(&bar[XB_XSUB(b.x)], 1u);
        const unsigned gen = old / nloc;
        if (old + 1u == (gen + 1u) * nloc) {
            __builtin_amdgcn_fence(__ATOMIC_RELEASE, "agent");
            asm volatile("s_waitcnt vmcnt(0)" ::: "memory");
            const unsigned og = xb_add(&bar[XB_TOP], 1u);
            const unsigned tg = og / nx;
            if (og + 1u == (tg + 1u) * nx) xb_add(&bar[XB_TOPGEN], 1u);
            else XB_SPIN(xb_ld(&bar[XB_TOPGEN]) == tg, bar);
            __builtin_amdgcn_fence(__ATOMIC_ACQUIRE, "agent");
            xb_add(&bar[XB_XGEN(b.x)], 1u);
            asm volatile("s_waitcnt vmcnt(0)" ::: "memory");
        } else {
            XB_SPIN(xb_ld(&bar[XB_XGEN(b.x)]) == gen, bar);
            __builtin_amdgcn_fence(__ATOMIC_ACQUIRE, "agent");
            asm volatile("s_waitcnt vmcnt(0)" ::: "memory");
        }
    }
    __syncthreads();
}

struct Frame {
    LAS unsigned char* lds; volatile LAS unsigned* MISC; unsigned* ctl;
    int tid, lane, wave, G, bid;
    const float *x, *c, *ctx, *cctx, *w_ada, *b_ada, *norm_g, *ffn_wi, *ffn_wo, *w_in, *qk_g, *diff_lam, *subln_g, *w_branch, *w_out;
    float* out; unsigned char* ws;
};
#define WSP(T, off) ((T*)(F.ws + (off)))

__device__ __forceinline__ void transpose_item(const float* W, int N, bf16* WT, int ldt, int k0, int n0, int dst_row0, LAS float* scr, int lane, int tm_nk = 0) {
#pragma unroll 8
    for (int i = 0; i < 32; ++i) { const int kk = 2 * i + (lane >> 5); scr[kk * 33 + (lane & 31)] = W[(size_t)(k0 + kk) * N + n0 + (lane & 31)]; }
    LDS_WAIT(); asm volatile("" ::: "memory");
    const int c = lane & 7;
#pragma unroll
    for (int j = 0; j < 4; ++j) { const int n = (lane >> 3) + 8 * j; const LAS float* s = scr + (8 * c) * 33 + n;
        v4u o; o.x = pk2(s[0 * 33], s[1 * 33]); o.y = pk2(s[2 * 33], s[3 * 33]); o.z = pk2(s[4 * 33], s[5 * 33]); o.w = pk2(s[6 * 33], s[7 * 33]);
        const int dr = dst_row0 + n; bf16* dp = tm_nk ? WT + ((size_t)((dr >> 8) * tm_nk + (k0 >> 6)) * 256 + (dr & 255)) * 64 + 8 * c : WT + (size_t)dr * ldt + k0 + 8 * c;
        *(v4u*)dp = o; }
    LDS_WAIT(); asm volatile("" ::: "memory");
}
__device__ __forceinline__ void convert_weights(Frame& F, int l) {
    LAS float* scr = (LAS float*)(F.lds + F.wave * 16384);
    const int gw = F.bid * NWAVES + F.wave, NGW = F.G * NWAVES;
    constexpr int I_UP = 16 * 176, I_DN = 44 * 32, I_IN = 16 * 184, I_BR = 8 * 32, I_OUT = 16 * 32;
    constexpr int NITEMS = 2 * I_UP + 2 * I_DN + I_IN + 3 * I_BR + I_OUT;
    const float* wi = F.ffn_wi + (size_t)l * 2 * 1024 * NUP; const float* wo = F.ffn_wo + (size_t)l * 2 * DFF * 1024;
    const float* win = F.w_in + (size_t)l * 1024 * INW; const float* wbr = F.w_branch + (size_t)l * 3 * 512 * 1024; const float* wout = F.w_out + (size_t)l * 1024 * 1024;
    for (int it = gw; it < NITEMS; it += NGW) {
        int r = it;
        if (r < 2 * I_UP) { const int h = r / I_UP; r -= h * I_UP; const int kb = r / 176, nb = r % 176; int n0 = nb * 32; const int isu = n0 >= DFF; const int nn = n0 - isu * DFF;
            transpose_item(wi + (size_t)h * 1024 * NUP, NUP, WSP(bf16, h ? WS_WUP1 : WS_WUP0), 1024, kb * 64, n0, (nn / 128) * 256 + isu * 128 + (nn % 128), scr, F.lane); continue; }
        r -= 2 * I_UP;
        if (r < 2 * I_DN) { const int h = r / I_DN; r -= h * I_DN; const int kb = r / 32, nb = r % 32;
            transpose_item(wo + (size_t)h * DFF * 1024, 1024, WSP(bf16, h ? WS_WDN1 : WS_WDN0), DFF, kb * 64, nb * 32, nb * 32, scr, F.lane, DFF / 64); continue; }
        r -= 2 * I_DN;
        if (r < I_IN) { const int kb = r / 184, nb = r % 184; const int n0 = nb * 32;
            if (n0 >= 2304 && n0 < 2816) continue;
            transpose_item(win, INW, WSP(bf16, WS_WIN), 1024, kb * 64, n0, n0 < 2304 ? n0 : n0 - 512, scr, F.lane); continue; }
        r -= I_IN;
        if (r < 3 * I_BR) { const int i = r / I_BR; r -= i * I_BR; const int kb = r / 32, nb = r % 32;
            transpose_item(wbr + (size_t)i * 512 * 1024, 1024, WSP(bf16, WS_WBR), 512, kb * 64, nb * 32, i * 1024 + nb * 32, scr, F.lane); continue; }
        r -= 3 * I_BR;
        { const int kb = r / 32, nb = r % 32; transpose_item(wout, 1024, WSP(bf16, WS_WOUT), 1024, kb * 64, nb * 32, nb * 32, scr, F.lane); }
    }
    {
        const int t = F.bid * 512 + F.tid;
        if (t < 65536) {
            const int jl = t & 63, rest = t >> 6, kc = rest & 127, rj = rest >> 7; const int row = rj * 64 + jl, g = row >> 7, j = row & 127;
            float a[8];
#pragma unroll
            for (int e = 0; e < 8; ++e) a[e] = 0.f;
            const float* wp = win + (size_t)(kc * 8) * INW + 2304 + g * 128;
            for (int c4 = 0; c4 < 32; ++c4) {
                float cs[4];
#pragma unroll
                for (int q = 0; q < 4; ++q) { const int idx = ((c4 * 4 + q) * j) & 127; float sn, co; sincospif((float)idx * (1.0f / 64.0f), &sn, &co); cs[q] = sn + co; }
#pragma unroll
                for (int e = 0; e < 8; ++e) { const f32x4 w = *(const f32x4*)(wp + (size_t)e * INW + c4 * 4); a[e] += w[0] * cs[0] + w[1] * cs[1] + w[2] * cs[2] + w[3] * cs[3]; }
            }
            v4u o; o.x = pk2(a[0], a[1]); o.y = pk2(a[2], a[3]); o.z = pk2(a[4], a[5]); o.w = pk2(a[6], a[7]);
            *(v4u*)(WSP(bf16, WS_WC) + (size_t)row * 1024 + kc * 8) = o;
        }
    }
}
__device__ __forceinline__ void make_cas(Frame& F) {
    const int t0 = F.bid * 512 + F.tid, NT_ = F.G * 512;
    for (int it = t0; it < HN * HN / 8; it += NT_) { const int k = it >> 9, n0 = (it & 511) * 8; float v[8];
#pragma unroll
        for (int e = 0; e < 8; ++e) { const int idx = (k * (n0 + e)) & (HN - 1); float sn, co; sincospif((float)idx * (2.0f / HN), &sn, &co); v[e] = sn + co; }
        v4u o; o.x = pk2(v[0], v[1]); o.y = pk2(v[2], v[3]); o.z = pk2(v[4], v[5]); o.w = pk2(v[6], v[7]);
        *(v4u*)(WSP(bf16, WS_CAS) + (size_t)k * HN + n0) = o; }
    for (int it = t0; it < 256 * 256 / 8; it += NT_) { const int k = it >> 5, n0 = (it & 31) * 8; float v[8];
#pragma unroll
        for (int e = 0; e < 8; ++e) { const int idx = (k * (n0 + e)) & 255; float sn, co; sincospif((float)idx * (1.0f / 128.0f), &sn, &co); v[e] = sn + co; }
        v4u o; o.x = pk2(v[0], v[1]); o.y = pk2(v[2], v[3]); o.z = pk2(v[4], v[5]); o.w = pk2(v[6], v[7]);
        *(v4u*)(WSP(bf16, WS_CAS256) + (size_t)k * 256 + n0) = o; }
}
__device__ __forceinline__ void make_mod(Frame& F) {
    LAS float* red = (LAS float*)F.lds;
    for (int item = F.bid; item < 288; item += F.G) {
        const int l = item / 144, cb = item % 144;
        const int c4 = F.lane & 15, ks = F.lane >> 4, slice = F.wave * 4 + ks;
        const float* W = F.w_ada + (size_t)l * 1024 * MODW + cb * 64 + c4 * 4;
        f32x4 a0 = {0.f, 0.f, 0.f, 0.f}, a1 = a0, a2 = a0;
        for (int r = 0; r < 32; ++r) { const int k = slice * 32 + r; const f32x4 w = *(const f32x4*)(W + (size_t)k * MODW);
            const float s0 = siluf(F.c[k]), s1 = siluf(F.c[1024 + k]), s2 = siluf(F.cctx[k]); a0 += w * s0; a1 += w * s1; a2 += w * s2; }
#pragma unroll
        for (int q = 0; q < 4; ++q) { red[(slice * 3 + 0) * 64 + c4 * 4 + q] = a0[q]; red[(slice * 3 + 1) * 64 + c4 * 4 + q] = a1[q]; red[(slice * 3 + 2) * 64 + c4 * 4 + q] = a2[q]; }
        __syncthreads();
        if (F.tid < 192) { const int set = F.tid >> 6, col = F.tid & 63; float s = 0.f;
            for (int sl = 0; sl < 32; ++sl) s += red[(sl * 3 + set) * 64 + col];
            WSP(float, WS_MOD)[((size_t)l * 3 + set) * MODW + cb * 64 + col] = s + F.b_ada[(size_t)l * MODW + cb * 64 + col]; }
        __syncthreads();
    }
}
__device__ __forceinline__ const float* hrow_ptr(const float* lat, const float* ctxp, int row, int& set) {
    const int b = row / RPB, w = row % RPB;
    if (w < CTXL) { set = 2; return ctxp + ((size_t)b * CTXL + w) * 1024; }
    set = b; return lat + ((size_t)b * SEQL + (w - CTXL)) * 1024;
}
__device__ __forceinline__ void norm_mod(Frame& F, const float* lat, const float* ctxp, const float* g, const float* modl  , int ishift, float* copy_ctx, const float* parts, int nparts) {
    const int gw = F.bid * NWAVES + F.wave, NGW = F.G * NWAVES;
    constexpr int NR = 9;
    for (int row0 = gw; row0 < MROWS; row0 += NR * NGW) {
        f32x4 v[NR][4]; int set[NR]; const float* hr[NR]; bool ok[NR]; float ss[NR];
#pragma unroll
        for (int r = 0; r < NR; ++r) { const int row = row0 + r * NGW; ok[r] = row < MROWS; hr[r] = hrow_ptr(lat, ctxp, ok[r] ? row : gw, set[r]);
#pragma unroll
            for (int j = 0; j < 4; ++j) v[r][j] = *((const f32x4*)hr[r] + F.lane + 64 * j); }
#pragma unroll
        for (int r = 0; r < NR; ++r) {
            if (set[r] == 2 && parts != nullptr) { const float* pr = parts + (hr[r] - ctxp);
                for (int p = 0; p < nparts; ++p) {
#pragma unroll
                    for (int j = 0; j < 4; ++j) v[r][j] += *((const f32x4*)(pr + (size_t)p * 512 * 1024) + F.lane + 64 * j); } }
            float s = 0.f;
#pragma unroll
            for (int j = 0; j < 4; ++j) s += (v[r][j][0] * v[r][j][0] + v[r][j][1] * v[r][j][1]) + (v[r][j][2] * v[r][j][2] + v[r][j][3] * v[r][j][3]);
            ss[r] = s; }
#pragma unroll
        for (int o = 1; o < 64; o <<= 1) {
#pragma unroll
            for (int r = 0; r < NR; ++r) ss[r] += shfl_xor(ss[r], o); }
#pragma unroll
        for (int r = 0; r < NR; ++r) if (ok[r]) {
            const int row = row0 + r * NGW;
            const float rstd = 1.0f / sqrtf(ss[r] * (1.0f / 1024.0f) + EPSN);
            const float* sh = modl + (size_t)set[r] * MODW + ishift * 1024; const float* sc = sh + 1024;
            if (copy_ctx != nullptr && set[r] == 2) { f32x4* cp = (f32x4*)(copy_ctx + (hr[r] - ctxp)) + F.lane;
#pragma unroll
                for (int j = 0; j < 4; ++j) cp[64 * j] = v[r][j]; }
            unsigned long long* o8 = (unsigned long long*)(WSP(bf16, WS_HN) + (size_t)row * 1024) + F.lane;
#pragma unroll
            for (int j = 0; j < 4; ++j) { const f32x4 gg = *((const f32x4*)g + F.lane + 64 * j), s1 = *((const f32x4*)sc + F.lane + 64 * j), s0 = *((const f32x4*)sh + F.lane + 64 * j);
                const f32x4 y = v[r][j] * rstd * gg * (s1 + 1.0f) + s0;
                o8[64 * j] = (unsigned long long)pk2(y[0], y[1]) | ((unsigned long long)pk2(y[2], y[3]) << 32); }
        }
    }
}
__device__ __forceinline__ void make_rope(Frame& F) {
    const int t0 = F.bid * 512 + F.tid, NT_ = F.G * 512;
    float* ct = WSP(float, WS_ROPE); float* st = ct + SEQL * 32;
    for (int it = t0; it < SEQL * 32; it += NT_) { const int s = it >> 5, i = it & 31;
        const float inv = exp2f(-(float)(i & 15) * (13.287712379549449f / 16.0f));
        const float pos = (float)((i < 16) ? (s >> 6) : (s & 63)); float sn, cs; sincosf(pos * inv, &sn, &cs); ct[it] = cs; st[it] = sn; }
}
__device__ __forceinline__ void qk_rope(Frame& F, int l) {
    const int gw = F.bid * NWAVES + F.wave, NGW = F.G * NWAVES;
    const float* qg = F.qk_g + (size_t)l * 256;
    const float* ct = WSP(float, WS_ROPE); const float* st = ct + SEQL * 32;
    const int c = F.lane & 3;
    int col[2], gsel[2]; bool isq[2], act[2];
#pragma unroll
    for (int pass = 0; pass < 2; ++pass) { const int q = pass * 64 + F.lane; act[pass] = q < 104; const int hv = act[pass] ? (q >> 2) : 0;
        if (hv < 8) { col[pass] = ZQA + hv * 64; gsel[pass] = 0; isq[pass] = true; } else if (hv < 10) { col[pass] = ZKA + (hv - 8) * 64; gsel[pass] = 1; isq[pass] = false; }
        else if (hv < 18) { col[pass] = ZQB + (hv - 10) * 64; gsel[pass] = 2; isq[pass] = true; } else { col[pass] = ZKB + (hv - 18) * 64; gsel[pass] = 3; isq[pass] = false; } }
    constexpr int NRQ = 5;
    for (int row0 = gw; row0 < MROWS; row0 += NRQ * NGW) {
        v4u lo[NRQ][2], hi[NRQ][2];
#pragma unroll
        for (int rr = 0; rr < NRQ; ++rr) { const int row = row0 + rr * NGW; const bf16* zr = WSP(bf16, WS_Z) + (size_t)(row < MROWS ? row : gw) * ZW;
#pragma unroll
            for (int pass = 0; pass < 2; ++pass) { lo[rr][pass] = *(const v4u*)(zr + col[pass] + 8 * c); hi[rr][pass] = *(const v4u*)(zr + col[pass] + 32 + 8 * c); } }
#pragma unroll
        for (int rr = 0; rr < NRQ; ++rr) { const int row = row0 + rr * NGW; const bool ok = row < MROWS; const int w = (ok ? row : gw) % RPB; bf16* zr = WSP(bf16, WS_Z) + (size_t)(ok ? row : gw) * ZW;
#pragma unroll
            for (int pass = 0; pass < 2; ++pass) {
                const v4u lo_ = lo[rr][pass], hi_ = hi[rr][pass];
                float x1[8], x2[8];
                x1[0] = bflo(lo_.x); x1[1] = bfhi(lo_.x); x1[2] = bflo(lo_.y); x1[3] = bfhi(lo_.y); x1[4] = bflo(lo_.z); x1[5] = bfhi(lo_.z); x1[6] = bflo(lo_.w); x1[7] = bfhi(lo_.w);
                x2[0] = bflo(hi_.x); x2[1] = bfhi(hi_.x); x2[2] = bflo(hi_.y); x2[3] = bfhi(hi_.y); x2[4] = bflo(hi_.z); x2[5] = bfhi(hi_.z); x2[6] = bflo(hi_.w); x2[7] = bfhi(hi_.w);
                float ss = 0.f;
#pragma unroll
                for (int e = 0; e < 8; ++e) ss += x1[e] * x1[e] + x2[e] * x2[e];
                ss += shfl_xor(ss, 1); ss += shfl_xor(ss, 2);
                const float rstd = 1.0f / sqrtf(ss * (1.0f / 64.0f) + EPSN);
                const float sc = isq[pass] ? attn_body::C2 : 1.0f;
                const float* gq = qg + gsel[pass] * 64 + 8 * c;
                const f32x4 ga = *(const f32x4*)(gq), gb = *(const f32x4*)(gq + 4), gc = *(const f32x4*)(gq + 32), gd = *(const f32x4*)(gq + 36);
                f32x4 ca = {1.f, 1.f, 1.f, 1.f}, cb = ca, sa = {0.f, 0.f, 0.f, 0.f}, sb = sa;
                if (w >= CTXL) { const int s = w - CTXL; ca = *(const f32x4*)(ct + s * 32 + 8 * c); cb = *(const f32x4*)(ct + s * 32 + 8 * c + 4); sa = *(const f32x4*)(st + s * 32 + 8 * c); sb = *(const f32x4*)(st + s * 32 + 8 * c + 4); }
                float o1[8], o2[8];
#pragma unroll
                for (int e = 0; e < 8; ++e) { const float g1 = e < 4 ? ga[e & 3] : gb[e & 3], g2 = e < 4 ? gc[e & 3] : gd[e & 3], cs = e < 4 ? ca[e & 3] : cb[e & 3], sn = e < 4 ? sa[e & 3] : sb[e & 3];
                    const float y1 = x1[e] * rstd * g1, y2 = x2[e] * rstd * g2; o1[e] = (y1 * cs - y2 * sn) * sc; o2[e] = (y1 * sn + y2 * cs) * sc; }
                if (act[pass] && ok) { v4u a, b2; a.x = pk2(o1[0], o1[1]); a.y = pk2(o1[2], o1[3]); a.z = pk2(o1[4], o1[5]); a.w = pk2(o1[6], o1[7]);
                    b2.x = pk2(o2[0], o2[1]); b2.y = pk2(o2[2], o2[3]); b2.z = pk2(o2[4], o2[5]); b2.w = pk2(o2[6], o2[7]);
                    *(v4u*)(zr + col[pass] + 8 * c) = a; *(v4u*)(zr + col[pass] + 32 + 8 * c) = b2; }
            }
        }
    }
}
__device__ __forceinline__ void make_pq(Frame& F) {
    const int t0 = F.bid * 512 + F.tid, NT_ = F.G * 512;
    const bf16* T1 = WSP(bf16, WS_T1T); bf16* PQ = WSP(bf16, WS_PQ);
    for (int it0 = t0; it0 < 2 * 512 * HN; it0 += 16 * NT_) {
        float x0[16], x1[16], y0[16], y1[16];
#pragma unroll
        for (int u = 0; u < 16; ++u) { const int it = it0 + u * NT_; const int itc = it < 2 * 512 * HN ? it : t0;
            const int n = itc & (HN - 1), col = (itc >> 12) & 511, b = itc >> 21; const bf16* xr = T1 + (size_t)col * MROWS + b * RPB + CTXL; const int nm = (HN - n) & (HN - 1);
            x0[u] = bf2f(xr[n]); x1[u] = bf2f(xr[n + HN]); y0[u] = bf2f(xr[nm]); y1[u] = bf2f(xr[nm + HN]); }
#pragma unroll
        for (int u = 0; u < 16; ++u) { const int it = it0 + u * NT_; if (it < 2 * 512 * HN) {
            const int n = it & (HN - 1), col = (it >> 12) & 511, b = it >> 21; const int nm = (HN - n) & (HN - 1);
            float sn, co, snm, com; sincospif((float)n * (1.0f / HN), &sn, &co); sincospif((float)nm * (1.0f / HN), &snm, &com);
            const float p = x0[u] + x1[u], q = (x0[u] - x1[u]) * co + (y0[u] - y1[u]) * snm;
            PQ[((size_t)(b * 2 + 0) * 512 + col) * HN + n] = (bf16)(pk2(p, 0.f) & 0xffffu);
            PQ[((size_t)(b * 2 + 1) * 512 + col) * HN + n] = (bf16)(pk2(q, 0.f) & 0xffffu); } }
    }
}
__device__ __forceinline__ void post_mix(Frame& F, int l) {
    const int gw = F.bid * NWAVES + F.wave, NGW = F.G * NWAVES;
    const float lam_init = 0.8f - 0.6f * expf(-0.3f * (float)l);
    const float* dl = F.diff_lam + (size_t)l * 256;
    const float s1 = wave_sum(dl[F.lane] * dl[64 + F.lane]), s2 = wave_sum(dl[128 + F.lane] * dl[192 + F.lane]);
    const float lam = expf(s1) - expf(s2) + lam_init;
    const float* sg = F.subln_g + (size_t)l * 128 + (F.lane & 15) * 8;
    float gsc[8];
#pragma unroll
    for (int e = 0; e < 8; ++e) gsc[e] = sg[e] * (1.0f - lam_init);
    const bf16* OB = WSP(bf16, WS_HN); const bf16* T2 = WSP(bf16, WS_T2); const bf16* T2B = WSP(bf16, WS_T2B); bf16* Z = WSP(bf16, WS_Z);
    const int g = F.lane >> 4, j0 = (F.lane & 15) * 8;
    constexpr int NRP = 4;
    for (int row0 = gw; row0 < MROWS; row0 += NRP * NGW) {
        v4u a[NRP], c2[NRP], mv[NRP], mv2[NRP]; unsigned short rk1[NRP][8], rk2[NRP][8]; bool lat[NRP], ok[NRP]; float sc[NRP];
#pragma unroll
        for (int rr = 0; rr < NRP; ++rr) { const int rw = row0 + rr * NGW; ok[rr] = rw < MROWS; const int row = ok[rr] ? rw : gw; const int b = row / RPB, w = row % RPB;
            a[rr] = *(const v4u*)(OB + (size_t)row * 1024 + F.lane * 8); c2[rr] = *(const v4u*)(OB + (size_t)row * 1024 + 512 + F.lane * 8);
            int mrow; lat[rr] = w >= CTXL;
            if (!lat[rr]) { mrow = b * RPB + ((CTXL - w) & (CTXL - 1)); sc[rr] = 0.5f * 0.005524271728019903f; }
            else { const int s = w - CTXL; mrow = b * RPB + CTXL + ((SEQL - s) & (SEQL - 1)); sc[rr] = 1.0f / 2048.0f; }
            const bf16* rk = T2 + (size_t)row * 512 + g * 128; mv[rr] = *(const v4u*)(T2 + (size_t)mrow * 512 + g * 128 + j0);
            const bf16* rkb = (lat[rr] ? T2B : T2) + (size_t)row * 512 + g * 128; mv2[rr] = *(const v4u*)((lat[rr] ? T2B : T2) + (size_t)mrow * 512 + g * 128 + j0);
#pragma unroll
            for (int e = 0; e < 8; ++e) { rk1[rr][e] = rk[(128 - (j0 + e)) & 127]; rk2[rr][e] = rkb[(128 - (j0 + e)) & 127]; } }
#pragma unroll
        for (int rr = 0; rr < NRP; ++rr) if (ok[rr]) { const int row = row0 + rr * NGW;
            {
                const v4u a_ = a[rr], c_ = c2[rr];
                float d[8];
                d[0] = bflo(a_.x) - lam * bflo(c_.x); d[1] = bfhi(a_.x) - lam * bfhi(c_.x); d[2] = bflo(a_.y) - lam * bflo(c_.y); d[3] = bfhi(a_.y) - lam * bfhi(c_.y);
                d[4] = bflo(a_.z) - lam * bflo(c_.z); d[5] = bfhi(a_.z) - lam * bfhi(c_.z); d[6] = bflo(a_.w) - lam * bflo(c_.w); d[7] = bfhi(a_.w) - lam * bfhi(c_.w);
                float ss = 0.f;
#pragma unroll
                for (int e = 0; e < 8; ++e) ss += d[e] * d[e];
#pragma unroll
                for (int o = 1; o < 16; o <<= 1) ss += shfl_xor(ss, o);
                const float rstd = 1.0f / sqrtf(ss * (1.0f / 128.0f) + EPSN);
                v4u o; o.x = pk2(d[0] * rstd * gsc[0], d[1] * rstd * gsc[1]); o.y = pk2(d[2] * rstd * gsc[2], d[3] * rstd * gsc[3]);
                o.z = pk2(d[4] * rstd * gsc[4], d[5] * rstd * gsc[5]); o.w = pk2(d[6] * rstd * gsc[6], d[7] * rstd * gsc[7]);
                *(v4u*)(Z + (size_t)row * ZW + ZQB + F.lane * 8) = o;
            }
            {
                float r[8], mm_[8]; const v4u m1 = mv[rr], m2 = mv2[rr]; const float f2 = lat[rr] ? 1.0f : 0.0f;
#pragma unroll
                for (int e = 0; e < 8; ++e) r[e] = bf2f(rk1[rr][e]) + f2 * bf2f(rk2[rr][e]);
                mm_[0] = bflo(m1.x) + f2 * bflo(m2.x); mm_[1] = bfhi(m1.x) + f2 * bfhi(m2.x); mm_[2] = bflo(m1.y) + f2 * bflo(m2.y); mm_[3] = bfhi(m1.y) + f2 * bfhi(m2.y);
                mm_[4] = bflo(m1.z) + f2 * bflo(m2.z); mm_[5] = bfhi(m1.z) + f2 * bfhi(m2.z); mm_[6] = bflo(m1.w) + f2 * bflo(m2.w); mm_[7] = bfhi(m1.w) + f2 * bfhi(m2.w);
                const float s_ = sc[rr];
                v4u o; o.x = pk2((r[0] + mm_[0]) * s_, (r[1] + mm_[1]) * s_); o.y = pk2((r[2] + mm_[2]) * s_, (r[3] + mm_[3]) * s_);
                o.z = pk2((r[4] + mm_[4]) * s_, (r[5] + mm_[5]) * s_); o.w = pk2((r[6] + mm_[6]) * s_, (r[7] + mm_[7]) * s_);
                *(v4u*)(Z + (size_t)row * ZW + ZKB + F.lane * 8) = o;
            }
        }
    }
}
__device__ __forceinline__ void hartley_ctx(Frame& F) {
    for (int r = F.bid; r < 4; r += F.G) { const int b = r >> 1;
        pg8::Gemm g{WSP(bf16, WS_CAS256), WSP(bf16, WS_T1T) + (size_t)b * RPB, 256, 512, 256, 256, MROWS};
        pg8::OneUnit S{0, r & 1};
        pg8::EpiStore E{WSP(bf16, WS_T2), 512, 1 << 30, b * RPB, 1};
        pg8::gemm_phase<pg8::EpiStore, pg8::OneUnit, true, true, 256, 256, MROWS>(F.lds, g, S, E); }
}
__device__ __forceinline__ void mixer_phase(Frame& F, int l) {
    constexpr int QL = 64 + 64 + 32, QC = 4;
    const int qlen = (l == NLAYER - 1) ? QL : QL + QC;
    bf16* Z = WSP(bf16, WS_Z);
    const int myx = (int)(xb_xcc_id() & 7u);
    int dq = 0;
    for (;;) {
        if (F.tid == 0) { int it = -1, x = 0, d = dq;
            for (; d < 8; ++d) { x = (myx + d) & 7; const unsigned v = __hip_atomic_fetch_add(F.ctl + CW_Q + (l * 8 + x) * 64, 1u, __ATOMIC_RELAXED, __HIP_MEMORY_SCOPE_AGENT); if ((int)v < qlen) { it = (int)v; break; } }
            F.MISC[0] = (unsigned)it; F.MISC[1] = (unsigned)x; F.MISC[2] = (unsigned)d; }
        __syncthreads();
        const int it = (int)F.MISC[0], x = (int)F.MISC[1]; dq = (int)F.MISC[2];
        __syncthreads();
        if (it < 0) break;
        if (it >= 128 && it < QL) {
            int r = x * 32 + (it - 128); const int kh = r & 1; r >>= 1; const int b = r >> 6, r6 = r & 63, par = r6 >> 5, r2 = r6 & 31;
            pg8::Gemm g{WSP(bf16, WS_CAS) + kh * (HN / 2), WSP(bf16, WS_PQ) + (size_t)(b * 2 + par) * 512 * HN + kh * (HN / 2), HN, 512, HN / 2, HN, HN};
            pg8::OneUnit S{r2 >> 1, r2 & 1};
            pg8::EpiStore E{WSP(bf16, kh ? WS_T2B : WS_T2), 512, 1 << 30, b * RPB + CTXL + par, 2};
            pg8::gemm_phase<pg8::EpiStore, pg8::OneUnit, true, true, HN / 2, HN, HN>(F.lds, g, S, E);
        } else {
            int b, j, qrow, nt; bool big;
            if (it < 128) { big = it < 64; b = (it >> 5) & 1; j = x; qrow = b * RPB + CTXL + (it & 31) * 256; nt = RPB / 64; }
            else { const int r = x * 4 + (it - QL); big = r < 16; j = r & 7; b = (r >> 3) & 1; qrow = b * RPB; nt = CTXL / 64; }
            const size_t kv0 = (size_t)b * RPB;
            if (big) { const int h = j >> 1, mm = j & 1;
                const bf16* Qp = Z + ZQB + (h * 2 + mm) * 64; const bf16* Kp = Z + ZKB + (h * 2 + mm) * 64; const bf16* Vp = Z + ZVB + h * 128; bf16* Op = WSP(bf16, WS_HN) + mm * 512 + h * 128;
                attn_body::attn_unit128<8>((const attn_body::bf16*)(Qp + (size_t)qrow * ZW), ZW, (const attn_body::bf16*)(Kp + kv0 * ZW), ZW, (const attn_body::bf16*)(Vp + kv0 * ZW), ZW,
                                           (attn_body::bf16*)(Op + (size_t)qrow * 1024), 1024, nt, (char*)F.lds);
            } else {
                const bf16* Qp = Z + ZQA + j * 64; const bf16* Kp = Z + ZKA + (j >> 2) * 64; const bf16* Vp = Z + ZVA + (j >> 2) * 64; bf16* Op = Z + ZQA + j * 64;
                attn_body::attn_unit<8>((const attn_body::bf16*)(Qp + (size_t)qrow * ZW), ZW, (const attn_body::bf16*)(Kp + kv0 * ZW), ZW, (const attn_body::bf16*)(Vp + kv0 * ZW), ZW,
                                        (attn_body::bf16*)(Op + (size_t)qrow * ZW), ZW, nt, (char*)F.lds);
            }
        }
    }
}

#ifndef MK_PER_PHASE
#define MK_PER_PHASE 0
#endif
constexpr int NPHASE = 1 + 13 * NLAYER;
struct Args { const float* in[15]; float* out; unsigned char* ws; int ph_lo, ph_hi; };
__device__ __forceinline__ void load_frame(Frame& F) {
    const __attribute__((address_space(4))) Args* a = (const __attribute__((address_space(4))) Args*)__builtin_amdgcn_kernarg_segment_ptr();
    asm volatile("" : "+s"(a));
    extern __shared__ __attribute__((aligned(16))) unsigned char lds_raw[];
    F.lds = (LAS unsigned char*)lds_raw; F.MISC = (volatile LAS unsigned*)(F.lds + MISC_OFF);
    int t = my_tid(); asm volatile("" : "+v"(t));
    F.tid = t; F.lane = t & 63; F.wave = __builtin_amdgcn_readfirstlane(t >> 6); F.G = gridDim.x; F.bid = blockIdx.x;
    F.x = a->in[0]; F.c = a->in[1]; F.ctx = a->in[2]; F.cctx = a->in[3]; F.w_ada = a->in[4]; F.b_ada = a->in[5]; F.norm_g = a->in[6]; F.ffn_wi = a->in[7];
    F.ffn_wo = a->in[8]; F.w_in = a->in[9]; F.qk_g = a->in[10]; F.diff_lam = a->in[11]; F.subln_g = a->in[12]; F.w_branch = a->in[13]; F.w_out = a->in[14];
    F.out = a->out; F.ws = a->ws; F.ctl = (unsigned*)(a->ws + WS_CTL);
}
#ifndef MK_MASK
#define MK_MASK 0xffffffffu
#endif
#define EN(j) (((MK_MASK) >> (j)) & 1u)
#ifndef MK_DUP
#define MK_DUP 0
#endif
#define DUP(b) for (int rep_ = 0; rep_ < (((MK_DUP) >> (b)) & 1) + 1; ++rep_)
__device__ __forceinline__ void seam_barrier() {
    const __attribute__((address_space(4))) Args* a = (const __attribute__((address_space(4))) Args*)__builtin_amdgcn_kernarg_segment_ptr();
    asm volatile("" : "+s"(a));
    extern __shared__ __attribute__((aligned(16))) unsigned char lds_raw[];
    XcdBarrier b; b.bar = (unsigned*)(a->ws + WS_CTL) + CW_BAR; b.x = xb_xcc_id(); b.st = (volatile LAS unsigned*)((LAS unsigned char*)lds_raw + MISC_OFF) + 8;
    xcd_barrier(b);
}
#define LF() Frame F; load_frame(F); float* hlat = F.out; float* hctx = WSP(float, WS_HC); const float* modl = WSP(float, WS_MOD) + (size_t)l * 3 * MODW; const float* ng = F.norm_g + (size_t)l * 3 * 1024; \
    const float* slat = (l == 0) ? F.x : hlat; const float* sctx = (l == 0) ? F.ctx : hctx; (void)hlat; (void)hctx; (void)modl; (void)ng; (void)slat; (void)sctx
__global__ void __launch_bounds__(NWAVES * 64, 2) mk_fwd(Args args) {
    cg::grid_group grid = cg::this_grid();
    const int lo = args.ph_lo, hi = args.ph_hi;
    {
        extern __shared__ __attribute__((aligned(16))) unsigned char lds_raw[];
        volatile LAS unsigned* misc = (volatile LAS unsigned*)((LAS unsigned char*)lds_raw + MISC_OFF);
        const int t0 = threadIdx.x;
        if (t0 < 32) misc[t0] = 0u;
        if ((t0 & 63) == 0) ((volatile LAS int*)((LAS unsigned char*)lds_raw + WTAB_OFF))[hw_slot()] = t0 >> 6;
        __syncthreads();
        if (hi - lo > 1) (void)xcd_barrier_post((unsigned*)(args.ws + WS_CTL) + CW_BAR, misc + 8);
    }
#define IN(k) (lo <= (k) && (k) < hi)
    if (lo < 0) grid.sync();
#ifndef MK_TMASK
#define MK_TMASK 0
#endif
#define TSTAMP(kind) do { if (MK_TMASK) { if (blockIdx.x == 0 && my_tid() == 0) { extern __shared__ __attribute__((aligned(16))) unsigned char lds_raw[]; volatile LAS unsigned* tm = (volatile LAS unsigned*)((LAS unsigned char*)lds_raw + MISC_OFF) + 16; \
        const unsigned now = (unsigned)__builtin_amdgcn_s_memrealtime(); if (((MK_TMASK) >> (kind)) & 1) tm[1] += now - tm[0]; tm[0] = now; } } } while (0)
#define SEAM(k) do { if (IN(k) && IN((k) + 1)) { seam_barrier(); } } while (0)
    TSTAMP(31);
    if (EN(0) && IN(0)) { const int l = 0; LF(); DUP(4) { make_mod(F); convert_weights(F, 0); make_cas(F); make_rope(F); } }
    SEAM(0); TSTAMP(0);
    for (int l = 0; l < NLAYER; ++l) {
        const int p0 = 1 + 13 * l;
        if (EN(1) && IN(p0 + 0)) { LF(); if (l > 0) DUP(4) convert_weights(F, l); norm_mod(F, slat, sctx, ng, modl, 0, hctx, (l == 0) ? nullptr : WSP(float, WS_PART), DFF / 256); }
        SEAM(p0 + 0); TSTAMP(1);
        if (EN(2) && IN(p0 + 1)) { LF(); pg8::Gemm g{WSP(bf16, WS_HN), WSP(bf16, WS_WUP0), MROWS, NUP, 1024, 1024, 1024}; pg8::StaticOrder S; S.init(MROWS, NUP, F.G, F.bid);
            pg8::EpiSwiGLU E{WSP(bf16, WS_Z), DFF}; DUP(1) pg8::gemm_phase<pg8::EpiSwiGLU, pg8::StaticOrder, true, true, 1024, 1024, 1024>(F.lds, g, S, E); }
        SEAM(p0 + 1); TSTAMP(2);
        if (EN(3) && IN(p0 + 2)) { LF();
            { pg8::Gemm g{WSP(bf16, WS_Z), WSP(bf16, WS_WDN0), MROWS, 1024, DFF, DFF, DFF}; pg8::LatOrder S; S.init(1024, F.G, F.bid);
              pg8::EpiResid E{slat, sctx, hlat, hctx, modl + 2 * 1024, 0.5f}; for (int rep_ = 0; rep_ < ((((MK_DUP) >> 7) & 1) && l == 0 ? 4 : 1); ++rep_) pg8::gemm_phase<pg8::EpiResid, pg8::LatOrder, true, true, DFF, 64, 64, 32768, (DFF / 64) * 32768, 32768, (DFF / 64) * 32768>(F.lds, g, S, E); }
            { pg8::Gemm g{WSP(bf16, WS_Z), WSP(bf16, WS_WDN0), MROWS, 1024, 256, DFF, DFF}; pg8::CtxSplit S{F.G, F.G - 1 - F.bid, DFF / 256, 4 * 32768};
              pg8::EpiResidA E{WSP(float, WS_PART), modl + 2 * MODW + 2 * 1024, 0.5f}; pg8::gemm_phase<pg8::EpiResidA, pg8::CtxSplit, true, true, 256, 64, 64, 32768, (DFF / 64) * 32768, 32768, (DFF / 64) * 32768>(F.lds, g, S, E); } }
        SEAM(p0 + 2); TSTAMP(3);
        if (EN(4) && IN(p0 + 3)) { LF(); norm_mod(F, hlat, hctx, ng + 1024, modl, 3, hctx, WSP(float, WS_PART), DFF / 256); }
        SEAM(p0 + 3); TSTAMP(4);
        if (EN(5) && IN(p0 + 4)) { LF();
            { pg8::Gemm g{WSP(bf16, WS_HN), WSP(bf16, WS_WIN), MROWS, ZW, 1024, 1024, 1024}; pg8::StaticOrder S; S.init(MROWS, ZW, F.G, F.bid);
              pg8::EpiStore E{WSP(bf16, WS_Z), ZW, ZGATE, 0, 1}; DUP(5) pg8::gemm_phase<pg8::EpiStore, pg8::StaticOrder, true, true, 1024, 1024, 1024>(F.lds, g, S, E); }
            { pg8::Gemm g{WSP(bf16, WS_WC), WSP(bf16, WS_HN), 512, MROWS, 1024, 1024, 1024}; pg8::StaticOrder S; S.init(512, MROWS, F.G, F.G - 1 - F.bid);
              pg8::EpiStore E{WSP(bf16, WS_T1T), MROWS, 1 << 30, 0, 1}; DUP(5) pg8::gemm_phase<pg8::EpiStore, pg8::StaticOrder, true, true, 1024, 1024, 1024>(F.lds, g, S, E); }
        }
        SEAM(p0 + 4); TSTAMP(5);
        if (EN(6) && IN(p0 + 5)) { LF(); qk_rope(F, l); make_pq(F); if (l < NLAYER - 1) hartley_ctx(F); }
        SEAM(p0 + 5); TSTAMP(6);
        if (EN(7) && IN(p0 + 6)) { LF(); mixer_phase(F, l); }
        SEAM(p0 + 6); TSTAMP(7);
        if (EN(8) && IN(p0 + 7)) { LF(); post_mix(F, l); }
        SEAM(p0 + 7); TSTAMP(8);
        if (EN(9) && IN(p0 + 8)) { LF(); pg8::Gemm g{WSP(bf16, WS_Z), WSP(bf16, WS_WBR), MROWS, 3072, 512, ZW, 512}; pg8::MergeOrder S{F.G, F.bid, l == NLAYER - 1};
            pg8::EpiMerge E{WSP(bf16, WS_Z), WSP(bf16, WS_HN)}; DUP(6) pg8::gemm_phase<pg8::EpiMerge, pg8::MergeOrder, true, true, 512, ZW, 512>(F.lds, g, S, E); }
        SEAM(p0 + 8); TSTAMP(9);
        if (EN(10) && IN(p0 + 9)) { LF();
            { pg8::Gemm g{WSP(bf16, WS_HN), WSP(bf16, WS_WOUT), MROWS, 1024, 1024, 1024, 1024}; pg8::LatOrder S; S.init(1024, F.G, F.bid);
              pg8::EpiResid E{hlat, hctx, hlat, hctx, modl + 5 * 1024, 1.0f}; pg8::gemm_phase<pg8::EpiResid, pg8::LatOrder, true, true, 1024, 1024, 1024>(F.lds, g, S, E); }
            if (l < NLAYER - 1) { pg8::Gemm g{WSP(bf16, WS_HN), WSP(bf16, WS_WOUT), MROWS, 1024, 256, 1024, 1024}; pg8::CtxSplit S{F.G, F.G - 1 - F.bid, 4, 512};
              pg8::EpiResidA E{WSP(float, WS_PART), modl + 2 * MODW + 5 * 1024, 1.0f}; pg8::gemm_phase<pg8::EpiResidA, pg8::CtxSplit, true, true, 256, 1024, 1024>(F.lds, g, S, E); } }
        SEAM(p0 + 9); TSTAMP(10);
        if (EN(11) && IN(p0 + 10)) { LF(); norm_mod(F, hlat, hctx, ng + 2048, modl, 6, (l == 0) ? hctx : nullptr, (l == 0) ? WSP(float, WS_PART) : nullptr, 4); }
        SEAM(p0 + 10); TSTAMP(11);
        if (EN(12) && IN(p0 + 11)) { LF(); pg8::Gemm g{WSP(bf16, WS_HN), WSP(bf16, WS_WUP1), MROWS, NUP, 1024, 1024, 1024}; pg8::StaticOrder S; S.init(MROWS, NUP, F.G, F.bid);
            pg8::EpiSwiGLU E{WSP(bf16, WS_Z), DFF}; DUP(1) pg8::gemm_phase<pg8::EpiSwiGLU, pg8::StaticOrder, true, true, 1024, 1024, 1024>(F.lds, g, S, E); }
        SEAM(p0 + 11); TSTAMP(12);
        if (EN(13) && IN(p0 + 12)) { LF();
            { pg8::Gemm g{WSP(bf16, WS_Z), WSP(bf16, WS_WDN1), MROWS, 1024, DFF, DFF, DFF}; pg8::LatOrder S; S.init(1024, F.G, F.bid);
              pg8::EpiResid E{hlat, hctx, hlat, hctx, modl + 8 * 1024, 0.5f}; pg8::gemm_phase<pg8::EpiResid, pg8::LatOrder, true, true, DFF, 64, 64, 32768, (DFF / 64) * 32768, 32768, (DFF / 64) * 32768>(F.lds, g, S, E); }
            if (l < NLAYER - 1) { pg8::Gemm g{WSP(bf16, WS_Z), WSP(bf16, WS_WDN1), MROWS, 1024, 256, DFF, DFF}; pg8::CtxSplit S{F.G, F.G - 1 - F.bid, DFF / 256, 4 * 32768};
              pg8::EpiResidA E{WSP(float, WS_PART), modl + 2 * MODW + 8 * 1024, 0.5f}; pg8::gemm_phase<pg8::EpiResidA, pg8::CtxSplit, true, true, 256, 64, 64, 32768, (DFF / 64) * 32768, 32768, (DFF / 64) * 32768>(F.lds, g, S, E); } }
        SEAM(p0 + 12); TSTAMP(13);
    }
    if (MK_TMASK) { if (blockIdx.x == 0) { if (my_tid() == 0) { extern __shared__ __attribute__((aligned(16))) unsigned char lds_raw[]; volatile LAS unsigned* tm = (volatile LAS unsigned*)((LAS unsigned char*)lds_raw + MISC_OFF) + 16;
            const unsigned t0 = (unsigned)__builtin_amdgcn_s_memrealtime(), want = tm[1]; while ((unsigned)__builtin_amdgcn_s_memrealtime() - t0 < want) __builtin_amdgcn_s_sleep(16); }
        __syncthreads(); } }
#undef IN
#undef SEAM
}

extern "C" void kernel_launch(void* const* d_in, const int* in_sizes, int n_in, void* d_out, int out_size, void* d_ws, size_t ws_size, hipStream_t stream) {
    static int grid = 0;
    if (grid == 0) {
        if (n_in != 15 || ws_size < WS_END) { fprintf(stderr, "kernel_launch: need 15 inputs and >= %zu bytes of workspace; got n_in %d, ws %zu\n", (size_t)WS_END, n_in, ws_size); grid = -1; return; }
        int dev = 0, cus = 0, per_cu = 0;
        if (hipGetDevice(&dev) != hipSuccess || hipDeviceGetAttribute(&cus, hipDeviceAttributeMultiprocessorCount, dev) != hipSuccess) { grid = -1; return; }
        if (hipFuncSetAttribute((const void*)mk_fwd, hipFuncAttributeMaxDynamicSharedMemorySize, LDS_BYTES) != hipSuccess) { fprintf(stderr, "kernel_launch: hipFuncSetAttribute failed\n"); grid = -1; return; }
        if (hipOccupancyMaxActiveBlocksPerMultiprocessor(&per_cu, (const void*)mk_fwd, NWAVES * 64, LDS_BYTES) != hipSuccess || per_cu < 1) { fprintf(stderr, "kernel_launch: occupancy query says %d\n", per_cu); per_cu = 1; }
        (void)hipGetLastError();
        grid = cus * per_cu;
    }
    if (grid < 0) return;
    (void)hipMemsetAsync((char*)d_ws + WS_CTL, 0, CTL_ZERO_BYTES, stream);
    Args a{};
    for (int i = 0; i < 15; ++i) a.in[i] = (const float*)d_in[i];
    a.out = (float*)d_out; a.ws = (unsigned char*)d_ws;
#if MK_PER_PHASE
    for (int p = 0; p < NPHASE; ++p) { a.ph_lo = p; a.ph_hi = p + 1; hipLaunchKernelGGL(mk_fwd, dim3(grid), dim3(NWAVES * 64), LDS_BYTES, stream, a); }
#else
    a.ph_lo = 0; a.ph_hi = NPHASE;
    void* kargs[] = {&a};
    hipError_t e = hipLaunchCooperativeKernel((const void*)mk_fwd, dim3(grid), dim3(NWAVES * 64), kargs, LDS_BYTES, stream);
    if (e != hipSuccess) fprintf(stderr, "kernel_launch: cooperative launch failed: %s (grid %d)\n", hipGetErrorString(e), grid);
#endif
}
```

```cpp
#include <hip/hip_runtime.h>
#include <hip/hip_cooperative_groups.h>
#include <hip/hip_bf16.h>
#include <cstdio>
#include <cstdint>
#include <cmath>
namespace cg = cooperative_groups;

#define LAS __attribute__((address_space(3)))
constexpr int LDS_BYTES = 147456, MISC_OFF = 131072 + 320, WTAB_OFF = MISC_OFF + 128;
__device__ __forceinline__ int lane_id() { int l; asm volatile("v_mbcnt_lo_u32_b32 %0, -1, 0\n\tv_mbcnt_hi_u32_b32 %0, -1, %0" : "=&v"(l)); return l; }
__device__ __forceinline__ unsigned hw_slot() { return (unsigned)__builtin_amdgcn_s_getreg((5 << 11) | 4) & 63u; }
__device__ __forceinline__ int my_tid() {
    extern __shared__ __attribute__((aligned(16))) unsigned char lds_raw[];
    const int w = ((volatile LAS int*)((LAS unsigned char*)lds_raw + WTAB_OFF))[hw_slot()];
    return __builtin_amdgcn_readfirstlane(w) * 64 + lane_id();
}

namespace pg8 {
#define PG8_LAS __attribute__((address_space(3)))
typedef unsigned short bf16_t;
typedef short bf16x8 __attribute__((ext_vector_type(8)));
typedef float f32x4 __attribute__((ext_vector_type(4)));
typedef unsigned u32x4 __attribute__((ext_vector_type(4)));
constexpr int BM = 256, BK = 64, HALF = 128, HTB = HALF * BK * 2  , STAGE_BYTES = 8 * HTB, NXCD = 8, WGM = 8;

__host__ __device__ __forceinline__ int lds_byte(int r, int c) { const int st = (r >> 4) * 2 + (c >> 5), rr = r & 15, cc = c & 31, ob = rr * 64 + cc * 2; return st * 1024 + (ob ^ (((ob >> 9) & 1) << 5)); }
__host__ __device__ __forceinline__ void stage_rc(int b, int& R, int& C) { const int st = b / 1024, sb = b % 1024, swz = sb ^ (((sb >> 9) & 1) << 5); R = (st >> 1) * 16 + swz / 64; C = (st & 1) * 32 + (swz % 64) / 2; }
__host__ __device__ __forceinline__ int perm32(int rho) { const int n = rho >> 4, i = rho & 15; return 8 * (i >> 2) + 4 * n + (i & 3); }

struct Unit { int pm, pn, kp; };
struct Gemm { const bf16_t* A; const bf16_t* Bt; int M, N, K, lda, ldb; };

struct StaticOrder {
    int nM, nN, nwg, G, c;
    __host__ __device__ void init(int M, int N, int G_, int c_) { nM = M / BM; nN = N / BM; nwg = nM * nN; G = G_; c = c_; }
    __host__ __device__ bool next(int i, Unit& u) const {
        const long L = (long)i * G + c; if (L >= nwg) return false;
        int wgid = (int)L; { const int q = nwg / NXCD, r = nwg % NXCD, xcd = wgid % NXCD, off = wgid / NXCD; wgid = (xcd < r ? xcd * (q + 1) : r * (q + 1) + (xcd - r) * q) + off; }
        const int nig = WGM * nN, gid = wgid / nig, fm = gid * WGM, gsz = (nM - fm) < WGM ? (nM - fm) : WGM;
        u.pm = fm + ((wgid % nig) % gsz); u.pn = (wgid % nig) / gsz; return true;
    }
    __device__ __forceinline__ void a_ready(const Unit&) const {}
    __device__ __forceinline__ void done(const Unit&) const {}
    __device__ __forceinline__ size_t aoff(const Unit&) const { return 0; }
    __device__ __forceinline__ size_t boff(const Unit&) const { return 0; }
};


__device__ __forceinline__ unsigned cvt_pk_bf16(float lo, float hi) { unsigned r; asm volatile("v_cvt_pk_bf16_f32 %0, %1, %2" : "=v"(r) : "v"(lo), "v"(hi)); return r; }
typedef float f32x2 __attribute__((ext_vector_type(2)));

template <class Epi, class Sched, bool ALIGN_EPI, bool SP2, int TK, int TLDA, int TLDB, int KSA = 0, int TSA = 0, int KSB = 0, int TSB = 0>
__device__ __forceinline__ void gemm_phase(PG8_LAS unsigned char* lds, const Gemm g, const Sched& S, const Epi& E) {
    int tid_ = my_tid(); asm volatile("" : "+v"(tid_)); const int tid = tid_, wid = __builtin_amdgcn_readfirstlane(tid >> 6), lane = tid & 63, wr = wid >> 2, wc = wid & 3, fr = lane & 15, fq = lane >> 4;
    constexpr int K = TK, nt = K / BK;
    unsigned voffA[2], voffB[2];
#pragma unroll
    for (int i = 0; i < 2; ++i) { int R, C; stage_rc(tid * 16 + i * 8192, R, C); const int Rb = Epi::PERM ? ((R & ~31) + perm32(R & 31)) : R;
        voffA[i] = (unsigned)(R * TLDA + C) * 2u; voffB[i] = (unsigned)(Rb * TLDB + C) * 2u; }
    constexpr size_t kstepA = KSA ? (size_t)KSA : (size_t)(BK * 2), kstepB = KSB ? (size_t)KSB : (size_t)(BK * 2);
    const size_t hstepA = (size_t)HALF * TLDA * 2, hstepB = (size_t)HALF * TLDB * 2;
    const size_t tstepA = TSA ? (size_t)TSA : 2 * hstepA, tstepB = TSB ? (size_t)TSB : 2 * hstepB;
    const unsigned ldsw = (unsigned)wid * 1024u;
    const int aoff = lds_byte(wr * 64 + fr, fq * 8), boff = lds_byte(wc * 32 + fr, fq * 8);
#define PG8_SA(b, h) (((b) * 2 + (h)) * HTB)
#define PG8_SB(b, h) ((4 + (b) * 2 + (h)) * HTB)
#define PG8_STAGE(bufoff, gbase, voff) do { _Pragma("unroll") for (int _i = 0; _i < 2; ++_i) \
        __builtin_amdgcn_global_load_lds((const unsigned*)((const char*)(gbase) + (voff)[_i]), (PG8_LAS unsigned*)(lds + (bufoff) + ldsw + _i * 8192), 16, 0, 0); } while (0)
#define PG8_LDA(dst, b, h) do { _Pragma("unroll") for (int m = 0; m < 4; ++m) _Pragma("unroll") for (int k = 0; k < 2; ++k) dst[m][k] = *(const PG8_LAS bf16x8*)(lds + PG8_SA(b, h) + aoff + m * 2048 + k * 1024); } while (0)
#define PG8_LDB(dst, b, h) do { _Pragma("unroll") for (int n = 0; n < 2; ++n) _Pragma("unroll") for (int k = 0; k < 2; ++k) dst[n][k] = *(const PG8_LAS bf16x8*)(lds + PG8_SB(b, h) + boff + n * 2048 + k * 1024); } while (0)
#define PG8_MMA(ai, bj, At, Bt) do { __builtin_amdgcn_s_setprio(1); _Pragma("unroll") for (int m = 0; m < 4; ++m) _Pragma("unroll") for (int n = 0; n < 2; ++n) _Pragma("unroll") for (int k = 0; k < 2; ++k) \
        acc[ai][bj][m][n] = __builtin_amdgcn_mfma_f32_16x16x32_bf16(Bt[n][k], At[m][k], acc[ai][bj][m][n], 0, 0, 0); __builtin_amdgcn_s_setprio(0); } while (0)
#define PG8_WAIT_V(n) asm volatile("s_waitcnt vmcnt(" #n ")" ::: "memory")
#define PG8_WAIT_L(n) asm volatile("s_waitcnt lgkmcnt(" #n ")" ::: "memory")
#define PG8_BAR __builtin_amdgcn_s_barrier()
#define PG8_SCHED __builtin_amdgcn_sched_barrier(0)
    Unit cur, nxt; int ui = 0;
    if (!S.next(0, cur)) return;
    f32x4 acc[2][2][4][2];
#pragma unroll
    for (int a = 0; a < 2; ++a)
#pragma unroll
        for (int b = 0; b < 2; ++b)
#pragma unroll
            for (int m = 0; m < 4; ++m)
#pragma unroll
                for (int n = 0; n < 2; ++n) acc[a][b][m][n] = (f32x4){0.f, 0.f, 0.f, 0.f};
    bf16x8 At[4][2], B0[2][2], B1[2][2];
    const char* cA = (const char*)g.A + (size_t)cur.pm * tstepA + S.aoff(cur); const char* cB = (const char*)g.Bt + (size_t)cur.pn * tstepB + S.boff(cur);
    S.a_ready(cur);
    if constexpr (SP2) {
        PG8_STAGE(PG8_SB(0, 0), cB, voffB); PG8_STAGE(PG8_SB(0, 1), cB + hstepB, voffB); PG8_STAGE(PG8_SA(0, 0), cA, voffA); PG8_STAGE(PG8_SA(0, 1), cA + hstepA, voffA);
        if (wr == 1) PG8_BAR;
        PG8_WAIT_V(2); PG8_BAR;
        PG8_STAGE(PG8_SB(1, 0), cB + kstepB, voffB); PG8_STAGE(PG8_SA(1, 0), cA + kstepA, voffA); PG8_STAGE(PG8_SB(1, 1), cB + hstepB + kstepB, voffB);
        PG8_WAIT_V(6); PG8_BAR;
    } else {
        PG8_STAGE(PG8_SB(0, 0), cB, voffB); PG8_STAGE(PG8_SA(0, 0), cA, voffA); PG8_STAGE(PG8_SB(0, 1), cB + hstepB, voffB); PG8_STAGE(PG8_SA(0, 1), cA + hstepA, voffA);
        if (wr == 1) PG8_BAR;
        PG8_WAIT_V(4); PG8_BAR;
        PG8_STAGE(PG8_SB(1, 0), cB + kstepB, voffB); PG8_STAGE(PG8_SA(1, 0), cA + kstepA, voffA); PG8_STAGE(PG8_SB(1, 1), cB + hstepB + kstepB, voffB);
        PG8_WAIT_V(6); PG8_BAR;
    }
    for (;;) {
        const bool has_next = S.next(ui + 1, nxt);
        const char* nA = has_next ? (const char*)g.A + (size_t)nxt.pm * tstepA + S.aoff(nxt) : cA; const char* nB = has_next ? (const char*)g.Bt + (size_t)nxt.pn * tstepB + S.boff(nxt) : cB;
        for (int t = 0; t < nt; t += 2) {
            const bool last = (t == nt - 2);
            const char* a1 = cA + (size_t)(t + 1) * kstepA;
            const char* a2 = last ? nA : cA + (size_t)(t + 2) * kstepA; const char* b2 = last ? nB : cB + (size_t)(t + 2) * kstepB;
            const char* a3 = a2 + kstepA; const char* b3 = b2 + kstepB;
            if (last && has_next) S.a_ready(nxt);
            if constexpr (SP2) {
            PG8_LDB(B0, 0, 0); PG8_LDB(B1, 0, 1); PG8_SCHED; PG8_LDA(At, 0, 0); PG8_STAGE(PG8_SA(1, 1), a1 + hstepA, voffA);
            PG8_WAIT_V(8); PG8_WAIT_L(0); PG8_BAR; PG8_MMA(0, 0, At, B0); PG8_MMA(0, 1, At, B1); PG8_BAR; PG8_SCHED;
            PG8_LDA(At, 0, 1); PG8_STAGE(PG8_SB(0, 0), b2, voffB); PG8_STAGE(PG8_SB(0, 1), b2 + hstepB, voffB); PG8_STAGE(PG8_SA(0, 0), a2, voffA);
            PG8_WAIT_V(8); PG8_WAIT_L(0); PG8_BAR; PG8_MMA(1, 0, At, B0); PG8_MMA(1, 1, At, B1); PG8_BAR; PG8_SCHED;
            PG8_LDB(B0, 1, 0); PG8_LDB(B1, 1, 1); PG8_SCHED; PG8_LDA(At, 1, 0); PG8_STAGE(PG8_SA(0, 1), a2 + hstepA, voffA);
            PG8_WAIT_V(8); PG8_WAIT_L(0); PG8_BAR; PG8_MMA(0, 0, At, B0); PG8_MMA(0, 1, At, B1); PG8_BAR; PG8_SCHED;
            PG8_LDA(At, 1, 1); PG8_STAGE(PG8_SB(1, 0), b3, voffB); PG8_STAGE(PG8_SB(1, 1), b3 + hstepB, voffB); PG8_STAGE(PG8_SA(1, 0), a3, voffA);
            PG8_WAIT_V(8); PG8_WAIT_L(0); PG8_BAR; PG8_MMA(1, 0, At, B0); PG8_MMA(1, 1, At, B1); PG8_BAR; PG8_SCHED;
            } else {
            PG8_LDB(B0, 0, 0); PG8_SCHED; PG8_LDA(At, 0, 0); PG8_STAGE(PG8_SA(1, 1), a1 + hstepA, voffA);
            PG8_WAIT_L(8); PG8_BAR; PG8_WAIT_L(0); PG8_MMA(0, 0, At, B0); PG8_BAR; PG8_SCHED;
            PG8_LDB(B1, 0, 1); PG8_STAGE(PG8_SB(0, 0), b2, voffB);
            PG8_BAR; PG8_WAIT_L(0); PG8_MMA(0, 1, At, B1); PG8_BAR;
            PG8_LDA(At, 0, 1); PG8_STAGE(PG8_SA(0, 0), a2, voffA);
            PG8_BAR; PG8_WAIT_L(0); PG8_MMA(1, 0, At, B0); PG8_BAR; PG8_SCHED;
            PG8_STAGE(PG8_SB(0, 1), b2 + hstepB, voffB);
            PG8_WAIT_V(6); PG8_BAR; PG8_MMA(1, 1, At, B1); PG8_BAR;
            PG8_LDB(B0, 1, 0); PG8_SCHED; PG8_LDA(At, 1, 0); PG8_STAGE(PG8_SA(0, 1), a2 + hstepA, voffA);
            PG8_WAIT_L(8); PG8_BAR; PG8_WAIT_L(0); PG8_MMA(0, 0, At, B0); PG8_BAR; PG8_SCHED;
            PG8_LDB(B1, 1, 1); PG8_STAGE(PG8_SB(1, 0), b3, voffB);
            PG8_BAR; PG8_WAIT_L(0); PG8_MMA(0, 1, At, B1); PG8_BAR;
            PG8_LDA(At, 1, 1); PG8_STAGE(PG8_SA(1, 0), a3, voffA);
            PG8_BAR; PG8_WAIT_L(0); PG8_MMA(1, 0, At, B0); PG8_BAR; PG8_SCHED;
            PG8_STAGE(PG8_SB(1, 1), b3 + hstepB, voffB);
            PG8_WAIT_V(6); PG8_BAR; PG8_MMA(1, 1, At, B1); PG8_BAR;
            }
        }
        if constexpr (ALIGN_EPI) { if (wr == 0) PG8_BAR; }
        if constexpr (!Epi::AFTER_DRAIN) { E(acc, cur, wr, wc, fr, fq); S.done(cur); }
        if (!has_next) break;
#pragma unroll
        for (int a = 0; a < 2; ++a)
#pragma unroll
            for (int b = 0; b < 2; ++b)
#pragma unroll
                for (int m = 0; m < 4; ++m)
#pragma unroll
                    for (int n = 0; n < 2; ++n) acc[a][b][m][n] = (f32x4){0.f, 0.f, 0.f, 0.f};
        cur = nxt; cA = nA; cB = nB; ++ui;
        if constexpr (ALIGN_EPI) { if (wr == 1) PG8_BAR; }
    }
    PG8_WAIT_V(0);
    if constexpr (!ALIGN_EPI) { if (wr == 0) PG8_BAR; }
    PG8_BAR;
    if constexpr (Epi::AFTER_DRAIN) { E.fused(acc, cur, wr, wc, fr, fq, lds, wid, lane); S.done(cur); }
#undef PG8_SA
#undef PG8_SB
#undef PG8_STAGE
#undef PG8_LDA
#undef PG8_LDB
#undef PG8_MMA
#undef PG8_WAIT_V
#undef PG8_WAIT_L
#undef PG8_BAR
#undef PG8_SCHED
}
}


namespace attn_body {
using bf16=__hip_bfloat16;
using bf16x8=__attribute__((ext_vector_type(8)))short;
using s16x4=__attribute__((ext_vector_type(4)))short;
using f32x16=__attribute__((ext_vector_type(16)))float;
using u32x4=__attribute__((ext_vector_type(4)))unsigned;
constexpr int D=64;
constexpr int NW=8,QBLK=32,QB=QBLK*NW,KVBLK=64;
constexpr int ATTN_UNIT_ROWS=QB;
__device__ __forceinline__ int crow(int r,int hi){return (r&3)+8*(r>>2)+4*hi;}
#define SBAR() __builtin_amdgcn_sched_barrier(0)
constexpr int NSLOT=3, SLOTB=8192;
constexpr int LDS_K=0, LDS_V=NSLOT*SLOTB, LDS_WS=2*NSLOT*SLOTB, LDS_OST=LDS_WS+NW*64*4, LDS_BYTES=LDS_OST+NW*4096;
constexpr float C2=0.125f*1.4426950408889634f;
__device__ __forceinline__ void glds16(const void*gsrc,unsigned lds_dst){unsigned keep;
  asm volatile("s_mov_b32 %0, m0\n\ts_mov_b32 m0, %2\n\ts_nop 0\n\tglobal_load_lds_dwordx4 %1, off\n\ts_mov_b32 m0, %0":"=&s"(keep):"v"(gsrc),"s"(lds_dst):"memory");}
__device__ __forceinline__ float max3f(float a,float b,float c){float r;asm("v_max3_f32 %0, %1, %2, %3":"=v"(r):"v"(a),"v"(b),"v"(c));return r;}
__device__ __forceinline__ float max2f(float a,float b){float r;asm("v_max_f32_e32 %0, %1, %2":"=v"(r):"v"(a),"v"(b));return r;}
__device__ __forceinline__ float fadd_s(float a,float b){float r;asm("v_add_f32_e32 %0, %1, %2":"=v"(r):"v"(a),"v"(b));return r;}
__device__ __forceinline__ float fsub_s(float a,float b){float r;asm("v_sub_f32_e32 %0, %1, %2":"=v"(r):"v"(a),"v"(b));return r;}
typedef float f32x2_t __attribute__((ext_vector_type(2))); typedef __bf16 bf16x2_t __attribute__((ext_vector_type(2)));
__device__ __forceinline__ unsigned cvtpk_s(float lo,float hi){f32x2_t v={lo,hi};bf16x2_t b=__builtin_convertvector(v,bf16x2_t);return __builtin_bit_cast(unsigned,b);}
#define WAIT_BAR(N) asm volatile("s_waitcnt vmcnt(" #N ") lgkmcnt(0)\n\ts_barrier":::"memory")

__device__ __forceinline__ void qkt(f32x16&p0,f32x16&p1,const char*Kslot,const bf16x8*qr,const f32x16&negm,int r32,int hi){
  const char*kb=Kslot+hi*1024+r32*16;
  #pragma unroll
  for(int d0=0;d0<4;++d0){
    const bf16x8 b0=*reinterpret_cast<const bf16x8*>(kb+d0*2048);
    const bf16x8 b1=*reinterpret_cast<const bf16x8*>(kb+d0*2048+512);
    if(d0==0){p0=__builtin_amdgcn_mfma_f32_32x32x16_bf16(b0,qr[0],negm,0,0,0);p1=__builtin_amdgcn_mfma_f32_32x32x16_bf16(b1,qr[0],negm,0,0,0);}
    else{p0=__builtin_amdgcn_mfma_f32_32x32x16_bf16(b0,qr[d0],p0,0,0,0);p1=__builtin_amdgcn_mfma_f32_32x32x16_bf16(b1,qr[d0],p1,0,0,0);}}
}
typedef __attribute__((address_space(3))) const char* lds_cptr;
typedef short v4i16_t __attribute__((ext_vector_type(4)));
__device__ __forceinline__ void kload8(bf16x8*kf,lds_cptr kp){
  kf[0]=*(const __attribute__((address_space(3))) bf16x8*)(kp);      kf[1]=*(const __attribute__((address_space(3))) bf16x8*)(kp+512);
  kf[2]=*(const __attribute__((address_space(3))) bf16x8*)(kp+2048); kf[3]=*(const __attribute__((address_space(3))) bf16x8*)(kp+2560);
  kf[4]=*(const __attribute__((address_space(3))) bf16x8*)(kp+4096); kf[5]=*(const __attribute__((address_space(3))) bf16x8*)(kp+4608);
  kf[6]=*(const __attribute__((address_space(3))) bf16x8*)(kp+6144); kf[7]=*(const __attribute__((address_space(3))) bf16x8*)(kp+6656);
}
__device__ __forceinline__ void kload2(bf16x8*kf,lds_cptr kp,int j){ kf[2*j]=*(const __attribute__((address_space(3))) bf16x8*)(kp+j*2048); kf[2*j+1]=*(const __attribute__((address_space(3))) bf16x8*)(kp+j*2048+512); }
__device__ __forceinline__ s16x4 vtr(lds_cptr p){ return __builtin_bit_cast(s16x4,__builtin_amdgcn_ds_read_tr16_b64_v4i16((__attribute__((address_space(3))) v4i16_t*)p)); }
__device__ __forceinline__ float rowmax(const f32x16&p0,const f32x16&p1){
  float a=max3f(p0[0],p0[1],p1[0]),b=max3f(p0[2],p0[3],p1[1]);a=max3f(a,p1[2],p1[3]);
  #pragma unroll
  for(int r=4;r<16;r+=4){a=max3f(a,p0[r],p0[r+1]);b=max3f(b,p0[r+2],p0[r+3]);a=max3f(a,p1[r],p1[r+1]);b=max3f(b,p1[r+2],p1[r+3]);}
  const float m=max2f(a,b);
  auto rr=__builtin_amdgcn_permlane32_swap(__float_as_uint(m),__float_as_uint(m),false,false);
  return max2f(__uint_as_float(rr[0]),__uint_as_float(rr[1]));
}
__device__ __forceinline__ void pv(f32x16*o,int vb,bf16x8 pa0,bf16x8 pa1,bf16x8 pa2,bf16x8 pa3){
  #pragma unroll
  for(int d0=0;d0<2;++d0){s16x4 lo[4],hi[4];
    #pragma unroll
    for(int ks=0;ks<4;++ks){
      asm volatile("ds_read_b64_tr_b16 %0,%1 offset:%c2":"=&v"(lo[ks]):"v"(vb),"i"(d0*4096+ks*1024):"memory");
      asm volatile("ds_read_b64_tr_b16 %0,%1 offset:%c2":"=&v"(hi[ks]):"v"(vb),"i"(d0*4096+ks*1024+512):"memory");}
    asm volatile("s_waitcnt lgkmcnt(0)":::"memory");SBAR();
    #define PK(k) (bf16x8){lo[k][0],lo[k][1],lo[k][2],lo[k][3],hi[k][0],hi[k][1],hi[k][2],hi[k][3]}
    o[d0]=__builtin_amdgcn_mfma_f32_32x32x16_bf16(pa0,PK(0),o[d0],0,0,0);
    o[d0]=__builtin_amdgcn_mfma_f32_32x32x16_bf16(pa1,PK(1),o[d0],0,0,0);
    o[d0]=__builtin_amdgcn_mfma_f32_32x32x16_bf16(pa2,PK(2),o[d0],0,0,0);
    o[d0]=__builtin_amdgcn_mfma_f32_32x32x16_bf16(pa3,PK(3),o[d0],0,0,0);
    #undef PK
  }
}

#ifndef ATTN_STORE16
#define ATTN_STORE16(p,v) (*(u32x4*)(p)=(v))
#endif
template<int THRL> __device__ __forceinline__ void attn_unit(const bf16*Q0,int ldq,const bf16*__restrict__ Kh,int ldk,const bf16*__restrict__ Vh,int ldv,bf16*O0,int ldo,int NT,char*shm){
  int tid_=my_tid(); asm volatile("":"+v"(tid_)); const int tid=tid_,lane=tid&63,r32=lane&31,hi=lane>>5; const int wid=__builtin_amdgcn_readfirstlane(tid>>6);
  const bf16*Qw=Q0+(long)(wid*QBLK)*ldq;
  const unsigned lds0=(unsigned)(uintptr_t)shm;
  float*wsf=(float*)(shm+LDS_WS)+wid*64;
  const bf16*ksrc=Kh+(long)lane*ldk+wid*8;
  const bf16*vsrc=Vh+(long)(16*(wid&3)+(lane>>2))*ldv+(wid>>2)*32+(lane&3)*8;
  const unsigned kdst=lds0+LDS_K+wid*1024, vdst=lds0+LDS_V+wid*1024;
  #define DMA_K(t,slot) glds16(ksrc+(long)(t)*KVBLK*ldk,(unsigned)__builtin_amdgcn_readfirstlane(kdst+(slot)))
  #define DMA_V(t,slot) glds16(vsrc+(long)(t)*KVBLK*ldv,(unsigned)__builtin_amdgcn_readfirstlane(vdst+(slot)))
  const int vb0=(int)(lds0+LDS_V)+((lane>>4)&1)*32+(lane&3)*8+(4*hi+((lane&15)>>2))*64;
  const char*Kbase=shm+LDS_K; bf16x8 kf[8];
  const lds_cptr shm3=(lds_cptr)shm; const lds_cptr kp0=shm3+LDS_K+hi*1024+r32*16; const lds_cptr vp0=shm3+LDS_V+((lane>>4)&1)*32+(lane&3)*8+(4*hi+((lane&15)>>2))*64;
  DMA_K(0,0);DMA_V(0,0);DMA_K(1,SLOTB);
  bf16x8 qr[4];
  #pragma unroll
  for(int d0=0;d0<4;++d0)qr[d0]=*reinterpret_cast<const bf16x8*>(&Qw[(long)r32*ldq+d0*16+hi*8]);
  float mhat=0.f,l_reg=0.f;f32x16 o[2];o[0]=f32x16{};o[1]=f32x16{};f32x16 negm=f32x16{};asm volatile("":"+v"(negm));
  #define CMASK(P0,P1,t) do{}while(0)
  bool resc=false;
  #define START(P0,P1) do{ const float rm=rowmax(P0,P1); resc=false; \
    { const float dl=rm; mhat=fadd_s(mhat,dl); \
      _Pragma("unroll") for(int r=0;r<16;++r){P0[r]=fsub_s(P0[r],dl);P1[r]=fsub_s(P1[r],dl);} \
      _Pragma("unroll") for(int r=0;r<16;++r)negm[r]=-mhat; asm volatile("":"+v"(negm)); } \
    _Pragma("unroll") for(int r=0;r<16;++r)P0[r]=__builtin_amdgcn_exp2f(P0[r]); }while(0)
  #define RESC() do{ if(resc){ asm volatile("s_waitcnt lgkmcnt(0)":::"memory"); \
      _Pragma("unroll") for(int d_=0;d_<2;++d_) _Pragma("unroll") for(int r=0;r<16;++r)o[d_][r]*=wsf[crow(r,hi)]; } }while(0)
  f32x16 pA0,pA1,pB0,pB1;
  int sl_prev=0,sl_cur=0,sl_next=SLOTB;
  #define ROT() do{sl_prev=sl_cur;sl_cur=sl_next;sl_next=(sl_next==(NSLOT-1)*SLOTB)?0:sl_next+SLOTB;}while(0)
  DMA_K(2,2*SLOTB);
  WAIT_BAR(3);
  qkt(pA0,pA1,Kbase,qr,negm,r32,hi);asm volatile("s_nop 15\n\ts_nop 7":"+v"(pA0),"+v"(pA1));CMASK(pA0,pA1,0);
  START(pA0,pA1);
  _Pragma("unroll") for(int r=0;r<16;++r)pA1[r]=__builtin_amdgcn_exp2f(pA1[r]);
  WAIT_BAR(0);
  DMA_K(3,0);DMA_V(1,SLOTB);
  ROT();
  kload8(kf,kp0+sl_cur);
  WAIT_BAR(2);
  s16x4 vlo[8],vhi[8]; u32x4 pw0,pw1,pw2,pw3;
  #define PKW(P,B) cvtpk_s(P[B],P[B+1])
  #define PAF(k) __builtin_bit_cast(bf16x8,pw##k)
  #define VFR(i) (bf16x8){vlo[i][0],vlo[i][1],vlo[i][2],vlo[i][3],vhi[i][0],vhi[i][1],vhi[i][2],vhi[i][3]}
  #define PIN(x) asm volatile("":"+v"(x))
  #define MX3(a,b,c) __builtin_fmaxf(__builtin_fmaxf((a),(b)),(c))
  #define GAPA(MF,A0,A1,A2,A3,W0,W1,PW) do{ MF; sacc+=A0; sacc+=A1; sacc+=A2; sacc+=A3; PIN(sacc); W0; W1; PIN(PW); SBAR(); }while(0)
  #define EX(v) __builtin_amdgcn_exp2f(v)
  #define GAPB(MF,X,B) do{ MF; X[B]=EX(X[B]); X[B+1]=EX(X[B+1]); X[B+2]=EX(X[B+2]); X[B+3]=EX(X[B+3]); PIN(X); SBAR(); }while(0)
  #define VRD(i) do{ vlo[i]=vtr(vp_+(((i)>>2)*4096+((i)&3)*1024)); vhi[i]=vtr(vp_+(((i)>>2)*4096+((i)&3)*1024+512)); }while(0)
  #define KRD(G,j) do{ if(G){ kload2(kf,kp0+sl_next,j); SBAR(); } }while(0)
  #define STEP(C0,C1,P0,P1,t,GK,GV,GL) do{ SBAR(); \
    const lds_cptr vp_=vp0+sl_prev; \
    VRD(0); SBAR(); float sacc=(P0[0]+P0[1]); \
    GAPA(C0=__builtin_amdgcn_mfma_f32_32x32x16_bf16(kf[0],qr[0],negm,0,0,0), P0[2],P0[3],P0[4],P0[5],     pw0[0]=PKW(P0,0), pw0[1]=PKW(P0,2), pw0); \
    VRD(4); SBAR(); GAPA(C1=__builtin_amdgcn_mfma_f32_32x32x16_bf16(kf[1],qr[0],negm,0,0,0), P0[6],P0[7],P0[8],P0[9],     pw0[2]=PKW(P0,4), pw0[3]=PKW(P0,6), pw0); \
    VRD(1); SBAR(); GAPA(C0=__builtin_amdgcn_mfma_f32_32x32x16_bf16(kf[2],qr[1],C0,0,0,0),   P0[10],P0[11],P0[12],P0[13], pw1[0]=PKW(P0,8), pw1[1]=PKW(P0,10), pw1); \
    VRD(5); SBAR(); GAPA(C1=__builtin_amdgcn_mfma_f32_32x32x16_bf16(kf[3],qr[1],C1,0,0,0),   P0[14],P0[15],P1[0],P1[1],   pw1[2]=PKW(P0,12),pw1[3]=PKW(P0,14), pw1); \
    VRD(2); SBAR(); GAPA(C0=__builtin_amdgcn_mfma_f32_32x32x16_bf16(kf[4],qr[2],C0,0,0,0),   P1[2],P1[3],P1[4],P1[5],     pw2[0]=PKW(P1,0), pw2[1]=PKW(P1,2), pw2); \
    VRD(6); SBAR(); GAPA(C1=__builtin_amdgcn_mfma_f32_32x32x16_bf16(kf[5],qr[2],C1,0,0,0),   P1[6],P1[7],P1[8],P1[9],     pw2[2]=PKW(P1,4), pw2[3]=PKW(P1,6), pw2); \
    VRD(3); SBAR(); GAPA(C0=__builtin_amdgcn_mfma_f32_32x32x16_bf16(kf[6],qr[3],C0,0,0,0),   P1[10],P1[11],P1[12],P1[13], pw3[0]=PKW(P1,8), pw3[1]=PKW(P1,10), pw3); \
    VRD(7); SBAR(); GAPA(C1=__builtin_amdgcn_mfma_f32_32x32x16_bf16(kf[7],qr[3],C1,0,0,0),   P1[14],P1[15],0.f,0.f,       pw3[2]=PKW(P1,12),pw3[3]=PKW(P1,14), pw3); \
    l_reg+=sacc; \
    if(GK){DMA_K((t)+3,sl_cur);} if(GV){DMA_V((t)+1,sl_next);} \
    CMASK(C0,C1,t); \
    { float a=MX3(C0[0],C0[1],C1[0]),b=MX3(C0[2],C0[3],C1[1]); a=MX3(a,C1[2],C1[3]); \
      _Pragma("unroll") for(int r=4;r<16;r+=4){a=MX3(a,C0[r],C0[r+1]);b=MX3(b,C0[r+2],C0[r+3]);a=MX3(a,C1[r],C1[r+1]);b=MX3(b,C1[r+2],C1[r+3]);} \
      float rm=__builtin_fmaxf(a,b); { auto rr=__builtin_amdgcn_permlane32_swap(__float_as_uint(rm),__float_as_uint(rm),false,false); rm=__builtin_fmaxf(__uint_as_float(rr[0]),__uint_as_float(rr[1])); } \
      resc=false; \
      if(__builtin_expect(__any(rm>(float)THRL),0)){ const float dl=__builtin_fmaxf(rm,0.f); mhat+=dl; \
        _Pragma("unroll") for(int r=0;r<16;++r){C0[r]-=dl;C1[r]-=dl;} \
        _Pragma("unroll") for(int r=0;r<16;++r)negm[r]=-mhat; asm volatile("":"+v"(negm)); \
        const float f=__builtin_amdgcn_exp2f(-dl); l_reg*=f; if(hi==0)wsf[r32]=f; resc=true; } } \
    SBAR(); \
    GAPB(o[0]=__builtin_amdgcn_mfma_f32_32x32x16_bf16(PAF(0),VFR(0),o[0],0,0,0), C0,0); \
    GAPB(o[1]=__builtin_amdgcn_mfma_f32_32x32x16_bf16(PAF(0),VFR(4),o[1],0,0,0), C0,4); \
    KRD(GL,0); GAPB(o[0]=__builtin_amdgcn_mfma_f32_32x32x16_bf16(PAF(1),VFR(1),o[0],0,0,0), C0,8); \
    KRD(GL,1); GAPB(o[1]=__builtin_amdgcn_mfma_f32_32x32x16_bf16(PAF(1),VFR(5),o[1],0,0,0), C0,12); \
    KRD(GL,2); GAPB(o[0]=__builtin_amdgcn_mfma_f32_32x32x16_bf16(PAF(2),VFR(2),o[0],0,0,0), C1,0); \
    KRD(GL,3); GAPB(o[1]=__builtin_amdgcn_mfma_f32_32x32x16_bf16(PAF(2),VFR(6),o[1],0,0,0), C1,4); \
    GAPB(o[0]=__builtin_amdgcn_mfma_f32_32x32x16_bf16(PAF(3),VFR(3),o[0],0,0,0), C1,8); \
    GAPB(o[1]=__builtin_amdgcn_mfma_f32_32x32x16_bf16(PAF(3),VFR(7),o[1],0,0,0), C1,12); \
    }while(0)
  int t=1;
  #undef CMASK
  #define CMASK(P0,P1,t) do{}while(0)
  for(;t+5<NT;t+=2){
    STEP(pB0,pB1,pA0,pA1,t,true,true,true);     WAIT_BAR(2); RESC(); ROT();
    STEP(pA0,pA1,pB0,pB1,t+1,true,true,true);   WAIT_BAR(2); RESC(); ROT();
  }
  #undef CMASK
  #define CMASK(P0,P1,t) do{}while(0)
  #define ENDW(tt) do{ if((tt)+3<NT){WAIT_BAR(2);} else if((tt)+2<NT){WAIT_BAR(1);} else {WAIT_BAR(0);} }while(0)
  for(;t+1<NT;t+=2){
    STEP(pB0,pB1,pA0,pA1,t,(t+3<NT),(t+1<NT),(t+1<NT));       ENDW(t);   RESC(); ROT();
    STEP(pA0,pA1,pB0,pB1,t+1,(t+4<NT),(t+2<NT),(t+2<NT));     ENDW(t+1); RESC(); ROT();
  }
  STEP(pB0,pB1,pA0,pA1,NT-1,false,false,false); RESC();
  { float sacc=pB0[0]+pB0[1]; _Pragma("unroll") for(int r=2;r<16;++r)sacc+=pB0[r]; _Pragma("unroll") for(int r=0;r<16;++r)sacc+=pB1[r]; l_reg+=sacc;
    pw0=(u32x4){PKW(pB0,0),PKW(pB0,2),PKW(pB0,4),PKW(pB0,6)};pw1=(u32x4){PKW(pB0,8),PKW(pB0,10),PKW(pB0,12),PKW(pB0,14)};pw2=(u32x4){PKW(pB1,0),PKW(pB1,2),PKW(pB1,4),PKW(pB1,6)};pw3=(u32x4){PKW(pB1,8),PKW(pB1,10),PKW(pB1,12),PKW(pB1,14)};
    SBAR(); pv(o,vb0+sl_cur,PAF(0),PAF(1),PAF(2),PAF(3)); }
  #undef PKW
  #undef PAF
  #undef VFR
  #undef PIN
  #undef MX3
  #undef GAPA
  #undef GAPB
  #undef EX
  #undef VRD
  #undef KRD
  #undef STEP
  #undef ENDW
  {auto rr=__builtin_amdgcn_permlane32_swap(__float_as_uint(l_reg),__float_as_uint(l_reg),false,false);l_reg=__uint_as_float(rr[0])+__uint_as_float(rr[1]);}
  if(hi==0)wsf[32+r32]=l_reg;asm volatile("s_waitcnt lgkmcnt(0)":::"memory");
  float rli[16];
  #pragma unroll
  for(int r=0;r<16;++r)rli[r]=__builtin_amdgcn_rcpf(wsf[32+crow(r,hi)]);
  bf16*Ow=O0+(long)(wid*QBLK)*ldo;
  { bf16*stg=(bf16*)(shm+LDS_OST)+wid*2048;
    #pragma unroll
    for(int r=0;r<16;++r){const int orow=crow(r,hi);
      #pragma unroll
      for(int d0=0;d0<2;++d0)stg[orow*64+d0*32+r32]=__float2bfloat16(o[d0][r]*rli[r]);}
    asm volatile("s_waitcnt lgkmcnt(0)":::"memory");
    #pragma unroll
    for(int i=0;i<4;++i){const int row=i*8+(lane>>3),ch=lane&7; const u32x4 v=*(const u32x4*)(stg+row*64+ch*8); ATTN_STORE16(Ow+(long)row*ldo+ch*8,v);} }
  asm volatile("s_waitcnt lgkmcnt(0)\n\ts_barrier":::"memory");
  #undef DMA_K
  #undef DMA_V
  #undef CMASK
  #undef START
  #undef RESC
  #undef ROT
}
constexpr int LDS_WS128=LDS_V+NSLOT*16384, LDS_OST128=LDS_WS128+NW*64*4, LDS_BYTES128=LDS_OST128+NW*4096;
template<int THRL> __device__ __forceinline__ void attn_unit128(const bf16*Q0,int ldq,const bf16*__restrict__ Kh,int ldk,const bf16*__restrict__ Vh,int ldv,bf16*O0,int ldo,int NT,char*shm){
  int tid_=my_tid(); asm volatile("":"+v"(tid_)); const int tid=tid_,lane=tid&63,r32=lane&31,hi=lane>>5; const int wid=__builtin_amdgcn_readfirstlane(tid>>6);
  const bf16*Qw=Q0+(long)(wid*QBLK)*ldq;
  const unsigned lds0=(unsigned)(uintptr_t)shm;
  float*wsf=(float*)(shm+LDS_WS128)+wid*64;
  const bf16*ksrc=Kh+(long)lane*ldk+wid*8;
  const bf16*vsrc=Vh+(long)(16*(wid&3)+(lane>>2))*ldv+(wid>>2)*32+(lane&3)*8;
  const unsigned kdst=lds0+LDS_K+wid*1024, vdst=lds0+LDS_V+wid*1024;
  #define DMA_K(t,slot) glds16(ksrc+(long)(t)*KVBLK*ldk,(unsigned)__builtin_amdgcn_readfirstlane(kdst+(slot)))
  #define DMA_V(t,slot) do{ glds16(vsrc+(long)(t)*KVBLK*ldv,(unsigned)__builtin_amdgcn_readfirstlane(vdst+2*(slot))); glds16(vsrc+(long)(t)*KVBLK*ldv+64,(unsigned)__builtin_amdgcn_readfirstlane(vdst+2*(slot)+8192)); }while(0)
  const int vb0=(int)(lds0+LDS_V)+((lane>>4)&1)*32+(lane&3)*8+(4*hi+((lane&15)>>2))*64;
  const char*Kbase=shm+LDS_K; bf16x8 kf[8];
  const lds_cptr shm3=(lds_cptr)shm; const lds_cptr kp0=shm3+LDS_K+hi*1024+r32*16; const lds_cptr vp0=shm3+LDS_V+((lane>>4)&1)*32+(lane&3)*8+(4*hi+((lane&15)>>2))*64;
  DMA_K(0,0);DMA_V(0,0);DMA_K(1,SLOTB);
  bf16x8 qr[4];
  #pragma unroll
  for(int d0=0;d0<4;++d0)qr[d0]=*reinterpret_cast<const bf16x8*>(&Qw[(long)r32*ldq+d0*16+hi*8]);
  float mhat=0.f,l_reg=0.f;f32x16 o[4];o[0]=f32x16{};o[1]=f32x16{};o[2]=f32x16{};o[3]=f32x16{};f32x16 negm=f32x16{};asm volatile("":"+v"(negm));
  #define CMASK(P0,P1,t) do{}while(0)
  bool resc=false;
  #define START(P0,P1) do{ const float rm=rowmax(P0,P1); resc=false; \
    { const float dl=rm; mhat=fadd_s(mhat,dl); \
      _Pragma("unroll") for(int r=0;r<16;++r){P0[r]=fsub_s(P0[r],dl);P1[r]=fsub_s(P1[r],dl);} \
      _Pragma("unroll") for(int r=0;r<16;++r)negm[r]=-mhat; asm volatile("":"+v"(negm)); } \
    _Pragma("unroll") for(int r=0;r<16;++r)P0[r]=__builtin_amdgcn_exp2f(P0[r]); }while(0)
  #define RESC() do{ if(resc){ asm volatile("s_waitcnt lgkmcnt(0)":::"memory"); \
      _Pragma("unroll") for(int d_=0;d_<4;++d_) _Pragma("unroll") for(int r=0;r<16;++r)o[d_][r]*=wsf[crow(r,hi)]; } }while(0)
  f32x16 pA0,pA1,pB0,pB1;
  int sl_prev=0,sl_cur=0,sl_next=SLOTB;
  #define ROT() do{sl_prev=sl_cur;sl_cur=sl_next;sl_next=(sl_next==(NSLOT-1)*SLOTB)?0:sl_next+SLOTB;}while(0)
  DMA_K(2,2*SLOTB);
  WAIT_BAR(3);
  qkt(pA0,pA1,Kbase,qr,negm,r32,hi);asm volatile("s_nop 15\n\ts_nop 7":"+v"(pA0),"+v"(pA1));CMASK(pA0,pA1,0);
  START(pA0,pA1);
  _Pragma("unroll") for(int r=0;r<16;++r)pA1[r]=__builtin_amdgcn_exp2f(pA1[r]);
  WAIT_BAR(0);
  DMA_K(3,0);DMA_V(1,SLOTB);
  ROT();
  kload8(kf,kp0+sl_cur);
  WAIT_BAR(3);
  s16x4 vlo[8],vhi[8]; u32x4 pw0,pw1,pw2,pw3;
  #define PKW(P,B) cvtpk_s(P[B],P[B+1])
  #define PAF(k) __builtin_bit_cast(bf16x8,pw##k)
  #define VFR(i) (bf16x8){vlo[i][0],vlo[i][1],vlo[i][2],vlo[i][3],vhi[i][0],vhi[i][1],vhi[i][2],vhi[i][3]}
  #define PIN(x) asm volatile("":"+v"(x))
  #define MX3(a,b,c) __builtin_fmaxf(__builtin_fmaxf((a),(b)),(c))
  #define GAPA(MF,A0,A1,A2,A3,W0,W1,PW) do{ MF; sacc+=A0; sacc+=A1; sacc+=A2; sacc+=A3; PIN(sacc); W0; W1; PIN(PW); SBAR(); }while(0)
  #define EX(v) __builtin_amdgcn_exp2f(v)
  #define GAPB2(MF,X,B) do{ MF; X[B]=EX(X[B]); X[B+1]=EX(X[B+1]); PIN(X); SBAR(); }while(0)
  #define GAPB(MF,X,B) do{ MF; X[B]=EX(X[B]); X[B+1]=EX(X[B+1]); X[B+2]=EX(X[B+2]); X[B+3]=EX(X[B+3]); PIN(X); SBAR(); }while(0)
  #define VRD(i) do{ vlo[i]=vtr(vp_+(((i)>>2)*4096+((i)&3)*1024)); vhi[i]=vtr(vp_+(((i)>>2)*4096+((i)&3)*1024+512)); }while(0)
  #define VRDQ(i) do{ vlo[i]=vtr(vq_+(((i)>>2)*4096+((i)&3)*1024)); vhi[i]=vtr(vq_+(((i)>>2)*4096+((i)&3)*1024+512)); }while(0)
  #define KRD(G,j) do{ if(G){ kload2(kf,kp0+sl_next,j); SBAR(); } }while(0)
  #define STEP(C0,C1,P0,P1,t,GK,GV,GL) do{ SBAR(); \
    const lds_cptr vp_=vp0+2*sl_prev; const lds_cptr vq_=vp_+8192; \
    VRD(0); SBAR(); float sacc=(P0[0]+P0[1]); \
    GAPA(C0=__builtin_amdgcn_mfma_f32_32x32x16_bf16(kf[0],qr[0],negm,0,0,0), P0[2],P0[3],P0[4],P0[5],     pw0[0]=PKW(P0,0), pw0[1]=PKW(P0,2), pw0); \
    VRD(4); SBAR(); GAPA(C1=__builtin_amdgcn_mfma_f32_32x32x16_bf16(kf[1],qr[0],negm,0,0,0), P0[6],P0[7],P0[8],P0[9],     pw0[2]=PKW(P0,4), pw0[3]=PKW(P0,6), pw0); \
    VRD(1); SBAR(); GAPA(C0=__builtin_amdgcn_mfma_f32_32x32x16_bf16(kf[2],qr[1],C0,0,0,0),   P0[10],P0[11],P0[12],P0[13], pw1[0]=PKW(P0,8), pw1[1]=PKW(P0,10), pw1); \
    VRD(5); SBAR(); GAPA(C1=__builtin_amdgcn_mfma_f32_32x32x16_bf16(kf[3],qr[1],C1,0,0,0),   P0[14],P0[15],P1[0],P1[1],   pw1[2]=PKW(P0,12),pw1[3]=PKW(P0,14), pw1); \
    VRD(2); SBAR(); GAPA(C0=__builtin_amdgcn_mfma_f32_32x32x16_bf16(kf[4],qr[2],C0,0,0,0),   P1[2],P1[3],P1[4],P1[5],     pw2[0]=PKW(P1,0), pw2[1]=PKW(P1,2), pw2); \
    VRD(6); SBAR(); GAPA(C1=__builtin_amdgcn_mfma_f32_32x32x16_bf16(kf[5],qr[2],C1,0,0,0),   P1[6],P1[7],P1[8],P1[9],     pw2[2]=PKW(P1,4), pw2[3]=PKW(P1,6), pw2); \
    VRD(3); SBAR(); GAPA(C0=__builtin_amdgcn_mfma_f32_32x32x16_bf16(kf[6],qr[3],C0,0,0,0),   P1[10],P1[11],P1[12],P1[13], pw3[0]=PKW(P1,8), pw3[1]=PKW(P1,10), pw3); \
    VRD(7); SBAR(); GAPA(C1=__builtin_amdgcn_mfma_f32_32x32x16_bf16(kf[7],qr[3],C1,0,0,0),   P1[14],P1[15],0.f,0.f,       pw3[2]=PKW(P1,12),pw3[3]=PKW(P1,14), pw3); \
    l_reg+=sacc; \
    if(GK){DMA_K((t)+3,sl_cur);} if(GV){DMA_V((t)+1,sl_next);} \
    CMASK(C0,C1,t); \
    { float a=MX3(C0[0],C0[1],C1[0]),b=MX3(C0[2],C0[3],C1[1]); a=MX3(a,C1[2],C1[3]); \
      _Pragma("unroll") for(int r=4;r<16;r+=4){a=MX3(a,C0[r],C0[r+1]);b=MX3(b,C0[r+2],C0[r+3]);a=MX3(a,C1[r],C1[r+1]);b=MX3(b,C1[r+2],C1[r+3]);} \
      float rm=__builtin_fmaxf(a,b); { auto rr=__builtin_amdgcn_permlane32_swap(__float_as_uint(rm),__float_as_uint(rm),false,false); rm=__builtin_fmaxf(__uint_as_float(rr[0]),__uint_as_float(rr[1])); } \
      resc=false; \
      if(__builtin_expect(__any(rm>(float)THRL),0)){ const float dl=__builtin_fmaxf(rm,0.f); mhat+=dl; \
        _Pragma("unroll") for(int r=0;r<16;++r){C0[r]-=dl;C1[r]-=dl;} \
        _Pragma("unroll") for(int r=0;r<16;++r)negm[r]=-mhat; asm volatile("":"+v"(negm)); \
        const float f=__builtin_amdgcn_exp2f(-dl); l_reg*=f; if(hi==0)wsf[r32]=f; resc=true; } } \
    SBAR(); \
    GAPB2(o[0]=__builtin_amdgcn_mfma_f32_32x32x16_bf16(PAF(0),VFR(0),o[0],0,0,0), C0,0); \
    VRDQ(0); SBAR(); \
    GAPB2(o[1]=__builtin_amdgcn_mfma_f32_32x32x16_bf16(PAF(0),VFR(4),o[1],0,0,0), C0,2); \
    VRDQ(4); SBAR(); \
    KRD(GL,0); GAPB2(o[0]=__builtin_amdgcn_mfma_f32_32x32x16_bf16(PAF(1),VFR(1),o[0],0,0,0), C0,4); \
    VRDQ(1); SBAR(); \
    KRD(GL,1); GAPB2(o[1]=__builtin_amdgcn_mfma_f32_32x32x16_bf16(PAF(1),VFR(5),o[1],0,0,0), C0,6); \
    VRDQ(5); SBAR(); \
    KRD(GL,2); GAPB2(o[0]=__builtin_amdgcn_mfma_f32_32x32x16_bf16(PAF(2),VFR(2),o[0],0,0,0), C0,8); \
    VRDQ(2); SBAR(); \
    KRD(GL,3); GAPB2(o[1]=__builtin_amdgcn_mfma_f32_32x32x16_bf16(PAF(2),VFR(6),o[1],0,0,0), C0,10); \
    VRDQ(6); SBAR(); \
    GAPB2(o[0]=__builtin_amdgcn_mfma_f32_32x32x16_bf16(PAF(3),VFR(3),o[0],0,0,0), C0,12); \
    VRDQ(3); SBAR(); \
    GAPB2(o[1]=__builtin_amdgcn_mfma_f32_32x32x16_bf16(PAF(3),VFR(7),o[1],0,0,0), C0,14); \
    VRDQ(7); SBAR(); \
    GAPB2(o[2]=__builtin_amdgcn_mfma_f32_32x32x16_bf16(PAF(0),VFR(0),o[2],0,0,0), C1,0); \
    GAPB2(o[3]=__builtin_amdgcn_mfma_f32_32x32x16_bf16(PAF(0),VFR(4),o[3],0,0,0), C1,2); \
    GAPB2(o[2]=__builtin_amdgcn_mfma_f32_32x32x16_bf16(PAF(1),VFR(1),o[2],0,0,0), C1,4); \
    GAPB2(o[3]=__builtin_amdgcn_mfma_f32_32x32x16_bf16(PAF(1),VFR(5),o[3],0,0,0), C1,6); \
    GAPB2(o[2]=__builtin_amdgcn_mfma_f32_32x32x16_bf16(PAF(2),VFR(2),o[2],0,0,0), C1,8); \
    GAPB2(o[3]=__builtin_amdgcn_mfma_f32_32x32x16_bf16(PAF(2),VFR(6),o[3],0,0,0), C1,10); \
    GAPB2(o[2]=__builtin_amdgcn_mfma_f32_32x32x16_bf16(PAF(3),VFR(3),o[2],0,0,0), C1,12); \
    GAPB2(o[3]=__builtin_amdgcn_mfma_f32_32x32x16_bf16(PAF(3),VFR(7),o[3],0,0,0), C1,14); \
    }while(0)
  int t=1;
  #undef CMASK
  #define CMASK(P0,P1,t) do{}while(0)
  for(;t+5<NT;t+=2){
    STEP(pB0,pB1,pA0,pA1,t,true,true,true);     WAIT_BAR(3); RESC(); ROT();
    STEP(pA0,pA1,pB0,pB1,t+1,true,true,true);   WAIT_BAR(3); RESC(); ROT();
  }
  #undef CMASK
  #define CMASK(P0,P1,t) do{}while(0)
  #define ENDW(tt) do{ if((tt)+3<NT){WAIT_BAR(3);} else if((tt)+2<NT){WAIT_BAR(2);} else {WAIT_BAR(0);} }while(0)
  for(;t+1<NT;t+=2){
    STEP(pB0,pB1,pA0,pA1,t,(t+3<NT),(t+1<NT),(t+1<NT));       ENDW(t);   RESC(); ROT();
    STEP(pA0,pA1,pB0,pB1,t+1,(t+4<NT),(t+2<NT),(t+2<NT));     ENDW(t+1); RESC(); ROT();
  }
  STEP(pB0,pB1,pA0,pA1,NT-1,false,false,false); RESC();
  { float sacc=pB0[0]+pB0[1]; _Pragma("unroll") for(int r=2;r<16;++r)sacc+=pB0[r]; _Pragma("unroll") for(int r=0;r<16;++r)sacc+=pB1[r]; l_reg+=sacc;
    pw0=(u32x4){PKW(pB0,0),PKW(pB0,2),PKW(pB0,4),PKW(pB0,6)};pw1=(u32x4){PKW(pB0,8),PKW(pB0,10),PKW(pB0,12),PKW(pB0,14)};pw2=(u32x4){PKW(pB1,0),PKW(pB1,2),PKW(pB1,4),PKW(pB1,6)};pw3=(u32x4){PKW(pB1,8),PKW(pB1,10),PKW(pB1,12),PKW(pB1,14)};
    SBAR(); pv(o,vb0+2*sl_cur,PAF(0),PAF(1),PAF(2),PAF(3)); pv(o+2,vb0+2*sl_cur+8192,PAF(0),PAF(1),PAF(2),PAF(3)); }
  #undef PKW
  #undef PAF
  #undef VFR
  #undef PIN
  #undef MX3
  #undef GAPA
  #undef GAPB
  #undef GAPB2
  #undef EX
  #undef VRD
  #undef KRD
  #undef VRDQ
  #undef STEP
  #undef ENDW
  {auto rr=__builtin_amdgcn_permlane32_swap(__float_as_uint(l_reg),__float_as_uint(l_reg),false,false);l_reg=__uint_as_float(rr[0])+__uint_as_float(rr[1]);}
  if(hi==0)wsf[32+r32]=l_reg;asm volatile("s_waitcnt lgkmcnt(0)":::"memory");
  float rli[16];
  #pragma unroll
  for(int r=0;r<16;++r)rli[r]=__builtin_amdgcn_rcpf(wsf[32+crow(r,hi)]);
  bf16*Ow=O0+(long)(wid*QBLK)*ldo;
  { bf16*stg=(bf16*)(shm+LDS_OST128)+wid*2048;
    #pragma unroll
    for(int h2=0;h2<2;++h2){
      #pragma unroll
      for(int r=0;r<16;++r){const int orow=crow(r,hi);
        #pragma unroll
        for(int d0=0;d0<2;++d0)stg[orow*64+d0*32+r32]=__float2bfloat16(o[2*h2+d0][r]*rli[r]);}
      asm volatile("s_waitcnt lgkmcnt(0)":::"memory");
      #pragma unroll
      for(int i=0;i<4;++i){const int row=i*8+(lane>>3),ch=lane&7; const u32x4 v=*(const u32x4*)(stg+row*64+ch*8); ATTN_STORE16(Ow+(long)row*ldo+h2*64+ch*8,v);}
      asm volatile("s_waitcnt lgkmcnt(0)":::"memory"); } }
  asm volatile("s_waitcnt lgkmcnt(0)\n\ts_barrier":::"memory");
  #undef DMA_K
  #undef DMA_V
  #undef CMASK
  #undef START
  #undef RESC
  #undef ROT
}
constexpr int ATTN_LDS_BYTES=LDS_BYTES;
#undef SBAR
#undef WAIT_BAR
}


constexpr int NWAVES = 8;
constexpr int DMODEL = 1024, NBATCH = 2, SEQL = 8192, CTXL = 256, RPB = SEQL + CTXL, MROWS = NBATCH * RPB, NLAYER = 2;
constexpr int DFF = 2816, NUP = 2 * DFF, INW = 5888, ZW = 5376, NMODV = 9, MODW = NMODV * DMODEL;
constexpr int ZQA = 0, ZKA = 512, ZVA = 640, ZQB = 768, ZKB = 1280, ZVB = 1792, ZGATE = 2304;
constexpr int TPB = RPB / 256;
constexpr float EPSN = 1e-6f;
constexpr int HN = 4096;
constexpr int HQ = 2048;

constexpr size_t MiB = 1u << 20, KiB = 1024;
constexpr size_t WS_CTL = 0, CTL_ZERO_BYTES = 64 * KiB;
constexpr size_t WS_MOD = 1 * MiB;
constexpr size_t WS_CAS256 = 1 * MiB + 512 * KiB;
constexpr size_t WS_HC = 2 * MiB;
constexpr size_t WS_WUP0 = 4 * MiB, WS_WDN0 = 15 * MiB, WS_WUP1 = 20 * MiB + 512 * KiB, WS_WDN1 = 31 * MiB + 512 * KiB;
constexpr size_t WS_WIN = 37 * MiB, WS_WC = 47 * MiB + 512 * KiB, WS_WBR = 48 * MiB + 512 * KiB, WS_WOUT = 51 * MiB + 512 * KiB;
constexpr size_t WS_HN = 54 * MiB;
constexpr size_t WS_Z = 87 * MiB;
constexpr size_t WS_T1T = 261 * MiB;
constexpr size_t WS_PART = WS_T1T;
constexpr size_t WS_T2B = WS_T1T;
constexpr size_t WS_T2 = 278 * MiB;
constexpr size_t WS_PQ = 295 * MiB;
constexpr size_t WS_CAS = 311 * MiB;
constexpr size_t WS_ROPE = 343 * MiB;
constexpr size_t WS_END = 345 * MiB;
static_assert(WS_Z + (size_t)MROWS * ZW * 2 <= WS_T1T && WS_HN + (size_t)MROWS * DMODEL * 2 <= WS_Z && WS_WOUT + 2 * MiB <= WS_HN, "ws map");
constexpr int CW_BAR = 4096;
constexpr int CW_Q = 1024;


#define GAS __attribute__((address_space(1)))
typedef unsigned short bf16;
typedef unsigned v4u __attribute__((ext_vector_type(4)));
typedef float f32x4 __attribute__((ext_vector_type(4)));
#define LDS_WAIT() asm volatile("s_waitcnt lgkmcnt(0)" ::: "memory")

__device__ __forceinline__ float bf2f(unsigned v) { return __uint_as_float(v << 16); }
__device__ __forceinline__ float bflo(unsigned w) { return __uint_as_float(w << 16); }
__device__ __forceinline__ float bfhi(unsigned w) { return __uint_as_float(w & 0xffff0000u); }
__device__ __forceinline__ unsigned pk2(float lo, float hi) { return pg8::cvt_pk_bf16(lo, hi); }
__device__ __forceinline__ float fexp(float x) { return __builtin_amdgcn_exp2f(x * 1.4426950408889634f); }
__device__ __forceinline__ float sigm(float x) { return __builtin_amdgcn_rcpf(1.0f + fexp(-x)); }
__device__ __forceinline__ float siluf(float x) { return x * sigm(x); }
__device__ __forceinline__ float shfl_xor(float v, int o) { return __builtin_bit_cast(float, __builtin_amdgcn_ds_bpermute((lane_id() ^ o) << 2, __builtin_bit_cast(int, v))); }
__device__ __forceinline__ float wave_sum(float v) {
#pragma unroll
    for (int o = 1; o < 64; o <<= 1) v += shfl_xor(v, o);
    return v;
}

namespace pg8 {
struct EpiStore {
    static constexpr bool PERM = true, AFTER_DRAIN = false;
    bf16_t* O; int ldc; int sig_from; int rbase, rmul;
    __device__ __forceinline__ void operator()(const f32x4 (&acc)[2][2][4][2], const Unit& u, int wr, int wc, int fr_, int fq_) const {
        (void)fr_; (void)fq_; const int ln_ = lane_id(); const int fr = ln_ & 15, fq = ln_ >> 4;
        const int row0 = u.pm * BM + wr * 64 + fr, col0 = u.pn * BM + wc * 32 + 8 * fq;
        const bool sg = (u.pn * BM) >= sig_from;
#pragma unroll
        for (int ai = 0; ai < 2; ++ai)
#pragma unroll
            for (int m = 0; m < 4; ++m) { const int row = row0 + ai * HALF + m * 16; bf16_t* rowp = O + (size_t)(rbase + row * rmul) * ldc + col0;
#pragma unroll
                for (int bj = 0; bj < 2; ++bj) { f32x4 v0 = acc[ai][bj][m][0], v1 = acc[ai][bj][m][1];
                    if (sg) { v0[0] = sigm(v0[0]); v0[1] = sigm(v0[1]); v0[2] = sigm(v0[2]); v0[3] = sigm(v0[3]); v1[0] = sigm(v1[0]); v1[1] = sigm(v1[1]); v1[2] = sigm(v1[2]); v1[3] = sigm(v1[3]); }
                    u32x4 w; w.x = cvt_pk_bf16(v0[0], v0[1]); w.y = cvt_pk_bf16(v0[2], v0[3]); w.z = cvt_pk_bf16(v1[0], v1[1]); w.w = cvt_pk_bf16(v1[2], v1[3]);
                    *(u32x4*)(rowp + bj * HALF) = w; } }
    }
};
struct EpiSwiGLU {
    static constexpr bool PERM = true, AFTER_DRAIN = false;
    bf16_t* H; int ldc;
    __device__ __forceinline__ void operator()(const f32x4 (&acc)[2][2][4][2], const Unit& u, int wr, int wc, int fr_, int fq_) const {
        (void)fr_; (void)fq_; const int ln_ = lane_id(); const int fr = ln_ & 15, fq = ln_ >> 4;
        const int row0 = u.pm * BM + wr * 64 + fr, col0 = u.pn * HALF + wc * 32 + 8 * fq;
#pragma unroll
        for (int ai = 0; ai < 2; ++ai)
#pragma unroll
            for (int m = 0; m < 4; ++m) { const int row = row0 + ai * HALF + m * 16; bf16_t* rowp = H + (size_t)row * ldc + col0;
                const f32x4 g0 = acc[ai][0][m][0], g1 = acc[ai][0][m][1], u0 = acc[ai][1][m][0], u1 = acc[ai][1][m][1];
                u32x4 w; w.x = cvt_pk_bf16(siluf(g0[0]) * u0[0], siluf(g0[1]) * u0[1]); w.y = cvt_pk_bf16(siluf(g0[2]) * u0[2], siluf(g0[3]) * u0[3]);
                w.z = cvt_pk_bf16(siluf(g1[0]) * u1[0], siluf(g1[1]) * u1[1]); w.w = cvt_pk_bf16(siluf(g1[2]) * u1[2], siluf(g1[3]) * u1[3]);
                *(u32x4*)rowp = w; }
    }
};
template <bool ATOMIC> struct EpiResidT {
    static constexpr bool PERM = false, AFTER_DRAIN = false;
    const float* base_lat; const float* base_ctx; float* out_lat; float* out_ctx; const float* gate; float scale;
    __device__ __forceinline__ void operator()(const f32x4 (&acc)[2][2][4][2], const Unit& u, int wr, int wc, int fr_, int fq_) const {
        (void)fr_; (void)fq_; const int ln_ = lane_id(); const int fr = ln_ & 15, fq = ln_ >> 4;
        const int b = u.pm / 33, w = u.pm % 33; const int set = (w == 0) ? 2 : b;
        const size_t toff = (w == 0) ? (size_t)b * 256 * 1024 : ((size_t)b * 8192 + (size_t)(w - 1) * 256) * 1024;
        const float* base = ((w == 0) ? base_ctx : base_lat) + toff; float* out = ((w == 0) ? out_ctx : out_lat) + toff;
        const int frr = fr;
        const int col0 = u.pn * BM + wc * 32 + 4 * fq; const float* gp = gate + set * 9216 + col0;
#pragma unroll
        for (int bj = 0; bj < 2; ++bj)
#pragma unroll
            for (int n = 0; n < 2; ++n) { const f32x4 gv = *(const f32x4*)(gp + bj * HALF + n * 16) * scale;
#pragma unroll
                for (int ai = 0; ai < 2; ++ai) {
#pragma unroll
                    for (int m = 0; m < 4; ++m) { const unsigned off = (unsigned)(ai * HALF + wr * 64 + m * 16 + frr) * 1024u + (unsigned)(col0 + bj * HALF + n * 16);
                        if constexpr (ATOMIC) { float one = 1.0f; asm volatile("" : "+v"(one) :: "memory"); const f32x4 v = (gv * one) * acc[ai][bj][m][n]; __attribute__((address_space(1))) float* ap = (__attribute__((address_space(1))) float*)(out + off); (void)__builtin_amdgcn_global_atomic_fadd_f32(ap, v[0]); (void)__builtin_amdgcn_global_atomic_fadd_f32(ap + 1, v[1]); (void)__builtin_amdgcn_global_atomic_fadd_f32(ap + 2, v[2]); (void)__builtin_amdgcn_global_atomic_fadd_f32(ap + 3, v[3]); asm volatile("" ::: "memory"); }
                        else { const f32x4 bs = *(const f32x4*)(base + off); *(f32x4*)(out + off) = bs + gv * acc[ai][bj][m][n]; } }
                    asm volatile("" ::: "memory"); } }
    }
};
typedef EpiResidT<false> EpiResid;
struct EpiResidA {
    static constexpr bool PERM = false, AFTER_DRAIN = false;
    float* part; const float* gate; float scale;
    __device__ __forceinline__ void operator()(const f32x4 (&acc)[2][2][4][2], const Unit& u, int wr, int wc, int fr_, int fq_) const {
        (void)fr_; (void)fq_; const int ln_ = lane_id(); const int fr = ln_ & 15, fq = ln_ >> 4;
        const int col0 = u.pn * BM + wc * 32 + 4 * fq;
        float* out = part + ((size_t)u.kp * 512 + (u.pm ? 256 : 0)) * 1024 + (unsigned)((wr * 64 + fr) * 1024 + col0);
#pragma unroll
        for (int bj = 0; bj < 2; ++bj)
#pragma unroll
            for (int n = 0; n < 2; ++n) { const f32x4 gv = *(const f32x4*)(gate + col0 + bj * HALF + n * 16) * scale;
#pragma unroll
                for (int ai = 0; ai < 2; ++ai) {
#pragma unroll
                    for (int m = 0; m < 4; ++m) *(f32x4*)(out + (ai * HALF + m * 16) * 1024 + bj * HALF + n * 16) = gv * acc[ai][bj][m][n];
                    asm volatile("" ::: "memory"); } }
    }
};
struct EpiMerge {
    static constexpr bool PERM = true, AFTER_DRAIN = false;
    const bf16_t* Z; bf16_t* Mo;
    __device__ __forceinline__ void operator()(const f32x4 (&acc)[2][2][4][2], const Unit& u, int wr, int wc, int fr_, int fq_) const {
        (void)fr_; (void)fq_; const int ln_ = lane_id(); const int fr = ln_ & 15, fq = ln_ >> 4;
        const int br = u.pn >> 2, ct = u.pn & 3;
        const int row0 = u.pm * BM + wr * 64 + fr, col0 = ct * BM + wc * 32 + 8 * fq;
#pragma unroll
        for (int ai = 0; ai < 2; ++ai)
#pragma unroll
            for (int m = 0; m < 4; ++m) { const int row = row0 + ai * HALF + m * 16; const bf16_t* gp = Z + (size_t)row * 5376 + 2304 + br * 1024 + col0; bf16_t* mp = Mo + (size_t)row * 1024 + col0;
#pragma unroll
                for (int bj = 0; bj < 2; ++bj) { const u32x4 gw = *(const u32x4*)(gp + bj * HALF); const f32x4 a0 = acc[ai][bj][m][0], a1 = acc[ai][bj][m][1];
                    float r0 = __uint_as_float(gw.x << 16) * a0[0], r1 = __uint_as_float(gw.x & 0xffff0000u) * a0[1], r2 = __uint_as_float(gw.y << 16) * a0[2], r3 = __uint_as_float(gw.y & 0xffff0000u) * a0[3];
                    float r4 = __uint_as_float(gw.z << 16) * a1[0], r5 = __uint_as_float(gw.z & 0xffff0000u) * a1[1], r6 = __uint_as_float(gw.w << 16) * a1[2], r7 = __uint_as_float(gw.w & 0xffff0000u) * a1[3];
                    if (br > 0) { const u32x4 ow = *(const u32x4*)(mp + bj * HALF);
                        r0 += __uint_as_float(ow.x << 16); r1 += __uint_as_float(ow.x & 0xffff0000u); r2 += __uint_as_float(ow.y << 16); r3 += __uint_as_float(ow.y & 0xffff0000u);
                        r4 += __uint_as_float(ow.z << 16); r5 += __uint_as_float(ow.z & 0xffff0000u); r6 += __uint_as_float(ow.w << 16); r7 += __uint_as_float(ow.w & 0xffff0000u); }
                    u32x4 w; w.x = cvt_pk_bf16(r0, r1); w.y = cvt_pk_bf16(r2, r3); w.z = cvt_pk_bf16(r4, r5); w.w = cvt_pk_bf16(r6, r7);
                    *(u32x4*)(mp + bj * HALF) = w; } }
    }
};
struct MergeOrder {
    int G, c, lat;
    __device__ bool next(int i, Unit& u) const { const int grp = (i / 3) * G + c; if (grp >= (lat ? 256 : 264)) return false; int pm = grp >> 2; if (lat) pm = pm + 1 + (pm >= 32); u.pm = pm; u.pn = (grp & 3) + 4 * (i % 3); return true; }
    __device__ __forceinline__ void a_ready(const Unit&) const {}
    __device__ __forceinline__ void done(const Unit&) const {}
    __device__ __forceinline__ size_t aoff(const Unit& u) const { const int br = u.pn >> 2; return (size_t)(br == 0 ? 0 : (br == 1 ? 768 : 1280)) * 2; }
    __device__ __forceinline__ size_t boff(const Unit&) const { return 0; }
};
struct LatOrder {
    StaticOrder so;
    __device__ void init(int N, int G_, int c_) { so.init(64 * BM, N, G_, c_); }
    __device__ bool next(int i, Unit& u) const { if (!so.next(i, u)) return false; u.pm = u.pm + 1 + (u.pm >= 32); return true; }
    __device__ __forceinline__ void a_ready(const Unit&) const {}
    __device__ __forceinline__ void done(const Unit&) const {}
    __device__ __forceinline__ size_t aoff(const Unit&) const { return 0; }
    __device__ __forceinline__ size_t boff(const Unit&) const { return 0; }
};
struct CtxSplit {
    int G, c, KP;
    __device__ bool next(int i, Unit& u) const { const int s = i * G + c; if (s >= 8 * KP) return false; const int t = s / KP; u.pn = t & 3; u.kp = s % KP; u.pm = (t >> 2) * 33; return true; }
    __device__ __forceinline__ void a_ready(const Unit&) const {}
    __device__ __forceinline__ void done(const Unit&) const {}
    __device__ __forceinline__ size_t aoff(const Unit& u) const { return (size_t)u.kp * 512; }
    __device__ __forceinline__ size_t boff(const Unit& u) const { return (size_t)u.kp * 512; }
};
struct OneUnit {
    int pm, pn;
    __device__ bool next(int i, Unit& u) const { if (i) return false; u.pm = pm; u.pn = pn; return true; }
    __device__ __forceinline__ void a_ready(const Unit&) const {}
    __device__ __forceinline__ void done(const Unit&) const {}
    __device__ __forceinline__ size_t aoff(const Unit&) const { return 0; }
    __device__ __forceinline__ size_t boff(const Unit&) const { return 0; }
};
}

#define XB_TMO      128
#define XB_XCNT(j)  (256  + 64 * (j))
#define XB_XSUB(j)  (1280 + 64 * (j))
#define XB_XGEN(j)  (2304 + 64 * (j))
#define XB_TOP      3328
#define XB_TOPGEN   3392
#define XCD_BAR_WORDS 3456
#define XB_SPIN_CAP (1u << 18)

__device__ __forceinline__ unsigned xb_ld(unsigned* p)              { return __hip_atomic_load(p, __ATOMIC_RELAXED, __HIP_MEMORY_SCOPE_AGENT); }
__device__ __forceinline__ unsigned xb_add(unsigned* p, unsigned v) { return __hip_atomic_fetch_add(p, v, __ATOMIC_RELAXED, __HIP_MEMORY_SCOPE_AGENT); }
__device__ __forceinline__ unsigned xb_xcc_id() { return (unsigned)__builtin_amdgcn_s_getreg((3 << 11) | 20) & 0xFu; }
#define XB_SPIN(cond, bar) do { unsigned _sp = 0; while (cond) { __builtin_amdgcn_s_sleep(1); \
    if ((++_sp & 255u) == 0u) { if (xb_ld(&(bar)[XB_TMO])) break; if (_sp > XB_SPIN_CAP) { atomicAdd(&(bar)[XB_TMO], 1u); break; } } } } while (0)

struct XcdBarrier {
    unsigned* bar; unsigned x;
    volatile LAS unsigned* st;
};

__device__ __forceinline__ XcdBarrier xcd_barrier_post(unsigned* bar, volatile LAS unsigned* st) {
    XcdBarrier b; b.bar = bar; b.x = xb_xcc_id(); b.st = st;
    if (my_tid() == 0) (void)xb_add(&bar[XB_XCNT(b.x)], 1u);
    return b;
}
__device__ __forceinline__ void xcd_barrier_complete(unsigned* bar, unsigned x, unsigned& nloc, unsigned& nx) {
    const unsigned G = gridDim.x * gridDim.y * gridDim.z;
    unsigned sum, cnt, mine, sp = 0u;
    for (;;) {
        sum = 0u; cnt = 0u; mine = 0u;
#pragma unroll
        for (unsigned j = 0; j < 16; ++j) { const unsigned c = xb_ld(&bar[XB_XCNT(j)]); sum += c; cnt += (c > 0u) ? 1u : 0u; mine = (j == x) ? c : mine; }
        if (sum == G) break;
        __builtin_amdgcn_s_sleep(1);
        if ((++sp & 255u) == 0u) { if (xb_ld(&bar[XB_TMO])) break; if (sp > XB_SPIN_CAP) { atomicAdd(&bar[XB_TMO], 1u); break; } }
    }
    nloc = mine > 0u ? mine : 1u; nx = cnt > 0u ? cnt : 1u;
}

__device__ __forceinline__ void xcd_barrier(const XcdBarrier& b) {
    asm volatile("s_waitcnt vmcnt(0)" ::: "memory");
    __syncthreads();
    if (my_tid() == 0) {
        unsigned* bar = b.bar;
        __builtin_amdgcn_s_waitcnt(0);
        unsigned nloc = b.st[0], nx = b.st[1];
        if (nloc == 0u) { xcd_barrier_complete(bar, b.x, nloc, nx); b.st[0] = nloc; b.st[1] = nx; }
        const unsigned old = xb_add(&bar[XB_XSUB(b.x)], 1u);
        const unsigned gen = old / nloc;
        if (old + 1u == (gen + 1u) * nloc) {
            __builtin_amdgcn_fence(__ATOMIC_RELEASE, "agent");
            asm volatile("s_waitcnt vmcnt(0)" ::: "memory");
            const unsigned og = xb_add(&bar[XB_TOP], 1u);
            const unsigned tg = og / nx;
            if (og + 1u == (tg + 1u) * nx) xb_add(&bar[XB_TOPGEN], 1u);
            else XB_SPIN(xb_ld(&bar[XB_TOPGEN]) == tg, bar);
            __builtin_amdgcn_fence(__ATOMIC_ACQUIRE, "agent");
            xb_add(&bar[XB_XGEN(b.x)], 1u);
            asm volatile("s_waitcnt vmcnt(0)" ::: "memory");
        } else {
            XB_SPIN(xb_ld(&bar[XB_XGEN(b.x)]) == gen, bar);
            __builtin_amdgcn_fence(__ATOMIC_ACQUIRE, "agent");
            asm volatile("s_waitcnt vmcnt(0)" ::: "memory");
        }
    }
    __syncthreads();
}

struct Frame {
    LAS unsigned char* lds; volatile LAS unsigned* MISC; unsigned* ctl;
    int tid, lane, wave, G, bid;
    const float *x, *c, *ctx, *cctx, *w_ada, *b_ada, *norm_g, *ffn_wi, *ffn_wo, *w_in, *qk_g, *diff_lam, *subln_g, *w_branch, *w_out;
    float* out; unsigned char* ws;
};
#define WSP(T, off) ((T*)(F.ws + (off)))

__device__ __forceinline__ void transpose_item(const float* W, int N, bf16* WT, int ldt, int k0, int n0, int dst_row0, LAS float* scr, int lane) {
#pragma unroll 8
    for (int i = 0; i < 32; ++i) { const int kk = 2 * i + (lane >> 5); scr[kk * 33 + (lane & 31)] = W[(size_t)(k0 + kk) * N + n0 + (lane & 31)]; }
    LDS_WAIT(); asm volatile("" ::: "memory");
    const int c = lane & 7;
#pragma unroll
    for (int j = 0; j < 4; ++j) { const int n = (lane >> 3) + 8 * j; const LAS float* s = scr + (8 * c) * 33 + n;
        v4u o; o.x = pk2(s[0 * 33], s[1 * 33]); o.y = pk2(s[2 * 33], s[3 * 33]); o.z = pk2(s[4 * 33], s[5 * 33]); o.w = pk2(s[6 * 33], s[7 * 33]);
        *(v4u*)(WT + (size_t)(dst_row0 + n) * ldt + k0 + 8 * c) = o; }
    LDS_WAIT(); asm volatile("" ::: "memory");
}
__device__ __forceinline__ void convert_weights(Frame& F, int l) {
    LAS float* scr = (LAS float*)(F.lds + F.wave * 16384);
    const int gw = F.bid * NWAVES + F.wave, NGW = F.G * NWAVES;
    constexpr int I_UP = 16 * 176, I_DN = 44 * 32, I_IN = 16 * 184, I_BR = 8 * 32, I_OUT = 16 * 32;
    constexpr int NITEMS = 2 * I_UP + 2 * I_DN + I_IN + 3 * I_BR + I_OUT;
    const float* wi = F.ffn_wi + (size_t)l * 2 * 1024 * NUP; const float* wo = F.ffn_wo + (size_t)l * 2 * DFF * 1024;
    const float* win = F.w_in + (size_t)l * 1024 * INW; const float* wbr = F.w_branch + (size_t)l * 3 * 512 * 1024; const float* wout = F.w_out + (size_t)l * 1024 * 1024;
    for (int it = gw; it < NITEMS; it += NGW) {
        int r = it;
        if (r < 2 * I_UP) { const int h = r / I_UP; r -= h * I_UP; const int kb = r / 176, nb = r % 176; int n0 = nb * 32; const int isu = n0 >= DFF; const int nn = n0 - isu * DFF;
            transpose_item(wi + (size_t)h * 1024 * NUP, NUP, WSP(bf16, h ? WS_WUP1 : WS_WUP0), 1024, kb * 64, n0, (nn / 128) * 256 + isu * 128 + (nn % 128), scr, F.lane); continue; }
        r -= 2 * I_UP;
        if (r < 2 * I_DN) { const int h = r / I_DN; r -= h * I_DN; const int kb = r / 32, nb = r % 32;
            transpose_item(wo + (size_t)h * DFF * 1024, 1024, WSP(bf16, h ? WS_WDN1 : WS_WDN0), DFF, kb * 64, nb * 32, nb * 32, scr, F.lane); continue; }
        r -= 2 * I_DN;
        if (r < I_IN) { const int kb = r / 184, nb = r % 184; const int n0 = nb * 32;
            if (n0 >= 2304 && n0 < 2816) continue;
            transpose_item(win, INW, WSP(bf16, WS_WIN), 1024, kb * 64, n0, n0 < 2304 ? n0 : n0 - 512, scr, F.lane); continue; }
        r -= I_IN;
        if (r < 3 * I_BR) { const int i = r / I_BR; r -= i * I_BR; const int kb = r / 32, nb = r % 32;
            transpose_item(wbr + (size_t)i * 512 * 1024, 1024, WSP(bf16, WS_WBR), 512, kb * 64, nb * 32, i * 1024 + nb * 32, scr, F.lane); continue; }
        r -= 3 * I_BR;
        { const int kb = r / 32, nb = r % 32; transpose_item(wout, 1024, WSP(bf16, WS_WOUT), 1024, kb * 64, nb * 32, nb * 32, scr, F.lane); }
    }
    {
        const int t = F.bid * 512 + F.tid;
        if (t < 65536) {
            const int jl = t & 63, rest = t >> 6, kc = rest & 127, rj = rest >> 7; const int row = rj * 64 + jl, g = row >> 7, j = row & 127;
            float a[8];
#pragma unroll
            for (int e = 0; e < 8; ++e) a[e] = 0.f;
            const float* wp = win + (size_t)(kc * 8) * INW + 2304 + g * 128;
            for (int c4 = 0; c4 < 32; ++c4) {
                float cs[4];
#pragma unroll
                for (int q = 0; q < 4; ++q) { const int idx = ((c4 * 4 + q) * j) & 127; float sn, co; sincospif((float)idx * (1.0f / 64.0f), &sn, &co); cs[q] = sn + co; }
#pragma unroll
                for (int e = 0; e < 8; ++e) { const f32x4 w = *(const f32x4*)(wp + (size_t)e * INW + c4 * 4); a[e] += w[0] * cs[0] + w[1] * cs[1] + w[2] * cs[2] + w[3] * cs[3]; }
            }
            v4u o; o.x = pk2(a[0], a[1]); o.y = pk2(a[2], a[3]); o.z = pk2(a[4], a[5]); o.w = pk2(a[6], a[7]);
            *(v4u*)(WSP(bf16, WS_WC) + (size_t)row * 1024 + kc * 8) = o;
        }
    }
}
__device__ __forceinline__ void make_cas(Frame& F) {
    const int t0 = F.bid * 512 + F.tid, NT_ = F.G * 512;
    for (int it = t0; it < HQ * HQ / 8; it += NT_) { const int k = it >> 8, n0 = (it & 255) * 8; float v[8];
#pragma unroll
        for (int e = 0; e < 8; ++e) { const int idx = (k * (n0 + e)) & (HQ - 1); float sn, co; sincospif((float)idx * (2.0f / HQ), &sn, &co); v[e] = sn + co; }
        v4u o; o.x = pk2(v[0], v[1]); o.y = pk2(v[2], v[3]); o.z = pk2(v[4], v[5]); o.w = pk2(v[6], v[7]);
        *(v4u*)(WSP(bf16, WS_CAS) + (size_t)k * HQ + n0) = o; }
    for (int it = t0; it < 256 * 256 / 8; it += NT_) { const int k = it >> 5, n0 = (it & 31) * 8; float v[8];
#pragma unroll
        for (int e = 0; e < 8; ++e) { const int idx = (k * (n0 + e)) & 255; float sn, co; sincospif((float)idx * (1.0f / 128.0f), &sn, &co); v[e] = sn + co; }
        v4u o; o.x = pk2(v[0], v[1]); o.y = pk2(v[2], v[3]); o.z = pk2(v[4], v[5]); o.w = pk2(v[6], v[7]);
        *(v4u*)(WSP(bf16, WS_CAS256) + (size_t)k * 256 + n0) = o; }
}
__device__ __forceinline__ void make_mod(Frame& F) {
    LAS float* red = (LAS float*)F.lds;
    for (int item = F.bid; item < 288; item += F.G) {
        const int l = item / 144, cb = item % 144;
        const int c4 = F.lane & 15, ks = F.lane >> 4, slice = F.wave * 4 + ks;
        const float* W = F.w_ada + (size_t)l * 1024 * MODW + cb * 64 + c4 * 4;
        f32x4 a0 = {0.f, 0.f, 0.f, 0.f}, a1 = a0, a2 = a0;
        for (int r = 0; r < 32; ++r) { const int k = slice * 32 + r; const f32x4 w = *(const f32x4*)(W + (size_t)k * MODW);
            const float s0 = siluf(F.c[k]), s1 = siluf(F.c[1024 + k]), s2 = siluf(F.cctx[k]); a0 += w * s0; a1 += w * s1; a2 += w * s2; }
#pragma unroll
        for (int q = 0; q < 4; ++q) { red[(slice * 3 + 0) * 64 + c4 * 4 + q] = a0[q]; red[(slice * 3 + 1) * 64 + c4 * 4 + q] = a1[q]; red[(slice * 3 + 2) * 64 + c4 * 4 + q] = a2[q]; }
        __syncthreads();
        if (F.tid < 192) { const int set = F.tid >> 6, col = F.tid & 63; float s = 0.f;
            for (int sl = 0; sl < 32; ++sl) s += red[(sl * 3 + set) * 64 + col];
            WSP(float, WS_MOD)[((size_t)l * 3 + set) * MODW + cb * 64 + col] = s + F.b_ada[(size_t)l * MODW + cb * 64 + col]; }
        __syncthreads();
    }
}
__device__ __forceinline__ const float* hrow_ptr(const float* lat, const float* ctxp, int row, int& set) {
    const int b = row / RPB, w = row % RPB;
    if (w < CTXL) { set = 2; return ctxp + ((size_t)b * CTXL + w) * 1024; }
    set = b; return lat + ((size_t)b * SEQL + (w - CTXL)) * 1024;
}
__device__ __forceinline__ void norm_mod(Frame& F, const float* lat, const float* ctxp, const float* g, const float* modl  , int ishift, float* copy_ctx, const float* parts, int nparts) {
    const int gw = F.bid * NWAVES + F.wave, NGW = F.G * NWAVES;
    constexpr int NR = 9;
    for (int row0 = gw; row0 < MROWS; row0 += NR * NGW) {
        f32x4 v[NR][4]; int set[NR]; const float* hr[NR]; bool ok[NR]; float ss[NR];
#pragma unroll
        for (int r = 0; r < NR; ++r) { const int row = row0 + r * NGW; ok[r] = row < MROWS; hr[r] = hrow_ptr(lat, ctxp, ok[r] ? row : gw, set[r]);
#pragma unroll
            for (int j = 0; j < 4; ++j) v[r][j] = *((const f32x4*)hr[r] + F.lane + 64 * j); }
#pragma unroll
        for (int r = 0; r < NR; ++r) {
            if (set[r] == 2 && parts != nullptr) { const float* pr = parts + (hr[r] - ctxp);
                for (int p = 0; p < nparts; ++p) {
#pragma unroll
                    for (int j = 0; j < 4; ++j) v[r][j] += *((const f32x4*)(pr + (size_t)p * 512 * 1024) + F.lane + 64 * j); } }
            float s = 0.f;
#pragma unroll
            for (int j = 0; j < 4; ++j) s += (v[r][j][0] * v[r][j][0] + v[r][j][1] * v[r][j][1]) + (v[r][j][2] * v[r][j][2] + v[r][j][3] * v[r][j][3]);
            ss[r] = s; }
#pragma unroll
        for (int o = 1; o < 64; o <<= 1) {
#pragma unroll
            for (int r = 0; r < NR; ++r) ss[r] += shfl_xor(ss[r], o); }
#pragma unroll
        for (int r = 0; r < NR; ++r) if (ok[r]) {
            const int row = row0 + r * NGW;
            const float rstd = 1.0f / sqrtf(ss[r] * (1.0f / 1024.0f) + EPSN);
            const float* sh = modl + (size_t)set[r] * MODW + ishift * 1024; const float* sc = sh + 1024;
            if (copy_ctx != nullptr && set[r] == 2) { f32x4* cp = (f32x4*)(copy_ctx + (hr[r] - ctxp)) + F.lane;
#pragma unroll
                for (int j = 0; j < 4; ++j) cp[64 * j] = v[r][j]; }
            unsigned long long* o8 = (unsigned long long*)(WSP(bf16, WS_HN) + (size_t)row * 1024) + F.lane;
#pragma unroll
            for (int j = 0; j < 4; ++j) { const f32x4 gg = *((const f32x4*)g + F.lane + 64 * j), s1 = *((const f32x4*)sc + F.lane + 64 * j), s0 = *((const f32x4*)sh + F.lane + 64 * j);
                const f32x4 y = v[r][j] * rstd * gg * (s1 + 1.0f) + s0;
                o8[64 * j] = (unsigned long long)pk2(y[0], y[1]) | ((unsigned long long)pk2(y[2], y[3]) << 32); }
        }
    }
}
__device__ __forceinline__ void make_rope(Frame& F) {
    const int t0 = F.bid * 512 + F.tid, NT_ = F.G * 512;
    float* ct = WSP(float, WS_ROPE); float* st = ct + SEQL * 32;
    for (int it = t0; it < SEQL * 32; it += NT_) { const int s = it >> 5, i = it & 31;
        const float inv = exp2f(-(float)(i & 15) * (13.287712379549449f / 16.0f));
        const float pos = (float)((i < 16) ? (s >> 6) : (s & 63)); float sn, cs; sincosf(pos * inv, &sn, &cs); ct[it] = cs; st[it] = sn; }
}
__device__ __forceinline__ void qk_rope(Frame& F, int l) {
    const int gw = F.bid * NWAVES + F.wave, NGW = F.G * NWAVES;
    const float* qg = F.qk_g + (size_t)l * 256;
    const float* ct = WSP(float, WS_ROPE); const float* st = ct + SEQL * 32;
    const int c = F.lane & 3;
    int col[2], gsel[2]; bool isq[2], act[2];
#pragma unroll
    for (int pass = 0; pass < 2; ++pass) { const int q = pass * 64 + F.lane; act[pass] = q < 104; const int hv = act[pass] ? (q >> 2) : 0;
        if (hv < 8) { col[pass] = ZQA + hv * 64; gsel[pass] = 0; isq[pass] = true; } else if (hv < 10) { col[pass] = ZKA + (hv - 8) * 64; gsel[pass] = 1; isq[pass] = false; }
        else if (hv < 18) { col[pass] = ZQB + (hv - 10) * 64; gsel[pass] = 2; isq[pass] = true; } else { col[pass] = ZKB + (hv - 18) * 64; gsel[pass] = 3; isq[pass] = false; } }
    constexpr int NRQ = 5;
    for (int row0 = gw; row0 < MROWS; row0 += NRQ * NGW) {
        v4u lo[NRQ][2], hi[NRQ][2];
#pragma unroll
        for (int rr = 0; rr < NRQ; ++rr) { const int row = row0 + rr * NGW; const bf16* zr = WSP(bf16, WS_Z) + (size_t)(row < MROWS ? row : gw) * ZW;
#pragma unroll
            for (int pass = 0; pass < 2; ++pass) { lo[rr][pass] = *(const v4u*)(zr + col[pass] + 8 * c); hi[rr][pass] = *(const v4u*)(zr + col[pass] + 32 + 8 * c); } }
#pragma unroll
        for (int rr = 0; rr < NRQ; ++rr) { const int row = row0 + rr * NGW; const bool ok = row < MROWS; const int w = (ok ? row : gw) % RPB; bf16* zr = WSP(bf16, WS_Z) + (size_t)(ok ? row : gw) * ZW;
#pragma unroll
            for (int pass = 0; pass < 2; ++pass) {
                const v4u lo_ = lo[rr][pass], hi_ = hi[rr][pass];
                float x1[8], x2[8];
                x1[0] = bflo(lo_.x); x1[1] = bfhi(lo_.x); x1[2] = bflo(lo_.y); x1[3] = bfhi(lo_.y); x1[4] = bflo(lo_.z); x1[5] = bfhi(lo_.z); x1[6] = bflo(lo_.w); x1[7] = bfhi(lo_.w);
                x2[0] = bflo(hi_.x); x2[1] = bfhi(hi_.x); x2[2] = bflo(hi_.y); x2[3] = bfhi(hi_.y); x2[4] = bflo(hi_.z); x2[5] = bfhi(hi_.z); x2[6] = bflo(hi_.w); x2[7] = bfhi(hi_.w);
                float ss = 0.f;
#pragma unroll
                for (int e = 0; e < 8; ++e) ss += x1[e] * x1[e] + x2[e] * x2[e];
                ss += shfl_xor(ss, 1); ss += shfl_xor(ss, 2);
                const float rstd = 1.0f / sqrtf(ss * (1.0f / 64.0f) + EPSN);
                const float sc = isq[pass] ? attn_body::C2 : 1.0f;
                const float* gq = qg + gsel[pass] * 64 + 8 * c;
                const f32x4 ga = *(const f32x4*)(gq), gb = *(const f32x4*)(gq + 4), gc = *(const f32x4*)(gq + 32), gd = *(const f32x4*)(gq + 36);
                f32x4 ca = {1.f, 1.f, 1.f, 1.f}, cb = ca, sa = {0.f, 0.f, 0.f, 0.f}, sb = sa;
                if (w >= CTXL) { const int s = w - CTXL; ca = *(const f32x4*)(ct + s * 32 + 8 * c); cb = *(const f32x4*)(ct + s * 32 + 8 * c + 4); sa = *(const f32x4*)(st + s * 32 + 8 * c); sb = *(const f32x4*)(st + s * 32 + 8 * c + 4); }
                float o1[8], o2[8];
#pragma unroll
                for (int e = 0; e < 8; ++e) { const float g1 = e < 4 ? ga[e & 3] : gb[e & 3], g2 = e < 4 ? gc[e & 3] : gd[e & 3], cs = e < 4 ? ca[e & 3] : cb[e & 3], sn = e < 4 ? sa[e & 3] : sb[e & 3];
                    const float y1 = x1[e] * rstd * g1, y2 = x2[e] * rstd * g2; o1[e] = (y1 * cs - y2 * sn) * sc; o2[e] = (y1 * sn + y2 * cs) * sc; }
                if (act[pass] && ok) { v4u a, b2; a.x = pk2(o1[0], o1[1]); a.y = pk2(o1[2], o1[3]); a.z = pk2(o1[4], o1[5]); a.w = pk2(o1[6], o1[7]);
                    b2.x = pk2(o2[0], o2[1]); b2.y = pk2(o2[2], o2[3]); b2.z = pk2(o2[4], o2[5]); b2.w = pk2(o2[6], o2[7]);
                    *(v4u*)(zr + col[pass] + 8 * c) = a; *(v4u*)(zr + col[pass] + 32 + 8 * c) = b2; }
            }
        }
    }
}
__device__ __forceinline__ void make_pq(Frame& F) {
    const int t0 = F.bid * 512 + F.tid, NT_ = F.G * 512;
    const bf16* T1 = WSP(bf16, WS_T1T); bf16* PQ = WSP(bf16, WS_PQ);
    constexpr int NIT = 2 * 512 * HQ, NU = 4;
    for (int it0 = t0; it0 < NIT; it0 += NU * NT_) {
        float xa[NU][4], xb[NU][4];
#pragma unroll
        for (int u = 0; u < NU; ++u) { const int it = it0 + u * NT_; const int itc = it < NIT ? it : t0;
            const int n = itc & (HQ - 1), col = (itc >> 11) & 511, b = itc >> 20; const bf16* xr = T1 + (size_t)col * MROWS + b * RPB + CTXL; const int m = (HQ - n) & (HQ - 1);
            xa[u][0] = bf2f(xr[n]); xa[u][1] = bf2f(xr[n + HQ]); xa[u][2] = bf2f(xr[m]); xa[u][3] = bf2f(xr[m + HQ]);
            xb[u][0] = bf2f(xr[n + HN]); xb[u][1] = bf2f(xr[n + HQ + HN]); xb[u][2] = bf2f(xr[m + HN]); xb[u][3] = bf2f(xr[m + HQ + HN]); }
#pragma unroll
        for (int u = 0; u < NU; ++u) { const int it = it0 + u * NT_; if (it < NIT) {
            const int n = it & (HQ - 1), col = (it >> 11) & 511, b = it >> 20; const int m = (HQ - n) & (HQ - 1);
            const int idx[4] = {n, n + HQ, m, m + HQ};
            float P[4], d[4], cs[4], sn[4], Q[4];
#pragma unroll
            for (int k = 0; k < 4; ++k) { P[k] = xa[u][k] + xb[u][k]; d[k] = xa[u][k] - xb[u][k]; sincospif((float)idx[k] * (1.0f / HN), &sn[k], &cs[k]); }
#pragma unroll
            for (int k = 0; k < 4; ++k) { const int mk = (n == 0) ? k : 3 - k; Q[k] = d[k] * cs[k] + ((mk == 0) ? d[0] * sn[0] : (mk == 1) ? d[1] * sn[1] : (mk == 2) ? d[2] * sn[2] : d[3] * sn[3]); }
            float s2n, c2n, s2m, c2m; sincospif((float)n * (1.0f / HQ), &s2n, &c2n); sincospif((float)m * (1.0f / HQ), &s2m, &c2m);
            const float pp = P[0] + P[1], pq = (P[0] - P[1]) * c2n + (P[2] - P[3]) * s2m;
            const float qp = Q[0] + Q[1], qq = (Q[0] - Q[1]) * c2n + (Q[2] - Q[3]) * s2m;
            bf16* o = PQ + ((size_t)(b * 4) * 512 + col) * HQ + n;
            o[0] = (bf16)(pk2(pp, 0.f) & 0xffffu); o[(size_t)512 * HQ] = (bf16)(pk2(pq, 0.f) & 0xffffu);
            o[(size_t)2 * 512 * HQ] = (bf16)(pk2(qp, 0.f) & 0xffffu); o[(size_t)3 * 512 * HQ] = (bf16)(pk2(qq, 0.f) & 0xffffu); } }
    }
}
__device__ __forceinline__ void post_mix(Frame& F, int l) {
    const int gw = F.bid * NWAVES + F.wave, NGW = F.G * NWAVES;
    const float lam_init = 0.8f - 0.6f * expf(-0.3f * (float)l);
    const float* dl = F.diff_lam + (size_t)l * 256;
    const float s1 = wave_sum(dl[F.lane] * dl[64 + F.lane]), s2 = wave_sum(dl[128 + F.lane] * dl[192 + F.lane]);
    const float lam = expf(s1) - expf(s2) + lam_init;
    const float* sg = F.subln_g + (size_t)l * 128 + (F.lane & 15) * 8;
    float gsc[8];
#pragma unroll
    for (int e = 0; e < 8; ++e) gsc[e] = sg[e] * (1.0f - lam_init);
    const bf16* OB = WSP(bf16, WS_HN); const bf16* T2 = WSP(bf16, WS_T2); const bf16* T2B = WSP(bf16, WS_T2B); bf16* Z = WSP(bf16, WS_Z);
    const int g = F.lane >> 4, j0 = (F.lane & 15) * 8;
    constexpr int NRP = 4;
    for (int row0 = gw; row0 < MROWS; row0 += NRP * NGW) {
        v4u a[NRP], c2[NRP], mv[NRP], mv2[NRP]; unsigned short rk1[NRP][8], rk2[NRP][8]; bool lat[NRP], ok[NRP]; float sc[NRP];
#pragma unroll
        for (int rr = 0; rr < NRP; ++rr) { const int rw = row0 + rr * NGW; ok[rr] = rw < MROWS; const int row = ok[rr] ? rw : gw; const int b = row / RPB, w = row % RPB;
            a[rr] = *(const v4u*)(OB + (size_t)row * 1024 + F.lane * 8); c2[rr] = *(const v4u*)(OB + (size_t)row * 1024 + 512 + F.lane * 8);
            int mrow; lat[rr] = w >= CTXL;
            if (!lat[rr]) { mrow = b * RPB + ((CTXL - w) & (CTXL - 1)); sc[rr] = 0.5f * 0.005524271728019903f; }
            else { const int s = w - CTXL; mrow = b * RPB + CTXL + ((SEQL - s) & (SEQL - 1)); sc[rr] = 1.0f / 2048.0f; }
            const bf16* rk = T2 + (size_t)row * 512 + g * 128; mv[rr] = *(const v4u*)(T2 + (size_t)mrow * 512 + g * 128 + j0);
            const bf16* rkb = (lat[rr] ? T2B : T2) + (size_t)row * 512 + g * 128; mv2[rr] = *(const v4u*)((lat[rr] ? T2B : T2) + (size_t)mrow * 512 + g * 128 + j0);
#pragma unroll
            for (int e = 0; e < 8; ++e) { rk1[rr][e] = rk[(128 - (j0 + e)) & 127]; rk2[rr][e] = rkb[(128 - (j0 + e)) & 127]; } }
#pragma unroll
        for (int rr = 0; rr < NRP; ++rr) if (ok[rr]) { const int row = row0 + rr * NGW;
            {
                const v4u a_ = a[rr], c_ = c2[rr];
                float d[8];
                d[0] = bflo(a_.x) - lam * bflo(c_.x); d[1] = bfhi(a_.x) - lam * bfhi(c_.x); d[2] = bflo(a_.y) - lam * bflo(c_.y); d[3] = bfhi(a_.y) - lam * bfhi(c_.y);
                d[4] = bflo(a_.z) - lam * bflo(c_.z); d[5] = bfhi(a_.z) - lam * bfhi(c_.z); d[6] = bflo(a_.w) - lam * bflo(c_.w); d[7] = bfhi(a_.w) - lam * bfhi(c_.w);
                float ss = 0.f;
#pragma unroll
                for (int e = 0; e < 8; ++e) ss += d[e] * d[e];
#pragma unroll
                for (int o = 1; o < 16; o <<= 1) ss += shfl_xor(ss, o);
                const float rstd = 1.0f / sqrtf(ss * (1.0f / 128.0f) + EPSN);
                v4u o; o.x = pk2(d[0] * rstd * gsc[0], d[1] * rstd * gsc[1]); o.y = pk2(d[2] * rstd * gsc[2], d[3] * rstd * gsc[3]);
                o.z = pk2(d[4] * rstd * gsc[4], d[5] * rstd * gsc[5]); o.w = pk2(d[6] * rstd * gsc[6], d[7] * rstd * gsc[7]);
                *(v4u*)(Z + (size_t)row * ZW + ZQB + F.lane * 8) = o;
            }
            {
                float r[8], mm_[8]; const v4u m1 = mv[rr], m2 = mv2[rr]; const float f2 = lat[rr] ? 1.0f : 0.0f;
#pragma unroll
                for (int e = 0; e < 8; ++e) r[e] = bf2f(rk1[rr][e]) + f2 * bf2f(rk2[rr][e]);
                mm_[0] = bflo(m1.x) + f2 * bflo(m2.x); mm_[1] = bfhi(m1.x) + f2 * bfhi(m2.x); mm_[2] = bflo(m1.y) + f2 * bflo(m2.y); mm_[3] = bfhi(m1.y) + f2 * bfhi(m2.y);
                mm_[4] = bflo(m1.z) + f2 * bflo(m2.z); mm_[5] = bfhi(m1.z) + f2 * bfhi(m2.z); mm_[6] = bflo(m1.w) + f2 * bflo(m2.w); mm_[7] = bfhi(m1.w) + f2 * bfhi(m2.w);
                const float s_ = sc[rr];
                v4u o; o.x = pk2((r[0] + mm_[0]) * s_, (r[1] + mm_[1]) * s_); o.y = pk2((r[2] + mm_[2]) * s_, (r[3] + mm_[3]) * s_);
                o.z = pk2((r[4] + mm_[4]) * s_, (r[5] + mm_[5]) * s_); o.w = pk2((r[6] + mm_[6]) * s_, (r[7] + mm_[7]) * s_);
                *(v4u*)(Z + (size_t)row * ZW + ZKB + F.lane * 8) = o;
            }
        }
    }
}
__device__ __forceinline__ void hartley_ctx(Frame& F) {
    for (int r = F.bid; r < 4; r += F.G) { const int b = r >> 1;
        pg8::Gemm g{WSP(bf16, WS_CAS256), WSP(bf16, WS_T1T) + (size_t)b * RPB, 256, 512, 256, 256, MROWS};
        pg8::OneUnit S{0, r & 1};
        pg8::EpiStore E{WSP(bf16, WS_T2), 512, 1 << 30, b * RPB, 1};
        pg8::gemm_phase<pg8::EpiStore, pg8::OneUnit, true, true, 256, 256, MROWS>(F.lds, g, S, E); }
}
__device__ __forceinline__ void mixer_phase(Frame& F, int l) {
    constexpr int QL = 64 + 64 + 32, QC = 4;
    const int qlen = (l == NLAYER - 1) ? QL : QL + QC;
    bf16* Z = WSP(bf16, WS_Z);
    const int myx = (int)(xb_xcc_id() & 7u);
    int dq = 0;
    for (;;) {
        if (F.tid == 0) { int it = -1, x = 0, d = dq;
            for (; d < 8; ++d) { x = (myx + d) & 7; const unsigned v = __hip_atomic_fetch_add(F.ctl + CW_Q + (l * 8 + x) * 64, 1u, __ATOMIC_RELAXED, __HIP_MEMORY_SCOPE_AGENT); if ((int)v < qlen) { it = (int)v; break; } }
            F.MISC[0] = (unsigned)it; F.MISC[1] = (unsigned)x; F.MISC[2] = (unsigned)d; }
        __syncthreads();
        const int it = (int)F.MISC[0], x = (int)F.MISC[1]; dq = (int)F.MISC[2];
        __syncthreads();
        if (it < 0) break;
        if (it >= 128 && it < QL) {
            int r = x * 32 + (it - 128); const int kh = r & 1; r >>= 1; const int b = r >> 6, kind = (r >> 4) & 3, r2 = r & 15;
            pg8::Gemm g{WSP(bf16, WS_CAS) + kh * (HQ / 2), WSP(bf16, WS_PQ) + (size_t)(b * 4 + kind) * 512 * HQ + kh * (HQ / 2), HQ, 512, HQ / 2, HQ, HQ};
            pg8::OneUnit S{r2 >> 1, r2 & 1};
            pg8::EpiStore E{WSP(bf16, kh ? WS_T2B : WS_T2), 512, 1 << 30, b * RPB + CTXL + ((kind & 1) << 1) + (kind >> 1), 4};
            pg8::gemm_phase<pg8::EpiStore, pg8::OneUnit, true, true, HQ / 2, HQ, HQ>(F.lds, g, S, E);
        } else {
            int b, j, qrow, nt; bool big;
            if (it < 128) { big = it < 64; b = (it >> 5) & 1; j = x; qrow = b * RPB + CTXL + (it & 31) * 256; nt = RPB / 64; }
            else { const int r = x * 4 + (it - QL); big = r < 16; j = r & 7; b = (r >> 3) & 1; qrow = b * RPB; nt = CTXL / 64; }
            const size_t kv0 = (size_t)b * RPB;
            if (big) { const int h = j >> 1, mm = j & 1;
                const bf16* Qp = Z + ZQB + (h * 2 + mm) * 64; const bf16* Kp = Z + ZKB + (h * 2 + mm) * 64; const bf16* Vp = Z + ZVB + h * 128; bf16* Op = WSP(bf16, WS_HN) + mm * 512 + h * 128;
                attn_body::attn_unit128<8>((const attn_body::bf16*)(Qp + (size_t)qrow * ZW), ZW, (const attn_body::bf16*)(Kp + kv0 * ZW), ZW, (const attn_body::bf16*)(Vp + kv0 * ZW), ZW,
                                           (attn_body::bf16*)(Op + (size_t)qrow * 1024), 1024, nt, (char*)F.lds);
            } else {
                const bf16* Qp = Z + ZQA + j * 64; const bf16* Kp = Z + ZKA + (j >> 2) * 64; const bf16* Vp = Z + ZVA + (j >> 2) * 64; bf16* Op = Z + ZQA + j * 64;
                attn_body::attn_unit<8>((const attn_body::bf16*)(Qp + (size_t)qrow * ZW), ZW, (const attn_body::bf16*)(Kp + kv0 * ZW), ZW, (const attn_body::bf16*)(Vp + kv0 * ZW), ZW,
                                        (attn_body::bf16*)(Op + (size_t)qrow * ZW), ZW, nt, (char*)F.lds);
            }
        }
    }
}

#ifndef MK_PER_PHASE
#define MK_PER_PHASE 0
#endif
constexpr int NPHASE = 1 + 13 * NLAYER;
struct Args { const float* in[15]; float* out; unsigned char* ws; int ph_lo, ph_hi; };
__device__ __forceinline__ void load_frame(Frame& F) {
    const __attribute__((address_space(4))) Args* a = (const __attribute__((address_space(4))) Args*)__builtin_amdgcn_kernarg_segment_ptr();
    asm volatile("" : "+s"(a));
    extern __shared__ __attribute__((aligned(16))) unsigned char lds_raw[];
    F.lds = (LAS unsigned char*)lds_raw; F.MISC = (volatile LAS unsigned*)(F.lds + MISC_OFF);
    int t = my_tid(); asm volatile("" : "+v"(t));
    F.tid = t; F.lane = t & 63; F.wave = __builtin_amdgcn_readfirstlane(t >> 6); F.G = gridDim.x; F.bid = blockIdx.x;
    F.x = a->in[0]; F.c = a->in[1]; F.ctx = a->in[2]; F.cctx = a->in[3]; F.w_ada = a->in[4]; F.b_ada = a->in[5]; F.norm_g = a->in[6]; F.ffn_wi = a->in[7];
    F.ffn_wo = a->in[8]; F.w_in = a->in[9]; F.qk_g = a->in[10]; F.diff_lam = a->in[11]; F.subln_g = a->in[12]; F.w_branch = a->in[13]; F.w_out = a->in[14];
    F.out = a->out; F.ws = a->ws; F.ctl = (unsigned*)(a->ws + WS_CTL);
}
#ifndef MK_MASK
#define MK_MASK 0xffffffffu
#endif
#define EN(j) (((MK_MASK) >> (j)) & 1u)
#ifndef MK_DUP
#define MK_DUP 0
#endif
#define DUP(b) for (int rep_ = 0; rep_ < (((MK_DUP) >> (b)) & 1) + 1; ++rep_)
__device__ __forceinline__ void seam_barrier() {
    const __attribute__((address_space(4))) Args* a = (const __attribute__((address_space(4))) Args*)__builtin_amdgcn_kernarg_segment_ptr();
    asm volatile("" : "+s"(a));
    extern __shared__ __attribute__((aligned(16))) unsigned char lds_raw[];
    XcdBarrier b; b.bar = (unsigned*)(a->ws + WS_CTL) + CW_BAR; b.x = xb_xcc_id(); b.st = (volatile LAS unsigned*)((LAS unsigned char*)lds_raw + MISC_OFF) + 8;
    xcd_barrier(b);
}
#define LF() Frame F; load_frame(F); float* hlat = F.out; float* hctx = WSP(float, WS_HC); const float* modl = WSP(float, WS_MOD) + (size_t)l * 3 * MODW; const float* ng = F.norm_g + (size_t)l * 3 * 1024; \
    const float* slat = (l == 0) ? F.x : hlat; const float* sctx = (l == 0) ? F.ctx : hctx; (void)hlat; (void)hctx; (void)modl; (void)ng; (void)slat; (void)sctx
__global__ void __launch_bounds__(NWAVES * 64, 2) mk_fwd(Args args) {
    cg::grid_group grid = cg::this_grid();
    const int lo = args.ph_lo, hi = args.ph_hi;
    {
        extern __shared__ __attribute__((aligned(16))) unsigned char lds_raw[];
        volatile LAS unsigned* misc = (volatile LAS unsigned*)((LAS unsigned char*)lds_raw + MISC_OFF);
        const int t0 = threadIdx.x;
        if (t0 < 32) misc[t0] = 0u;
        if ((t0 & 63) == 0) ((volatile LAS int*)((LAS unsigned char*)lds_raw + WTAB_OFF))[hw_slot()] = t0 >> 6;
        __syncthreads();
        if (hi - lo > 1) (void)xcd_barrier_post((unsigned*)(args.ws + WS_CTL) + CW_BAR, misc + 8);
    }
#define IN(k) (lo <= (k) && (k) < hi)
    if (lo < 0) grid.sync();
#ifndef MK_TMASK
#define MK_TMASK 0
#endif
#define TSTAMP(kind) do { if (MK_TMASK) { if (blockIdx.x == 0 && my_tid() == 0) { extern __shared__ __attribute__((aligned(16))) unsigned char lds_raw[]; volatile LAS unsigned* tm = (volatile LAS unsigned*)((LAS unsigned char*)lds_raw + MISC_OFF) + 16; \
        const unsigned now = (unsigned)__builtin_amdgcn_s_memrealtime(); if (((MK_TMASK) >> (kind)) & 1) tm[1] += now - tm[0]; tm[0] = now; } } } while (0)
#define SEAM(k) do { if (IN(k) && IN((k) + 1)) { seam_barrier(); } } while (0)
    TSTAMP(31);
    if (EN(0) && IN(0)) { const int l = 0; LF(); DUP(4) { make_mod(F); convert_weights(F, 0); make_cas(F); make_rope(F); } }
    SEAM(0); TSTAMP(0);
    for (int l = 0; l < NLAYER; ++l) {
        const int p0 = 1 + 13 * l;
        if (EN(1) && IN(p0 + 0)) { LF(); if (l > 0) DUP(4) convert_weights(F, l); norm_mod(F, slat, sctx, ng, modl, 0, hctx, (l == 0) ? nullptr : WSP(float, WS_PART), DFF / 256); }
        SEAM(p0 + 0); TSTAMP(1);
        if (EN(2) && IN(p0 + 1)) { LF(); pg8::Gemm g{WSP(bf16, WS_HN), WSP(bf16, WS_WUP0), MROWS, NUP, 1024, 1024, 1024}; pg8::StaticOrder S; S.init(MROWS, NUP, F.G, F.bid);
            pg8::EpiSwiGLU E{WSP(bf16, WS_Z), DFF}; DUP(1) pg8::gemm_phase<pg8::EpiSwiGLU, pg8::StaticOrder, true, true, 1024, 1024, 1024>(F.lds, g, S, E); }
        SEAM(p0 + 1); TSTAMP(2);
        if (EN(3) && IN(p0 + 2)) { LF();
            { pg8::Gemm g{WSP(bf16, WS_Z), WSP(bf16, WS_WDN0), MROWS, 1024, DFF, DFF, DFF}; pg8::LatOrder S; S.init(1024, F.G, F.bid);
              pg8::EpiResid E{slat, sctx, hlat, hctx, modl + 2 * 1024, 0.5f}; for (int rep_ = 0; rep_ < ((((MK_DUP) >> 7) & 1) && l == 0 ? 4 : 1); ++rep_) pg8::gemm_phase<pg8::EpiResid, pg8::LatOrder, true, true, DFF, DFF, DFF>(F.lds, g, S, E); }
            { pg8::Gemm g{WSP(bf16, WS_Z), WSP(bf16, WS_WDN0), MROWS, 1024, 256, DFF, DFF}; pg8::CtxSplit S{F.G, F.G - 1 - F.bid, DFF / 256};
              pg8::EpiResidA E{WSP(float, WS_PART), modl + 2 * MODW + 2 * 1024, 0.5f}; pg8::gemm_phase<pg8::EpiResidA, pg8::CtxSplit, true, true, 256, DFF, DFF>(F.lds, g, S, E); } }
        SEAM(p0 + 2); TSTAMP(3);
        if (EN(4) && IN(p0 + 3)) { LF(); norm_mod(F, hlat, hctx, ng + 1024, modl, 3, hctx, WSP(float, WS_PART), DFF / 256); }
        SEAM(p0 + 3); TSTAMP(4);
        if (EN(5) && IN(p0 + 4)) { LF();
            { pg8::Gemm g{WSP(bf16, WS_HN), WSP(bf16, WS_WIN), MROWS, ZW, 1024, 1024, 1024}; pg8::StaticOrder S; S.init(MROWS, ZW, F.G, F.bid);
              pg8::EpiStore E{WSP(bf16, WS_Z), ZW, ZGATE, 0, 1}; DUP(5) pg8::gemm_phase<pg8::EpiStore, pg8::StaticOrder, true, true, 1024, 1024, 1024>(F.lds, g, S, E); }
            { pg8::Gemm g{WSP(bf16, WS_WC), WSP(bf16, WS_HN), 512, MROWS, 1024, 1024, 1024}; pg8::StaticOrder S; S.init(512, MROWS, F.G, F.G - 1 - F.bid);
              pg8::EpiStore E{WSP(bf16, WS_T1T), MROWS, 1 << 30, 0, 1}; DUP(5) pg8::gemm_phase<pg8::EpiStore, pg8::StaticOrder, true, true, 1024, 1024, 1024>(F.lds, g, S, E); }
        }
        SEAM(p0 + 4); TSTAMP(5);
        if (EN(6) && IN(p0 + 5)) { LF(); qk_rope(F, l); make_pq(F); if (l < NLAYER - 1) hartley_ctx(F); }
        SEAM(p0 + 5); TSTAMP(6);
        if (EN(7) && IN(p0 + 6)) { LF(); mixer_phase(F, l); }
        SEAM(p0 + 6); TSTAMP(7);
        if (EN(8) && IN(p0 + 7)) { LF(); post_mix(F, l); }
        SEAM(p0 + 7); TSTAMP(8);
        if (EN(9) && IN(p0 + 8)) { LF(); pg8::Gemm g{WSP(bf16, WS_Z), WSP(bf16, WS_WBR), MROWS, 3072, 512, ZW, 512}; pg8::MergeOrder S{F.G, F.bid, l == NLAYER - 1};
            pg8::EpiMerge E{WSP(bf16, WS_Z), WSP(bf16, WS_HN)}; DUP(6) pg8::gemm_phase<pg8::EpiMerge, pg8::MergeOrder, true, true, 512, ZW, 512>(F.lds, g, S, E); }
        SEAM(p0 + 8); TSTAMP(9);
        if (EN(10) && IN(p0 + 9)) { LF();
            { pg8::Gemm g{WSP(bf16, WS_HN), WSP(bf16, WS_WOUT), MROWS, 1024, 1024, 1024, 1024}; pg8::LatOrder S; S.init(1024, F.G, F.bid);
              pg8::EpiResid E{hlat, hctx, hlat, hctx, modl + 5 * 1024, 1.0f}; pg8::gemm_phase<pg8::EpiResid, pg8::LatOrder, true, true, 1024, 1024, 1024>(F.lds, g, S, E); }
            if (l < NLAYER - 1) { pg8::Gemm g{WSP(bf16, WS_HN), WSP(bf16, WS_WOUT), MROWS, 1024, 256, 1024, 1024}; pg8::CtxSplit S{F.G, F.G - 1 - F.bid, 4};
              pg8::EpiResidA E{WSP(float, WS_PART), modl + 2 * MODW + 5 * 1024, 1.0f}; pg8::gemm_phase<pg8::EpiResidA, pg8::CtxSplit, true, true, 256, 1024, 1024>(F.lds, g, S, E); } }
        SEAM(p0 + 9); TSTAMP(10);
        if (EN(11) && IN(p0 + 10)) { LF(); norm_mod(F, hlat, hctx, ng + 2048, modl, 6, (l == 0) ? hctx : nullptr, (l == 0) ? WSP(float, WS_PART) : nullptr, 4); }
        SEAM(p0 + 10); TSTAMP(11);
        if (EN(12) && IN(p0 + 11)) { LF(); pg8::Gemm g{WSP(bf16, WS_HN), WSP(bf16, WS_WUP1), MROWS, NUP, 1024, 1024, 1024}; pg8::StaticOrder S; S.init(MROWS, NUP, F.G, F.bid);
            pg8::EpiSwiGLU E{WSP(bf16, WS_Z), DFF}; DUP(1) pg8::gemm_phase<pg8::EpiSwiGLU, pg8::StaticOrder, true, true, 1024, 1024, 1024>(F.lds, g, S, E); }
        SEAM(p0 + 11); TSTAMP(12);
        if (EN(13) && IN(p0 + 12)) { LF();
            { pg8::Gemm g{WSP(bf16, WS_Z), WSP(bf16, WS_WDN1), MROWS, 1024, DFF, DFF, DFF}; pg8::LatOrder S; S.init(1024, F.G, F.bid);
              pg8::EpiResid E{hlat, hctx, hlat, hctx, modl + 8 * 1024, 0.5f}; pg8::gemm_phase<pg8::EpiResid, pg8::LatOrder, true, true, DFF, DFF, DFF>(F.lds, g, S, E); }
            if (l < NLAYER - 1) { pg8::Gemm g{WSP(bf16, WS_Z), WSP(bf16, WS_WDN1), MROWS, 1024, 256, DFF, DFF}; pg8::CtxSplit S{F.G, F.G - 1 - F.bid, DFF / 256};
              pg8::EpiResidA E{WSP(float, WS_PART), modl + 2 * MODW + 8 * 1024, 0.5f}; pg8::gemm_phase<pg8::EpiResidA, pg8::CtxSplit, true, true, 256, DFF, DFF>(F.lds, g, S, E); } }
        SEAM(p0 + 12); TSTAMP(13);
    }
    if (MK_TMASK) { if (blockIdx.x == 0) { if (my_tid() == 0) { extern __shared__ __attribute__((aligned(16))) unsigned char lds_raw[]; volatile LAS unsigned* tm = (volatile LAS unsigned*)((LAS unsigned char*)lds_raw + MISC_OFF) + 16;
            const unsigned t0 = (unsigned)__builtin_amdgcn_s_memrealtime(), want = tm[1]; while ((unsigned)__builtin_amdgcn_s_memrealtime() - t0 < want) __builtin_amdgcn_s_sleep(16); }
        __syncthreads(); } }
#undef IN
#undef SEAM
}

extern "C" void kernel_launch(void* const* d_in, const int* in_sizes, int n_in, void* d_out, int out_size, void* d_ws, size_t ws_size, hipStream_t stream) {
    static int grid = 0;
    if (grid == 0) {
        if (n_in != 15 || ws_size < WS_END) { fprintf(stderr, "kernel_launch: need 15 inputs and >= %zu bytes of workspace; got n_in %d, ws %zu\n", (size_t)WS_END, n_in, ws_size); grid = -1; return; }
        int dev = 0, cus = 0, per_cu = 0;
        if (hipGetDevice(&dev) != hipSuccess || hipDeviceGetAttribute(&cus, hipDeviceAttributeMultiprocessorCount, dev) != hipSuccess) { grid = -1; return; }
        if (hipFuncSetAttribute((const void*)mk_fwd, hipFuncAttributeMaxDynamicSharedMemorySize, LDS_BYTES) != hipSuccess) { fprintf(stderr, "kernel_launch: hipFuncSetAttribute failed\n"); grid = -1; return; }
        if (hipOccupancyMaxActiveBlocksPerMultiprocessor(&per_cu, (const void*)mk_fwd, NWAVES * 64, LDS_BYTES) != hipSuccess || per_cu < 1) { fprintf(stderr, "kernel_launch: occupancy query says %d\n", per_cu); per_cu = 1; }
        (void)hipGetLastError();
        grid = cus * per_cu;
    }
    if (grid < 0) return;
    (void)hipMemsetAsync((char*)d_ws + WS_CTL, 0, CTL_ZERO_BYTES, stream);
    Args a{};
    for (int i = 0; i < 15; ++i) a.in[i] = (const float*)d_in[i];
    a.out = (float*)d_out; a.ws = (unsigned char*)d_ws;
#if MK_PER_PHASE
    for (int p = 0; p < NPHASE; ++p) { a.ph_lo = p; a.ph_hi = p + 1; hipLaunchKernelGGL(mk_fwd, dim3(grid), dim3(NWAVES * 64), LDS_BYTES, stream, a); }
#else
    a.ph_lo = 0; a.ph_hi = NPHASE;
    void* kargs[] = {&a};
    hipError_t e = hipLaunchCooperativeKernel((const void*)mk_fwd, dim3(grid), dim3(NWAVES * 64), kargs, LDS_BYTES, stream);
    if (e != hipSuccess) fprintf(stderr, "kernel_launch: cooperative launch failed: %s (grid %d)\n", hipGetErrorString(e), grid);
#endif
}
```

```cpp
#include <hip/hip_runtime.h>
#include <hip/hip_cooperative_groups.h>
#include <hip/hip_bf16.h>
#include <cstdio>
#include <cstdint>
#include <cmath>
namespace cg = cooperative_groups;

#define LAS __attribute__((address_space(3)))
constexpr int LDS_BYTES = 147456, MISC_OFF = 131072 + 320, WTAB_OFF = MISC_OFF + 128;
__device__ __forceinline__ int lane_id() { int l; asm volatile("v_mbcnt_lo_u32_b32 %0, -1, 0\n\tv_mbcnt_hi_u32_b32 %0, -1, %0" : "=&v"(l)); return l; }
__device__ __forceinline__ unsigned hw_slot() { return (unsigned)__builtin_amdgcn_s_getreg((5 << 11) | 4) & 63u; }
__device__ __forceinline__ int my_tid() {
    extern __shared__ __attribute__((aligned(16))) unsigned char lds_raw[];
    const int w = ((volatile LAS int*)((LAS unsigned char*)lds_raw + WTAB_OFF))[hw_slot()];
    return __builtin_amdgcn_readfirstlane(w) * 64 + lane_id();
}

namespace pg8 {
#define PG8_LAS __attribute__((address_space(3)))
typedef unsigned short bf16_t;
typedef short bf16x8 __attribute__((ext_vector_type(8)));
typedef float f32x4 __attribute__((ext_vector_type(4)));
typedef unsigned u32x4 __attribute__((ext_vector_type(4)));
constexpr int BM = 256, BK = 64, HALF = 128, HTB = HALF * BK * 2  , STAGE_BYTES = 8 * HTB, NXCD = 8, WGM = 8;

__host__ __device__ __forceinline__ int lds_byte(int r, int c) { const int st = (r >> 4) * 2 + (c >> 5), rr = r & 15, cc = c & 31, ob = rr * 64 + cc * 2; return st * 1024 + (ob ^ (((ob >> 9) & 1) << 5)); }
__host__ __device__ __forceinline__ void stage_rc(int b, int& R, int& C) { const int st = b / 1024, sb = b % 1024, swz = sb ^ (((sb >> 9) & 1) << 5); R = (st >> 1) * 16 + swz / 64; C = (st & 1) * 32 + (swz % 64) / 2; }
__host__ __device__ __forceinline__ int perm32(int rho) { const int n = rho >> 4, i = rho & 15; return 8 * (i >> 2) + 4 * n + (i & 3); }

struct Unit { int pm, pn, kp; };
struct Gemm { const bf16_t* A; const bf16_t* Bt; int M, N, K, lda, ldb; };

struct StaticOrder {
    int nM, nN, nwg, G, c;
    __host__ __device__ void init(int M, int N, int G_, int c_) { nM = M / BM; nN = N / BM; nwg = nM * nN; G = G_; c = c_; }
    __host__ __device__ bool next(int i, Unit& u) const {
        const long L = (long)i * G + c; if (L >= nwg) return false;
        int wgid = (int)L; { const int q = nwg / NXCD, r = nwg % NXCD, xcd = wgid % NXCD, off = wgid / NXCD; wgid = (xcd < r ? xcd * (q + 1) : r * (q + 1) + (xcd - r) * q) + off; }
        const int nig = WGM * nN, gid = wgid / nig, fm = gid * WGM, gsz = (nM - fm) < WGM ? (nM - fm) : WGM;
        u.pm = fm + ((wgid % nig) % gsz); u.pn = (wgid % nig) / gsz; return true;
    }
    __device__ __forceinline__ void a_ready(const Unit&) const {}
    __device__ __forceinline__ void done(const Unit&) const {}
    __device__ __forceinline__ size_t aoff(const Unit&) const { return 0; }
    __device__ __forceinline__ size_t boff(const Unit&) const { return 0; }
};


__device__ __forceinline__ unsigned cvt_pk_bf16(float lo, float hi) { unsigned r; asm volatile("v_cvt_pk_bf16_f32 %0, %1, %2" : "=v"(r) : "v"(lo), "v"(hi)); return r; }
typedef float f32x2 __attribute__((ext_vector_type(2)));

template <class Epi, class Sched, bool ALIGN_EPI, bool SP2, int TK, int TLDA, int TLDB, int KSA = 0, int TSA = 0, int KSB = 0, int TSB = 0>
__device__ __forceinline__ void gemm_phase(PG8_LAS unsigned char* lds, const Gemm g, const Sched& S, const Epi& E) {
    int tid_ = my_tid(); asm volatile("" : "+v"(tid_)); const int tid = tid_, wid = __builtin_amdgcn_readfirstlane(tid >> 6), lane = tid & 63, wr = wid >> 2, wc = wid & 3, fr = lane & 15, fq = lane >> 4;
    constexpr int K = TK, nt = K / BK;
    unsigned voffA[2], voffB[2];
#pragma unroll
    for (int i = 0; i < 2; ++i) { int R, C; stage_rc(tid * 16 + i * 8192, R, C); const int Rb = Epi::PERM ? ((R & ~31) + perm32(R & 31)) : R;
        voffA[i] = (unsigned)(R * TLDA + C) * 2u; voffB[i] = (unsigned)(Rb * TLDB + C) * 2u; }
    constexpr size_t kstepA = KSA ? (size_t)KSA : (size_t)(BK * 2), kstepB = KSB ? (size_t)KSB : (size_t)(BK * 2);
    const size_t hstepA = (size_t)HALF * TLDA * 2, hstepB = (size_t)HALF * TLDB * 2;
    const size_t tstepA = TSA ? (size_t)TSA : 2 * hstepA, tstepB = TSB ? (size_t)TSB : 2 * hstepB;
    const unsigned ldsw = (unsigned)wid * 1024u;
    const int aoff = lds_byte(wr * 64 + fr, fq * 8), boff = lds_byte(wc * 32 + fr, fq * 8);
#define PG8_SA(b, h) (((b) * 2 + (h)) * HTB)
#define PG8_SB(b, h) ((4 + (b) * 2 + (h)) * HTB)
#define PG8_STAGE(bufoff, gbase, voff) do { _Pragma("unroll") for (int _i = 0; _i < 2; ++_i) \
        __builtin_amdgcn_global_load_lds((const unsigned*)((const char*)(gbase) + (voff)[_i]), (PG8_LAS unsigned*)(lds + (bufoff) + ldsw + _i * 8192), 16, 0, 0); } while (0)
#define PG8_LDA(dst, b, h) do { _Pragma("unroll") for (int m = 0; m < 4; ++m) _Pragma("unroll") for (int k = 0; k < 2; ++k) dst[m][k] = *(const PG8_LAS bf16x8*)(lds + PG8_SA(b, h) + aoff + m * 2048 + k * 1024); } while (0)
#define PG8_LDB(dst, b, h) do { _Pragma("unroll") for (int n = 0; n < 2; ++n) _Pragma("unroll") for (int k = 0; k < 2; ++k) dst[n][k] = *(const PG8_LAS bf16x8*)(lds + PG8_SB(b, h) + boff + n * 2048 + k * 1024); } while (0)
#define PG8_MMA(ai, bj, At, Bt) do { __builtin_amdgcn_s_setprio(1); _Pragma("unroll") for (int m = 0; m < 4; ++m) _Pragma("unroll") for (int n = 0; n < 2; ++n) _Pragma("unroll") for (int k = 0; k < 2; ++k) \
        acc[ai][bj][m][n] = __builtin_amdgcn_mfma_f32_16x16x32_bf16(Bt[n][k], At[m][k], acc[ai][bj][m][n], 0, 0, 0); __builtin_amdgcn_s_setprio(0); } while (0)
#define PG8_WAIT_V(n) asm volatile("s_waitcnt vmcnt(" #n ")" ::: "memory")
#define PG8_WAIT_L(n) asm volatile("s_waitcnt lgkmcnt(" #n ")" ::: "memory")
#define PG8_BAR __builtin_amdgcn_s_barrier()
#define PG8_SCHED __builtin_amdgcn_sched_barrier(0)
    Unit cur, nxt; int ui = 0;
    if (!S.next(0, cur)) return;
    f32x4 acc[2][2][4][2];
#pragma unroll
    for (int a = 0; a < 2; ++a)
#pragma unroll
        for (int b = 0; b < 2; ++b)
#pragma unroll
            for (int m = 0; m < 4; ++m)
#pragma unroll
                for (int n = 0; n < 2; ++n) acc[a][b][m][n] = (f32x4){0.f, 0.f, 0.f, 0.f};
    bf16x8 At[4][2], B0[2][2], B1[2][2];
    const char* cA = (const char*)g.A + (size_t)cur.pm * tstepA + S.aoff(cur); const char* cB = (const char*)g.Bt + (size_t)cur.pn * tstepB + S.boff(cur);
    S.a_ready(cur);
    if constexpr (SP2) {
        PG8_STAGE(PG8_SB(0, 0), cB, voffB); PG8_STAGE(PG8_SB(0, 1), cB + hstepB, voffB); PG8_STAGE(PG8_SA(0, 0), cA, voffA); PG8_STAGE(PG8_SA(0, 1), cA + hstepA, voffA);
        if (wr == 1) PG8_BAR;
        PG8_WAIT_V(2); PG8_BAR;
        PG8_STAGE(PG8_SB(1, 0), cB + kstepB, voffB); PG8_STAGE(PG8_SA(1, 0), cA + kstepA, voffA); PG8_STAGE(PG8_SB(1, 1), cB + hstepB + kstepB, voffB);
        PG8_WAIT_V(6); PG8_BAR;
    } else {
        PG8_STAGE(PG8_SB(0, 0), cB, voffB); PG8_STAGE(PG8_SA(0, 0), cA, voffA); PG8_STAGE(PG8_SB(0, 1), cB + hstepB, voffB); PG8_STAGE(PG8_SA(0, 1), cA + hstepA, voffA);
        if (wr == 1) PG8_BAR;
        PG8_WAIT_V(4); PG8_BAR;
        PG8_STAGE(PG8_SB(1, 0), cB + kstepB, voffB); PG8_STAGE(PG8_SA(1, 0), cA + kstepA, voffA); PG8_STAGE(PG8_SB(1, 1), cB + hstepB + kstepB, voffB);
        PG8_WAIT_V(6); PG8_BAR;
    }
    for (;;) {
        const bool has_next = S.next(ui + 1, nxt);
        const char* nA = has_next ? (const char*)g.A + (size_t)nxt.pm * tstepA + S.aoff(nxt) : cA; const char* nB = has_next ? (const char*)g.Bt + (size_t)nxt.pn * tstepB + S.boff(nxt) : cB;
        for (int t = 0; t < nt; t += 2) {
            const bool last = (t == nt - 2);
            const char* a1 = cA + (size_t)(t + 1) * kstepA;
            const char* a2 = last ? nA : cA + (size_t)(t + 2) * kstepA; const char* b2 = last ? nB : cB + (size_t)(t + 2) * kstepB;
            const char* a3 = a2 + kstepA; const char* b3 = b2 + kstepB;
            if (last && has_next) S.a_ready(nxt);
            if constexpr (SP2) {
            PG8_LDB(B0, 0, 0); PG8_LDB(B1, 0, 1); PG8_SCHED; PG8_LDA(At, 0, 0); PG8_STAGE(PG8_SA(1, 1), a1 + hstepA, voffA);
            PG8_WAIT_V(8); PG8_WAIT_L(0); PG8_BAR; PG8_MMA(0, 0, At, B0); PG8_MMA(0, 1, At, B1); PG8_BAR; PG8_SCHED;
            PG8_LDA(At, 0, 1); PG8_STAGE(PG8_SB(0, 0), b2, voffB); PG8_STAGE(PG8_SB(0, 1), b2 + hstepB, voffB); PG8_STAGE(PG8_SA(0, 0), a2, voffA);
            PG8_WAIT_V(8); PG8_WAIT_L(0); PG8_BAR; PG8_MMA(1, 0, At, B0); PG8_MMA(1, 1, At, B1); PG8_BAR; PG8_SCHED;
            PG8_LDB(B0, 1, 0); PG8_LDB(B1, 1, 1); PG8_SCHED; PG8_LDA(At, 1, 0); PG8_STAGE(PG8_SA(0, 1), a2 + hstepA, voffA);
            PG8_WAIT_V(8); PG8_WAIT_L(0); PG8_BAR; PG8_MMA(0, 0, At, B0); PG8_MMA(0, 1, At, B1); PG8_BAR; PG8_SCHED;
            PG8_LDA(At, 1, 1); PG8_STAGE(PG8_SB(1, 0), b3, voffB); PG8_STAGE(PG8_SB(1, 1), b3 + hstepB, voffB); PG8_STAGE(PG8_SA(1, 0), a3, voffA);
            PG8_WAIT_V(8); PG8_WAIT_L(0); PG8_BAR; PG8_MMA(1, 0, At, B0); PG8_MMA(1, 1, At, B1); PG8_BAR; PG8_SCHED;
            } else {
            PG8_LDB(B0, 0, 0); PG8_SCHED; PG8_LDA(At, 0, 0); PG8_STAGE(PG8_SA(1, 1), a1 + hstepA, voffA);
            PG8_WAIT_L(8); PG8_BAR; PG8_WAIT_L(0); PG8_MMA(0, 0, At, B0); PG8_BAR; PG8_SCHED;
            PG8_LDB(B1, 0, 1); PG8_STAGE(PG8_SB(0, 0), b2, voffB);
            PG8_BAR; PG8_WAIT_L(0); PG8_MMA(0, 1, At, B1); PG8_BAR;
            PG8_LDA(At, 0, 1); PG8_STAGE(PG8_SA(0, 0), a2, voffA);
            PG8_BAR; PG8_WAIT_L(0); PG8_MMA(1, 0, At, B0); PG8_BAR; PG8_SCHED;
            PG8_STAGE(PG8_SB(0, 1), b2 + hstepB, voffB);
            PG8_WAIT_V(6); PG8_BAR; PG8_MMA(1, 1, At, B1); PG8_BAR;
            PG8_LDB(B0, 1, 0); PG8_SCHED; PG8_LDA(At, 1, 0); PG8_STAGE(PG8_SA(0, 1), a2 + hstepA, voffA);
            PG8_WAIT_L(8); PG8_BAR; PG8_WAIT_L(0); PG8_MMA(0, 0, At, B0); PG8_BAR; PG8_SCHED;
            PG8_LDB(B1, 1, 1); PG8_STAGE(PG8_SB(1, 0), b3, voffB);
            PG8_BAR; PG8_WAIT_L(0); PG8_MMA(0, 1, At, B1); PG8_BAR;
            PG8_LDA(At, 1, 1); PG8_STAGE(PG8_SA(1, 0), a3, voffA);
            PG8_BAR; PG8_WAIT_L(0); PG8_MMA(1, 0, At, B0); PG8_BAR; PG8_SCHED;
            PG8_STAGE(PG8_SB(1, 1), b3 + hstepB, voffB);
            PG8_WAIT_V(6); PG8_BAR; PG8_MMA(1, 1, At, B1); PG8_BAR;
            }
        }
        if constexpr (ALIGN_EPI) { if (wr == 0) PG8_BAR; }
        if constexpr (!Epi::AFTER_DRAIN) { E(acc, cur, wr, wc, fr, fq); S.done(cur); }
        if (!has_next) break;
#pragma unroll
        for (int a = 0; a < 2; ++a)
#pragma unroll
            for (int b = 0; b < 2; ++b)
#pragma unroll
                for (int m = 0; m < 4; ++m)
#pragma unroll
                    for (int n = 0; n < 2; ++n) acc[a][b][m][n] = (f32x4){0.f, 0.f, 0.f, 0.f};
        cur = nxt; cA = nA; cB = nB; ++ui;
        if constexpr (ALIGN_EPI) { if (wr == 1) PG8_BAR; }
    }
    PG8_WAIT_V(0);
    if constexpr (!ALIGN_EPI) { if (wr == 0) PG8_BAR; }
    PG8_BAR;
    if constexpr (Epi::AFTER_DRAIN) { E.fused(acc, cur, wr, wc, fr, fq, lds, wid, lane); S.done(cur); }
#undef PG8_SA
#undef PG8_SB
#undef PG8_STAGE
#undef PG8_LDA
#undef PG8_LDB
#undef PG8_MMA
#undef PG8_WAIT_V
#undef PG8_WAIT_L
#undef PG8_BAR
#undef PG8_SCHED
}
}


namespace attn_body {
using bf16=__hip_bfloat16;
using bf16x8=__attribute__((ext_vector_type(8)))short;
using s16x4=__attribute__((ext_vector_type(4)))short;
using f32x16=__attribute__((ext_vector_type(16)))float;
using u32x4=__attribute__((ext_vector_type(4)))unsigned;
constexpr int D=64;
constexpr int NW=8,QBLK=32,QB=QBLK*NW,KVBLK=64;
constexpr int ATTN_UNIT_ROWS=QB;
__device__ __forceinline__ int crow(int r,int hi){return (r&3)+8*(r>>2)+4*hi;}
#define SBAR() __builtin_amdgcn_sched_barrier(0)
constexpr int NSLOT=3, SLOTB=8192;
constexpr int LDS_K=0, LDS_V=NSLOT*SLOTB, LDS_WS=2*NSLOT*SLOTB, LDS_OST=LDS_WS+NW*64*4, LDS_BYTES=LDS_OST+NW*4096;
constexpr float C2=0.125f*1.4426950408889634f;
__device__ __forceinline__ void glds16(const void*gsrc,unsigned lds_dst){unsigned keep;
  asm volatile("s_mov_b32 %0, m0\n\ts_mov_b32 m0, %2\n\ts_nop 0\n\tglobal_load_lds_dwordx4 %1, off\n\ts_mov_b32 m0, %0":"=&s"(keep):"v"(gsrc),"s"(lds_dst):"memory");}
__device__ __forceinline__ float max3f(float a,float b,float c){float r;asm("v_max3_f32 %0, %1, %2, %3":"=v"(r):"v"(a),"v"(b),"v"(c));return r;}
__device__ __forceinline__ float max2f(float a,float b){float r;asm("v_max_f32_e32 %0, %1, %2":"=v"(r):"v"(a),"v"(b));return r;}
__device__ __forceinline__ float fadd_s(float a,float b){float r;asm("v_add_f32_e32 %0, %1, %2":"=v"(r):"v"(a),"v"(b));return r;}
__device__ __forceinline__ float fsub_s(float a,float b){float r;asm("v_sub_f32_e32 %0, %1, %2":"=v"(r):"v"(a),"v"(b));return r;}
typedef float f32x2_t __attribute__((ext_vector_type(2))); typedef __bf16 bf16x2_t __attribute__((ext_vector_type(2)));
__device__ __forceinline__ unsigned cvtpk_s(float lo,float hi){f32x2_t v={lo,hi};bf16x2_t b=__builtin_convertvector(v,bf16x2_t);return __builtin_bit_cast(unsigned,b);}
#define WAIT_BAR(N) asm volatile("s_waitcnt vmcnt(" #N ") lgkmcnt(0)\n\ts_barrier":::"memory")

__device__ __forceinline__ void qkt(f32x16&p0,f32x16&p1,const char*Kslot,const bf16x8*qr,const f32x16&negm,int r32,int hi){
  const char*kb=Kslot+hi*1024+r32*16;
  #pragma unroll
  for(int d0=0;d0<4;++d0){
    const bf16x8 b0=*reinterpret_cast<const bf16x8*>(kb+d0*2048);
    const bf16x8 b1=*reinterpret_cast<const bf16x8*>(kb+d0*2048+512);
    if(d0==0){p0=__builtin_amdgcn_mfma_f32_32x32x16_bf16(b0,qr[0],negm,0,0,0);p1=__builtin_amdgcn_mfma_f32_32x32x16_bf16(b1,qr[0],negm,0,0,0);}
    else{p0=__builtin_amdgcn_mfma_f32_32x32x16_bf16(b0,qr[d0],p0,0,0,0);p1=__builtin_amdgcn_mfma_f32_32x32x16_bf16(b1,qr[d0],p1,0,0,0);}}
}
typedef __attribute__((address_space(3))) const char* lds_cptr;
typedef short v4i16_t __attribute__((ext_vector_type(4)));
__device__ __forceinline__ void kload8(bf16x8*kf,lds_cptr kp){
  kf[0]=*(const __attribute__((address_space(3))) bf16x8*)(kp);      kf[1]=*(const __attribute__((address_space(3))) bf16x8*)(kp+512);
  kf[2]=*(const __attribute__((address_space(3))) bf16x8*)(kp+2048); kf[3]=*(const __attribute__((address_space(3))) bf16x8*)(kp+2560);
  kf[4]=*(const __attribute__((address_space(3))) bf16x8*)(kp+4096); kf[5]=*(const __attribute__((address_space(3))) bf16x8*)(kp+4608);
  kf[6]=*(const __attribute__((address_space(3))) bf16x8*)(kp+6144); kf[7]=*(const __attribute__((address_space(3))) bf16x8*)(kp+6656);
}
__device__ __forceinline__ void kload2(bf16x8*kf,lds_cptr kp,int j){ kf[2*j]=*(const __attribute__((address_space(3))) bf16x8*)(kp+j*2048); kf[2*j+1]=*(const __attribute__((address_space(3))) bf16x8*)(kp+j*2048+512); }
__device__ __forceinline__ s16x4 vtr(lds_cptr p){ return __builtin_bit_cast(s16x4,__builtin_amdgcn_ds_read_tr16_b64_v4i16((__attribute__((address_space(3))) v4i16_t*)p)); }
__device__ __forceinline__ float rowmax(const f32x16&p0,const f32x16&p1){
  float a=max3f(p0[0],p0[1],p1[0]),b=max3f(p0[2],p0[3],p1[1]);a=max3f(a,p1[2],p1[3]);
  #pragma unroll
  for(int r=4;r<16;r+=4){a=max3f(a,p0[r],p0[r+1]);b=max3f(b,p0[r+2],p0[r+3]);a=max3f(a,p1[r],p1[r+1]);b=max3f(b,p1[r+2],p1[r+3]);}
  const float m=max2f(a,b);
  auto rr=__builtin_amdgcn_permlane32_swap(__float_as_uint(m),__float_as_uint(m),false,false);
  return max2f(__uint_as_float(rr[0]),__uint_as_float(rr[1]));
}
__device__ __forceinline__ void pv(f32x16*o,int vb,bf16x8 pa0,bf16x8 pa1,bf16x8 pa2,bf16x8 pa3){
  #pragma unroll
  for(int d0=0;d0<2;++d0){s16x4 lo[4],hi[4];
    #pragma unroll
    for(int ks=0;ks<4;++ks){
      asm volatile("ds_read_b64_tr_b16 %0,%1 offset:%c2":"=&v"(lo[ks]):"v"(vb),"i"(d0*4096+ks*1024):"memory");
      asm volatile("ds_read_b64_tr_b16 %0,%1 offset:%c2":"=&v"(hi[ks]):"v"(vb),"i"(d0*4096+ks*1024+512):"memory");}
    asm volatile("s_waitcnt lgkmcnt(0)":::"memory");SBAR();
    #define PK(k) (bf16x8){lo[k][0],lo[k][1],lo[k][2],lo[k][3],hi[k][0],hi[k][1],hi[k][2],hi[k][3]}
    o[d0]=__builtin_amdgcn_mfma_f32_32x32x16_bf16(pa0,PK(0),o[d0],0,0,0);
    o[d0]=__builtin_amdgcn_mfma_f32_32x32x16_bf16(pa1,PK(1),o[d0],0,0,0);
    o[d0]=__builtin_amdgcn_mfma_f32_32x32x16_bf16(pa2,PK(2),o[d0],0,0,0);
    o[d0]=__builtin_amdgcn_mfma_f32_32x32x16_bf16(pa3,PK(3),o[d0],0,0,0);
    #undef PK
  }
}

#ifndef ATTN_STORE16
#define ATTN_STORE16(p,v) (*(u32x4*)(p)=(v))
#endif
template<int THRL> __device__ __forceinline__ void attn_unit(const bf16*Q0,int ldq,const bf16*__restrict__ Kh,int ldk,const bf16*__restrict__ Vh,int ldv,bf16*O0,int ldo,int NT,char*shm){
  int tid_=my_tid(); asm volatile("":"+v"(tid_)); const int tid=tid_,lane=tid&63,r32=lane&31,hi=lane>>5; const int wid=__builtin_amdgcn_readfirstlane(tid>>6);
  const bf16*Qw=Q0+(long)(wid*QBLK)*ldq;
  const unsigned lds0=(unsigned)(uintptr_t)shm;
  float*wsf=(float*)(shm+LDS_WS)+wid*64;
  const bf16*ksrc=Kh+(long)lane*ldk+wid*8;
  const bf16*vsrc=Vh+(long)(16*(wid&3)+(lane>>2))*ldv+(wid>>2)*32+(lane&3)*8;
  const unsigned kdst=lds0+LDS_K+wid*1024, vdst=lds0+LDS_V+wid*1024;
  #define DMA_K(t,slot) glds16(ksrc+(long)(t)*KVBLK*ldk,(unsigned)__builtin_amdgcn_readfirstlane(kdst+(slot)))
  #define DMA_V(t,slot) glds16(vsrc+(long)(t)*KVBLK*ldv,(unsigned)__builtin_amdgcn_readfirstlane(vdst+(slot)))
  const int vb0=(int)(lds0+LDS_V)+((lane>>4)&1)*32+(lane&3)*8+(4*hi+((lane&15)>>2))*64;
  const char*Kbase=shm+LDS_K; bf16x8 kf[8];
  const lds_cptr shm3=(lds_cptr)shm; const lds_cptr kp0=shm3+LDS_K+hi*1024+r32*16; const lds_cptr vp0=shm3+LDS_V+((lane>>4)&1)*32+(lane&3)*8+(4*hi+((lane&15)>>2))*64;
  DMA_K(0,0);DMA_V(0,0);DMA_K(1,SLOTB);
  bf16x8 qr[4];
  #pragma unroll
  for(int d0=0;d0<4;++d0)qr[d0]=*reinterpret_cast<const bf16x8*>(&Qw[(long)r32*ldq+d0*16+hi*8]);
  float mhat=0.f,l_reg=0.f;f32x16 o[2];o[0]=f32x16{};o[1]=f32x16{};f32x16 negm=f32x16{};asm volatile("":"+v"(negm));
  #define CMASK(P0,P1,t) do{}while(0)
  bool resc=false;
  #define START(P0,P1) do{ const float rm=rowmax(P0,P1); resc=false; \
    { const float dl=rm; mhat=fadd_s(mhat,dl); \
      _Pragma("unroll") for(int r=0;r<16;++r){P0[r]=fsub_s(P0[r],dl);P1[r]=fsub_s(P1[r],dl);} \
      _Pragma("unroll") for(int r=0;r<16;++r)negm[r]=-mhat; asm volatile("":"+v"(negm)); } \
    _Pragma("unroll") for(int r=0;r<16;++r)P0[r]=__builtin_amdgcn_exp2f(P0[r]); }while(0)
  #define RESC() do{ if(resc){ asm volatile("s_waitcnt lgkmcnt(0)":::"memory"); \
      _Pragma("unroll") for(int d_=0;d_<2;++d_) _Pragma("unroll") for(int r=0;r<16;++r)o[d_][r]*=wsf[crow(r,hi)]; } }while(0)
  f32x16 pA0,pA1,pB0,pB1;
  int sl_prev=0,sl_cur=0,sl_next=SLOTB;
  #define ROT() do{sl_prev=sl_cur;sl_cur=sl_next;sl_next=(sl_next==(NSLOT-1)*SLOTB)?0:sl_next+SLOTB;}while(0)
  DMA_K(2,2*SLOTB);
  WAIT_BAR(3);
  qkt(pA0,pA1,Kbase,qr,negm,r32,hi);asm volatile("s_nop 15\n\ts_nop 7":"+v"(pA0),"+v"(pA1));CMASK(pA0,pA1,0);
  START(pA0,pA1);
  _Pragma("unroll") for(int r=0;r<16;++r)pA1[r]=__builtin_amdgcn_exp2f(pA1[r]);
  WAIT_BAR(0);
  DMA_K(3,0);DMA_V(1,SLOTB);
  ROT();
  kload8(kf,kp0+sl_cur);
  WAIT_BAR(2);
  s16x4 vlo[8],vhi[8]; u32x4 pw0,pw1,pw2,pw3;
  #define PKW(P,B) cvtpk_s(P[B],P[B+1])
  #define PAF(k) __builtin_bit_cast(bf16x8,pw##k)
  #define VFR(i) (bf16x8){vlo[i][0],vlo[i][1],vlo[i][2],vlo[i][3],vhi[i][0],vhi[i][1],vhi[i][2],vhi[i][3]}
  #define PIN(x) asm volatile("":"+v"(x))
  #define MX3(a,b,c) __builtin_fmaxf(__builtin_fmaxf((a),(b)),(c))
  #define GAPA(MF,A0,A1,A2,A3,W0,W1,PW) do{ MF; sacc+=A0; sacc+=A1; sacc+=A2; sacc+=A3; PIN(sacc); W0; W1; PIN(PW); SBAR(); }while(0)
  #define EX(v) __builtin_amdgcn_exp2f(v)
  #define GAPB(MF,X,B) do{ MF; X[B]=EX(X[B]); X[B+1]=EX(X[B+1]); X[B+2]=EX(X[B+2]); X[B+3]=EX(X[B+3]); PIN(X); SBAR(); }while(0)
  #define VRD(i) do{ vlo[i]=vtr(vp_+(((i)>>2)*4096+((i)&3)*1024)); vhi[i]=vtr(vp_+(((i)>>2)*4096+((i)&3)*1024+512)); }while(0)
  #define KRD(G,j) do{ if(G){ kload2(kf,kp0+sl_next,j); SBAR(); } }while(0)
  #define STEP(C0,C1,P0,P1,t,GK,GV,GL) do{ SBAR(); \
    const lds_cptr vp_=vp0+sl_prev; \
    VRD(0); SBAR(); float sacc=(P0[0]+P0[1]); \
    GAPA(C0=__builtin_amdgcn_mfma_f32_32x32x16_bf16(kf[0],qr[0],negm,0,0,0), P0[2],P0[3],P0[4],P0[5],     pw0[0]=PKW(P0,0), pw0[1]=PKW(P0,2), pw0); \
    VRD(4); SBAR(); GAPA(C1=__builtin_amdgcn_mfma_f32_32x32x16_bf16(kf[1],qr[0],negm,0,0,0), P0[6],P0[7],P0[8],P0[9],     pw0[2]=PKW(P0,4), pw0[3]=PKW(P0,6), pw0); \
    VRD(1); SBAR(); GAPA(C0=__builtin_amdgcn_mfma_f32_32x32x16_bf16(kf[2],qr[1],C0,0,0,0),   P0[10],P0[11],P0[12],P0[13], pw1[0]=PKW(P0,8), pw1[1]=PKW(P0,10), pw1); \
    VRD(5); SBAR(); GAPA(C1=__builtin_amdgcn_mfma_f32_32x32x16_bf16(kf[3],qr[1],C1,0,0,0),   P0[14],P0[15],P1[0],P1[1],   pw1[2]=PKW(P0,12),pw1[3]=PKW(P0,14), pw1); \
    VRD(2); SBAR(); GAPA(C0=__builtin_amdgcn_mfma_f32_32x32x16_bf16(kf[4],qr[2],C0,0,0,0),   P1[2],P1[3],P1[4],P1[5],     pw2[0]=PKW(P1,0), pw2[1]=PKW(P1,2), pw2); \
    VRD(6); SBAR(); GAPA(C1=__builtin_amdgcn_mfma_f32_32x32x16_bf16(kf[5],qr[2],C1,0,0,0),   P1[6],P1[7],P1[8],P1[9],     pw2[2]=PKW(P1,4), pw2[3]=PKW(P1,6), pw2); \
    VRD(3); SBAR(); GAPA(C0=__builtin_amdgcn_mfma_f32_32x32x16_bf16(kf[6],qr[3],C0,0,0,0),   P1[10],P1[11],P1[12],P1[13], pw3[0]=PKW(P1,8), pw3[1]=PKW(P1,10), pw3); \
    VRD(7); SBAR(); GAPA(C1=__builtin_amdgcn_mfma_f32_32x32x16_bf16(kf[7],qr[3],C1,0,0,0),   P1[14],P1[15],0.f,0.f,       pw3[2]=PKW(P1,12),pw3[3]=PKW(P1,14), pw3); \
    l_reg+=sacc; \
    if(GK){DMA_K((t)+3,sl_cur);} if(GV){DMA_V((t)+1,sl_next);} \
    CMASK(C0,C1,t); \
    { float a=MX3(C0[0],C0[1],C1[0]),b=MX3(C0[2],C0[3],C1[1]); a=MX3(a,C1[2],C1[3]); \
      _Pragma("unroll") for(int r=4;r<16;r+=4){a=MX3(a,C0[r],C0[r+1]);b=MX3(b,C0[r+2],C0[r+3]);a=MX3(a,C1[r],C1[r+1]);b=MX3(b,C1[r+2],C1[r+3]);} \
      float rm=__builtin_fmaxf(a,b); { auto rr=__builtin_amdgcn_permlane32_swap(__float_as_uint(rm),__float_as_uint(rm),false,false); rm=__builtin_fmaxf(__uint_as_float(rr[0]),__uint_as_float(rr[1])); } \
      resc=false; \
      if(__builtin_expect(__any(rm>(float)THRL),0)){ const float dl=__builtin_fmaxf(rm,0.f); mhat+=dl; \
        _Pragma("unroll") for(int r=0;r<16;++r){C0[r]-=dl;C1[r]-=dl;} \
        _Pragma("unroll") for(int r=0;r<16;++r)negm[r]=-mhat; asm volatile("":"+v"(negm)); \
        const float f=__builtin_amdgcn_exp2f(-dl); l_reg*=f; if(hi==0)wsf[r32]=f; resc=true; } } \
    SBAR(); \
    GAPB(o[0]=__builtin_amdgcn_mfma_f32_32x32x16_bf16(PAF(0),VFR(0),o[0],0,0,0), C0,0); \
    GAPB(o[1]=__builtin_amdgcn_mfma_f32_32x32x16_bf16(PAF(0),VFR(4),o[1],0,0,0), C0,4); \
    KRD(GL,0); GAPB(o[0]=__builtin_amdgcn_mfma_f32_32x32x16_bf16(PAF(1),VFR(1),o[0],0,0,0), C0,8); \
    KRD(GL,1); GAPB(o[1]=__builtin_amdgcn_mfma_f32_32x32x16_bf16(PAF(1),VFR(5),o[1],0,0,0), C0,12); \
    KRD(GL,2); GAPB(o[0]=__builtin_amdgcn_mfma_f32_32x32x16_bf16(PAF(2),VFR(2),o[0],0,0,0), C1,0); \
    KRD(GL,3); GAPB(o[1]=__builtin_amdgcn_mfma_f32_32x32x16_bf16(PAF(2),VFR(6),o[1],0,0,0), C1,4); \
    GAPB(o[0]=__builtin_amdgcn_mfma_f32_32x32x16_bf16(PAF(3),VFR(3),o[0],0,0,0), C1,8); \
    GAPB(o[1]=__builtin_amdgcn_mfma_f32_32x32x16_bf16(PAF(3),VFR(7),o[1],0,0,0), C1,12); \
    }while(0)
  int t=1;
  #undef CMASK
  #define CMASK(P0,P1,t) do{}while(0)
  for(;t+5<NT;t+=2){
    STEP(pB0,pB1,pA0,pA1,t,true,true,true);     WAIT_BAR(2); RESC(); ROT();
    STEP(pA0,pA1,pB0,pB1,t+1,true,true,true);   WAIT_BAR(2); RESC(); ROT();
  }
  #undef CMASK
  #define CMASK(P0,P1,t) do{}while(0)
  #define ENDW(tt) do{ if((tt)+3<NT){WAIT_BAR(2);} else if((tt)+2<NT){WAIT_BAR(1);} else {WAIT_BAR(0);} }while(0)
  for(;t+1<NT;t+=2){
    STEP(pB0,pB1,pA0,pA1,t,(t+3<NT),(t+1<NT),(t+1<NT));       ENDW(t);   RESC(); ROT();
    STEP(pA0,pA1,pB0,pB1,t+1,(t+4<NT),(t+2<NT),(t+2<NT));     ENDW(t+1); RESC(); ROT();
  }
  STEP(pB0,pB1,pA0,pA1,NT-1,false,false,false); RESC();
  { float sacc=pB0[0]+pB0[1]; _Pragma("unroll") for(int r=2;r<16;++r)sacc+=pB0[r]; _Pragma("unroll") for(int r=0;r<16;++r)sacc+=pB1[r]; l_reg+=sacc;
    pw0=(u32x4){PKW(pB0,0),PKW(pB0,2),PKW(pB0,4),PKW(pB0,6)};pw1=(u32x4){PKW(pB0,8),PKW(pB0,10),PKW(pB0,12),PKW(pB0,14)};pw2=(u32x4){PKW(pB1,0),PKW(pB1,2),PKW(pB1,4),PKW(pB1,6)};pw3=(u32x4){PKW(pB1,8),PKW(pB1,10),PKW(pB1,12),PKW(pB1,14)};
    SBAR(); pv(o,vb0+sl_cur,PAF(0),PAF(1),PAF(2),PAF(3)); }
  #undef PKW
  #undef PAF
  #undef VFR
  #undef PIN
  #undef MX3
  #undef GAPA
  #undef GAPB
  #undef EX
  #undef VRD
  #undef KRD
  #undef STEP
  #undef ENDW
  {auto rr=__builtin_amdgcn_permlane32_swap(__float_as_uint(l_reg),__float_as_uint(l_reg),false,false);l_reg=__uint_as_float(rr[0])+__uint_as_float(rr[1]);}
  if(hi==0)wsf[32+r32]=l_reg;asm volatile("s_waitcnt lgkmcnt(0)":::"memory");
  float rli[16];
  #pragma unroll
  for(int r=0;r<16;++r)rli[r]=__builtin_amdgcn_rcpf(wsf[32+crow(r,hi)]);
  bf16*Ow=O0+(long)(wid*QBLK)*ldo;
  { bf16*stg=(bf16*)(shm+LDS_OST)+wid*2048;
    #pragma unroll
    for(int r=0;r<16;++r){const int orow=crow(r,hi);
      #pragma unroll
      for(int d0=0;d0<2;++d0)stg[orow*64+d0*32+r32]=__float2bfloat16(o[d0][r]*rli[r]);}
    asm volatile("s_waitcnt lgkmcnt(0)":::"memory");
    #pragma unroll
    for(int i=0;i<4;++i){const int row=i*8+(lane>>3),ch=lane&7; const u32x4 v=*(const u32x4*)(stg+row*64+ch*8); ATTN_STORE16(Ow+(long)row*ldo+ch*8,v);} }
  asm volatile("s_waitcnt lgkmcnt(0)\n\ts_barrier":::"memory");
  #undef DMA_K
  #undef DMA_V
  #undef CMASK
  #undef START
  #undef RESC
  #undef ROT
}
constexpr int LDS_WS128=LDS_V+NSLOT*16384, LDS_OST128=LDS_WS128+NW*64*4, LDS_BYTES128=LDS_OST128+NW*4096;
template<int THRL> __device__ __forceinline__ void attn_unit128(const bf16*Q0,int ldq,const bf16*__restrict__ Kh,int ldk,const bf16*__restrict__ Vh,int ldv,bf16*O0,int ldo,int NT,char*shm){
  int tid_=my_tid(); asm volatile("":"+v"(tid_)); const int tid=tid_,lane=tid&63,r32=lane&31,hi=lane>>5; const int wid=__builtin_amdgcn_readfirstlane(tid>>6);
  const bf16*Qw=Q0+(long)(wid*QBLK)*ldq;
  const unsigned lds0=(unsigned)(uintptr_t)shm;
  float*wsf=(float*)(shm+LDS_WS128)+wid*64;
  const bf16*ksrc=Kh+(long)lane*ldk+wid*8;
  const bf16*vsrc=Vh+(long)(16*(wid&3)+(lane>>2))*ldv+(wid>>2)*32+(lane&3)*8;
  const unsigned kdst=lds0+LDS_K+wid*1024, vdst=lds0+LDS_V+wid*1024;
  #define DMA_K(t,slot) glds16(ksrc+(long)(t)*KVBLK*ldk,(unsigned)__builtin_amdgcn_readfirstlane(kdst+(slot)))
  #define DMA_V(t,slot) do{ glds16(vsrc+(long)(t)*KVBLK*ldv,(unsigned)__builtin_amdgcn_readfirstlane(vdst+2*(slot))); glds16(vsrc+(long)(t)*KVBLK*ldv+64,(unsigned)__builtin_amdgcn_readfirstlane(vdst+2*(slot)+8192)); }while(0)
  const int vb0=(int)(lds0+LDS_V)+((lane>>4)&1)*32+(lane&3)*8+(4*hi+((lane&15)>>2))*64;
  const char*Kbase=shm+LDS_K; bf16x8 kf[8];
  const lds_cptr shm3=(lds_cptr)shm; const lds_cptr kp0=shm3+LDS_K+hi*1024+r32*16; const lds_cptr vp0=shm3+LDS_V+((lane>>4)&1)*32+(lane&3)*8+(4*hi+((lane&15)>>2))*64;
  DMA_K(0,0);DMA_V(0,0);DMA_K(1,SLOTB);
  bf16x8 qr[4];
  #pragma unroll
  for(int d0=0;d0<4;++d0)qr[d0]=*reinterpret_cast<const bf16x8*>(&Qw[(long)r32*ldq+d0*16+hi*8]);
  float mhat=0.f,l_reg=0.f;f32x16 o[4];o[0]=f32x16{};o[1]=f32x16{};o[2]=f32x16{};o[3]=f32x16{};f32x16 negm=f32x16{};asm volatile("":"+v"(negm));
  #define CMASK(P0,P1,t) do{}while(0)
  bool resc=false;
  #define START(P0,P1) do{ const float rm=rowmax(P0,P1); resc=false; \
    { const float dl=rm; mhat=fadd_s(mhat,dl); \
      _Pragma("unroll") for(int r=0;r<16;++r){P0[r]=fsub_s(P0[r],dl);P1[r]=fsub_s(P1[r],dl);} \
      _Pragma("unroll") for(int r=0;r<16;++r)negm[r]=-mhat; asm volatile("":"+v"(negm)); } \
    _Pragma("unroll") for(int r=0;r<16;++r)P0[r]=__builtin_amdgcn_exp2f(P0[r]); }while(0)
  #define RESC() do{ if(resc){ asm volatile("s_waitcnt lgkmcnt(0)":::"memory"); \
      _Pragma("unroll") for(int d_=0;d_<4;++d_) _Pragma("unroll") for(int r=0;r<16;++r)o[d_][r]*=wsf[crow(r,hi)]; } }while(0)
  f32x16 pA0,pA1,pB0,pB1;
  int sl_prev=0,sl_cur=0,sl_next=SLOTB;
  #define ROT() do{sl_prev=sl_cur;sl_cur=sl_next;sl_next=(sl_next==(NSLOT-1)*SLOTB)?0:sl_next+SLOTB;}while(0)
  DMA_K(2,2*SLOTB);
  WAIT_BAR(3);
  qkt(pA0,pA1,Kbase,qr,negm,r32,hi);asm volatile("s_nop 15\n\ts_nop 7":"+v"(pA0),"+v"(pA1));CMASK(pA0,pA1,0);
  START(pA0,pA1);
  _Pragma("unroll") for(int r=0;r<16;++r)pA1[r]=__builtin_amdgcn_exp2f(pA1[r]);
  WAIT_BAR(0);
  DMA_K(3,0);DMA_V(1,SLOTB);
  ROT();
  kload8(kf,kp0+sl_cur);
  WAIT_BAR(3);
  s16x4 vlo[8],vhi[8]; u32x4 pw0,pw1,pw2,pw3;
  #define PKW(P,B) cvtpk_s(P[B],P[B+1])
  #define PAF(k) __builtin_bit_cast(bf16x8,pw##k)
  #define VFR(i) (bf16x8){vlo[i][0],vlo[i][1],vlo[i][2],vlo[i][3],vhi[i][0],vhi[i][1],vhi[i][2],vhi[i][3]}
  #define PIN(x) asm volatile("":"+v"(x))
  #define MX3(a,b,c) __builtin_fmaxf(__builtin_fmaxf((a),(b)),(c))
  #define GAPA(MF,A0,A1,A2,A3,W0,W1,PW) do{ MF; sacc+=A0; sacc+=A1; sacc+=A2; sacc+=A3; PIN(sacc); W0; W1; PIN(PW); SBAR(); }while(0)
  #define EX(v) __builtin_amdgcn_exp2f(v)
  #define GAPB2(MF,X,B) do{ MF; X[B]=EX(X[B]); X[B+1]=EX(X[B+1]); PIN(X); SBAR(); }while(0)
  #define GAPB(MF,X,B) do{ MF; X[B]=EX(X[B]); X[B+1]=EX(X[B+1]); X[B+2]=EX(X[B+2]); X[B+3]=EX(X[B+3]); PIN(X); SBAR(); }while(0)
  #define VRD(i) do{ vlo[i]=vtr(vp_+(((i)>>2)*4096+((i)&3)*1024)); vhi[i]=vtr(vp_+(((i)>>2)*4096+((i)&3)*1024+512)); }while(0)
  #define VRDQ(i) do{ vlo[i]=vtr(vq_+(((i)>>2)*4096+((i)&3)*1024)); vhi[i]=vtr(vq_+(((i)>>2)*4096+((i)&3)*1024+512)); }while(0)
  #define KRD(G,j) do{ if(G){ kload2(kf,kp0+sl_next,j); SBAR(); } }while(0)
  #define STEP(C0,C1,P0,P1,t,GK,GV,GL) do{ SBAR(); \
    const lds_cptr vp_=vp0+2*sl_prev; const lds_cptr vq_=vp_+8192; \
    VRD(0); SBAR(); float sacc=(P0[0]+P0[1]); \
    GAPA(C0=__builtin_amdgcn_mfma_f32_32x32x16_bf16(kf[0],qr[0],negm,0,0,0), P0[2],P0[3],P0[4],P0[5],     pw0[0]=PKW(P0,0), pw0[1]=PKW(P0,2), pw0); \
    VRD(4); SBAR(); GAPA(C1=__builtin_amdgcn_mfma_f32_32x32x16_bf16(kf[1],qr[0],negm,0,0,0), P0[6],P0[7],P0[8],P0[9],     pw0[2]=PKW(P0,4), pw0[3]=PKW(P0,6), pw0); \
    VRD(1); SBAR(); GAPA(C0=__builtin_amdgcn_mfma_f32_32x32x16_bf16(kf[2],qr[1],C0,0,0,0),   P0[10],P0[11],P0[12],P0[13], pw1[0]=PKW(P0,8), pw1[1]=PKW(P0,10), pw1); \
    VRD(5); SBAR(); GAPA(C1=__builtin_amdgcn_mfma_f32_32x32x16_bf16(kf[3],qr[1],C1,0,0,0),   P0[14],P0[15],P1[0],P1[1],   pw1[2]=PKW(P0,12),pw1[3]=PKW(P0,14), pw1); \
    VRD(2); SBAR(); GAPA(C0=__builtin_amdgcn_mfma_f32_32x32x16_bf16(kf[4],qr[2],C0,0,0,0),   P1[2],P1[3],P1[4],P1[5],     pw2[0]=PKW(P1,0), pw2[1]=PKW(P1,2), pw2); \
    VRD(6); SBAR(); GAPA(C1=__builtin_amdgcn_mfma_f32_32x32x16_bf16(kf[5],qr[2],C1,0,0,0),   P1[6],P1[7],P1[8],P1[9],     pw2[2]=PKW(P1,4), pw2[3]=PKW(P1,6), pw2); \
    VRD(3); SBAR(); GAPA(C0=__builtin_amdgcn_mfma_f32_32x32x16_bf16(kf[6],qr[3],C0,0,0,0),   P1[10],P1[11],P1[12],P1[13], pw3[0]=PKW(P1,8), pw3[1]=PKW(P1,10), pw3); \
    VRD(7); SBAR(); GAPA(C1=__builtin_amdgcn_mfma_f32_32x32x16_bf16(kf[7],qr[3],C1,0,0,0),   P1[14],P1[15],0.f,0.f,       pw3[2]=PKW(P1,12),pw3[3]=PKW(P1,14), pw3); \
    l_reg+=sacc; \
    if(GK){DMA_K((t)+3,sl_cur);} if(GV){DMA_V((t)+1,sl_next);} \
    CMASK(C0,C1,t); \
    { float a=MX3(C0[0],C0[1],C1[0]),b=MX3(C0[2],C0[3],C1[1]); a=MX3(a,C1[2],C1[3]); \
      _Pragma("unroll") for(int r=4;r<16;r+=4){a=MX3(a,C0[r],C0[r+1]);b=MX3(b,C0[r+2],C0[r+3]);a=MX3(a,C1[r],C1[r+1]);b=MX3(b,C1[r+2],C1[r+3]);} \
      float rm=__builtin_fmaxf(a,b); { auto rr=__builtin_amdgcn_permlane32_swap(__float_as_uint(rm),__float_as_uint(rm),false,false); rm=__builtin_fmaxf(__uint_as_float(rr[0]),__uint_as_float(rr[1])); } \
      resc=false; \
      if(__builtin_expect(__any(rm>(float)THRL),0)){ const float dl=__builtin_fmaxf(rm,0.f); mhat+=dl; \
        _Pragma("unroll") for(int r=0;r<16;++r){C0[r]-=dl;C1[r]-=dl;} \
        _Pragma("unroll") for(int r=0;r<16;++r)negm[r]=-mhat; asm volatile("":"+v"(negm)); \
        const float f=__builtin_amdgcn_exp2f(-dl); l_reg*=f; if(hi==0)wsf[r32]=f; resc=true; } } \
    SBAR(); \
    GAPB2(o[0]=__builtin_amdgcn_mfma_f32_32x32x16_bf16(PAF(0),VFR(0),o[0],0,0,0), C0,0); \
    VRDQ(0); SBAR(); \
    GAPB2(o[1]=__builtin_amdgcn_mfma_f32_32x32x16_bf16(PAF(0),VFR(4),o[1],0,0,0), C0,2); \
    VRDQ(4); SBAR(); \
    KRD(GL,0); GAPB2(o[0]=__builtin_amdgcn_mfma_f32_32x32x16_bf16(PAF(1),VFR(1),o[0],0,0,0), C0,4); \
    VRDQ(1); SBAR(); \
    KRD(GL,1); GAPB2(o[1]=__builtin_amdgcn_mfma_f32_32x32x16_bf16(PAF(1),VFR(5),o[1],0,0,0), C0,6); \
    VRDQ(5); SBAR(); \
    KRD(GL,2); GAPB2(o[0]=__builtin_amdgcn_mfma_f32_32x32x16_bf16(PAF(2),VFR(2),o[0],0,0,0), C0,8); \
    VRDQ(2); SBAR(); \
    KRD(GL,3); GAPB2(o[1]=__builtin_amdgcn_mfma_f32_32x32x16_bf16(PAF(2),VFR(6),o[1],0,0,0), C0,10); \
    VRDQ(6); SBAR(); \
    GAPB2(o[0]=__builtin_amdgcn_mfma_f32_32x32x16_bf16(PAF(3),VFR(3),o[0],0,0,0), C0,12); \
    VRDQ(3); SBAR(); \
    GAPB2(o[1]=__builtin_amdgcn_mfma_f32_32x32x16_bf16(PAF(3),VFR(7),o[1],0,0,0), C0,14); \
    VRDQ(7); SBAR(); \
    GAPB2(o[2]=__builtin_amdgcn_mfma_f32_32x32x16_bf16(PAF(0),VFR(0),o[2],0,0,0), C1,0); \
    GAPB2(o[3]=__builtin_amdgcn_mfma_f32_32x32x16_bf16(PAF(0),VFR(4),o[3],0,0,0), C1,2); \
    GAPB2(o[2]=__builtin_amdgcn_mfma_f32_32x32x16_bf16(PAF(1),VFR(1),o[2],0,0,0), C1,4); \
    GAPB2(o[3]=__builtin_amdgcn_mfma_f32_32x32x16_bf16(PAF(1),VFR(5),o[3],0,0,0), C1,6); \
    GAPB2(o[2]=__builtin_amdgcn_mfma_f32_32x32x16_bf16(PAF(2),VFR(2),o[2],0,0,0), C1,8); \
    GAPB2(o[3]=__builtin_amdgcn_mfma_f32_32x32x16_bf16(PAF(2),VFR(6),o[3],0,0,0), C1,10); \
    GAPB2(o[2]=__builtin_amdgcn_mfma_f32_32x32x16_bf16(PAF(3),VFR(3),o[2],0,0,0), C1,12); \
    GAPB2(o[3]=__builtin_amdgcn_mfma_f32_32x32x16_bf16(PAF(3),VFR(7),o[3],0,0,0), C1,14); \
    }while(0)
  int t=1;
  #undef CMASK
  #define CMASK(P0,P1,t) do{}while(0)
  for(;t+5<NT;t+=2){
    STEP(pB0,pB1,pA0,pA1,t,true,true,true);     WAIT_BAR(3); RESC(); ROT();
    STEP(pA0,pA1,pB0,pB1,t+1,true,true,true);   WAIT_BAR(3); RESC(); ROT();
  }
  #undef CMASK
  #define CMASK(P0,P1,t) do{}while(0)
  #define ENDW(tt) do{ if((tt)+3<NT){WAIT_BAR(3);} else if((tt)+2<NT){WAIT_BAR(2);} else {WAIT_BAR(0);} }while(0)
  for(;t+1<NT;t+=2){
    STEP(pB0,pB1,pA0,pA1,t,(t+3<NT),(t+1<NT),(t+1<NT));       ENDW(t);   RESC(); ROT();
    STEP(pA0,pA1,pB0,pB1,t+1,(t+4<NT),(t+2<NT),(t+2<NT));     ENDW(t+1); RESC(); ROT();
  }
  STEP(pB0,pB1,pA0,pA1,NT-1,false,false,false); RESC();
  { float sacc=pB0[0]+pB0[1]; _Pragma("unroll") for(int r=2;r<16;++r)sacc+=pB0[r]; _Pragma("unroll") for(int r=0;r<16;++r)sacc+=pB1[r]; l_reg+=sacc;
    pw0=(u32x4){PKW(pB0,0),PKW(pB0,2),PKW(pB0,4),PKW(pB0,6)};pw1=(u32x4){PKW(pB0,8),PKW(pB0,10),PKW(pB0,12),PKW(pB0,14)};pw2=(u32x4){PKW(pB1,0),PKW(pB1,2),PKW(pB1,4),PKW(pB1,6)};pw3=(u32x4){PKW(pB1,8),PKW(pB1,10),PKW(pB1,12),PKW(pB1,14)};
    SBAR(); pv(o,vb0+2*sl_cur,PAF(0),PAF(1),PAF(2),PAF(3)); pv(o+2,vb0+2*sl_cur+8192,PAF(0),PAF(1),PAF(2),PAF(3)); }
  #undef PKW
  #undef PAF
  #undef VFR
  #undef PIN
  #undef MX3
  #undef GAPA
  #undef GAPB
  #undef GAPB2
  #undef EX
  #undef VRD
  #undef KRD
  #undef VRDQ
  #undef STEP
  #undef ENDW
  {auto rr=__builtin_amdgcn_permlane32_swap(__float_as_uint(l_reg),__float_as_uint(l_reg),false,false);l_reg=__uint_as_float(rr[0])+__uint_as_float(rr[1]);}
  if(hi==0)wsf[32+r32]=l_reg;asm volatile("s_waitcnt lgkmcnt(0)":::"memory");
  float rli[16];
  #pragma unroll
  for(int r=0;r<16;++r)rli[r]=__builtin_amdgcn_rcpf(wsf[32+crow(r,hi)]);
  bf16*Ow=O0+(long)(wid*QBLK)*ldo;
  { bf16*stg=(bf16*)(shm+LDS_OST128)+wid*2048;
    #pragma unroll
    for(int h2=0;h2<2;++h2){
      #pragma unroll
      for(int r=0;r<16;++r){const int orow=crow(r,hi);
        #pragma unroll
        for(int d0=0;d0<2;++d0)stg[orow*64+d0*32+r32]=__float2bfloat16(o[2*h2+d0][r]*rli[r]);}
      asm volatile("s_waitcnt lgkmcnt(0)":::"memory");
      #pragma unroll
      for(int i=0;i<4;++i){const int row=i*8+(lane>>3),ch=lane&7; const u32x4 v=*(const u32x4*)(stg+row*64+ch*8); ATTN_STORE16(Ow+(long)row*ldo+h2*64+ch*8,v);}
      asm volatile("s_waitcnt lgkmcnt(0)":::"memory"); } }
  asm volatile("s_waitcnt lgkmcnt(0)\n\ts_barrier":::"memory");
  #undef DMA_K
  #undef DMA_V
  #undef CMASK
  #undef START
  #undef RESC
  #undef ROT
}
constexpr int ATTN_LDS_BYTES=LDS_BYTES;
#undef SBAR
#undef WAIT_BAR
}


constexpr int NWAVES = 8;
constexpr int DMODEL = 1024, NBATCH = 2, SEQL = 8192, CTXL = 256, RPB = SEQL + CTXL, MROWS = NBATCH * RPB, NLAYER = 2;
constexpr int DFF = 2816, NUP = 2 * DFF, INW = 5888, ZW = 5376, NMODV = 9, MODW = NMODV * DMODEL;
constexpr int ZQA = 0, ZKA = 512, ZVA = 640, ZQB = 768, ZKB = 1280, ZVB = 1792, ZGATE = 2304;
constexpr int TPB = RPB / 256;
constexpr float EPSN = 1e-6f;
constexpr int HN = 4096;
constexpr int HQ = 2048;

constexpr size_t MiB = 1u << 20, KiB = 1024;
constexpr size_t WS_CTL = 0, CTL_ZERO_BYTES = 64 * KiB;
constexpr size_t WS_MOD = 1 * MiB;
constexpr size_t WS_CAS256 = 1 * MiB + 512 * KiB;
constexpr size_t WS_HC = 2 * MiB;
constexpr size_t WS_WUP0 = 4 * MiB, WS_WDN0 = 15 * MiB, WS_WUP1 = 20 * MiB + 512 * KiB, WS_WDN1 = 31 * MiB + 512 * KiB;
constexpr size_t WS_WIN = 37 * MiB, WS_WC = 47 * MiB + 512 * KiB, WS_WBR = 48 * MiB + 512 * KiB, WS_WOUT = 51 * MiB + 512 * KiB;
constexpr size_t WS_HN = 54 * MiB;
constexpr size_t WS_Z = 87 * MiB;
constexpr size_t WS_T1T = 261 * MiB;
constexpr size_t WS_PART = WS_T1T;
constexpr size_t WS_T2B = WS_T1T;
constexpr size_t WS_T2 = 278 * MiB;
constexpr size_t WS_PQ = 295 * MiB;
constexpr size_t WS_CAS = 311 * MiB;
constexpr size_t WS_ROPE = 343 * MiB;
constexpr size_t WS_END = 345 * MiB;
static_assert(WS_Z + (size_t)MROWS * ZW * 2 <= WS_T1T && WS_HN + (size_t)MROWS * DMODEL * 2 <= WS_Z && WS_WOUT + 2 * MiB <= WS_HN, "ws map");
constexpr int CW_BAR = 4096;
constexpr int CW_Q = 1024;


#define GAS __attribute__((address_space(1)))
typedef unsigned short bf16;
typedef unsigned v4u __attribute__((ext_vector_type(4)));
typedef float f32x4 __attribute__((ext_vector_type(4)));
#define LDS_WAIT() asm volatile("s_waitcnt lgkmcnt(0)" ::: "memory")

__device__ __forceinline__ float bf2f(unsigned v) { return __uint_as_float(v << 16); }
__device__ __forceinline__ float bflo(unsigned w) { return __uint_as_float(w << 16); }
__device__ __forceinline__ float bfhi(unsigned w) { return __uint_as_float(w & 0xffff0000u); }
__device__ __forceinline__ unsigned pk2(float lo, float hi) { return pg8::cvt_pk_bf16(lo, hi); }
__device__ __forceinline__ float fexp(float x) { return __builtin_amdgcn_exp2f(x * 1.4426950408889634f); }
__device__ __forceinline__ float sigm(float x) { return __builtin_amdgcn_rcpf(1.0f + fexp(-x)); }
__device__ __forceinline__ float siluf(float x) { return x * sigm(x); }
__device__ __forceinline__ float shfl_xor(float v, int o) { return __builtin_bit_cast(float, __builtin_amdgcn_ds_bpermute((lane_id() ^ o) << 2, __builtin_bit_cast(int, v))); }
__device__ __forceinline__ float wave_sum(float v) {
#pragma unroll
    for (int o = 1; o < 64; o <<= 1) v += shfl_xor(v, o);
    return v;
}

namespace pg8 {
struct EpiStore {
    static constexpr bool PERM = true, AFTER_DRAIN = false;
    bf16_t* O; int ldc; int sig_from; int rbase, rmul;
    __device__ __forceinline__ void operator()(const f32x4 (&acc)[2][2][4][2], const Unit& u, int wr, int wc, int fr_, int fq_) const {
        (void)fr_; (void)fq_; const int ln_ = lane_id(); const int fr = ln_ & 15, fq = ln_ >> 4;
        const int row0 = u.pm * BM + wr * 64 + fr, col0 = u.pn * BM + wc * 32 + 8 * fq;
        const bool sg = (u.pn * BM) >= sig_from;
#pragma unroll
        for (int ai = 0; ai < 2; ++ai)
#pragma unroll
            for (int m = 0; m < 4; ++m) { const int row = row0 + ai * HALF + m * 16; bf16_t* rowp = O + (size_t)(rbase + row * rmul) * ldc + col0;
#pragma unroll
                for (int bj = 0; bj < 2; ++bj) { f32x4 v0 = acc[ai][bj][m][0], v1 = acc[ai][bj][m][1];
                    if (sg) { v0[0] = sigm(v0[0]); v0[1] = sigm(v0[1]); v0[2] = sigm(v0[2]); v0[3] = sigm(v0[3]); v1[0] = sigm(v1[0]); v1[1] = sigm(v1[1]); v1[2] = sigm(v1[2]); v1[3] = sigm(v1[3]); }
                    u32x4 w; w.x = cvt_pk_bf16(v0[0], v0[1]); w.y = cvt_pk_bf16(v0[2], v0[3]); w.z = cvt_pk_bf16(v1[0], v1[1]); w.w = cvt_pk_bf16(v1[2], v1[3]);
                    *(u32x4*)(rowp + bj * HALF) = w; } }
    }
};
struct EpiSwiGLU {
    static constexpr bool PERM = true, AFTER_DRAIN = false;
    bf16_t* H; int ldc;
    __device__ __forceinline__ void operator()(const f32x4 (&acc)[2][2][4][2], const Unit& u, int wr, int wc, int fr_, int fq_) const {
        (void)fr_; (void)fq_; const int ln_ = lane_id(); const int fr = ln_ & 15, fq = ln_ >> 4;
        const int row0 = u.pm * BM + wr * 64 + fr, col0 = u.pn * HALF + wc * 32 + 8 * fq;
#pragma unroll
        for (int ai = 0; ai < 2; ++ai)
#pragma unroll
            for (int m = 0; m < 4; ++m) { const int row = row0 + ai * HALF + m * 16; bf16_t* rowp = H + (size_t)row * ldc + col0;
                const f32x4 g0 = acc[ai][0][m][0], g1 = acc[ai][0][m][1], u0 = acc[ai][1][m][0], u1 = acc[ai][1][m][1];
                u32x4 w; w.x = cvt_pk_bf16(siluf(g0[0]) * u0[0], siluf(g0[1]) * u0[1]); w.y = cvt_pk_bf16(siluf(g0[2]) * u0[2], siluf(g0[3]) * u0[3]);
                w.z = cvt_pk_bf16(siluf(g1[0]) * u1[0], siluf(g1[1]) * u1[1]); w.w = cvt_pk_bf16(siluf(g1[2]) * u1[2], siluf(g1[3]) * u1[3]);
                *(u32x4*)rowp = w; }
    }
};
template <bool ATOMIC> struct EpiResidT {
    static constexpr bool PERM = false, AFTER_DRAIN = false;
    const float* base_lat; const float* base_ctx; float* out_lat; float* out_ctx; const float* gate; float scale;
    __device__ __forceinline__ void operator()(const f32x4 (&acc)[2][2][4][2], const Unit& u, int wr, int wc, int fr_, int fq_) const {
        (void)fr_; (void)fq_; const int ln_ = lane_id(); const int fr = ln_ & 15, fq = ln_ >> 4;
        const int b = u.pm / 33, w = u.pm % 33; const int set = (w == 0) ? 2 : b;
        const size_t toff = (w == 0) ? (size_t)b * 256 * 1024 : ((size_t)b * 8192 + (size_t)(w - 1) * 256) * 1024;
        const float* base = ((w == 0) ? base_ctx : base_lat) + toff; float* out = ((w == 0) ? out_ctx : out_lat) + toff;
        const int frr = fr;
        const int col0 = u.pn * BM + wc * 32 + 4 * fq; const float* gp = gate + set * 9216 + col0;
#pragma unroll
        for (int bj = 0; bj < 2; ++bj)
#pragma unroll
            for (int n = 0; n < 2; ++n) { const f32x4 gv = *(const f32x4*)(gp + bj * HALF + n * 16) * scale;
#pragma unroll
                for (int ai = 0; ai < 2; ++ai) {
#pragma unroll
                    for (int m = 0; m < 4; ++m) { const unsigned off = (unsigned)(ai * HALF + wr * 64 + m * 16 + frr) * 1024u + (unsigned)(col0 + bj * HALF + n * 16);
                        if constexpr (ATOMIC) { float one = 1.0f; asm volatile("" : "+v"(one) :: "memory"); const f32x4 v = (gv * one) * acc[ai][bj][m][n]; __attribute__((address_space(1))) float* ap = (__attribute__((address_space(1))) float*)(out + off); (void)__builtin_amdgcn_global_atomic_fadd_f32(ap, v[0]); (void)__builtin_amdgcn_global_atomic_fadd_f32(ap + 1, v[1]); (void)__builtin_amdgcn_global_atomic_fadd_f32(ap + 2, v[2]); (void)__builtin_amdgcn_global_atomic_fadd_f32(ap + 3, v[3]); asm volatile("" ::: "memory"); }
                        else { const f32x4 bs = *(const f32x4*)(base + off); *(f32x4*)(out + off) = bs + gv * acc[ai][bj][m][n]; } }
                    asm volatile("" ::: "memory"); } }
    }
};
typedef EpiResidT<false> EpiResid;
struct EpiResidA {
    static constexpr bool PERM = false, AFTER_DRAIN = false;
    float* part; const float* gate; float scale;
    __device__ __forceinline__ void operator()(const f32x4 (&acc)[2][2][4][2], const Unit& u, int wr, int wc, int fr_, int fq_) const {
        (void)fr_; (void)fq_; const int ln_ = lane_id(); const int fr = ln_ & 15, fq = ln_ >> 4;
        const int col0 = u.pn * BM + wc * 32 + 4 * fq;
        float* out = part + ((size_t)u.kp * 512 + (u.pm ? 256 : 0)) * 1024 + (unsigned)((wr * 64 + fr) * 1024 + col0);
#pragma unroll
        for (int bj = 0; bj < 2; ++bj)
#pragma unroll
            for (int n = 0; n < 2; ++n) { const f32x4 gv = *(const f32x4*)(gate + col0 + bj * HALF + n * 16) * scale;
#pragma unroll
                for (int ai = 0; ai < 2; ++ai) {
#pragma unroll
                    for (int m = 0; m < 4; ++m) *(f32x4*)(out + (ai * HALF + m * 16) * 1024 + bj * HALF + n * 16) = gv * acc[ai][bj][m][n];
                    asm volatile("" ::: "memory"); } }
    }
};
struct EpiMerge {
    static constexpr bool PERM = true, AFTER_DRAIN = false;
    const bf16_t* Z; bf16_t* Mo;
    __device__ __forceinline__ void operator()(const f32x4 (&acc)[2][2][4][2], const Unit& u, int wr, int wc, int fr_, int fq_) const {
        (void)fr_; (void)fq_; const int ln_ = lane_id(); const int fr = ln_ & 15, fq = ln_ >> 4;
        const int br = u.pn >> 2, ct = u.pn & 3;
        const int row0 = u.pm * BM + wr * 64 + fr, col0 = ct * BM + wc * 32 + 8 * fq;
#pragma unroll
        for (int ai = 0; ai < 2; ++ai)
#pragma unroll
            for (int m = 0; m < 4; ++m) { const int row = row0 + ai * HALF + m * 16; const bf16_t* gp = Z + (size_t)row * 5376 + 2304 + br * 1024 + col0; bf16_t* mp = Mo + (size_t)row * 1024 + col0;
#pragma unroll
                for (int bj = 0; bj < 2; ++bj) { const u32x4 gw = *(const u32x4*)(gp + bj * HALF); const f32x4 a0 = acc[ai][bj][m][0], a1 = acc[ai][bj][m][1];
                    float r0 = sigm(__uint_as_float(gw.x << 16)) * a0[0], r1 = sigm(__uint_as_float(gw.x & 0xffff0000u)) * a0[1], r2 = sigm(__uint_as_float(gw.y << 16)) * a0[2], r3 = sigm(__uint_as_float(gw.y & 0xffff0000u)) * a0[3];
                    float r4 = sigm(__uint_as_float(gw.z << 16)) * a1[0], r5 = sigm(__uint_as_float(gw.z & 0xffff0000u)) * a1[1], r6 = sigm(__uint_as_float(gw.w << 16)) * a1[2], r7 = sigm(__uint_as_float(gw.w & 0xffff0000u)) * a1[3];
                    if (br > 0) { const u32x4 ow = *(const u32x4*)(mp + bj * HALF);
                        r0 += __uint_as_float(ow.x << 16); r1 += __uint_as_float(ow.x & 0xffff0000u); r2 += __uint_as_float(ow.y << 16); r3 += __uint_as_float(ow.y & 0xffff0000u);
                        r4 += __uint_as_float(ow.z << 16); r5 += __uint_as_float(ow.z & 0xffff0000u); r6 += __uint_as_float(ow.w << 16); r7 += __uint_as_float(ow.w & 0xffff0000u); }
                    u32x4 w; w.x = cvt_pk_bf16(r0, r1); w.y = cvt_pk_bf16(r2, r3); w.z = cvt_pk_bf16(r4, r5); w.w = cvt_pk_bf16(r6, r7);
                    *(u32x4*)(mp + bj * HALF) = w; } }
    }
};
struct MergeOrder {
    int G, c, lat;
    __device__ bool next(int i, Unit& u) const { const int grp = (i / 3) * G + c; if (grp >= (lat ? 256 : 264)) return false; int pm = grp >> 2; if (lat) pm = pm + 1 + (pm >= 32); u.pm = pm; u.pn = (grp & 3) + 4 * (i % 3); return true; }
    __device__ __forceinline__ void a_ready(const Unit&) const {}
    __device__ __forceinline__ void done(const Unit&) const {}
    __device__ __forceinline__ size_t aoff(const Unit& u) const { const int br = u.pn >> 2; return (size_t)(br == 0 ? 0 : (br == 1 ? 768 : 1280)) * 2; }
    __device__ __forceinline__ size_t boff(const Unit&) const { return 0; }
};
struct LatOrder {
    StaticOrder so;
    __device__ void init(int N, int G_, int c_) { so.init(64 * BM, N, G_, c_); }
    __device__ bool next(int i, Unit& u) const { if (!so.next(i, u)) return false; u.pm = u.pm + 1 + (u.pm >= 32); return true; }
    __device__ __forceinline__ void a_ready(const Unit&) const {}
    __device__ __forceinline__ void done(const Unit&) const {}
    __device__ __forceinline__ size_t aoff(const Unit&) const { return 0; }
    __device__ __forceinline__ size_t boff(const Unit&) const { return 0; }
};
struct CtxSplit {
    int G, c, KP;
    __device__ bool next(int i, Unit& u) const { const int s = i * G + c; if (s >= 8 * KP) return false; const int t = s / KP; u.pn = t & 3; u.kp = s % KP; u.pm = (t >> 2) * 33; return true; }
    __device__ __forceinline__ void a_ready(const Unit&) const {}
    __device__ __forceinline__ void done(const Unit&) const {}
    __device__ __forceinline__ size_t aoff(const Unit& u) const { return (size_t)u.kp * 512; }
    __device__ __forceinline__ size_t boff(const Unit& u) const { return (size_t)u.kp * 512; }
};
struct OneUnit {
    int pm, pn;
    __device__ bool next(int i, Unit& u) const { if (i) return false; u.pm = pm; u.pn = pn; return true; }
    __device__ __forceinline__ void a_ready(const Unit&) const {}
    __device__ __forceinline__ void done(const Unit&) const {}
    __device__ __forceinline__ size_t aoff(const Unit&) const { return 0; }
    __device__ __forceinline__ size_t boff(const Unit&) const { return 0; }
};
}

#define XB_TMO      128
#define XB_XCNT(j)  (256  + 64 * (j))
#define XB_XSUB(j)  (1280 + 64 * (j))
#define XB_XGEN(j)  (2304 + 64 * (j))
#define XB_TOP      3328
#define XB_TOPGEN   3392
#define XCD_BAR_WORDS 3456
#define XB_SPIN_CAP (1u << 18)

__device__ __forceinline__ unsigned xb_ld(unsigned* p)              { return __hip_atomic_load(p, __ATOMIC_RELAXED, __HIP_MEMORY_SCOPE_AGENT); }
__device__ __forceinline__ unsigned xb_add(unsigned* p, unsigned v) { return __hip_atomic_fetch_add(p, v, __ATOMIC_RELAXED, __HIP_MEMORY_SCOPE_AGENT); }
__device__ __forceinline__ unsigned xb_xcc_id() { return (unsigned)__builtin_amdgcn_s_getreg((3 << 11) | 20) & 0xFu; }
#define XB_SPIN(cond, bar) do { unsigned _sp = 0; while (cond) { __builtin_amdgcn_s_sleep(1); \
    if ((++_sp & 255u) == 0u) { if (xb_ld(&(bar)[XB_TMO])) break; if (_sp > XB_SPIN_CAP) { atomicAdd(&(bar)[XB_TMO], 1u); break; } } } } while (0)

struct XcdBarrier {
    unsigned* bar; unsigned x;
    volatile LAS unsigned* st;
};

__device__ __forceinline__ XcdBarrier xcd_barrier_post(unsigned* bar, volatile LAS unsigned* st) {
    XcdBarrier b; b.bar = bar; b.x = xb_xcc_id(); b.st = st;
    if (my_tid() == 0) (void)xb_add(&bar[XB_XCNT(b.x)], 1u);
    return b;
}
__device__ __forceinline__ void xcd_barrier_complete(unsigned* bar, unsigned x, unsigned& nloc, unsigned& nx) {
    const unsigned G = gridDim.x * gridDim.y * gridDim.z;
    unsigned sum, cnt, mine, sp = 0u;
    for (;;) {
        sum = 0u; cnt = 0u; mine = 0u;
#pragma unroll
        for (unsigned j = 0; j < 16; ++j) { const unsigned c = xb_ld(&bar[XB_XCNT(j)]); sum += c; cnt += (c > 0u) ? 1u : 0u; mine = (j == x) ? c : mine; }
        if (sum == G) break;
        __builtin_amdgcn_s_sleep(1);
        if ((++sp & 255u) == 0u) { if (xb_ld(&bar[XB_TMO])) break; if (sp > XB_SPIN_CAP) { atomicAdd(&bar[XB_TMO], 1u); break; } }
    }
    nloc = mine > 0u ? mine : 1u; nx = cnt > 0u ? cnt : 1u;
}

__device__ __forceinline__ void xcd_barrier(const XcdBarrier& b) {
    asm volatile("s_waitcnt vmcnt(0)" ::: "memory");
    __syncthreads();
    if (my_tid() == 0) {
        unsigned* bar = b.bar;
        __builtin_amdgcn_s_waitcnt(0);
        unsigned nloc = b.st[0], nx = b.st[1];
        if (nloc == 0u) { xcd_barrier_complete(bar, b.x, nloc, nx); b.st[0] = nloc; b.st[1] = nx; }
        const unsigned old = xb_add(&bar[XB_XSUB(b.x)], 1u);
        const unsigned gen = old / nloc;
        if (old + 1u == (gen + 1u) * nloc) {
            __builtin_amdgcn_fence(__ATOMIC_RELEASE, "agent");
            asm volatile("s_waitcnt vmcnt(0)" ::: "memory");
            const unsigned og = xb_add(&bar[XB_TOP], 1u);
            const unsigned tg = og / nx;
            if (og + 1u == (tg + 1u) * nx) xb_add(&bar[XB_TOPGEN], 1u);
            else XB_SPIN(xb_ld(&bar[XB_TOPGEN]) == tg, bar);
            __builtin_amdgcn_fence(__ATOMIC_ACQUIRE, "agent");
            xb_add(&bar[XB_XGEN(b.x)], 1u);
            asm volatile("s_waitcnt vmcnt(0)" ::: "memory");
        } else {
            XB_SPIN(xb_ld(&bar[XB_XGEN(b.x)]) == gen, bar);
            __builtin_amdgcn_fence(__ATOMIC_ACQUIRE, "agent");
            asm volatile("s_waitcnt vmcnt(0)" ::: "memory");
        }
    }
    __syncthreads();
}

struct Frame {
    LAS unsigned char* lds; volatile LAS unsigned* MISC; unsigned* ctl;
    int tid, lane, wave, G, bid;
    const float *x, *c, *ctx, *cctx, *w_ada, *b_ada, *norm_g, *ffn_wi, *ffn_wo, *w_in, *qk_g, *diff_lam, *subln_g, *w_branch, *w_out;
    float* out; unsigned char* ws;
};
#define WSP(T, off) ((T*)(F.ws + (off)))

__device__ __forceinline__ void transpose_item(const float* W, int N, bf16* WT, int ldt, int k0, int n0, int dst_row0, LAS float* scr, int lane) {
#pragma unroll 8
    for (int i = 0; i < 32; ++i) { const int kk = 2 * i + (lane >> 5); scr[kk * 33 + (lane & 31)] = W[(size_t)(k0 + kk) * N + n0 + (lane & 31)]; }
    LDS_WAIT(); asm volatile("" ::: "memory");
    const int c = lane & 7;
#pragma unroll
    for (int j = 0; j < 4; ++j) { const int n = (lane >> 3) + 8 * j; const LAS float* s = scr + (8 * c) * 33 + n;
        v4u o; o.x = pk2(s[0 * 33], s[1 * 33]); o.y = pk2(s[2 * 33], s[3 * 33]); o.z = pk2(s[4 * 33], s[5 * 33]); o.w = pk2(s[6 * 33], s[7 * 33]);
        *(v4u*)(WT + (size_t)(dst_row0 + n) * ldt + k0 + 8 * c) = o; }
    LDS_WAIT(); asm volatile("" ::: "memory");
}
__device__ __forceinline__ void convert_weights(Frame& F, int l) {
    LAS float* scr = (LAS float*)(F.lds + F.wave * 16384);
    const int gw = F.bid * NWAVES + F.wave, NGW = F.G * NWAVES;
    constexpr int I_UP = 16 * 176, I_DN = 44 * 32, I_IN = 16 * 184, I_BR = 8 * 32, I_OUT = 16 * 32;
    constexpr int NITEMS = 2 * I_UP + 2 * I_DN + I_IN + 3 * I_BR + I_OUT;
    const float* wi = F.ffn_wi + (size_t)l * 2 * 1024 * NUP; const float* wo = F.ffn_wo + (size_t)l * 2 * DFF * 1024;
    const float* win = F.w_in + (size_t)l * 1024 * INW; const float* wbr = F.w_branch + (size_t)l * 3 * 512 * 1024; const float* wout = F.w_out + (size_t)l * 1024 * 1024;
    for (int it = gw; it < NITEMS; it += NGW) {
        int r = it;
        if (r < 2 * I_UP) { const int h = r / I_UP; r -= h * I_UP; const int kb = r / 176, nb = r % 176; int n0 = nb * 32; const int isu = n0 >= DFF; const int nn = n0 - isu * DFF;
            transpose_item(wi + (size_t)h * 1024 * NUP, NUP, WSP(bf16, h ? WS_WUP1 : WS_WUP0), 1024, kb * 64, n0, (nn / 128) * 256 + isu * 128 + (nn % 128), scr, F.lane); continue; }
        r -= 2 * I_UP;
        if (r < 2 * I_DN) { const int h = r / I_DN; r -= h * I_DN; const int kb = r / 32, nb = r % 32;
            transpose_item(wo + (size_t)h * DFF * 1024, 1024, WSP(bf16, h ? WS_WDN1 : WS_WDN0), DFF, kb * 64, nb * 32, nb * 32, scr, F.lane); continue; }
        r -= 2 * I_DN;
        if (r < I_IN) { const int kb = r / 184, nb = r % 184; const int n0 = nb * 32;
            if (n0 >= 2304 && n0 < 2816) continue;
            transpose_item(win, INW, WSP(bf16, WS_WIN), 1024, kb * 64, n0, n0 < 2304 ? n0 : n0 - 512, scr, F.lane); continue; }
        r -= I_IN;
        if (r < 3 * I_BR) { const int i = r / I_BR; r -= i * I_BR; const int kb = r / 32, nb = r % 32;
            transpose_item(wbr + (size_t)i * 512 * 1024, 1024, WSP(bf16, WS_WBR), 512, kb * 64, nb * 32, i * 1024 + nb * 32, scr, F.lane); continue; }
        r -= 3 * I_BR;
        { const int kb = r / 32, nb = r % 32; transpose_item(wout, 1024, WSP(bf16, WS_WOUT), 1024, kb * 64, nb * 32, nb * 32, scr, F.lane); }
    }
    {
        const int t = F.bid * 512 + F.tid;
        if (t < 65536) {
            const int jl = t & 63, rest = t >> 6, kc = rest & 127, rj = rest >> 7; const int row = rj * 64 + jl, g = row >> 7, j = row & 127;
            float a[8];
#pragma unroll
            for (int e = 0; e < 8; ++e) a[e] = 0.f;
            const float* wp = win + (size_t)(kc * 8) * INW + 2304 + g * 128;
            for (int c4 = 0; c4 < 32; ++c4) {
                float cs[4];
#pragma unroll
                for (int q = 0; q < 4; ++q) { const int idx = ((c4 * 4 + q) * j) & 127; float sn, co; sincospif((float)idx * (1.0f / 64.0f), &sn, &co); cs[q] = sn + co; }
#pragma unroll
                for (int e = 0; e < 8; ++e) { const f32x4 w = *(const f32x4*)(wp + (size_t)e * INW + c4 * 4); a[e] += w[0] * cs[0] + w[1] * cs[1] + w[2] * cs[2] + w[3] * cs[3]; }
            }
            v4u o; o.x = pk2(a[0], a[1]); o.y = pk2(a[2], a[3]); o.z = pk2(a[4], a[5]); o.w = pk2(a[6], a[7]);
            *(v4u*)(WSP(bf16, WS_WC) + (size_t)row * 1024 + kc * 8) = o;
        }
    }
}
__device__ __forceinline__ void make_cas(Frame& F) {
    const int t0 = F.bid * 512 + F.tid, NT_ = F.G * 512;
    for (int it = t0; it < HQ * HQ / 8; it += NT_) { const int k = it >> 8, n0 = (it & 255) * 8; float v[8];
#pragma unroll
        for (int e = 0; e < 8; ++e) { const int idx = (k * (n0 + e)) & (HQ - 1); float sn, co; sincospif((float)idx * (2.0f / HQ), &sn, &co); v[e] = sn + co; }
        v4u o; o.x = pk2(v[0], v[1]); o.y = pk2(v[2], v[3]); o.z = pk2(v[4], v[5]); o.w = pk2(v[6], v[7]);
        *(v4u*)(WSP(bf16, WS_CAS) + (size_t)k * HQ + n0) = o; }
    for (int it = t0; it < 256 * 256 / 8; it += NT_) { const int k = it >> 5, n0 = (it & 31) * 8; float v[8];
#pragma unroll
        for (int e = 0; e < 8; ++e) { const int idx = (k * (n0 + e)) & 255; float sn, co; sincospif((float)idx * (1.0f / 128.0f), &sn, &co); v[e] = sn + co; }
        v4u o; o.x = pk2(v[0], v[1]); o.y = pk2(v[2], v[3]); o.z = pk2(v[4], v[5]); o.w = pk2(v[6], v[7]);
        *(v4u*)(WSP(bf16, WS_CAS256) + (size_t)k * 256 + n0) = o; }
}
__device__ __forceinline__ void make_mod(Frame& F) {
    LAS float* red = (LAS float*)F.lds;
    for (int item = F.bid; item < 288; item += F.G) {
        const int l = item / 144, cb = item % 144;
        const int c4 = F.lane & 15, ks = F.lane >> 4, slice = F.wave * 4 + ks;
        const float* W = F.w_ada + (size_t)l * 1024 * MODW + cb * 64 + c4 * 4;
        f32x4 a0 = {0.f, 0.f, 0.f, 0.f}, a1 = a0, a2 = a0;
        for (int r = 0; r < 32; ++r) { const int k = slice * 32 + r; const f32x4 w = *(const f32x4*)(W + (size_t)k * MODW);
            const float s0 = siluf(F.c[k]), s1 = siluf(F.c[1024 + k]), s2 = siluf(F.cctx[k]); a0 += w * s0; a1 += w * s1; a2 += w * s2; }
#pragma unroll
        for (int q = 0; q < 4; ++q) { red[(slice * 3 + 0) * 64 + c4 * 4 + q] = a0[q]; red[(slice * 3 + 1) * 64 + c4 * 4 + q] = a1[q]; red[(slice * 3 + 2) * 64 + c4 * 4 + q] = a2[q]; }
        __syncthreads();
        if (F.tid < 192) { const int set = F.tid >> 6, col = F.tid & 63; float s = 0.f;
            for (int sl = 0; sl < 32; ++sl) s += red[(sl * 3 + set) * 64 + col];
            WSP(float, WS_MOD)[((size_t)l * 3 + set) * MODW + cb * 64 + col] = s + F.b_ada[(size_t)l * MODW + cb * 64 + col]; }
        __syncthreads();
    }
}
__device__ __forceinline__ const float* hrow_ptr(const float* lat, const float* ctxp, int row, int& set) {
    const int b = row / RPB, w = row % RPB;
    if (w < CTXL) { set = 2; return ctxp + ((size_t)b * CTXL + w) * 1024; }
    set = b; return lat + ((size_t)b * SEQL + (w - CTXL)) * 1024;
}
__device__ __forceinline__ void norm_mod(Frame& F, const float* lat, const float* ctxp, const float* g, const float* modl  , int ishift, float* copy_ctx, const float* parts, int nparts) {
    const int gw = F.bid * NWAVES + F.wave, NGW = F.G * NWAVES;
    constexpr int NR = 9;
    for (int row0 = gw; row0 < MROWS; row0 += NR * NGW) {
        f32x4 v[NR][4]; int set[NR]; const float* hr[NR]; bool ok[NR]; float ss[NR];
#pragma unroll
        for (int r = 0; r < NR; ++r) { const int row = row0 + r * NGW; ok[r] = row < MROWS; hr[r] = hrow_ptr(lat, ctxp, ok[r] ? row : gw, set[r]);
#pragma unroll
            for (int j = 0; j < 4; ++j) v[r][j] = *((const f32x4*)hr[r] + F.lane + 64 * j); }
#pragma unroll
        for (int r = 0; r < NR; ++r) {
            if (set[r] == 2 && parts != nullptr) { const float* pr = parts + (hr[r] - ctxp);
                for (int p = 0; p < nparts; ++p) {
#pragma unroll
                    for (int j = 0; j < 4; ++j) v[r][j] += *((const f32x4*)(pr + (size_t)p * 512 * 1024) + F.lane + 64 * j); } }
            float s = 0.f;
#pragma unroll
            for (int j = 0; j < 4; ++j) s += (v[r][j][0] * v[r][j][0] + v[r][j][1] * v[r][j][1]) + (v[r][j][2] * v[r][j][2] + v[r][j][3] * v[r][j][3]);
            ss[r] = s; }
#pragma unroll
        for (int o = 1; o < 64; o <<= 1) {
#pragma unroll
            for (int r = 0; r < NR; ++r) ss[r] += shfl_xor(ss[r], o); }
#pragma unroll
        for (int r = 0; r < NR; ++r) if (ok[r]) {
            const int row = row0 + r * NGW;
            const float rstd = 1.0f / sqrtf(ss[r] * (1.0f / 1024.0f) + EPSN);
            const float* sh = modl + (size_t)set[r] * MODW + ishift * 1024; const float* sc = sh + 1024;
            if (copy_ctx != nullptr && set[r] == 2) { f32x4* cp = (f32x4*)(copy_ctx + (hr[r] - ctxp)) + F.lane;
#pragma unroll
                for (int j = 0; j < 4; ++j) cp[64 * j] = v[r][j]; }
            unsigned long long* o8 = (unsigned long long*)(WSP(bf16, WS_HN) + (size_t)row * 1024) + F.lane;
#pragma unroll
            for (int j = 0; j < 4; ++j) { const f32x4 gg = *((const f32x4*)g + F.lane + 64 * j), s1 = *((const f32x4*)sc + F.lane + 64 * j), s0 = *((const f32x4*)sh + F.lane + 64 * j);
                const f32x4 y = v[r][j] * rstd * gg * (s1 + 1.0f) + s0;
                o8[64 * j] = (unsigned long long)pk2(y[0], y[1]) | ((unsigned long long)pk2(y[2], y[3]) << 32); }
        }
    }
}
__device__ __forceinline__ void make_rope(Frame& F) {
    const int t0 = F.bid * 512 + F.tid, NT_ = F.G * 512;
    float* ct = WSP(float, WS_ROPE); float* st = ct + SEQL * 32;
    for (int it = t0; it < SEQL * 32; it += NT_) { const int s = it >> 5, i = it & 31;
        const float inv = exp2f(-(float)(i & 15) * (13.287712379549449f / 16.0f));
        const float pos = (float)((i < 16) ? (s >> 6) : (s & 63)); float sn, cs; sincosf(pos * inv, &sn, &cs); ct[it] = cs; st[it] = sn; }
}
__device__ __forceinline__ void qk_rope(Frame& F, int l) {
    const int gw = F.bid * NWAVES + F.wave, NGW = F.G * NWAVES;
    const float* qg = F.qk_g + (size_t)l * 256;
    const float* ct = WSP(float, WS_ROPE); const float* st = ct + SEQL * 32;
    const int c = F.lane & 3;
    int col[2], gsel[2]; bool isq[2], act[2];
#pragma unroll
    for (int pass = 0; pass < 2; ++pass) { const int q = pass * 64 + F.lane; act[pass] = q < 104; const int hv = act[pass] ? (q >> 2) : 0;
        if (hv < 8) { col[pass] = ZQA + hv * 64; gsel[pass] = 0; isq[pass] = true; } else if (hv < 10) { col[pass] = ZKA + (hv - 8) * 64; gsel[pass] = 1; isq[pass] = false; }
        else if (hv < 18) { col[pass] = ZQB + (hv - 10) * 64; gsel[pass] = 2; isq[pass] = true; } else { col[pass] = ZKB + (hv - 18) * 64; gsel[pass] = 3; isq[pass] = false; } }
    constexpr int NRQ = 5;
    for (int row0 = gw; row0 < MROWS; row0 += NRQ * NGW) {
        v4u lo[NRQ][2], hi[NRQ][2];
#pragma unroll
        for (int rr = 0; rr < NRQ; ++rr) { const int row = row0 + rr * NGW; const bf16* zr = WSP(bf16, WS_Z) + (size_t)(row < MROWS ? row : gw) * ZW;
#pragma unroll
            for (int pass = 0; pass < 2; ++pass) { lo[rr][pass] = *(const v4u*)(zr + col[pass] + 8 * c); hi[rr][pass] = *(const v4u*)(zr + col[pass] + 32 + 8 * c); } }
#pragma unroll
        for (int rr = 0; rr < NRQ; ++rr) { const int row = row0 + rr * NGW; const bool ok = row < MROWS; const int w = (ok ? row : gw) % RPB; bf16* zr = WSP(bf16, WS_Z) + (size_t)(ok ? row : gw) * ZW;
#pragma unroll
            for (int pass = 0; pass < 2; ++pass) {
                const v4u lo_ = lo[rr][pass], hi_ = hi[rr][pass];
                float x1[8], x2[8];
                x1[0] = bflo(lo_.x); x1[1] = bfhi(lo_.x); x1[2] = bflo(lo_.y); x1[3] = bfhi(lo_.y); x1[4] = bflo(lo_.z); x1[5] = bfhi(lo_.z); x1[6] = bflo(lo_.w); x1[7] = bfhi(lo_.w);
                x2[0] = bflo(hi_.x); x2[1] = bfhi(hi_.x); x2[2] = bflo(hi_.y); x2[3] = bfhi(hi_.y); x2[4] = bflo(hi_.z); x2[5] = bfhi(hi_.z); x2[6] = bflo(hi_.w); x2[7] = bfhi(hi_.w);
                float ss = 0.f;
#pragma unroll
                for (int e = 0; e < 8; ++e) ss += x1[e] * x1[e] + x2[e] * x2[e];
                ss += shfl_xor(ss, 1); ss += shfl_xor(ss, 2);
                const float rstd = 1.0f / sqrtf(ss * (1.0f / 64.0f) + EPSN);
                const float sc = isq[pass] ? attn_body::C2 : 1.0f;
                const float* gq = qg + gsel[pass] * 64 + 8 * c;
                const f32x4 ga = *(const f32x4*)(gq), gb = *(const f32x4*)(gq + 4), gc = *(const f32x4*)(gq + 32), gd = *(const f32x4*)(gq + 36);
                f32x4 ca = {1.f, 1.f, 1.f, 1.f}, cb = ca, sa = {0.f, 0.f, 0.f, 0.f}, sb = sa;
                if (w >= CTXL) { const int s = w - CTXL; ca = *(const f32x4*)(ct + s * 32 + 8 * c); cb = *(const f32x4*)(ct + s * 32 + 8 * c + 4); sa = *(const f32x4*)(st + s * 32 + 8 * c); sb = *(const f32x4*)(st + s * 32 + 8 * c + 4); }
                float o1[8], o2[8];
#pragma unroll
                for (int e = 0; e < 8; ++e) { const float g1 = e < 4 ? ga[e & 3] : gb[e & 3], g2 = e < 4 ? gc[e & 3] : gd[e & 3], cs = e < 4 ? ca[e & 3] : cb[e & 3], sn = e < 4 ? sa[e & 3] : sb[e & 3];
                    const float y1 = x1[e] * rstd * g1, y2 = x2[e] * rstd * g2; o1[e] = (y1 * cs - y2 * sn) * sc; o2[e] = (y1 * sn + y2 * cs) * sc; }
                if (act[pass] && ok) { v4u a, b2; a.x = pk2(o1[0], o1[1]); a.y = pk2(o1[2], o1[3]); a.z = pk2(o1[4], o1[5]); a.w = pk2(o1[6], o1[7]);
                    b2.x = pk2(o2[0], o2[1]); b2.y = pk2(o2[2], o2[3]); b2.z = pk2(o2[4], o2[5]); b2.w = pk2(o2[6], o2[7]);
                    *(v4u*)(zr + col[pass] + 8 * c) = a; *(v4u*)(zr + col[pass] + 32 + 8 * c) = b2; }
            }
        }
    }
}
__device__ __forceinline__ void make_pq(Frame& F) {
    const int t0 = F.bid * 512 + F.tid, NT_ = F.G * 512;
    const bf16* T1 = WSP(bf16, WS_T1T); bf16* PQ = WSP(bf16, WS_PQ);
    constexpr int NIT = 2 * 512 * HQ, NU = 4;
    for (int it0 = t0; it0 < NIT; it0 += NU * NT_) {
        float xa[NU][4], xb[NU][4];
#pragma unroll
        for (int u = 0; u < NU; ++u) { const int it = it0 + u * NT_; const int itc = it < NIT ? it : t0;
            const int n = itc & (HQ - 1), col = (itc >> 11) & 511, b = itc >> 20; const bf16* xr = T1 + (size_t)col * MROWS + b * RPB + CTXL; const int m = (HQ - n) & (HQ - 1);
            xa[u][0] = bf2f(xr[n]); xa[u][1] = bf2f(xr[n + HQ]); xa[u][2] = bf2f(xr[m]); xa[u][3] = bf2f(xr[m + HQ]);
            xb[u][0] = bf2f(xr[n + HN]); xb[u][1] = bf2f(xr[n + HQ + HN]); xb[u][2] = bf2f(xr[m + HN]); xb[u][3] = bf2f(xr[m + HQ + HN]); }
#pragma unroll
        for (int u = 0; u < NU; ++u) { const int it = it0 + u * NT_; if (it < NIT) {
            const int n = it & (HQ - 1), col = (it >> 11) & 511, b = it >> 20; const int m = (HQ - n) & (HQ - 1);
            const int idx[4] = {n, n + HQ, m, m + HQ};
            float P[4], d[4], cs[4], sn[4], Q[4];
#pragma unroll
            for (int k = 0; k < 4; ++k) { P[k] = xa[u][k] + xb[u][k]; d[k] = xa[u][k] - xb[u][k]; sincospif((float)idx[k] * (1.0f / HN), &sn[k], &cs[k]); }
#pragma unroll
            for (int k = 0; k < 4; ++k) { const int mk = (n == 0) ? k : 3 - k; Q[k] = d[k] * cs[k] + ((mk == 0) ? d[0] * sn[0] : (mk == 1) ? d[1] * sn[1] : (mk == 2) ? d[2] * sn[2] : d[3] * sn[3]); }
            float s2n, c2n, s2m, c2m; sincospif((float)n * (1.0f / HQ), &s2n, &c2n); sincospif((float)m * (1.0f / HQ), &s2m, &c2m);
            const float pp = P[0] + P[1], pq = (P[0] - P[1]) * c2n + (P[2] - P[3]) * s2m;
            const float qp = Q[0] + Q[1], qq = (Q[0] - Q[1]) * c2n + (Q[2] - Q[3]) * s2m;
            bf16* o = PQ + ((size_t)(b * 4) * 512 + col) * HQ + n;
            o[0] = (bf16)(pk2(pp, 0.f) & 0xffffu); o[(size_t)512 * HQ] = (bf16)(pk2(pq, 0.f) & 0xffffu);
            o[(size_t)2 * 512 * HQ] = (bf16)(pk2(qp, 0.f) & 0xffffu); o[(size_t)3 * 512 * HQ] = (bf16)(pk2(qq, 0.f) & 0xffffu); } }
    }
}
__device__ __forceinline__ void post_mix(Frame& F, int l) {
    const int gw = F.bid * NWAVES + F.wave, NGW = F.G * NWAVES;
    const float lam_init = 0.8f - 0.6f * expf(-0.3f * (float)l);
    const float* dl = F.diff_lam + (size_t)l * 256;
    const float s1 = wave_sum(dl[F.lane] * dl[64 + F.lane]), s2 = wave_sum(dl[128 + F.lane] * dl[192 + F.lane]);
    const float lam = expf(s1) - expf(s2) + lam_init;
    const float* sg = F.subln_g + (size_t)l * 128 + (F.lane & 15) * 8;
    float gsc[8];
#pragma unroll
    for (int e = 0; e < 8; ++e) gsc[e] = sg[e] * (1.0f - lam_init);
    const bf16* OB = WSP(bf16, WS_HN); const bf16* T2 = WSP(bf16, WS_T2); const bf16* T2B = WSP(bf16, WS_T2B); bf16* Z = WSP(bf16, WS_Z);
    const int g = F.lane >> 4, j0 = (F.lane & 15) * 8;
    constexpr int NRP = 4;
    for (int row0 = gw; row0 < MROWS; row0 += NRP * NGW) {
        v4u a[NRP], c2[NRP], mv[NRP], mv2[NRP]; unsigned short rk1[NRP][8], rk2[NRP][8]; bool lat[NRP], ok[NRP]; float sc[NRP];
#pragma unroll
        for (int rr = 0; rr < NRP; ++rr) { const int rw = row0 + rr * NGW; ok[rr] = rw < MROWS; const int row = ok[rr] ? rw : gw; const int b = row / RPB, w = row % RPB;
            a[rr] = *(const v4u*)(OB + (size_t)row * 1024 + F.lane * 8); c2[rr] = *(const v4u*)(OB + (size_t)row * 1024 + 512 + F.lane * 8);
            int mrow; lat[rr] = w >= CTXL;
            if (!lat[rr]) { mrow = b * RPB + ((CTXL - w) & (CTXL - 1)); sc[rr] = 0.5f * 0.005524271728019903f; }
            else { const int s = w - CTXL; mrow = b * RPB + CTXL + ((SEQL - s) & (SEQL - 1)); sc[rr] = 1.0f / 2048.0f; }
            const bf16* rk = T2 + (size_t)row * 512 + g * 128; mv[rr] = *(const v4u*)(T2 + (size_t)mrow * 512 + g * 128 + j0);
            const bf16* rkb = (lat[rr] ? T2B : T2) + (size_t)row * 512 + g * 128; mv2[rr] = *(const v4u*)((lat[rr] ? T2B : T2) + (size_t)mrow * 512 + g * 128 + j0);
#pragma unroll
            for (int e = 0; e < 8; ++e) { rk1[rr][e] = rk[(128 - (j0 + e)) & 127]; rk2[rr][e] = rkb[(128 - (j0 + e)) & 127]; } }
#pragma unroll
        for (int rr = 0; rr < NRP; ++rr) if (ok[rr]) { const int row = row0 + rr * NGW;
            {
                const v4u a_ = a[rr], c_ = c2[rr];
                float d[8];
                d[0] = bflo(a_.x) - lam * bflo(c_.x); d[1] = bfhi(a_.x) - lam * bfhi(c_.x); d[2] = bflo(a_.y) - lam * bflo(c_.y); d[3] = bfhi(a_.y) - lam * bfhi(c_.y);
                d[4] = bflo(a_.z) - lam * bflo(c_.z); d[5] = bfhi(a_.z) - lam * bfhi(c_.z); d[6] = bflo(a_.w) - lam * bflo(c_.w); d[7] = bfhi(a_.w) - lam * bfhi(c_.w);
                float ss = 0.f;
#pragma unroll
                for (int e = 0; e < 8; ++e) ss += d[e] * d[e];
#pragma unroll
                for (int o = 1; o < 16; o <<= 1) ss += shfl_xor(ss, o);
                const float rstd = 1.0f / sqrtf(ss * (1.0f / 128.0f) + EPSN);
                v4u o; o.x = pk2(d[0] * rstd * gsc[0], d[1] * rstd * gsc[1]); o.y = pk2(d[2] * rstd * gsc[2], d[3] * rstd * gsc[3]);
                o.z = pk2(d[4] * rstd * gsc[4], d[5] * rstd * gsc[5]); o.w = pk2(d[6] * rstd * gsc[6], d[7] * rstd * gsc[7]);
                *(v4u*)(Z + (size_t)row * ZW + ZQB + F.lane * 8) = o;
            }
            {
                float r[8], mm_[8]; const v4u m1 = mv[rr], m2 = mv2[rr]; const float f2 = lat[rr] ? 1.0f : 0.0f;
#pragma unroll
                for (int e = 0; e < 8; ++e) r[e] = bf2f(rk1[rr][e]) + f2 * bf2f(rk2[rr][e]);
                mm_[0] = bflo(m1.x) + f2 * bflo(m2.x); mm_[1] = bfhi(m1.x) + f2 * bfhi(m2.x); mm_[2] = bflo(m1.y) + f2 * bflo(m2.y); mm_[3] = bfhi(m1.y) + f2 * bfhi(m2.y);
                mm_[4] = bflo(m1.z) + f2 * bflo(m2.z); mm_[5] = bfhi(m1.z) + f2 * bfhi(m2.z); mm_[6] = bflo(m1.w) + f2 * bflo(m2.w); mm_[7] = bfhi(m1.w) + f2 * bfhi(m2.w);
                const float s_ = sc[rr];
                v4u o; o.x = pk2((r[0] + mm_[0]) * s_, (r[1] + mm_[1]) * s_); o.y = pk2((r[2] + mm_[2]) * s_, (r[3] + mm_[3]) * s_);
                o.z = pk2((r[4] + mm_[4]) * s_, (r[5] + mm_[5]) * s_); o.w = pk2((r[6] + mm_[6]) * s_, (r[7] + mm_[7]) * s_);
                *(v4u*)(Z + (size_t)row * ZW + ZKB + F.lane * 8) = o;
            }
        }
    }
}
__device__ __forceinline__ void hartley_ctx(Frame& F) {
    for (int r = F.bid; r < 4; r += F.G) { const int b = r >> 1;
        pg8::Gemm g{WSP(bf16, WS_CAS256), WSP(bf16, WS_T1T) + (size_t)b * RPB, 256, 512, 256, 256, MROWS};
        pg8::OneUnit S{0, r & 1};
        pg8::EpiStore E{WSP(bf16, WS_T2), 512, 1 << 30, b * RPB, 1};
        pg8::gemm_phase<pg8::EpiStore, pg8::OneUnit, true, true, 256, 256, MROWS>(F.lds, g, S, E); }
}
__device__ __forceinline__ void mixer_phase(Frame& F, int l) {
    constexpr int QL = 64 + 64 + 32, QC = 4;
    const int qlen = (l == NLAYER - 1) ? QL : QL + QC;
    bf16* Z = WSP(bf16, WS_Z);
    const int myx = (int)(xb_xcc_id() & 7u);
    int dq = 0;
    for (;;) {
        if (F.tid == 0) { int it = -1, x = 0, d = dq;
            for (; d < 8; ++d) { x = (myx + d) & 7; const unsigned v = __hip_atomic_fetch_add(F.ctl + CW_Q + (l * 8 + x) * 64, 1u, __ATOMIC_RELAXED, __HIP_MEMORY_SCOPE_AGENT); if ((int)v < qlen) { it = (int)v; break; } }
            F.MISC[0] = (unsigned)it; F.MISC[1] = (unsigned)x; F.MISC[2] = (unsigned)d; }
        __syncthreads();
        const int it = (int)F.MISC[0], x = (int)F.MISC[1]; dq = (int)F.MISC[2];
        __syncthreads();
        if (it < 0) break;
        if (it >= 128 && it < QL) {
            int r = x * 32 + (it - 128); const int kh = r & 1; r >>= 1; const int b = r >> 6, kind = (r >> 4) & 3, r2 = r & 15;
            pg8::Gemm g{WSP(bf16, WS_CAS) + kh * (HQ / 2), WSP(bf16, WS_PQ) + (size_t)(b * 4 + kind) * 512 * HQ + kh * (HQ / 2), HQ, 512, HQ / 2, HQ, HQ};
            pg8::OneUnit S{r2 >> 1, r2 & 1};
            pg8::EpiStore E{WSP(bf16, kh ? WS_T2B : WS_T2), 512, 1 << 30, b * RPB + CTXL + ((kind & 1) << 1) + (kind >> 1), 4};
            pg8::gemm_phase<pg8::EpiStore, pg8::OneUnit, true, true, HQ / 2, HQ, HQ>(F.lds, g, S, E);
        } else {
            int b, j, qrow, nt; bool big;
            if (it < 128) { big = it < 64; b = (it >> 5) & 1; j = x; qrow = b * RPB + CTXL + (it & 31) * 256; nt = RPB / 64; }
            else { const int r = x * 4 + (it - QL); big = r < 16; j = r & 7; b = (r >> 3) & 1; qrow = b * RPB; nt = CTXL / 64; }
            const size_t kv0 = (size_t)b * RPB;
            if (big) { const int h = j >> 1, mm = j & 1;
                const bf16* Qp = Z + ZQB + (h * 2 + mm) * 64; const bf16* Kp = Z + ZKB + (h * 2 + mm) * 64; const bf16* Vp = Z + ZVB + h * 128; bf16* Op = WSP(bf16, WS_HN) + mm * 512 + h * 128;
                attn_body::attn_unit128<8>((const attn_body::bf16*)(Qp + (size_t)qrow * ZW), ZW, (const attn_body::bf16*)(Kp + kv0 * ZW), ZW, (const attn_body::bf16*)(Vp + kv0 * ZW), ZW,
                                           (attn_body::bf16*)(Op + (size_t)qrow * 1024), 1024, nt, (char*)F.lds);
            } else {
                const bf16* Qp = Z + ZQA + j * 64; const bf16* Kp = Z + ZKA + (j >> 2) * 64; const bf16* Vp = Z + ZVA + (j >> 2) * 64; bf16* Op = Z + ZQA + j * 64;
                attn_body::attn_unit<8>((const attn_body::bf16*)(Qp + (size_t)qrow * ZW), ZW, (const attn_body::bf16*)(Kp + kv0 * ZW), ZW, (const attn_body::bf16*)(Vp + kv0 * ZW), ZW,
                                        (attn_body::bf16*)(Op + (size_t)qrow * ZW), ZW, nt, (char*)F.lds);
            }
        }
    }
}

#ifndef MK_PER_PHASE
#define MK_PER_PHASE 0
#endif
constexpr int NPHASE = 1 + 13 * NLAYER;
struct Args { const float* in[15]; float* out; unsigned char* ws; int ph_lo, ph_hi; };
__device__ __forceinline__ void load_frame(Frame& F) {
    const __attribute__((address_space(4))) Args* a = (const __attribute__((address_space(4))) Args*)__builtin_amdgcn_kernarg_segment_ptr();
    asm volatile("" : "+s"(a));
    extern __shared__ __attribute__((aligned(16))) unsigned char lds_raw[];
    F.lds = (LAS unsigned char*)lds_raw; F.MISC = (volatile LAS unsigned*)(F.lds + MISC_OFF);
    int t = my_tid(); asm volatile("" : "+v"(t));
    F.tid = t; F.lane = t & 63; F.wave = __builtin_amdgcn_readfirstlane(t >> 6); F.G = gridDim.x; F.bid = blockIdx.x;
    F.x = a->in[0]; F.c = a->in[1]; F.ctx = a->in[2]; F.cctx = a->in[3]; F.w_ada = a->in[4]; F.b_ada = a->in[5]; F.norm_g = a->in[6]; F.ffn_wi = a->in[7];
    F.ffn_wo = a->in[8]; F.w_in = a->in[9]; F.qk_g = a->in[10]; F.diff_lam = a->in[11]; F.subln_g = a->in[12]; F.w_branch = a->in[13]; F.w_out = a->in[14];
    F.out = a->out; F.ws = a->ws; F.ctl = (unsigned*)(a->ws + WS_CTL);
}
#ifndef MK_MASK
#define MK_MASK 0xffffffffu
#endif
#define EN(j) (((MK_MASK) >> (j)) & 1u)
#ifndef MK_DUP
#define MK_DUP 0
#endif
#define DUP(b) for (int rep_ = 0; rep_ < (((MK_DUP) >> (b)) & 1) + 1; ++rep_)
__device__ __forceinline__ void seam_barrier() {
    const __attribute__((address_space(4))) Args* a = (const __attribute__((address_space(4))) Args*)__builtin_amdgcn_kernarg_segment_ptr();
    asm volatile("" : "+s"(a));
    extern __shared__ __attribute__((aligned(16))) unsigned char lds_raw[];
    XcdBarrier b; b.bar = (unsigned*)(a->ws + WS_CTL) + CW_BAR; b.x = xb_xcc_id(); b.st = (volatile LAS unsigned*)((LAS unsigned char*)lds_raw + MISC_OFF) + 8;
    xcd_barrier(b);
}
#define LF() Frame F; load_frame(F); float* hlat = F.out; float* hctx = WSP(float, WS_HC); const float* modl = WSP(float, WS_MOD) + (size_t)l * 3 * MODW; const float* ng = F.norm_g + (size_t)l * 3 * 1024; \
    const float* slat = (l == 0) ? F.x : hlat; const float* sctx = (l == 0) ? F.ctx : hctx; (void)hlat; (void)hctx; (void)modl; (void)ng; (void)slat; (void)sctx
__global__ void __launch_bounds__(NWAVES * 64, 2) mk_fwd(Args args) {
    cg::grid_group grid = cg::this_grid();
    const int lo = args.ph_lo, hi = args.ph_hi;
    {
        extern __shared__ __attribute__((aligned(16))) unsigned char lds_raw[];
        volatile LAS unsigned* misc = (volatile LAS unsigned*)((LAS unsigned char*)lds_raw + MISC_OFF);
        const int t0 = threadIdx.x;
        if (t0 < 32) misc[t0] = 0u;
        if ((t0 & 63) == 0) ((volatile LAS int*)((LAS unsigned char*)lds_raw + WTAB_OFF))[hw_slot()] = t0 >> 6;
        __syncthreads();
        if (hi - lo > 1) (void)xcd_barrier_post((unsigned*)(args.ws + WS_CTL) + CW_BAR, misc + 8);
    }
#define IN(k) (lo <= (k) && (k) < hi)
    if (lo < 0) grid.sync();
#ifndef MK_TMASK
#define MK_TMASK 0
#endif
#define TSTAMP(kind) do { if (MK_TMASK) { if (blockIdx.x == 0 && my_tid() == 0) { extern __shared__ __attribute__((aligned(16))) unsigned char lds_raw[]; volatile LAS unsigned* tm = (volatile LAS unsigned*)((LAS unsigned char*)lds_raw + MISC_OFF) + 16; \
        const unsigned now = (unsigned)__builtin_amdgcn_s_memrealtime(); if (((MK_TMASK) >> (kind)) & 1) tm[1] += now - tm[0]; tm[0] = now; } } } while (0)
#define SEAM(k) do { if (IN(k) && IN((k) + 1)) { seam_barrier(); } } while (0)
    TSTAMP(31);
    if (EN(0) && IN(0)) { const int l = 0; LF(); DUP(4) { make_mod(F); convert_weights(F, 0); make_cas(F); make_rope(F); } }
    SEAM(0); TSTAMP(0);
    for (int l = 0; l < NLAYER; ++l) {
        const int p0 = 1 + 13 * l;
        if (EN(1) && IN(p0 + 0)) { LF(); if (l > 0) DUP(4) convert_weights(F, l); norm_mod(F, slat, sctx, ng, modl, 0, hctx, (l == 0) ? nullptr : WSP(float, WS_PART), DFF / 256); }
        SEAM(p0 + 0); TSTAMP(1);
        if (EN(2) && IN(p0 + 1)) { LF(); pg8::Gemm g{WSP(bf16, WS_HN), WSP(bf16, WS_WUP0), MROWS, NUP, 1024, 1024, 1024}; pg8::StaticOrder S; S.init(MROWS, NUP, F.G, F.bid);
            pg8::EpiSwiGLU E{WSP(bf16, WS_Z), DFF}; DUP(1) pg8::gemm_phase<pg8::EpiSwiGLU, pg8::StaticOrder, true, true, 1024, 1024, 1024>(F.lds, g, S, E); }
        SEAM(p0 + 1); TSTAMP(2);
        if (EN(3) && IN(p0 + 2)) { LF();
            { pg8::Gemm g{WSP(bf16, WS_Z), WSP(bf16, WS_WDN0), MROWS, 1024, DFF, DFF, DFF}; pg8::LatOrder S; S.init(1024, F.G, F.bid);
              pg8::EpiResid E{slat, sctx, hlat, hctx, modl + 2 * 1024, 0.5f}; for (int rep_ = 0; rep_ < ((((MK_DUP) >> 7) & 1) && l == 0 ? 4 : 1); ++rep_) pg8::gemm_phase<pg8::EpiResid, pg8::LatOrder, true, true, DFF, DFF, DFF>(F.lds, g, S, E); }
            { pg8::Gemm g{WSP(bf16, WS_Z), WSP(bf16, WS_WDN0), MROWS, 1024, 256, DFF, DFF}; pg8::CtxSplit S{F.G, F.G - 1 - F.bid, DFF / 256};
              pg8::EpiResidA E{WSP(float, WS_PART), modl + 2 * MODW + 2 * 1024, 0.5f}; pg8::gemm_phase<pg8::EpiResidA, pg8::CtxSplit, true, true, 256, DFF, DFF>(F.lds, g, S, E); } }
        SEAM(p0 + 2); TSTAMP(3);
        if (EN(4) && IN(p0 + 3)) { LF(); norm_mod(F, hlat, hctx, ng + 1024, modl, 3, hctx, WSP(float, WS_PART), DFF / 256); }
        SEAM(p0 + 3); TSTAMP(4);
        if (EN(5) && IN(p0 + 4)) { LF();
            { pg8::Gemm g{WSP(bf16, WS_HN), WSP(bf16, WS_WIN), MROWS, ZW, 1024, 1024, 1024}; pg8::StaticOrder S; S.init(MROWS, ZW, F.G, F.bid);
              pg8::EpiStore E{WSP(bf16, WS_Z), ZW, 1 << 30, 0, 1}; DUP(5) pg8::gemm_phase<pg8::EpiStore, pg8::StaticOrder, true, true, 1024, 1024, 1024>(F.lds, g, S, E); }
            { pg8::Gemm g{WSP(bf16, WS_WC), WSP(bf16, WS_HN), 512, MROWS, 1024, 1024, 1024}; pg8::StaticOrder S; S.init(512, MROWS, F.G, F.G - 1 - F.bid);
              pg8::EpiStore E{WSP(bf16, WS_T1T), MROWS, 1 << 30, 0, 1}; DUP(5) pg8::gemm_phase<pg8::EpiStore, pg8::StaticOrder, true, true, 1024, 1024, 1024>(F.lds, g, S, E); }
        }
        SEAM(p0 + 4); TSTAMP(5);
        if (EN(6) && IN(p0 + 5)) { LF(); qk_rope(F, l); make_pq(F); if (l < NLAYER - 1) hartley_ctx(F); }
        SEAM(p0 + 5); TSTAMP(6);
        if (EN(7) && IN(p0 + 6)) { LF(); mixer_phase(F, l); }
        SEAM(p0 + 6); TSTAMP(7);
        if (EN(8) && IN(p0 + 7)) { LF(); post_mix(F, l); }
        SEAM(p0 + 7); TSTAMP(8);
        if (EN(9) && IN(p0 + 8)) { LF(); pg8::Gemm g{WSP(bf16, WS_Z), WSP(bf16, WS_WBR), MROWS, 3072, 512, ZW, 512}; pg8::MergeOrder S{F.G, F.bid, l == NLAYER - 1};
            pg8::EpiMerge E{WSP(bf16, WS_Z), WSP(bf16, WS_HN)}; DUP(6) pg8::gemm_phase<pg8::EpiMerge, pg8::MergeOrder, true, true, 512, ZW, 512>(F.lds, g, S, E); }
        SEAM(p0 + 8); TSTAMP(9);
        if (EN(10) && IN(p0 + 9)) { LF();
            { pg8::Gemm g{WSP(bf16, WS_HN), WSP(bf16, WS_WOUT), MROWS, 1024, 1024, 1024, 1024}; pg8::LatOrder S; S.init(1024, F.G, F.bid);
              pg8::EpiResid E{hlat, hctx, hlat, hctx, modl + 5 * 1024, 1.0f}; pg8::gemm_phase<pg8::EpiResid, pg8::LatOrder, true, true, 1024, 1024, 1024>(F.lds, g, S, E); }
            if (l < NLAYER - 1) { pg8::Gemm g{WSP(bf16, WS_HN), WSP(bf16, WS_WOUT), MROWS, 1024, 256, 1024, 1024}; pg8::CtxSplit S{F.G, F.G - 1 - F.bid, 4};
              pg8::EpiResidA E{WSP(float, WS_PART), modl + 2 * MODW + 5 * 1024, 1.0f}; pg8::gemm_phase<pg8::EpiResidA, pg8::CtxSplit, true, true, 256, 1024, 1024>(F.lds, g, S, E); } }
        SEAM(p0 + 9); TSTAMP(10);
        if (EN(11) && IN(p0 + 10)) { LF(); norm_mod(F, hlat, hctx, ng + 2048, modl, 6, (l == 0) ? hctx : nullptr, (l == 0) ? WSP(float, WS_PART) : nullptr, 4); }
        SEAM(p0 + 10); TSTAMP(11);
        if (EN(12) && IN(p0 + 11)) { LF(); pg8::Gemm g{WSP(bf16, WS_HN), WSP(bf16, WS_WUP1), MROWS, NUP, 1024, 1024, 1024}; pg8::StaticOrder S; S.init(MROWS, NUP, F.G, F.bid);
            pg8::EpiSwiGLU E{WSP(bf16, WS_Z), DFF}; DUP(1) pg8::gemm_phase<pg8::EpiSwiGLU, pg8::StaticOrder, true, true, 1024, 1024, 1024>(F.lds, g, S, E); }
        SEAM(p0 + 11); TSTAMP(12);
        if (EN(13) && IN(p0 + 12)) { LF();
            { pg8::Gemm g{WSP(bf16, WS_Z), WSP(bf16, WS_WDN1), MROWS, 1024, DFF, DFF, DFF}; pg8::LatOrder S; S.init(1024, F.G, F.bid);
              pg8::EpiResid E{hlat, hctx, hlat, hctx, modl + 8 * 1024, 0.5f}; pg8::gemm_phase<pg8::EpiResid, pg8::LatOrder, true, true, DFF, DFF, DFF>(F.lds, g, S, E); }
            if (l < NLAYER - 1) { pg8::Gemm g{WSP(bf16, WS_Z), WSP(bf16, WS_WDN1), MROWS, 1024, 256, DFF, DFF}; pg8::CtxSplit S{F.G, F.G - 1 - F.bid, DFF / 256};
              pg8::EpiResidA E{WSP(float, WS_PART), modl + 2 * MODW + 8 * 1024, 0.5f}; pg8::gemm_phase<pg8::EpiResidA, pg8::CtxSplit, true, true, 256, DFF, DFF>(F.lds, g, S, E); } }
        SEAM(p0 + 12); TSTAMP(13);
    }
    if (MK_TMASK) { if (blockIdx.x == 0) { if (my_tid() == 0) { extern __shared__ __attribute__((aligned(16))) unsigned char lds_raw[]; volatile LAS unsigned* tm = (volatile LAS unsigned*)((LAS unsigned char*)lds_raw + MISC_OFF) + 16;
            const unsigned t0 = (unsigned)__builtin_amdgcn_s_memrealtime(), want = tm[1]; while ((unsigned)__builtin_amdgcn_s_memrealtime() - t0 < want) __builtin_amdgcn_s_sleep(16); }
        __syncthreads(); } }
#undef IN
#undef SEAM
}

extern "C" void kernel_launch(void* const* d_in, const int* in_sizes, int n_in, void* d_out, int out_size, void* d_ws, size_t ws_size, hipStream_t stream) {
    static int grid = 0;
    if (grid == 0) {
        if (n_in != 15 || ws_size < WS_END) { fprintf(stderr, "kernel_launch: need 15 inputs and >= %zu bytes of workspace; got n_in %d, ws %zu\n", (size_t)WS_END, n_in, ws_size); grid = -1; return; }
        int dev = 0, cus = 0, per_cu = 0;
        if (hipGetDevice(&dev) != hipSuccess || hipDeviceGetAttribute(&cus, hipDeviceAttributeMultiprocessorCount, dev) != hipSuccess) { grid = -1; return; }
        if (hipFuncSetAttribute((const void*)mk_fwd, hipFuncAttributeMaxDynamicSharedMemorySize, LDS_BYTES) != hipSuccess) { fprintf(stderr, "kernel_launch: hipFuncSetAttribute failed\n"); grid = -1; return; }
        if (hipOccupancyMaxActiveBlocksPerMultiprocessor(&per_cu, (const void*)mk_fwd, NWAVES * 64, LDS_BYTES) != hipSuccess || per_cu < 1) { fprintf(stderr, "kernel_launch: occupancy query says %d\n", per_cu); per_cu = 1; }
        (void)hipGetLastError();
        grid = cus * per_cu;
    }
    if (grid < 0) return;
    (void)hipMemsetAsync((char*)d_ws + WS_CTL, 0, CTL_ZERO_BYTES, stream);
    Args a{};
    for (int i = 0; i < 15; ++i) a.in[i] = (const float*)d_in[i];
    a.out = (float*)d_out; a.ws = (unsigned char*)d_ws;
#if MK_PER_PHASE
    for (int p = 0; p < NPHASE; ++p) { a.ph_lo = p; a.ph_hi = p + 1; hipLaunchKernelGGL(mk_fwd, dim3(grid), dim3(NWAVES * 64), LDS_BYTES, stream, a); }
#else
    a.ph_lo = 0; a.ph_hi = NPHASE;
    void* kargs[] = {&a};
    hipError_t e = hipLaunchCooperativeKernel((const void*)mk_fwd, dim3(grid), dim3(NWAVES * 64), kargs, LDS_BYTES, stream);
    if (e != hipSuccess) fprintf(stderr, "kernel_launch: cooperative launch failed: %s (grid %d)\n", hipGetErrorString(e), grid);
#endif
}
```
